# Optimizing an MI355X kernel written in HIP

```python
import jax
import jax.numpy as jnp
from jax import lax
import numpy as np

D_MODEL = 1024
BATCH = 8
SEQ = 2048
DEPTH = 2

GRID_W = 64
CTX_LEN = 256

N_MLSTM_HEADS = 4
MLSTM_WIDTH = D_MODEL // 2
MLSTM_HEAD_DIM = MLSTM_WIDTH // N_MLSTM_HEADS
N_ROW_HEADS = N_MLSTM_HEADS // 2
MLSTM_CHUNK = 64
CONV_CH = D_MODEL // 4
CONV_K = 31
FOURIER_CH = D_MODEL // 4
N_FOURIER_GROUPS = 4
FOURIER_GROUP_CH = FOURIER_CH // N_FOURIER_GROUPS
MIX_WIDTH = MLSTM_WIDTH + CONV_CH + FOURIER_CH
N_GATES = 4
QKVG_COLS = 3 * MLSTM_WIDTH + N_GATES * N_MLSTM_HEADS
IN_COLS = QKVG_COLS + MLSTM_WIDTH + 2 * CONV_CH + FOURIER_CH
N_EXPERTS = 16
EC_CAPACITY_FACTOR = 2
EXPERT_HIDDEN = D_MODEL
N_ADA = 6
EPS = 1e-6

kernel_name = 'hybrid_mlstm_conv_fourier_ecmoe_dit'


def _rms(x, gain):
    xf = x.astype(jnp.float32)
    return xf * lax.rsqrt(jnp.mean(xf * xf, axis=-1, keepdims=True) + EPS) * gain.astype(jnp.float32)


def modulated_rmsnorm(x, gain, shift, scale):
    y = _rms(x, gain) * (1.0 + scale.astype(jnp.float32)) + shift.astype(jnp.float32)
    return y.astype(x.dtype)


def layernorm(x, gain, bias):
    xf = x.astype(jnp.float32)
    mu = jnp.mean(xf, axis=-1, keepdims=True)
    var = jnp.mean(jnp.square(xf - mu), axis=-1, keepdims=True)
    y = (xf - mu) * lax.rsqrt(var + EPS) * gain.astype(jnp.float32) + bias.astype(jnp.float32)
    return y.astype(x.dtype)


def _raster_to_colmajor(a, rows):
    b, h, t, f = a.shape
    return a.reshape(b, h, rows, GRID_W, f).swapaxes(2, 3).reshape(b, h, t, f)


def _colmajor_to_raster(a, rows):
    b, h, t, f = a.shape
    return a.reshape(b, h, GRID_W, rows, f).swapaxes(2, 3).reshape(b, h, t, f)


def _to_chunks(a):
    b, h, t = a.shape[:3]
    a = a.reshape((b, h, t // MLSTM_CHUNK, MLSTM_CHUNK) + a.shape[3:])
    return jnp.moveaxis(a, 2, 0)


def _from_chunks(a):
    a = jnp.moveaxis(a, 0, 2)
    return a.reshape((a.shape[0], a.shape[1], -1) + a.shape[4:])


def _chunk_outputs(q, k, v, i_pre, b, c_st, n_st, m_st):
    L = q.shape[-2]
    lower = jnp.tril(jnp.ones((L, L), dtype=bool))
    dlog = jnp.where(lower, b[..., :, None] - b[..., None, :] + i_pre[..., None, :], -jnp.inf)
    inter = b + m_st[..., None]
    m_t = jnp.maximum(inter, jnp.max(dlog, axis=-1))
    s = jnp.einsum('...td,...sd->...ts', q, k) * jnp.exp(dlog - m_t[..., None])
    w_inter = jnp.exp(inter - m_t)
    num = w_inter[..., None] * jnp.einsum('...ed,...td->...te', c_st, q) + jnp.einsum('...ts,...se->...te', s, v)
    den = w_inter * jnp.einsum('...td,...d->...t', q, n_st) + jnp.sum(s, axis=-1)
    return num / jnp.maximum(jnp.abs(den), jnp.exp(-m_t))[..., None]


def mlstm_direction(q, k, v, i_pre, log_f, state0, with_outputs):
    qc, kc, vc, ic = (_to_chunks(a) for a in (q, k, v, i_pre))
    bc = jnp.cumsum(_to_chunks(log_f), axis=-1)

    def step(state, inp):
        c_st, n_st, m_st = state
        kx, vx, ix, bx = inp
        b_last = bx[..., -1]
        wlog = b_last[..., None] - bx + ix
        m_new = jnp.maximum(b_last + m_st, jnp.max(wlog, axis=-1))
        decay = jnp.exp(b_last + m_st - m_new)
        w = jnp.exp(wlog - m_new[..., None])
        c_new = decay[..., None, None] * c_st + jnp.einsum('bhs,bhse,bhsd->bhed', w, vx, kx)
        n_new = decay[..., None] * n_st + jnp.einsum('bhs,bhsd->bhd', w, kx)
        return (c_new, n_new, m_new), (state if with_outputs else None)

    final, starts = lax.scan(step, state0, (kc, vc, ic, bc))
    if not with_outputs:
        return None, final
    h = _chunk_outputs(qc, kc, vc, ic, bc, *starts)
    return _from_chunks(h), final


def mlstm_bidir(q, k, v, gates, init_fwd, init_bwd, with_outputs):
    flip = lambda a: jnp.flip(a, axis=2)
    h_f, st_f = mlstm_direction(q, k, v, gates[..., 0], jax.nn.log_sigmoid(gates[..., 1]), init_fwd, with_outputs)
    h_b, st_b = mlstm_direction(flip(q), flip(k), flip(v), flip(gates[..., 2]),
                                flip(jax.nn.log_sigmoid(gates[..., 3])), init_bwd, with_outputs)
    h = h_f + flip(h_b) if with_outputs else None
    return h, st_f, st_b


def zero_state(bsz):
    return (jnp.zeros((bsz, N_MLSTM_HEADS, MLSTM_HEAD_DIM, MLSTM_HEAD_DIM), jnp.float32),
            jnp.zeros((bsz, N_MLSTM_HEADS, MLSTM_HEAD_DIM), jnp.float32),
            jnp.zeros((bsz, N_MLSTM_HEADS), jnp.float32))


def mlstm_heads(u_qkvg, b_gates, rows):
    bsz, t, _ = u_qkvg.shape
    per_head = lambda a: a.reshape(bsz, t, N_MLSTM_HEADS, -1).transpose(0, 2, 1, 3)
    q, k, v, g = jnp.split(u_qkvg.astype(jnp.float32), [MLSTM_WIDTH, 2 * MLSTM_WIDTH, 3 * MLSTM_WIDTH], axis=-1)
    z = jnp.concatenate([per_head(q), per_head(k) * MLSTM_HEAD_DIM ** -0.5, per_head(v),
                         per_head(g) + b_gates.astype(jnp.float32)[None, :, None, :]], axis=-1)
    if rows is not None:
        z = jnp.concatenate([z[:, :N_ROW_HEADS], _raster_to_colmajor(z[:, N_ROW_HEADS:], rows)], axis=1)
    return jnp.split(z, [MLSTM_HEAD_DIM, 2 * MLSTM_HEAD_DIM, 3 * MLSTM_HEAD_DIM], axis=-1)


def conformer_conv(a, g, conv_w, conv_b, ln_g, ln_b):
    y = a * jax.nn.sigmoid(g)
    y = lax.conv_general_dilated(y, conv_w[:, None, :], window_strides=(1,),
                                 padding=[(CONV_K // 2, CONV_K // 2)],
                                 dimension_numbers=('NWC', 'WIO', 'NWC'),
                                 feature_group_count=y.shape[-1]) + conv_b
    return jax.nn.silu(layernorm(y, ln_g, ln_b))


def fourier_mix(f):
    bsz, t, _ = f.shape
    z = f.astype(jnp.float32).reshape(bsz, t, N_FOURIER_GROUPS, FOURIER_GROUP_CH)
    z = jnp.fft.fft2(z, axes=(1, 3), norm='ortho').real
    return z.reshape(bsz, t, FOURIER_CH).astype(f.dtype)


def token_mixer(u, b_gates, g_hnorm, conv_w, conv_b, conv_ln_g, conv_ln_b, init_fwd, init_bwd, rows):
    bsz, t, _ = u.shape
    o0 = QKVG_COLS + MLSTM_WIDTH
    u_qkvg, o, ca, cg, fr = jnp.split(u, [QKVG_COLS, o0, o0 + CONV_CH, o0 + 2 * CONV_CH], axis=-1)
    q, k, v, g = mlstm_heads(u_qkvg, b_gates, rows)
    h, st_f, st_b = mlstm_bidir(q, k, v, g, init_fwd, init_bwd, True)
    if rows is not None:
        h = jnp.concatenate([h[:, :N_ROW_HEADS], _colmajor_to_raster(h[:, N_ROW_HEADS:], rows)], axis=1)
    h = h * lax.rsqrt(jnp.mean(h * h, axis=-1, keepdims=True) + EPS) \
        * g_hnorm.astype(jnp.float32).reshape(N_MLSTM_HEADS, 1, MLSTM_HEAD_DIM)
    h = h.transpose(0, 2, 1, 3).reshape(bsz, t, MLSTM_WIDTH).astype(u.dtype) * jax.nn.sigmoid(o)
    y = jnp.concatenate([h, conformer_conv(ca, cg, conv_w, conv_b, conv_ln_g, conv_ln_b), fourier_mix(fr)], axis=-1)
    return y, st_f, st_b


def expert_choice_ffn(xn, w_router, w_gate, w_up, w_down):
    bsz, n, _ = xn.shape
    cap = EC_CAPACITY_FACTOR * n // N_EXPERTS
    aff = jax.nn.softmax(jnp.einsum('bnd,de->bne', xn, w_router).astype(jnp.float32), axis=-1)
    gate, idx = lax.top_k(jnp.swapaxes(aff, 1, 2), cap)
    bidx = jnp.arange(bsz)[:, None, None]
    xs = xn[bidx, idx]
    hid = jax.nn.silu(jnp.einsum('becd,edf->becf', xs, w_gate)) * jnp.einsum('becd,edf->becf', xs, w_up)
    ys = jnp.einsum('becf,efd->becd', hid, w_down) * gate[..., None].astype(xn.dtype)
    return jnp.zeros_like(xn).at[bidx, idx].add(ys)


def setup_inputs(seed: int = 0) -> dict:
    key = jax.random.key(seed)
    ks = jax.random.split(key, 24)
    nrm = lambda k, shape, s: jax.random.normal(k, shape, jnp.float32) * s
    D, L, H = D_MODEL, DEPTH, N_MLSTM_HEADS
    ig = nrm(ks[8], (L, H, 2), 0.1)
    fg = jnp.linspace(3.0, 6.0, H)[None, :, None] + nrm(ks[9], (L, H, 2), 0.1)
    b_gates = jnp.stack([ig[..., 0], fg[..., 0], ig[..., 1], fg[..., 1]], axis=-1)
    return {
        'x': nrm(ks[0], (BATCH, SEQ, D), 1.0),
        'c': nrm(ks[1], (BATCH, D), 1.0),
        'ctx': nrm(ks[2], (BATCH, CTX_LEN, D), 1.0),
        'c_ctx': nrm(ks[3], (D,), 1.0),
        'w_ada': nrm(ks[4], (L, D, N_ADA * D), 0.5 * D ** -0.5),
        'b_ada': nrm(ks[5], (L, N_ADA * D), 0.02),
        'g_norm1': 1.0 + nrm(ks[6], (L, D), 0.02),
        'w_in': nrm(ks[7], (L, D, IN_COLS), D ** -0.5),
        'b_gates': b_gates,
        'g_hnorm': 1.0 + nrm(ks[10], (L, MLSTM_WIDTH), 0.02),
        'conv_w': nrm(ks[11], (L, CONV_K, CONV_CH), CONV_K ** -0.5),
        'conv_b': nrm(ks[12], (L, CONV_CH), 0.02),
        'conv_ln_g': 1.0 + nrm(ks[13], (L, CONV_CH), 0.02),
        'conv_ln_b': nrm(ks[14], (L, CONV_CH), 0.02),
        'w_out': nrm(ks[15], (L, MIX_WIDTH, D), MIX_WIDTH ** -0.5),
        'g_norm2': 1.0 + nrm(ks[16], (L, D), 0.02),
        'w_router': nrm(ks[17], (L, D, N_EXPERTS), D ** -0.5),
        'w_e_gate': nrm(ks[18], (L, N_EXPERTS, D, EXPERT_HIDDEN), D ** -0.5),
        'w_e_up': nrm(ks[19], (L, N_EXPERTS, D, EXPERT_HIDDEN), D ** -0.5),
        'w_e_down': nrm(ks[20], (L, N_EXPERTS, EXPERT_HIDDEN, D), EXPERT_HIDDEN ** -0.5),
        'g_final': 1.0 + nrm(ks[21], (D,), 0.02),
    }


def reference(x, c, ctx, c_ctx, w_ada, b_ada, g_norm1, w_in, b_gates, g_hnorm, conv_w, conv_b,
              conv_ln_g, conv_ln_b, w_out, g_norm2, w_router, w_e_gate, w_e_up, w_e_down, g_final):
    bsz, t, _ = x.shape
    rows = t // GRID_W
    h_ctx = ctx
    silu_c = jax.nn.silu(c)
    silu_cc = jax.nn.silu(c_ctx)
    for l in range(DEPTH):
        last = l == DEPTH - 1
        mod = silu_c @ w_ada[l] + b_ada[l]
        mod_c = silu_cc @ w_ada[l] + b_ada[l]
        sh1, sc1, gt1, sh2, sc2, gt2 = jnp.split(mod[:, None, :], N_ADA, axis=-1)
        csh1, csc1, cgt1, csh2, csc2, cgt2 = jnp.split(mod_c, N_ADA)
        init = zero_state(h_ctx.shape[0])
        xn_c = modulated_rmsnorm(h_ctx, g_norm1[l], csh1, csc1)
        if last:
            q, k, v, g = mlstm_heads(xn_c @ w_in[l][:, :QKVG_COLS], b_gates[l], None)
            _, st_f, st_b = mlstm_bidir(q, k, v, g, init, init, False)
        else:
            mix_c, st_f, st_b = token_mixer(xn_c @ w_in[l], b_gates[l], g_hnorm[l], conv_w[l], conv_b[l],
                                            conv_ln_g[l], conv_ln_b[l], init, init, None)
            h_ctx = h_ctx + cgt1 * (mix_c @ w_out[l])
            h_ctx = h_ctx + cgt2 * expert_choice_ffn(modulated_rmsnorm(h_ctx, g_norm2[l], csh2, csc2),
                                                     w_router[l], w_e_gate[l], w_e_up[l], w_e_down[l])
        xn = modulated_rmsnorm(x, g_norm1[l], sh1, sc1)
        mix_x, _, _ = token_mixer(xn @ w_in[l], b_gates[l], g_hnorm[l], conv_w[l], conv_b[l],
                                  conv_ln_g[l], conv_ln_b[l], st_f, st_b, rows)
        x = x + gt1 * (mix_x @ w_out[l])
        x = x + gt2 * expert_choice_ffn(modulated_rmsnorm(x, g_norm2[l], sh2, sc2),
                                        w_router[l], w_e_gate[l], w_e_up[l], w_e_down[l])
    return _rms(x, g_final).astype(x.dtype)
```

```cpp
#include <hip/hip_runtime.h>
#include <cstdio>
#include <cstdint>

#ifndef N_LAUNCHES
#define N_LAUNCHES 1
#endif
#ifndef USE_MFMA_GEMM
#define USE_MFMA_GEMM 1
#endif

#define LAS __attribute__((address_space(3)))
#define GAS __attribute__((address_space(1)))
typedef unsigned short bf16_t;
typedef short bf16x8 __attribute__((ext_vector_type(8)));
typedef float f32x4 __attribute__((ext_vector_type(4)));
typedef float f32x2 __attribute__((ext_vector_type(2)));
typedef unsigned u32x4 __attribute__((ext_vector_type(4)));
typedef unsigned u32x2 __attribute__((ext_vector_type(2)));
typedef GAS unsigned gu32;
#define RLX_AGENT __ATOMIC_RELAXED, __HIP_MEMORY_SCOPE_AGENT
#define LDS_WAIT() asm volatile("s_waitcnt lgkmcnt(0)" ::: "memory")
#define VM_WAIT() asm volatile("s_waitcnt vmcnt(0)" ::: "memory")

constexpr int D = 1024, NB = 8, SEQ = 2048, CTXL = 256;
constexpr int NLAT = NB * SEQ, NCTX = NB * CTXL, NTOK = NLAT + NCTX;
constexpr int INC = 2832, NIN = 2816;
constexpr int KOUT = 1280;
constexpr int NE = 16, RPE = 2304;
constexpr float EPS = 1e-6f;
constexpr int NTHR = 512, NWAVES = 8;

constexpr size_t al256(size_t x) { return (x + 255) & ~(size_t)255; }
constexpr size_t WS_CTL = 0;
constexpr size_t WS_MOD = WS_CTL + 65536;
constexpr size_t WS_WIN = WS_MOD + al256((size_t)2 * 9 * 6144 * 4);
constexpr size_t WS_WOUT = WS_WIN + (size_t)2 * NIN * D * 2;
constexpr size_t WS_WGU = WS_WOUT + (size_t)2 * D * KOUT * 2;
constexpr size_t WS_WD = WS_WGU + (size_t)NE * 2048 * D * 2;
constexpr size_t WS_FL = WS_WD + (size_t)NE * D * D * 2;
constexpr size_t WS_FC = WS_FL + (size_t)4096 * 2048 * 2;
constexpr size_t WS_X = WS_FC + (size_t)512 * 2048 * 2;
constexpr size_t WS_XN = WS_X + (size_t)NTOK * D * 4;
constexpr size_t WS_GATES = WS_XN + (size_t)NTOK * D * 2;
constexpr size_t WS_AFF = WS_GATES + (size_t)NTOK * 16 * 4;
constexpr size_t WS_INV = WS_AFF + (size_t)NTOK * 16 * 4;
constexpr size_t WS_ROWTOK = WS_INV + (size_t)NTOK * 16 * 4;
constexpr size_t WS_GATEV = WS_ROWTOK + (size_t)NE * RPE * 4;
constexpr size_t WS_R1 = WS_GATEV + (size_t)NE * RPE * 4;
constexpr size_t SZ_QKV = (size_t)NTOK * 512 * 2;
constexpr size_t WS_Q = WS_R1, WS_K = WS_Q + SZ_QKV, WS_V = WS_K + SZ_QKV, WS_O = WS_V + SZ_QKV;
constexpr size_t WS_HID = WS_R1;
constexpr size_t WS_R2 = WS_R1 + 4 * SZ_QKV;
constexpr size_t SZ_C = (size_t)NTOK * 256 * 2;
constexpr size_t WS_CA = WS_R2, WS_CG = WS_CA + SZ_C, WS_FR = WS_CG + SZ_C, WS_ZT = WS_FR + SZ_C;
constexpr size_t WS_ZTC = WS_ZT + (size_t)2048 * 2048 * 2;
constexpr size_t WS_HF = WS_ZT + 2 * (size_t)2048 * 2048 * 2, WS_HB = WS_HF + SZ_QKV, WS_Y = WS_HB + SZ_QKV;
constexpr size_t WS_YS = WS_R2;
constexpr size_t WS_END = WS_Y + (size_t)NTOK * KOUT * 2;
static_assert((size_t)NE * RPE * D * 2 <= 4 * SZ_QKV, "HID alias");
static_assert(WS_YS + (size_t)NE * RPE * D * 2 <= WS_END, "YS alias");

constexpr int RING_BYTES = 139264;
constexpr int LDSCTL_OFF = RING_BYTES;
constexpr int LDS_BYTES = RING_BYTES + 1024;

__device__ __forceinline__ unsigned f2bf(float f) { unsigned u = __float_as_uint(f); u += 0x7FFFu + ((u >> 16) & 1u); return u >> 16; }
typedef __bf16 bf16x2_t __attribute__((ext_vector_type(2)));
__device__ __forceinline__ unsigned pk2(float lo, float hi) { const bf16x2_t r = __builtin_convertvector((f32x2){lo, hi}, bf16x2_t); return __builtin_bit_cast(unsigned, r); }
__device__ __forceinline__ float bf2f(unsigned b) { return __uint_as_float(b << 16); }
__device__ __forceinline__ float bflo(unsigned w) { return __uint_as_float(w << 16); }
__device__ __forceinline__ float bfhi(unsigned w) { return __uint_as_float(w & 0xffff0000u); }
__device__ __forceinline__ float sigmoidf_(float x) { return 1.0f / (1.0f + __expf(-x)); }
__device__ __forceinline__ float siluf_(float x) { return x / (1.0f + __expf(-x)); }
__device__ __forceinline__ float logsigmoidf_(float x) { return x >= 0.f ? -log1pf(expf(-x)) : x - log1pf(expf(x)); }
__device__ __forceinline__ float wave_sum(float v) {
#pragma unroll
    for (int o = 1; o < 64; o <<= 1) v += __shfl_xor(v, o);
    return v;
}
__device__ __forceinline__ u32x2 pk4(f32x4 v) { u32x2 w; w.x = pk2(v[0], v[1]); w.y = pk2(v[2], v[3]); return w; }

#define XB_TMO      128
#define XB_XCNT(j)  (256  + 64 * (j))
#define XB_XSUB(j)  (1280 + 64 * (j))
#define XB_XGEN(j)  (2304 + 64 * (j))
#define XB_TOP      3328
#define XB_TOPGEN   3392
#define XCD_BAR_WORDS 3456
#define XB_SPIN_CAP (1u << 22)
__device__ __forceinline__ unsigned xb_ld(unsigned* p)              { return __hip_atomic_load(p, __ATOMIC_RELAXED, __HIP_MEMORY_SCOPE_AGENT); }
__device__ __forceinline__ unsigned xb_add(unsigned* p, unsigned v) { return __hip_atomic_fetch_add(p, v, __ATOMIC_RELAXED, __HIP_MEMORY_SCOPE_AGENT); }
__device__ __forceinline__ unsigned xb_xcc_id() { return (unsigned)__builtin_amdgcn_s_getreg((3 << 11) | 20) & 0xFu; }
#define XB_SPIN(cond, bar) do { unsigned _sp = 0; while (cond) { __builtin_amdgcn_s_sleep(1); \
    if ((++_sp & 255u) == 0u) { if (xb_ld(&(bar)[XB_TMO])) break; if (_sp > XB_SPIN_CAP) { atomicAdd(&(bar)[XB_TMO], 1u); break; } } } } while (0)
struct XcdBarrier { unsigned* bar; unsigned x; volatile LAS unsigned* st; };
__device__ __forceinline__ XcdBarrier xcd_barrier_post(unsigned* bar, volatile LAS unsigned* st) {
    XcdBarrier b; b.bar = bar; b.x = xb_xcc_id(); b.st = st;
    if (threadIdx.x == 0) (void)xb_add(&bar[XB_XCNT(b.x)], 1u);
    return b;
}
__device__ __forceinline__ void xcd_barrier_complete(unsigned* bar, unsigned x, unsigned& nloc, unsigned& nx) {
    const unsigned G = gridDim.x * gridDim.y * gridDim.z;
    unsigned sum, cnt, mine, sp = 0u;
    for (;;) {
        sum = 0u; cnt = 0u; mine = 0u;
#pragma unroll
        for (unsigned j = 0; j < 16; ++j) { const unsigned c = xb_ld(&bar[XB_XCNT(j)]); sum += c; cnt += (c > 0u) ? 1u : 0u; mine = (j == x) ? c : mine; }
        if (sum == G) break;
        __builtin_amdgcn_s_sleep(1);
        if ((++sp & 255u) == 0u) { if (xb_ld(&bar[XB_TMO])) break; if (sp > XB_SPIN_CAP) { atomicAdd(&bar[XB_TMO], 1u); break; } }
    }
    nloc = mine > 0u ? mine : 1u; nx = cnt > 0u ? cnt : 1u;
}
__device__ __forceinline__ void xcd_barrier(const XcdBarrier& b) {
    asm volatile("s_waitcnt vmcnt(0)" ::: "memory");
    __syncthreads();
    if (threadIdx.x == 0) {
        unsigned* bar = b.bar;
        __builtin_amdgcn_s_waitcnt(0);
        unsigned nloc = b.st[0], nx = b.st[1];
        if (nloc == 0u) { xcd_barrier_complete(bar, b.x, nloc, nx); b.st[0] = nloc; b.st[1] = nx; }
        const unsigned old = xb_add(&bar[XB_XSUB(b.x)], 1u);
        const unsigned gen = old / nloc;
        if (old + 1u == (gen + 1u) * nloc) {
            __builtin_amdgcn_fence(__ATOMIC_RELEASE, "agent");
            asm volatile("s_waitcnt vmcnt(0)" ::: "memory");
            const unsigned og = xb_add(&bar[XB_TOP], 1u);
            const unsigned tg = og / nx;
            if (og + 1u == (tg + 1u) * nx) xb_add(&bar[XB_TOPGEN], 1u);
            else XB_SPIN(xb_ld(&bar[XB_TOPGEN]) == tg, bar);
            __builtin_amdgcn_fence(__ATOMIC_ACQUIRE, "agent");
            xb_add(&bar[XB_XGEN(b.x)], 1u);
            asm volatile("s_waitcnt vmcnt(0)" ::: "memory");
        } else {
            XB_SPIN(xb_ld(&bar[XB_XGEN(b.x)]) == gen, bar);
            __builtin_amdgcn_fence(__ATOMIC_ACQUIRE, "agent");
            asm volatile("s_waitcnt vmcnt(0)" ::: "memory");
        }
    }
    __syncthreads();
}

namespace pg8 {
constexpr int BM = 256, BK = 64, HALF = 128, HTB = HALF * BK * 2, STAGE_BYTES = 8 * HTB, NXCD = 8, WGM = 8;
__host__ __device__ __forceinline__ int lds_byte(int r, int c) { const int st = (r >> 4) * 2 + (c >> 5), rr = r & 15, cc = c & 31, ob = rr * 64 + cc * 2; return st * 1024 + (ob ^ (((ob >> 9) & 1) << 5)); }
__host__ __device__ __forceinline__ void stage_rc(int b, int& R, int& C) { const int st = b / 1024, sb = b % 1024, swz = sb ^ (((sb >> 9) & 1) << 5); R = (st >> 1) * 16 + swz / 64; C = (st & 1) * 32 + (swz % 64) / 2; }

struct Unit { const char* A; const char* B; const int* rows; int K, pm, pn, ex; };

__device__ __forceinline__ void map_tile(int L, int nM, int nN, int& pm, int& pn) {
    const int nwg = nM * nN; int wgid = L;
    { const int q = nwg / NXCD, r = nwg % NXCD, xcd = wgid % NXCD, off = wgid / NXCD; wgid = (xcd < r ? xcd * (q + 1) : r * (q + 1) + (xcd - r) * q) + off; }
    const int nig = WGM * nN, gid = wgid / nig, fm = gid * WGM, gsz = (nM - fm) < WGM ? (nM - fm) : WGM;
    pm = fm + ((wgid % nig) % gsz); pn = (wgid % nig) / gsz;
}
__device__ __forceinline__ void a_offs(const Unit& u, int lda, int tid, unsigned (&vA)[2][2]) {
    if (u.rows) {
        const int* rw = u.rows;
#pragma unroll
        for (int h = 0; h < 2; ++h)
#pragma unroll
            for (int i = 0; i < 2; ++i) { int R, C; stage_rc(tid * 16 + i * 8192, R, C); vA[h][i] = (unsigned)(rw[h * HALF + R] * lda + C) * 2u; }
    } else {
#pragma unroll
        for (int h = 0; h < 2; ++h)
#pragma unroll
            for (int i = 0; i < 2; ++i) { int R, C; stage_rc(tid * 16 + i * 8192, R, C); vA[h][i] = (unsigned)((h * HALF + R) * lda + C) * 2u; }
    }
}

template <class Epi, class Sched>
__device__ __forceinline__ void gemm_phase(LAS unsigned char* lds, const int tid, const int lda, const int ldb, const Sched& S, const Epi& E) {
    const int wid = __builtin_amdgcn_readfirstlane(tid >> 6), lane = tid & 63, wr = wid >> 2, wc = wid & 3, fr = lane & 15, fq = lane >> 4;
    unsigned voffB[2];
#pragma unroll
    for (int i = 0; i < 2; ++i) { int R, C; stage_rc(tid * 16 + i * 8192, R, C); voffB[i] = (unsigned)(R * ldb + C) * 2u; }
    const size_t kstep = (size_t)(BK * 2);
    const size_t hsB = (size_t)HALF * ldb * 2;
    const unsigned ldsw = (unsigned)wid * 1024u;
    const int aoff = lds_byte(wr * 64 + fr, fq * 8), boff = lds_byte(wc * 32 + fr, fq * 8);
#define PG8_SA(b, h) (((b) * 2 + (h)) * HTB)
#define PG8_SB(b, h) ((4 + (b) * 2 + (h)) * HTB)
#define PG8_STAGE(bufoff, gbase, voff) do { _Pragma("unroll") for (int _i = 0; _i < 2; ++_i) \
        __builtin_amdgcn_global_load_lds((const unsigned*)((const char*)(gbase) + (voff)[_i]), (LAS unsigned*)(lds + (bufoff) + ldsw + _i * 8192), 16, 0, 0); } while (0)
#define PG8_LDA(dst, b, h) do { _Pragma("unroll") for (int m = 0; m < 4; ++m) _Pragma("unroll") for (int k = 0; k < 2; ++k) dst[m][k] = *(const LAS bf16x8*)(lds + PG8_SA(b, h) + aoff + m * 2048 + k * 1024); } while (0)
#define PG8_LDB(dst, b, h) do { _Pragma("unroll") for (int n = 0; n < 2; ++n) _Pragma("unroll") for (int k = 0; k < 2; ++k) dst[n][k] = *(const LAS bf16x8*)(lds + PG8_SB(b, h) + boff + n * 2048 + k * 1024); } while (0)
#define PG8_MMA(ai, bj, At, Bt) do { __builtin_amdgcn_s_setprio(1); _Pragma("unroll") for (int m = 0; m < 4; ++m) _Pragma("unroll") for (int n = 0; n < 2; ++n) _Pragma("unroll") for (int k = 0; k < 2; ++k) \
        acc[ai][bj][m][n] = __builtin_amdgcn_mfma_f32_16x16x32_bf16(Bt[n][k], At[m][k], acc[ai][bj][m][n], 0, 0, 0); __builtin_amdgcn_s_setprio(0); } while (0)
#define PG8_WAIT_V(n) asm volatile("s_waitcnt vmcnt(" #n ")" ::: "memory")
#define PG8_WAIT_L(n) asm volatile("s_waitcnt lgkmcnt(" #n ")" ::: "memory")
#define PG8_BAR __builtin_amdgcn_s_barrier()
#define PG8_SCHED __builtin_amdgcn_sched_barrier(0)
    Unit cur, nxt; int ui = 0;
    if (!S.next(0, cur)) return;
    f32x4 acc[2][2][4][2];
#pragma unroll
    for (int a = 0; a < 2; ++a)
#pragma unroll
        for (int b = 0; b < 2; ++b)
#pragma unroll
            for (int m = 0; m < 4; ++m)
#pragma unroll
                for (int n = 0; n < 2; ++n) acc[a][b][m][n] = (f32x4){0.f, 0.f, 0.f, 0.f};
    bf16x8 At[4][2], B0[2][2], B1[2][2];
    unsigned vA[2][2], wA[2][2];
    a_offs(cur, lda, tid, vA);
    const char* cA = cur.A; const char* cB = cur.B;
    PG8_STAGE(PG8_SB(0, 0), cB, voffB); PG8_STAGE(PG8_SB(0, 1), cB + hsB, voffB); PG8_STAGE(PG8_SA(0, 0), cA, vA[0]); PG8_STAGE(PG8_SA(0, 1), cA, vA[1]);
    if (wr == 1) PG8_BAR;
    PG8_WAIT_V(2); PG8_BAR;
    PG8_STAGE(PG8_SB(1, 0), cB + kstep, voffB); PG8_STAGE(PG8_SA(1, 0), cA + kstep, vA[0]); PG8_STAGE(PG8_SB(1, 1), cB + hsB + kstep, voffB);
    PG8_WAIT_V(6); PG8_BAR;
    for (;;) {
        const bool has_next = S.next(ui + 1, nxt);
        if (!has_next) nxt = cur;
        const char* nA = nxt.A; const char* nB = nxt.B;
        a_offs(nxt, lda, tid, wA);
        const int nt = cur.K / BK;
        for (int t = 0; t < nt; t += 2) {
            const bool last = (t == nt - 2);
            const char* a1 = cA + (size_t)(t + 1) * kstep;
            const char* a2 = last ? nA : cA + (size_t)(t + 2) * kstep; const char* b2 = last ? nB : cB + (size_t)(t + 2) * kstep;
            const char* a3 = a2 + kstep; const char* b3 = b2 + kstep;
            PG8_LDB(B0, 0, 0); PG8_LDB(B1, 0, 1); PG8_SCHED; PG8_LDA(At, 0, 0); PG8_STAGE(PG8_SA(1, 1), a1, vA[1]);
            if (last) {
#pragma unroll
                for (int h = 0; h < 2; ++h)
#pragma unroll
                    for (int i = 0; i < 2; ++i) vA[h][i] = wA[h][i];
            }
            PG8_WAIT_V(8); PG8_WAIT_L(0); PG8_BAR; PG8_MMA(0, 0, At, B0); PG8_MMA(0, 1, At, B1); PG8_BAR; PG8_SCHED;
            PG8_LDA(At, 0, 1); PG8_STAGE(PG8_SB(0, 0), b2, voffB); PG8_STAGE(PG8_SB(0, 1), b2 + hsB, voffB); PG8_STAGE(PG8_SA(0, 0), a2, vA[0]);
            PG8_WAIT_V(8); PG8_WAIT_L(0); PG8_BAR; PG8_MMA(1, 0, At, B0); PG8_MMA(1, 1, At, B1); PG8_BAR; PG8_SCHED;
            PG8_LDB(B0, 1, 0); PG8_LDB(B1, 1, 1); PG8_SCHED; PG8_LDA(At, 1, 0); PG8_STAGE(PG8_SA(0, 1), a2, vA[1]);
            PG8_WAIT_V(8); PG8_WAIT_L(0); PG8_BAR; PG8_MMA(0, 0, At, B0); PG8_MMA(0, 1, At, B1); PG8_BAR; PG8_SCHED;
            PG8_LDA(At, 1, 1); PG8_STAGE(PG8_SB(1, 0), b3, voffB); PG8_STAGE(PG8_SB(1, 1), b3 + hsB, voffB); PG8_STAGE(PG8_SA(1, 0), a3, vA[0]);
            PG8_WAIT_V(8); PG8_WAIT_L(0); PG8_BAR; PG8_MMA(1, 0, At, B0); PG8_MMA(1, 1, At, B1); PG8_BAR; PG8_SCHED;
        }
        if (wr == 0) PG8_BAR;
        { int fr_ = fr, fq_ = fq; asm volatile("" : "+v"(fr_), "+v"(fq_));
          E.run(acc, cur, wr, wc, fr_, fq_); }
        if (!has_next) break;
#pragma unroll
        for (int a = 0; a < 2; ++a)
#pragma unroll
            for (int b = 0; b < 2; ++b)
#pragma unroll
                for (int m = 0; m < 4; ++m)
#pragma unroll
                    for (int n = 0; n < 2; ++n) acc[a][b][m][n] = (f32x4){0.f, 0.f, 0.f, 0.f};
        cur = nxt; cA = nA; cB = nB; ++ui;
        if (wr == 1) PG8_BAR;
    }
    PG8_WAIT_V(0);
    PG8_BAR;
#undef PG8_SA
#undef PG8_SB
#undef PG8_STAGE
#undef PG8_LDA
#undef PG8_LDB
#undef PG8_MMA
#undef PG8_WAIT_V
#undef PG8_WAIT_L
#undef PG8_BAR
#undef PG8_SCHED
}
template <class Epi, class Sched>
__device__ __forceinline__ void gemm_phase_simt(LAS unsigned char* lds, const int tid, const int lda, const int ldb, const Sched& S, const Epi& E) {
    LAS float* As = (LAS float*)lds;
    LAS float* Bs = (LAS float*)(lds + 32 * 132 * 4);
    const int ty = tid >> 4, tx = tid & 15, c0 = (tx >> 2) * 32 + (tx & 3) * 4;
    const int lr = tid >> 2, lk = (tid & 3) * 8;
    Unit u;
    for (int ui = 0; S.next(ui, u); ++ui) {
        for (int sub = 0; sub < 4; ++sub) {
            const int sr = sub >> 1, sc = sub & 1;
            float acc[4][8];
#pragma unroll
            for (int i = 0; i < 4; ++i)
#pragma unroll
                for (int j = 0; j < 8; ++j) acc[i][j] = 0.f;
            const int arow = sr * 128 + lr, brow = sc * 128 + lr;
            const int ar = u.rows ? u.rows[arow] : arow;
            const bf16_t* ap = (const bf16_t*)u.A + (size_t)ar * lda + lk;
            const bf16_t* bp = (const bf16_t*)u.B + (size_t)brow * ldb + lk;
            for (int k0 = 0; k0 < u.K; k0 += 32) {
                const u32x4 av = *(const u32x4*)(ap + k0), bv = *(const u32x4*)(bp + k0);
                __syncthreads();
#pragma unroll
                for (int j = 0; j < 4; ++j) {
                    As[(lk + 2 * j) * 132 + lr] = bflo(av[j]); As[(lk + 2 * j + 1) * 132 + lr] = bfhi(av[j]);
                    Bs[(lk + 2 * j) * 132 + lr] = bflo(bv[j]); Bs[(lk + 2 * j + 1) * 132 + lr] = bfhi(bv[j]);
                }
                __syncthreads();
#pragma unroll 4
                for (int k = 0; k < 32; ++k) {
                    const f32x4 a4 = *(const LAS f32x4*)(As + k * 132 + ty * 4);
                    const f32x4 b0 = *(const LAS f32x4*)(Bs + k * 132 + c0), b1 = *(const LAS f32x4*)(Bs + k * 132 + c0 + 16);
#pragma unroll
                    for (int i = 0; i < 4; ++i)
#pragma unroll
                        for (int j = 0; j < 4; ++j) { acc[i][j] += a4[i] * b0[j]; acc[i][4 + j] += a4[i] * b1[j]; }
                }
            }
#pragma unroll
            for (int i = 0; i < 4; ++i)
                E.store1(u, sr * 128 + ty * 4 + i, sc * 128 + c0, (f32x4){acc[i][0], acc[i][1], acc[i][2], acc[i][3]}, (f32x4){acc[i][4], acc[i][5], acc[i][6], acc[i][7]});
        }
    }
    __syncthreads();
}
}

#if USE_MFMA_GEMM
#define GEMM_PHASE(lds, lda, ldb, S, E) pg8::gemm_phase(lds, F.tid, lda, ldb, S, E)
#else
#define GEMM_PHASE(lds, lda, ldb, S, E) pg8::gemm_phase_simt(lds, F.tid, lda, ldb, S, E)
#endif

struct Args { const float* in[21]; float* out; unsigned char* ws; int ph_lo, ph_hi; };
enum { I_X = 0, I_C, I_CTX, I_CCTX, I_WADA, I_BADA, I_GN1, I_WIN, I_BG, I_GH, I_CW, I_CB, I_CLG, I_CLB, I_WOUT, I_GN2, I_WR, I_WEG, I_WEU, I_WED, I_GF };
__device__ __forceinline__ const float* arg_in(const Args& a, int i) { asm volatile("" : "+s"(i)); return a.in[i]; }
struct Frame {
    LAS unsigned char* lds;
    int tid, lane, wave, G, bid;
    unsigned char* ws;
    const Args& A;
};
#define FIN(i) arg_in(F.A, (i))
#define WSP(T, off) ((T*)(F.ws + (off)))

template <class Src>
__device__ __forceinline__ void tr_item(const Src& src, bf16_t* dst, int ldd, int n0, int k0, LAS float* scr, int lane) {
    f32x4 v[8];
#pragma unroll
    for (int i = 0; i < 8; ++i) v[i] = src.ld4(k0 + i * 8 + (lane >> 3), n0 + (lane & 7) * 4);
#pragma unroll
    for (int i = 0; i < 8; ++i) { LAS float* p = scr + (i * 8 + (lane >> 3)) * 33 + (lane & 7) * 4; p[0] = v[i][0]; p[1] = v[i][1]; p[2] = v[i][2]; p[3] = v[i][3]; }
    LDS_WAIT(); asm volatile("" ::: "memory");
    const int c = lane & 7;
#pragma unroll
    for (int j = 0; j < 4; ++j) { const int n = (lane >> 3) + 8 * j; const LAS float* s = scr + (8 * c) * 33 + n;
        u32x4 o; o.x = pk2(s[0 * 33], s[1 * 33]); o.y = pk2(s[2 * 33], s[3 * 33]); o.z = pk2(s[4 * 33], s[5 * 33]); o.w = pk2(s[6 * 33], s[7 * 33]);
        *(u32x4*)(dst + (size_t)(n0 + n) * ldd + k0 + 8 * c) = o; }
    LDS_WAIT(); asm volatile("" ::: "memory");
}
struct SrcWin { const float* w; __device__ __forceinline__ f32x4 ld4(int k, int n) const { return *(const f32x4*)(w + (size_t)k * INC + (n < 1536 ? n : n + 16)); } };
struct SrcPlain { const float* w; int ld; __device__ __forceinline__ f32x4 ld4(int k, int n) const { return *(const f32x4*)(w + (size_t)k * ld + n); } };
struct SrcGU { const float* wg; const float* wu; __device__ __forceinline__ f32x4 ld4(int k, int n) const { const int grp = n >> 5, i = n & 31;
    const uintptr_t base = (uintptr_t)wg + ((i < 16) ? (uintptr_t)0 : ((uintptr_t)wu - (uintptr_t)wg));
    return *(const f32x4*)((const float*)base + (size_t)k * D + grp * 16 + (i & 15)); } };

__device__ __forceinline__ void convert_moe_weights(Frame& F, int l, int gw, int ngw) {
    LAS float* scr = (LAS float*)(F.lds + F.wave * 8448);
    bf16_t* WGU = WSP(bf16_t, WS_WGU); bf16_t* WD = WSP(bf16_t, WS_WD);
    const float* w_e_gate = FIN(I_WEG); const float* w_e_up = FIN(I_WEU); const float* w_e_down = FIN(I_WED);
    constexpr int I_GU = NE * 64 * 16, I_D = NE * 32 * 16;
    for (int it = gw; it < I_GU + I_D; it += ngw) {
        if (it < I_GU) { const int e = it / 1024, r = it % 1024, nb = r / 16, kb = r % 16;
            SrcGU s{w_e_gate + ((size_t)l * NE + e) * D * D, w_e_up + ((size_t)l * NE + e) * D * D};
            tr_item(s, WGU + (size_t)e * 2048 * D, D, nb * 32, kb * 64, scr, F.lane);
        } else { const int r0 = it - I_GU, e = r0 / 512, r = r0 % 512, nb = r / 16, kb = r % 16;
            SrcPlain s{w_e_down + ((size_t)l * NE + e) * D * D, D};
            tr_item(s, WD + (size_t)e * D * D, D, nb * 32, kb * 64, scr, F.lane);
        }
    }
}

__device__ __forceinline__ void phase_prep(Frame& F) {
    const int tid = F.tid;
    {
        LAS float* s = (LAS float*)F.lds;
        LAS float* red = (LAS float*)(F.lds + 9 * 1024 * 4);
        float* MOD = WSP(float, WS_MOD);
        const float* c_in = FIN(I_C); const float* c_ctx = FIN(I_CCTX); const float* w_ada = FIN(I_WADA); const float* b_ada = FIN(I_BADA);
        bool staged = false;
        for (int it = F.bid; it < 192; it += F.G) {
            if (!staged) { for (int i = tid; i < 9 * 1024; i += NTHR) { const int r = i >> 10, k = i & 1023; const float cv = (r < 8) ? c_in[r * 1024 + k] : c_ctx[k]; s[i] = siluf_(cv); } staged = true; }
            __syncthreads();
            const int l = it / 96, cgp = it % 96, col = cgp * 64 + (tid & 63), kq = tid >> 6;
            float acc[9];
#pragma unroll
            for (int r = 0; r < 9; ++r) acc[r] = 0.f;
            const float* w = w_ada + ((size_t)l * 1024 + kq * 128) * 6144 + col;
#pragma unroll 4
            for (int k = 0; k < 128; ++k) { const float wv = w[(size_t)k * 6144];
#pragma unroll
                for (int r = 0; r < 9; ++r) acc[r] += s[r * 1024 + kq * 128 + k] * wv; }
#pragma unroll
            for (int r = 0; r < 9; ++r) red[(kq * 9 + r) * 64 + (tid & 63)] = acc[r];
            __syncthreads();
            for (int o = tid; o < 576; o += NTHR) { const int r = o >> 6, cc = o & 63; float sum = 0.f;
#pragma unroll
                for (int q = 0; q < 8; ++q) sum += red[(q * 9 + r) * 64 + cc];
                MOD[((size_t)l * 9 + r) * 6144 + cgp * 64 + cc] = sum + b_ada[l * 6144 + cgp * 64 + cc]; }
            __syncthreads();
        }
        __syncthreads();
    }
    {
        bf16_t* FL = WSP(bf16_t, WS_FL); bf16_t* FC = WSP(bf16_t, WS_FC);
        const size_t gth = (size_t)F.bid * NTHR + tid, nth = (size_t)F.G * NTHR;
        for (size_t it = gth; it < (size_t)4096 * 2048 / 8; it += nth) {
            const int r = (int)(it / 256), t0 = (int)(it % 256) * 8, part = r >> 11, k = r & 2047; unsigned w[4];
#pragma unroll
            for (int j = 0; j < 4; ++j) { float v[2];
#pragma unroll
                for (int q = 0; q < 2; ++q) { const int ph = (k * (t0 + 2 * j + q)) & 2047; const float ang = (float)ph * (6.283185307179586f / 2048.f); v[q] = (part ? sinf(ang) : cosf(ang)) * 0.022097086912079608f; }
                w[j] = pk2(v[0], v[1]); }
            *(u32x4*)(FL + (size_t)r * 2048 + t0) = (u32x4){w[0], w[1], w[2], w[3]};
        }
        for (size_t it = gth; it < (size_t)512 * 256 / 8; it += nth) {
            const int r = (int)(it / 32), t0 = (int)(it % 32) * 8, part = r >> 8, k = r & 255; unsigned w[4];
#pragma unroll
            for (int j = 0; j < 4; ++j) { float v[2];
#pragma unroll
                for (int q = 0; q < 2; ++q) { const int ph = (k * (t0 + 2 * j + q)) & 255; const float ang = (float)ph * (6.283185307179586f / 256.f); v[q] = (part ? sinf(ang) : cosf(ang)) * 0.0625f; }
                w[j] = pk2(v[0], v[1]); }
            *(u32x4*)(FC + (size_t)r * SEQ + t0) = (u32x4){w[0], w[1], w[2], w[3]};
        }
    }
    const int gw = F.bid * NWAVES + F.wave, ngw = F.G * NWAVES;
    {
        LAS float* scr = (LAS float*)(F.lds + F.wave * 8448);
        bf16_t* WIN = WSP(bf16_t, WS_WIN); bf16_t* WOUT = WSP(bf16_t, WS_WOUT);
        const float* w_in = FIN(I_WIN); const float* w_out = FIN(I_WOUT);
        constexpr int I_IN = 2 * 88 * 16, I_OP = 2 * 32 * 12, I_PQ = 2 * 32 * 8;
        for (int it = gw; it < I_IN + I_OP + I_PQ; it += ngw) {
            if (it < I_IN) { const int l = it / 1408, r = it % 1408, nb = r / 16, kb = r % 16;
                SrcWin s{w_in + (size_t)l * D * INC};
                tr_item(s, WIN + (size_t)l * NIN * D, D, nb * 32, kb * 64, scr, F.lane);
            } else if (it < I_IN + I_OP) { const int r0 = it - I_IN, l = r0 / 384, r = r0 % 384, nb = r / 12, kb = r % 12;
                SrcPlain s{w_out + (size_t)l * D * D, D};
                tr_item(s, WOUT + (size_t)l * D * KOUT, KOUT, nb * 32, kb * 64, scr, F.lane);
            } else { const int r0 = it - I_IN - I_OP, l = r0 / 256, r = r0 % 256, nb = r / 8, gp = r % 8, g = gp & 3, part = gp >> 2;
                const float* wsrc = w_out + (size_t)l * D * D + (size_t)(768 + g * 64) * D + nb * 32;
#pragma unroll 8
                for (int i = 0; i < 32; ++i) { const int kk = 2 * i + (F.lane >> 5), nn = F.lane & 31; scr[kk * 33 + nn] = wsrc[(size_t)kk * D + nn]; }
                LDS_WAIT(); asm volatile("" ::: "memory");
                const int c8 = F.lane & 7;
#pragma unroll
                for (int j = 0; j < 4; ++j) { const int n = (F.lane >> 3) + 8 * j; float o[8];
#pragma unroll
                    for (int q = 0; q < 8; ++q) o[q] = 0.f;
                    for (int m = 0; m < 64; ++m) { const float bv = scr[m * 33 + n];
#pragma unroll
                        for (int q = 0; q < 8; ++q) { const int cc = c8 * 8 + q; const float ang = (float)((m * cc) & 63) * (6.283185307179586f / 64.f); o[q] += (part ? -__sinf(ang) : __cosf(ang)) * bv; } }
                    u32x4 ov; ov.x = pk2(o[0] * 0.125f, o[1] * 0.125f); ov.y = pk2(o[2] * 0.125f, o[3] * 0.125f); ov.z = pk2(o[4] * 0.125f, o[5] * 0.125f); ov.w = pk2(o[6] * 0.125f, o[7] * 0.125f);
                    *(u32x4*)(WOUT + (size_t)l * D * KOUT + (size_t)(nb * 32 + n) * KOUT + 768 + part * 256 + g * 64 + c8 * 8) = ov; }
                LDS_WAIT(); asm volatile("" ::: "memory");
            }
        }
    }
}

__device__ __forceinline__ void stage_small_w(Frame& F, LAS float* wT, const float* src, int ld, int coloff) {
    for (int i = F.tid; i < 16 * 1024; i += NTHR) { const int k = i >> 4, c = i & 15; wT[c * 1024 + k] = src[(size_t)k * ld + coloff + c]; }
    __syncthreads();
}
__device__ __forceinline__ float reduce16(float (&acc)[16], int lane) {
    float v8[8], v4[4], v2[2], v1;
#pragma unroll
    for (int i = 0; i < 8; ++i) { const float snd = (lane & 32) ? acc[i] : acc[i + 8], kp = (lane & 32) ? acc[i + 8] : acc[i]; v8[i] = kp + __shfl_xor(snd, 32); }
#pragma unroll
    for (int i = 0; i < 4; ++i) { const float snd = (lane & 16) ? v8[i] : v8[i + 4], kp = (lane & 16) ? v8[i + 4] : v8[i]; v4[i] = kp + __shfl_xor(snd, 16); }
#pragma unroll
    for (int i = 0; i < 2; ++i) { const float snd = (lane & 8) ? v4[i] : v4[i + 2], kp = (lane & 8) ? v4[i + 2] : v4[i]; v2[i] = kp + __shfl_xor(snd, 8); }
    { const float snd = (lane & 4) ? v2[0] : v2[1], kp = (lane & 4) ? v2[1] : v2[0]; v1 = kp + __shfl_xor(snd, 4); }
    v1 += __shfl_xor(v1, 2); v1 += __shfl_xor(v1, 1);
    return v1;
}
__device__ __forceinline__ float norm_row(const f32x4 (&v)[4], const float* gain, const float* shift, const float* scale, bf16_t* xn_row, const LAS float* wT, int lane) {
    float ss = 0.f;
#pragma unroll
    for (int j = 0; j < 4; ++j) ss += (v[j][0] * v[j][0] + v[j][1] * v[j][1]) + (v[j][2] * v[j][2] + v[j][3] * v[j][3]);
    ss = wave_sum(ss);
    const float r = 1.0f / sqrtf(ss * (1.0f / D) + EPS);
    float acc[16];
#pragma unroll
    for (int c = 0; c < 16; ++c) acc[c] = 0.f;
#pragma unroll
    for (int j = 0; j < 4; ++j) {
        const int o = 4 * lane + 256 * j;
        const f32x4 g = *(const f32x4*)(gain + o), sh = *(const f32x4*)(shift + o), sc = *(const f32x4*)(scale + o);
        f32x4 y;
#pragma unroll
        for (int q = 0; q < 4; ++q) y[q] = v[j][q] * r * g[q] * (1.0f + sc[q]) + sh[q];
        *(u32x2*)(xn_row + o) = pk4(y);
#pragma unroll
        for (int c = 0; c < 16; ++c) { const f32x4 w = *(const LAS f32x4*)(wT + c * 1024 + o); acc[c] += (y[0] * w[0] + y[1] * w[1]) + (y[2] * w[2] + y[3] * w[3]); }
        asm volatile("" ::: "memory");
    }
    return reduce16(acc, lane);
}
__device__ __forceinline__ void row_tail_gates(float myv, const float* b_gates_l, float* gates_row, int lane) {
    if ((lane & 3) == 0) { const int c = lane >> 2; gates_row[c] = myv + b_gates_l[c]; }
}
__device__ __forceinline__ void row_tail_router(float myv, float* aff_row, int lane) {
    float mx = myv;
#pragma unroll
    for (int o = 4; o < 64; o <<= 1) mx = fmaxf(mx, __shfl_xor(mx, o));
    const float e = expf(myv - mx); float s = e;
#pragma unroll
    for (int o = 4; o < 64; o <<= 1) s += __shfl_xor(s, o);
    if ((lane & 3) == 0) aff_row[lane >> 2] = e / s;
}
__device__ __forceinline__ int mod_row(int tok) { return tok < NLAT ? (tok >> 11) : 8; }

__device__ __forceinline__ void phase_norm1_l0(Frame& F) {
    LAS float* wT = (LAS float*)F.lds;
    stage_small_w(F, wT, FIN(I_WIN), INC, 1536);
    const float* MOD = WSP(float, WS_MOD); bf16_t* XN = WSP(bf16_t, WS_XN); float* GATES = WSP(float, WS_GATES);
    const float* x_in = FIN(I_X); const float* ctx_in = FIN(I_CTX); const float* g_norm1 = FIN(I_GN1); const float* b_gates = FIN(I_BG);
    const int gw = F.bid * NWAVES + F.wave, ngw = F.G * NWAVES;
    for (int tok = gw; tok < NTOK; tok += ngw) {
        const float* src = tok < NLAT ? x_in + (size_t)tok * D : ctx_in + (size_t)(tok - NLAT) * D;
        f32x4 v[4];
#pragma unroll
        for (int j = 0; j < 4; ++j) v[j] = *(const f32x4*)(src + 4 * F.lane + 256 * j);
        const float* md = MOD + (size_t)mod_row(tok) * 6144;
        const float myv = norm_row(v, g_norm1, md, md + 1024, XN + (size_t)tok * D, wT, F.lane);
        row_tail_gates(myv, b_gates, GATES + (size_t)tok * 16, F.lane);
    }
    __syncthreads();
}
__device__ __forceinline__ void phase_norm2(Frame& F, int l) {
    LAS float* wT = (LAS float*)F.lds;
    stage_small_w(F, wT, FIN(I_WR) + (size_t)l * D * 16, 16, 0);
    const float* g_norm2 = FIN(I_GN2);
    const float* MOD = WSP(float, WS_MOD); bf16_t* XN = WSP(bf16_t, WS_XN); float* AFF = WSP(float, WS_AFF); const float* X = WSP(float, WS_X);
    const int gw = F.bid * NWAVES + F.wave, ngw = F.G * NWAVES;
    const int ntok = (l == 0) ? NTOK : NLAT;
    for (int tok = gw; tok < ntok; tok += ngw) {
        f32x4 v[4];
#pragma unroll
        for (int j = 0; j < 4; ++j) v[j] = *(const f32x4*)(X + (size_t)tok * D + 4 * F.lane + 256 * j);
        const float* md = MOD + ((size_t)l * 9 + mod_row(tok)) * 6144;
        const float myv = norm_row(v, g_norm2 + l * D, md + 3 * 1024, md + 4 * 1024, XN + (size_t)tok * D, wT, F.lane);
        row_tail_router(myv, AFF + (size_t)tok * 16, F.lane);
    }
    __syncthreads();
}
__device__ __forceinline__ void phase_combine(Frame& F, int l) {
    LAS float* wT = (LAS float*)F.lds;
    if (l == 0) stage_small_w(F, wT, FIN(I_WIN) + (size_t)1 * D * INC, INC, 1536);
    const float* g_norm1 = FIN(I_GN1); const float* b_gates = FIN(I_BG); const float* g_final = FIN(I_GF); float* outp = F.A.out;
    const float* MOD = WSP(float, WS_MOD); bf16_t* XN = WSP(bf16_t, WS_XN); float* GATES = WSP(float, WS_GATES); float* X = WSP(float, WS_X);
    const int* INV = WSP(int, WS_INV); const bf16_t* YS = WSP(bf16_t, WS_YS);
    const int gw = F.bid * NWAVES + F.wave, ngw = F.G * NWAVES;
    const int ntok = (l == 0) ? NTOK : NLAT;
    for (int tok = gw; tok < ntok; tok += ngw) {
        f32x4 v[4], a[4];
#pragma unroll
        for (int j = 0; j < 4; ++j) { v[j] = *(const f32x4*)(X + (size_t)tok * D + 4 * F.lane + 256 * j); a[j] = (f32x4){0.f, 0.f, 0.f, 0.f}; }
        for (int e = 0; e < NE; ++e) {
            const int r = __builtin_amdgcn_readfirstlane(INV[(size_t)tok * 16 + e]);
            if (r >= 0) { const bf16_t* yr = YS + ((size_t)e * RPE + r) * D;
#pragma unroll
                for (int j = 0; j < 4; ++j) { const u32x2 w = *(const u32x2*)(yr + 4 * F.lane + 256 * j); a[j][0] += bflo(w.x); a[j][1] += bfhi(w.x); a[j][2] += bflo(w.y); a[j][3] += bfhi(w.y); } }
        }
        const float* md = MOD + ((size_t)l * 9 + mod_row(tok)) * 6144;
#pragma unroll
        for (int j = 0; j < 4; ++j) { const f32x4 gt = *(const f32x4*)(md + 5 * 1024 + 4 * F.lane + 256 * j); v[j] = v[j] + gt * a[j]; }
        if (l == 0) {
#pragma unroll
            for (int j = 0; j < 4; ++j) *(f32x4*)(X + (size_t)tok * D + 4 * F.lane + 256 * j) = v[j];
            const float* md1 = MOD + ((size_t)9 + mod_row(tok)) * 6144;
            const float myv = norm_row(v, g_norm1 + D, md1, md1 + 1024, XN + (size_t)tok * D, wT, F.lane);
            row_tail_gates(myv, b_gates + 16, GATES + (size_t)tok * 16, F.lane);
        } else {
            float ss = 0.f;
#pragma unroll
            for (int j = 0; j < 4; ++j) ss += (v[j][0] * v[j][0] + v[j][1] * v[j][1]) + (v[j][2] * v[j][2] + v[j][3] * v[j][3]);
            ss = wave_sum(ss);
            const float r = 1.0f / sqrtf(ss * (1.0f / D) + EPS);
#pragma unroll
            for (int j = 0; j < 4; ++j) { const f32x4 g = *(const f32x4*)(g_final + 4 * F.lane + 256 * j); *(f32x4*)(outp + (size_t)tok * D + 4 * F.lane + 256 * j) = v[j] * r * g; }
        }
    }
    __syncthreads();
}

__device__ __forceinline__ int block_count(LAS int* cbuf, int par, int wave, int lane, int c_wave  ) {
    if (lane == 0) cbuf[par * 8 + wave] = c_wave;
    __syncthreads();
    int t = 0;
#pragma unroll
    for (int q = 0; q < 8; ++q) t += cbuf[par * 8 + q];
    return t;
}
__device__ __forceinline__ void phase_topk(Frame& F, int l) {
    LAS int* cbuf = (LAS int*)F.lds;
    const float* AFF = WSP(float, WS_AFF); int* INV = WSP(int, WS_INV); int* ROWTOK = WSP(int, WS_ROWTOK); float* GATEV = WSP(float, WS_GATEV);
    const int nitems = (l == 0) ? 256 : 128;
    for (int it = F.bid; it < nitems; it += F.G) {
        const int s = it >> 4, e = it & 15;
        const bool lat = s < 8;
        const int n = lat ? SEQ : CTXL, cap = lat ? 256 : 32, tok0 = lat ? s * SEQ : NLAT + (s - 8) * CTXL, rowbase = lat ? s * 256 : 2048 + (s - 8) * 32;
        const bool active = 4 * F.tid < n;
        unsigned k[4];
#pragma unroll
        for (int q = 0; q < 4; ++q) k[q] = active ? __float_as_uint(AFF[(size_t)(tok0 + 4 * F.tid + q) * 16 + e]) : 0u;
        __syncthreads();
        unsigned T = 0u; int par = 0;
        for (int bit = 30; bit >= 0; --bit) {
            const unsigned cand = T | (1u << bit);
            int cw = 0;
#pragma unroll
            for (int q = 0; q < 4; ++q) cw += __popcll(__ballot(k[q] >= cand));
            const int tot = block_count(cbuf, par, F.wave, F.lane, cw); par ^= 1;
            if (tot >= cap) T = cand;
        }
        int cw = 0;
#pragma unroll
        for (int q = 0; q < 4; ++q) cw += __popcll(__ballot(k[q] > T));
        const int c_gt = block_count(cbuf, par, F.wave, F.lane, cw); par ^= 1;
        int mg = 0, me = 0;
#pragma unroll
        for (int q = 0; q < 4; ++q) { mg += (k[q] > T) ? 1 : 0; me += (k[q] == T && active) ? 1 : 0; }
        int pk_ = mg | (me << 16), inc = pk_;
#pragma unroll
        for (int o = 1; o < 64; o <<= 1) { const int y = __shfl_up(inc, o); if (F.lane >= o) inc += y; }
        if (F.lane == 63) cbuf[16 + F.wave] = inc;
        __syncthreads();
        int base = 0;
#pragma unroll
        for (int q = 0; q < 8; ++q) base += (q < F.wave) ? cbuf[16 + q] : 0;
        int pre = base + inc - pk_; int pg = pre & 0xffff, pe = pre >> 16;
        if (active) {
#pragma unroll
            for (int q = 0; q < 4; ++q) {
                const int tok = tok0 + 4 * F.tid + q; int slot = -1;
                if (k[q] > T) { slot = pg; ++pg; }
                else if (k[q] == T) { if (c_gt + pe < cap) slot = c_gt + pe; ++pe; }
                if (slot >= 0) { ROWTOK[e * RPE + rowbase + slot] = tok; GATEV[e * RPE + rowbase + slot] = __uint_as_float(k[q]); }
                INV[(size_t)tok * 16 + e] = slot >= 0 ? rowbase + slot : -1;
            }
        }
        __syncthreads();
    }
    __syncthreads();
}

__device__ __forceinline__ void conv_items(Frame& F, int l, int first, int stride) {
    LAS float* gl = (LAS float*)F.lds;
    LAS float* ob = gl + 62 * 256;
    const bf16_t* CA = WSP(bf16_t, WS_CA); const bf16_t* CG = WSP(bf16_t, WS_CG); bf16_t* Y = WSP(bf16_t, WS_Y);
    const int nitems = (l == 0) ? 512 + 64 : 512;
    const int ch = F.tid & 255, th = F.tid >> 8;
    const float* conv_w = FIN(I_CW); const float* conv_b = FIN(I_CB); const float* conv_ln_g = FIN(I_CLG); const float* conv_ln_b = FIN(I_CLB);
    float w[31];
#pragma unroll
    for (int j = 0; j < 31; ++j) w[j] = conv_w[((size_t)l * 31 + j) * 256 + ch];
    const float cb = conv_b[l * 256 + ch];
    for (int it = first; it < nitems; it += stride) {
        const bool lat = it < 512;
        const int seqlen = lat ? SEQ : CTXL;
        const int b = lat ? it >> 6 : (it - 512) >> 3, t0 = lat ? (it & 63) * 32 : ((it - 512) & 7) * 32;
        const int tokb = lat ? b * SEQ : NLAT + b * CTXL;
        __syncthreads();
        for (int i = F.tid; i < 62 * 64; i += NTHR) {
            const int rr = i >> 6, c4 = (i & 63) * 4, t = t0 - 15 + rr;
            f32x4 g = (f32x4){0.f, 0.f, 0.f, 0.f};
            if (t >= 0 && t < seqlen) { const size_t o = (size_t)(tokb + t) * 256 + c4; const u32x2 a = *(const u32x2*)(CA + o), gg = *(const u32x2*)(CG + o);
                g[0] = bflo(a.x) * sigmoidf_(bflo(gg.x)); g[1] = bfhi(a.x) * sigmoidf_(bfhi(gg.x)); g[2] = bflo(a.y) * sigmoidf_(bflo(gg.y)); g[3] = bfhi(a.y) * sigmoidf_(bfhi(gg.y)); }
            *(LAS f32x4*)(gl + rr * 256 + c4) = g;
        }
        __syncthreads();
        for (int tt = 0; tt < 16; ++tt) {
            const LAS float* gp = gl + (th * 16 + tt) * 256 + ch;
            float o = cb;
#pragma unroll
            for (int j = 0; j < 31; ++j) o += w[j] * gp[j * 256];
            ob[(th * 16 + tt) * 256 + ch] = o;
        }
        __syncthreads();
        for (int tt = F.wave; tt < 32; tt += NWAVES) {
            const f32x4 v = *(const LAS f32x4*)(ob + tt * 256 + 4 * F.lane);
            const float mean = wave_sum((v[0] + v[1]) + (v[2] + v[3])) * (1.0f / 256.f);
            const f32x4 d = v - mean;
            const float var = wave_sum((d[0] * d[0] + d[1] * d[1]) + (d[2] * d[2] + d[3] * d[3])) * (1.0f / 256.f);
            const float rs = 1.0f / sqrtf(var + EPS);
            const f32x4 lg = *(const f32x4*)(conv_ln_g + l * 256 + 4 * F.lane), lb = *(const f32x4*)(conv_ln_b + l * 256 + 4 * F.lane);
            f32x4 y;
#pragma unroll
            for (int q = 0; q < 4; ++q) y[q] = siluf_(d[q] * rs * lg[q] + lb[q]);
            *(u32x2*)(Y + (size_t)(tokb + t0 + tt) * KOUT + 512 + 4 * F.lane) = pk4(y);
        }
    }
    __syncthreads();
}
__device__ __forceinline__ void ztrans_items(Frame& F, int l, int first, int stride) {
    LAS unsigned short* tl = (LAS unsigned short*)(F.lds + F.wave * (64 * 66 * 2));
    const bf16_t* FR = WSP(bf16_t, WS_FR); bf16_t* ZTL = WSP(bf16_t, WS_ZT); bf16_t* ZTC = WSP(bf16_t, WS_ZTC);
    const int nlat = 8 * 32 * 4, nctx = (l == 0) ? 8 * 4 * 4 : 0;
    for (int it = first; it < nlat + nctx; it += stride) {
        const bool lat = it < nlat; const int r = lat ? it : it - nlat;
        const int b = lat ? r >> 7 : r >> 4, tb = lat ? (r >> 2) & 31 : (r >> 2) & 3, cb = r & 3;
        const int tokb = (lat ? b * SEQ : NLAT + b * CTXL) + tb * 64;
#pragma unroll
        for (int i = 0; i < 8; ++i) { const int tt = (F.lane >> 3) + 8 * i, c8 = (F.lane & 7) * 8;
            const u32x4 v = *(const u32x4*)(FR + (size_t)(tokb + tt) * 256 + cb * 64 + c8);
#pragma unroll
            for (int q = 0; q < 4; ++q) { tl[(c8 + 2 * q) * 66 + tt] = (unsigned short)(v[q] & 0xffffu); tl[(c8 + 2 * q + 1) * 66 + tt] = (unsigned short)(v[q] >> 16); } }
        LDS_WAIT(); asm volatile("" ::: "memory");
        bf16_t* dst = lat ? ZTL + (size_t)(b * 256 + cb * 64) * SEQ + tb * 64 : ZTC + (size_t)(b * 256 + cb * 64) * SEQ + tb * 64;
        const int ldz = SEQ;
#pragma unroll
        for (int i = 0; i < 8; ++i) { const int cc = (F.lane >> 3) + 8 * i, t8 = (F.lane & 7) * 8; u32x4 o;
#pragma unroll
            for (int q = 0; q < 4; ++q) o[q] = (unsigned)tl[cc * 66 + t8 + 2 * q] | ((unsigned)tl[cc * 66 + t8 + 2 * q + 1] << 16);
            *(u32x4*)(dst + (size_t)cc * ldz + t8) = o; }
        LDS_WAIT(); asm volatile("" ::: "memory");
    }
}
__device__ __forceinline__ void finalize_h(Frame& F, int l) {
    const bf16_t* HF = WSP(bf16_t, WS_HF); const bf16_t* HB = WSP(bf16_t, WS_HB); const bf16_t* O = WSP(bf16_t, WS_O); bf16_t* Y = WSP(bf16_t, WS_Y);
    const int gw = F.bid * NWAVES + F.wave, ngw = F.G * NWAVES;
    const int ntok = (l == 0) ? NTOK : NLAT;
    float gh[8];
    const float* g_hnorm = FIN(I_GH);
#pragma unroll
    for (int q = 0; q < 8; ++q) gh[q] = g_hnorm[l * 512 + 8 * F.lane + q];
    for (int tok = gw; tok < ntok; tok += ngw) {
        const size_t o = (size_t)tok * 512 + 8 * F.lane;
        const u32x4 a = *(const u32x4*)(HF + o), b = *(const u32x4*)(HB + o), og = *(const u32x4*)(O + o);
        float h[8]; float ss = 0.f;
#pragma unroll
        for (int q = 0; q < 4; ++q) { h[2 * q] = bflo(a[q]) + bflo(b[q]); h[2 * q + 1] = bfhi(a[q]) + bfhi(b[q]); ss += h[2 * q] * h[2 * q] + h[2 * q + 1] * h[2 * q + 1]; }
#pragma unroll
        for (int s = 1; s < 16; s <<= 1) ss += __shfl_xor(ss, s);
        const float r = 1.0f / sqrtf(ss * (1.0f / 128.f) + EPS);
        u32x4 w;
#pragma unroll
        for (int q = 0; q < 4; ++q) w[q] = pk2(h[2 * q] * r * gh[2 * q] * bflo(og[q]), h[2 * q + 1] * r * gh[2 * q + 1] * bfhi(og[q]));
        *(u32x4*)(Y + (size_t)tok * KOUT + 8 * F.lane) = w;
    }
}

using pg8::Unit;
enum { GM_INPROJ = 0, GM_DFT, GM_OUT, GM_MOE1, GM_MOE2 };
struct GemmCtl {
    int mode, l, G, c; unsigned char* ws; const Args& A;
    __device__ __forceinline__ unsigned char* W() const { unsigned char* p = ws; asm volatile("" : "+s"(p)); return p; }
    __device__ __forceinline__ bool next(int i, Unit& u) const {
        const int L = i * G + c; int pm, pn;
        u.rows = nullptr; u.ex = 0;
        switch (mode) {
        case GM_INPROJ: {
            const int n0 = 64 * 11, npn = (l == 0) ? 11 : 6;
            if (L >= n0 + 8 * npn) return false;
            if (L < n0) pg8::map_tile(L, 64, 11, pm, pn); else { pg8::map_tile(L - n0, 8, npn, pm, pn); pm += 64; }
            u.A = (const char*)(W() + WS_XN) + (size_t)pm * 256 * D * 2; u.B = (const char*)(W() + WS_WIN) + ((size_t)l * NIN + pn * 256) * D * 2; u.K = D;
        } break;
        case GM_DFT: {
            const int nctx = (l == 0) ? 16 : 0;
            if (L >= 128 + nctx) return false;
            if (L < 128) { pg8::map_tile(L, 16, 8, pm, pn); u.A = (const char*)(W() + WS_FL) + (size_t)pm * 256 * SEQ * 2; u.B = (const char*)(W() + WS_ZT) + (size_t)pn * 256 * SEQ * 2; u.K = SEQ; }
            else { const int r = L - 128; pm = r & 1; pn = r >> 1; u.A = (const char*)(W() + WS_FC) + (size_t)pm * 256 * SEQ * 2; u.B = (const char*)(W() + WS_ZTC) + (size_t)pn * 256 * SEQ * 2; u.K = CTXL; u.ex = 1; }
        } break;
        case GM_OUT: {
            const int nM = (l == 0) ? 72 : 64;
            if (L >= nM * 4) return false;
            pg8::map_tile(L, nM, 4, pm, pn);
            u.A = (const char*)(W() + WS_Y) + (size_t)pm * 256 * KOUT * 2; u.B = (const char*)(W() + WS_WOUT) + ((size_t)l * D + pn * 256) * KOUT * 2; u.K = KOUT;
        } break;
        case GM_MOE1: {
            const int nMe = (l == 0) ? 9 : 8; int pmg;
            if (L >= NE * nMe * 8) return false;
            pg8::map_tile(L, NE * nMe, 8, pmg, pn);
            const int e = pmg / nMe; pm = pmg % nMe;
            u.A = (const char*)(W() + WS_XN); u.rows = (const int*)(W() + WS_ROWTOK) + e * RPE + pm * 256; u.B = (const char*)(W() + WS_WGU) + ((size_t)e * 2048 + pn * 256) * D * 2; u.K = D; u.ex = e;
        } break;
        default: {
            const int nMe = (l == 0) ? 9 : 8; int pmg;
            if (L >= NE * nMe * 4) return false;
            pg8::map_tile(L, NE * nMe, 4, pmg, pn);
            const int e = pmg / nMe; pm = pmg % nMe;
            u.A = (const char*)(W() + WS_HID) + ((size_t)e * RPE + pm * 256) * D * 2; u.B = (const char*)(W() + WS_WD) + ((size_t)e * D + pn * 256) * D * 2; u.K = D; u.ex = e;
        } break;
        }
        u.pm = pm; u.pn = pn;
        return true;
    }
    struct CxIn { bf16_t* dst; int ld; float sc; int act; };
    __device__ __forceinline__ CxIn prep_in(const Unit& u) const {
        CxIn c; const int pn = u.pn; c.sc = 1.f; c.act = 0; size_t off; int cb;
        if (pn < 2) { off = WS_Q; c.ld = 512; cb = pn * 256; }
        else if (pn < 4) { off = WS_K; c.ld = 512; cb = (pn - 2) * 256; c.sc = 0.08838834764831845f; }
        else if (pn < 6) { off = WS_V; c.ld = 512; cb = (pn - 4) * 256; }
        else if (pn < 8) { off = WS_O; c.ld = 512; cb = (pn - 6) * 256; c.act = 1; }
        else if (pn == 8) { off = WS_CA; c.ld = 256; cb = 0; }
        else if (pn == 9) { off = WS_CG; c.ld = 256; cb = 0; }
        else { off = WS_FR; c.ld = 256; cb = 0; }
        c.dst = (bf16_t*)(W() + off) + (size_t)u.pm * 256 * c.ld + cb;
        return c;
    }
    __device__ __forceinline__ void store_in(const CxIn& c, int r, int col, f32x4 v0, f32x4 v1) const {
        if (c.act) {
#pragma unroll
            for (int q = 0; q < 4; ++q) { v0[q] = sigmoidf_(v0[q]); v1[q] = sigmoidf_(v1[q]); }
        } else { v0 = v0 * c.sc; v1 = v1 * c.sc; }
        bf16_t* p = c.dst + (size_t)r * c.ld + col;
        *(u32x2*)p = pk4(v0); *(u32x2*)(p + 16) = pk4(v1);
    }
    __device__ __forceinline__ bf16_t* prep_dft(const Unit& u) const {
        int part, tokb;
        if (u.ex == 0) { part = u.pm >> 3; tokb = u.pn * SEQ + (u.pm & 7) * 256; } else { part = u.pm; tokb = NLAT + u.pn * CTXL; }
        return (bf16_t*)(W() + WS_Y) + (size_t)tokb * KOUT + 768 + part * 256;
    }
    __device__ __forceinline__ void store_dft(bf16_t* dst, int r, int col, f32x4 v0, f32x4 v1) const {
        bf16_t* p = dst + (size_t)r * KOUT + col;
        *(u32x2*)p = pk4(v0); *(u32x2*)(p + 16) = pk4(v1);
    }
    struct CxOut { const float* src; float* dst; const float* gt; };
    __device__ __forceinline__ CxOut prep_out(const Unit& u) const {
        CxOut c; const int tok0 = u.pm * 256, col0 = u.pn * 256;
        if (l == 0) c.src = (tok0 < NLAT ? arg_in(A, I_X) + (size_t)tok0 * D : arg_in(A, I_CTX) + (size_t)(tok0 - NLAT) * D) + col0;
        else c.src = (const float*)(W() + WS_X) + (size_t)tok0 * D + col0;
        c.dst = (float*)(W() + WS_X) + (size_t)tok0 * D + col0;
        c.gt = (const float*)(W() + WS_MOD) + ((size_t)l * 9 + mod_row(tok0)) * 6144 + 2 * 1024 + col0;
        return c;
    }
    __device__ __forceinline__ void store_out(const CxOut& c, int r, int col, f32x4 v0, f32x4 v1) const {
        const size_t o = (size_t)r * D + col;
        const f32x4 g0 = *(const f32x4*)(c.gt + col), g1 = *(const f32x4*)(c.gt + col + 16);
        const f32x4 s0 = *(const f32x4*)(c.src + o), s1 = *(const f32x4*)(c.src + o + 16);
        *(f32x4*)(c.dst + o) = s0 + g0 * v0; *(f32x4*)(c.dst + o + 16) = s1 + g1 * v1;
    }
    __device__ __forceinline__ bf16_t* prep_m1(const Unit& u) const { return (bf16_t*)(W() + WS_HID) + ((size_t)u.ex * RPE + u.pm * 256) * D + u.pn * 128; }
    __device__ __forceinline__ void store_m1(bf16_t* dst, int r, int col, f32x4 v0, f32x4 v1) const {
        f32x4 h;
#pragma unroll
        for (int q = 0; q < 4; ++q) h[q] = siluf_(v0[q]) * v1[q];
        *(u32x2*)(dst + (size_t)r * D + (col >> 5) * 16 + (col & 15)) = pk4(h);
    }
    struct CxM2 { bf16_t* dst; const float* g; };
    __device__ __forceinline__ CxM2 prep_m2(const Unit& u) const { CxM2 c; c.dst = (bf16_t*)(W() + WS_YS) + ((size_t)u.ex * RPE + u.pm * 256) * D + u.pn * 256; c.g = (const float*)(W() + WS_GATEV) + u.ex * RPE + u.pm * 256; return c; }
    __device__ __forceinline__ void store_m2(const CxM2& c, int r, int col, f32x4 v0, f32x4 v1) const {
        const float g = c.g[r];
        bf16_t* p = c.dst + (size_t)r * D + col;
        *(u32x2*)p = pk4(v0 * g); *(u32x2*)(p + 16) = pk4(v1 * g);
    }
#define EPI_WALK(PREP, STORE) do { const auto cx = PREP(u); _Pragma("unroll") for (int ai = 0; ai < 2; ++ai) _Pragma("unroll") for (int m = 0; m < 4; ++m) _Pragma("unroll") for (int bj = 0; bj < 2; ++bj) \
        STORE(cx, ai * 128 + wr * 64 + m * 16 + fr, bj * 128 + wc * 32 + 4 * fq, acc[ai][bj][m][0], acc[ai][bj][m][1]); } while (0)
    __device__ __forceinline__ void run(const f32x4 (&acc)[2][2][4][2], const Unit& u, int wr, int wc, int fr, int fq) const {
        switch (mode) {
        case GM_INPROJ: EPI_WALK(prep_in, store_in); break;
        case GM_DFT: EPI_WALK(prep_dft, store_dft); break;
        case GM_OUT: EPI_WALK(prep_out, store_out); break;
        case GM_MOE1: EPI_WALK(prep_m1, store_m1); break;
        default: EPI_WALK(prep_m2, store_m2); break;
        }
    }
    __device__ __forceinline__ void store1(const Unit& u, int r, int c, f32x4 v0, f32x4 v1) const {
        switch (mode) {
        case GM_INPROJ: store_in(prep_in(u), r, c, v0, v1); break;
        case GM_DFT: store_dft(prep_dft(u), r, c, v0, v1); break;
        case GM_OUT: store_out(prep_out(u), r, c, v0, v1); break;
        case GM_MOE1: store_m1(prep_m1(u), r, c, v0, v1); break;
        default: store_m2(prep_m2(u), r, c, v0, v1); break;
        }
    }
};

__device__ __forceinline__ void scan_simt(Frame& F, int l) {
    if (F.bid >= 64) return;
    const int b = F.bid >> 3, h = (F.bid >> 1) & 3, dir = F.bid & 1;
    LAS float* qs = (LAS float*)F.lds; LAS float* ks = qs + 64 * 132; LAS float* vs = ks + 64 * 132; LAS float* st = vs + 64 * 132;
    LAS float* sm = st + 64 * 65;
    LAS float* as_ = sm; LAS float* Ms = sm + 64; LAS float* wint = sm + 128; LAS float* enm = sm + 192; LAS float* wst = sm + 256; LAS float* denom = sm + 320;
    LAS float* nvec = sm + 384; LAS float* ig = sm + 512; LAS float* lf = sm + 576; LAS int* toks = (LAS int*)(sm + 640); LAS float* scal = sm + 704;
    const bf16_t* Q = WSP(bf16_t, WS_Q); const bf16_t* K = WSP(bf16_t, WS_K); const bf16_t* V = WSP(bf16_t, WS_V); const float* GATES = WSP(float, WS_GATES);
    bf16_t* H = dir ? WSP(bf16_t, WS_HB) : WSP(bf16_t, WS_HF);
    float Creg[32];
#pragma unroll
    for (int i = 0; i < 32; ++i) Creg[i] = 0.f;
    float m_st = 0.f;
    if (F.tid < 128) nvec[F.tid] = 0.f;
    __syncthreads();
    for (int cc = 0; cc < 36; ++cc) {
        int tid = F.tid; asm volatile("" : "+v"(tid));
        const int lane = tid & 63, e = tid >> 2, dq = tid & 3;
        const bool isctx = cc < 4;
        const int c = isctx ? (dir ? 3 - cc : cc) : (dir ? 35 - cc : cc - 4);
        const bool want_out = !(isctx && l == 1);
        if (tid < 64) { const int j = tid;
            const int tok = isctx ? NLAT + b * CTXL + c * 64 + j : (h < 2 ? b * SEQ + c * 64 + j : b * SEQ + (j & 31) * 64 + 2 * c + (j >> 5));
            toks[j] = tok; const float* g = GATES + (size_t)tok * 16 + h * 4 + 2 * dir; ig[j] = g[0]; lf[j] = logsigmoidf_(g[1]); }
        __syncthreads();
        for (int it = tid; it < 1024; it += NTHR) { const int j = it >> 4, c8 = (it & 15) * 8; const size_t o = (size_t)toks[j] * 512 + h * 128 + c8;
            const u32x4 qv = *(const u32x4*)(Q + o), kv = *(const u32x4*)(K + o), vv = *(const u32x4*)(V + o);
#pragma unroll
            for (int q = 0; q < 4; ++q) { qs[j * 132 + c8 + 2 * q] = bflo(qv[q]); qs[j * 132 + c8 + 2 * q + 1] = bfhi(qv[q]); ks[j * 132 + c8 + 2 * q] = bflo(kv[q]); ks[j * 132 + c8 + 2 * q + 1] = bfhi(kv[q]);
                vs[j * 132 + c8 + 2 * q] = bflo(vv[q]); vs[j * 132 + c8 + 2 * q + 1] = bfhi(vv[q]); } }
        if (F.wave == 0) {
            const int p = dir ? 63 - lane : lane;
            float x = lf[p];
#pragma unroll
            for (int o = 1; o < 64; o <<= 1) { const float y = __shfl_up(x, o); if (lane >= o) x += y; }
            const float a = ig[p] - x; float cm = a;
#pragma unroll
            for (int o = 1; o < 64; o <<= 1) { const float y = __shfl_up(cm, o); if (lane >= o) cm = fmaxf(cm, y); }
            const float M = fmaxf(m_st, cm), Mend = __shfl(M, 63), blast = __shfl(x, 63);
            as_[p] = a; Ms[p] = M; wint[p] = expf(m_st - M); enm[p] = expf(-(x + M)); wst[p] = expf(a - Mend);
            if (lane == 0) { scal[0] = Mend; scal[1] = blast; }
        }
        __syncthreads();
        const float Mend = scal[0], blast = scal[1], decay = expf(m_st - Mend);
        if (want_out) {
            { const int t = tid >> 3, sg = tid & 7; float sacc[8];
#pragma unroll
                for (int i = 0; i < 8; ++i) sacc[i] = 0.f;
                for (int d4 = 0; d4 < 32; ++d4) { const f32x4 q4 = *(const LAS f32x4*)(qs + t * 132 + d4 * 4);
#pragma unroll
                    for (int i = 0; i < 8; ++i) { const f32x4 k4 = *(const LAS f32x4*)(ks + (i * 8 + sg) * 132 + d4 * 4); sacc[i] += (q4[0] * k4[0] + q4[1] * k4[1]) + (q4[2] * k4[2] + q4[3] * k4[3]); } }
#pragma unroll
                for (int i = 0; i < 8; ++i) { const int s = i * 8 + sg; const bool valid = dir ? (s >= t) : (s <= t); st[t * 65 + s] = valid ? sacc[i] * expf(as_[s] - Ms[t]) : 0.f; } }
            __syncthreads();
            if (tid < 64) { const int t = tid; float qn = 0.f, ssum = 0.f;
                for (int d = 0; d < 128; ++d) qn += qs[t * 132 + d] * nvec[d];
                for (int s = 0; s < 64; ++s) ssum += st[t * 65 + s];
                const float den = wint[t] * qn + ssum; denom[t] = fmaxf(fabsf(den), enm[t]); }
            float mine[16];
#pragma unroll
            for (int tt = 0; tt < 16; ++tt) {
                mine[tt] = 0.f;
#pragma unroll
                for (int u = 0; u < 4; ++u) { const int t = 4 * tt + u; float p = 0.f;
#pragma unroll
                    for (int i4 = 0; i4 < 8; ++i4) { const f32x4 q4 = *(const LAS f32x4*)(qs + t * 132 + dq * 32 + i4 * 4); p += (Creg[4 * i4] * q4[0] + Creg[4 * i4 + 1] * q4[1]) + (Creg[4 * i4 + 2] * q4[2] + Creg[4 * i4 + 3] * q4[3]); }
                    p += __shfl_xor(p, 1); p += __shfl_xor(p, 2);
                    mine[tt] = (u == dq) ? p : mine[tt]; asm volatile("" ::: "memory"); }
            }
#pragma unroll
            for (int tt = 0; tt < 16; ++tt) { const int t = 4 * tt + dq; float intra = 0.f;
#pragma unroll 8
                for (int s = 0; s < 64; ++s) intra += st[t * 65 + s] * vs[s * 132 + e];
                mine[tt] = wint[t] * mine[tt] + intra; asm volatile("" ::: "memory"); }
            __syncthreads();
#pragma unroll
            for (int tt = 0; tt < 16; ++tt) { const int t = 4 * tt + dq; H[(size_t)toks[t] * 512 + h * 128 + e] = (bf16_t)f2bf(mine[tt] / denom[t]); }
        }
#pragma unroll
        for (int i = 0; i < 32; ++i) Creg[i] *= decay;
#pragma unroll 2
        for (int s = 0; s < 64; ++s) { const float wv = wst[s] * vs[s * 132 + e];
#pragma unroll
            for (int i4 = 0; i4 < 8; ++i4) { const f32x4 k4 = *(const LAS f32x4*)(ks + s * 132 + dq * 32 + i4 * 4); Creg[4 * i4] += wv * k4[0]; Creg[4 * i4 + 1] += wv * k4[1]; Creg[4 * i4 + 2] += wv * k4[2]; Creg[4 * i4 + 3] += wv * k4[3]; } }
        float nn = 0.f;
        if (tid < 128) { nn = decay * nvec[tid]; for (int s = 0; s < 64; ++s) nn += wst[s] * ks[s * 132 + tid]; }
        __syncthreads();
        if (tid < 128) nvec[tid] = nn;
        m_st = blast + Mend;
        __syncthreads();
    }
}

__device__ __forceinline__ int scan_tok(bool isctx, int b, int h, int c, int j) {
    return isctx ? NLAT + b * CTXL + c * 64 + j : (h < 2 ? b * SEQ + c * 64 + j : b * SEQ + (j & 31) * 64 + 2 * c + (j >> 5));
}
__device__ __forceinline__ int img256(int row, int chunk) { return row * 256 + ((chunk ^ (row & 15)) << 4); }
__device__ __forceinline__ int img128(int row, int chunk) { return row * 128 + ((chunk ^ ((row >> 1) & 7)) << 4); }
__device__ __forceinline__ int off_b(int row, int ch) { return 256 * row + 16 * (ch ^ (((row & 3) << 2) | ((row >> 2) & 3))); }
__device__ __forceinline__ int rowrd16(int lane, int rb, int ks) { return off_b((lane & 15) + 16 * rb, 4 * ks + (lane >> 4)); }
__device__ __forceinline__ int trrd16(int lane, int c, int ks, int t) { const int g = lane >> 4, q = (lane & 15) >> 2, p = lane & 3;
    return off_b(32 * ks + 8 * g + 4 * t + q, 2 * c + (p >> 1)) + 8 * (p & 1); }
typedef short s16x4 __attribute__((ext_vector_type(4)));
__device__ __forceinline__ bf16x8 tr_frag(LAS unsigned char* img, int lane, int c, int ks, unsigned zv) {
    const s16x4 lo = __builtin_amdgcn_ds_read_tr16_b64_v4i16((LAS s16x4*)(img + trrd16(lane, c, ks, 0)));
    const s16x4 hi = __builtin_amdgcn_ds_read_tr16_b64_v4i16((LAS s16x4*)(img + trrd16(lane, c, ks, 1)));
    u32x2 a = __builtin_bit_cast(u32x2, lo), b = __builtin_bit_cast(u32x2, hi);
    a.x ^= zv; a.y ^= zv; b.x ^= zv; b.y ^= zv;
    const u32x4 r = (u32x4){a.x, a.y, b.x, b.y};
    return __builtin_bit_cast(bf16x8, r);
}
__device__ __forceinline__ void scan_mfma(Frame& F, int l) {
    if (F.bid >= 64) return;
    const int b = F.bid >> 3, h = (F.bid >> 1) & 3, dir = F.bid & 1;
    LAS unsigned char* L = F.lds;
    constexpr int O_QI = 0, O_KI = 16384, O_VI = 32768, O_ST = 49152, O_CL = 57344, O_HO = 94208, O_SM = 110592;
    LAS float* GV = (LAS float*)(L + O_SM);
    LAS float* SC = GV + 36 * 192;
    LAS float* DEN = SC + 36 * 4;
    const bf16_t* Q = WSP(bf16_t, WS_Q); const bf16_t* K = WSP(bf16_t, WS_K); const bf16_t* V = WSP(bf16_t, WS_V); const float* GATES = WSP(float, WS_GATES);
    bf16_t* H = dir ? WSP(bf16_t, WS_HB) : WSP(bf16_t, WS_HF);
    const int w = F.wave;
    { unsigned z0 = 0u; asm volatile("" : "+v"(z0));
      for (int i = F.tid; i < 36864 / 16; i += NTHR) *(LAS u32x4*)(L + O_CL + i * 16) = (u32x4){z0, z0, z0, z0}; }
    for (int cc = w; cc < 36; cc += NWAVES) {
        const bool ic = cc < 4; const int c_ = ic ? (dir ? 3 - cc : cc) : (dir ? 35 - cc : cc - 4), p_ = dir ? 63 - F.lane : F.lane;
        const f32x2 g = *(const f32x2*)(GATES + (size_t)scan_tok(ic, b, h, c_, p_) * 16 + h * 4 + 2 * dir);
        float x = logsigmoidf_(g[1]);
#pragma unroll
        for (int o = 1; o < 64; o <<= 1) { const float y = __shfl_up(x, o); if (F.lane >= o) x += y; }
        const float a = g[0] - x; float cm = a;
#pragma unroll
        for (int o = 1; o < 64; o <<= 1) { const float y = __shfl_up(cm, o); if (F.lane >= o) cm = fmaxf(cm, y); }
        GV[cc * 192 + p_] = a; GV[cc * 192 + 64 + p_] = x; GV[cc * 192 + 128 + p_] = cm;
        if (F.lane == 63) { SC[cc * 4 + 3] = x; SC[cc * 4 + 1] = cm; }
    }
    __syncthreads();
    if (F.tid == 0) { float m = 0.f;
        for (int cc = 0; cc < 36; ++cc) { const float Mend = fmaxf(m, SC[cc * 4 + 1]); SC[cc * 4 + 0] = m; SC[cc * 4 + 1] = Mend; SC[cc * 4 + 2] = expf(m - Mend); m = SC[cc * 4 + 3] + Mend; } }
    f32x4 accC[9];
#pragma unroll
    for (int i = 0; i < 9; ++i) accC[i] = (f32x4){0.f, 0.f, 0.f, 0.f};
    u32x4 pq[2], pk[2], pv[2];
#define SC_LOAD(CC) do { const int cc_ = (CC); const bool ic_ = cc_ < 4; const int c_ = ic_ ? (dir ? 3 - cc_ : cc_) : (dir ? 35 - cc_ : cc_ - 4); \
        _Pragma("unroll") for (int i_ = 0; i_ < 2; ++i_) { const int it_ = tid + NTHR * i_, s_ = it_ >> 4, c8_ = it_ & 15; const size_t o_ = (size_t)scan_tok(ic_, b, h, c_, s_) * 512 + h * 128 + c8_ * 8; \
            pq[i_] = *(const u32x4*)(Q + o_); pk[i_] = *(const u32x4*)(K + o_); pv[i_] = *(const u32x4*)(V + o_); } } while (0)
#define SC_WRITE() do { _Pragma("unroll") for (int i_ = 0; i_ < 2; ++i_) { const int it_ = tid + NTHR * i_, s_ = it_ >> 4, c8_ = it_ & 15; \
            *(LAS u32x4*)(L + O_QI + img256(s_, c8_)) = pq[i_]; *(LAS u32x4*)(L + O_KI + off_b(s_, c8_)) = pk[i_]; *(LAS u32x4*)(L + O_VI + off_b(s_, c8_)) = pv[i_]; } } while (0)
#define SC_MFMA(A, B, C) __builtin_amdgcn_mfma_f32_16x16x32_bf16((A), (B), (C), 0, 0, 0)
#define SC_BAR() do { asm volatile("s_waitcnt lgkmcnt(0)" ::: "memory"); __builtin_amdgcn_s_barrier(); asm volatile("" ::: "memory"); } while (0)
    {
        const int tid = F.tid;
        SC_LOAD(0);
        __syncthreads();
        SC_WRITE();
        __syncthreads();
    }
    for (int cc = 0; cc < 36; ++cc) {
        int tid = F.tid; asm volatile("" : "+v"(tid));
        const int lane = tid & 63, fr = lane & 15, fq = lane >> 4;
        const bool isctx = cc < 4, want_out = !(isctx && l == 1), more = cc + 1 < 36;
        const int c = isctx ? (dir ? 3 - cc : cc) : (dir ? 35 - cc : cc - 4);
        const LAS float* vb = GV + cc * 192; const float m_in = SC[cc * 4 + 0];
        unsigned zv = 0u; asm volatile("" : "+v"(zv));
        const short one_ = (fr == 0) ? (short)0x3F80 : (short)0;
        const bf16x8 ONES = (bf16x8){one_, one_, one_, one_, one_, one_, one_, one_};
        if (more) SC_LOAD(cc + 1);
        if (want_out) {
            const int tb = w >> 1, sb = 2 * (w & 1);
            f32x4 s0 = (f32x4){0.f, 0.f, 0.f, 0.f}, s1 = s0;
#pragma unroll
            for (int ks = 0; ks < 4; ++ks) {
                const bf16x8 fy = *(const LAS bf16x8*)(L + O_QI + img256(tb * 16 + fr, ks * 4 + fq));
                const bf16x8 fx0 = *(const LAS bf16x8*)(L + O_KI + rowrd16(lane, sb, ks)), fx1 = *(const LAS bf16x8*)(L + O_KI + rowrd16(lane, sb + 1, ks));
                s0 = SC_MFMA(fx0, fy, s0); s1 = SC_MFMA(fx1, fy, s1); }
            const int t = tb * 16 + fr; const float Mt = fmaxf(m_in, vb[128 + t]);
#pragma unroll
            for (int i = 0; i < 2; ++i) { const int sr0 = (sb + i) * 16 + 4 * fq; const f32x4 a4 = *(const LAS f32x4*)(vb + sr0); const f32x4 sv = i ? s1 : s0; f32x4 o;
#pragma unroll
                for (int r = 0; r < 4; ++r) { const int sI = sr0 + r; const bool valid = dir ? (sI >= t) : (sI <= t); o[r] = valid ? sv[r] * __expf(a4[r] - Mt) : 0.f; }
                *(LAS u32x2*)(L + O_ST + img128(t, sr0 >> 3) + (sr0 & 7) * 2) = pk4(o); }
        }
        SC_BAR();
        {
            const float decay = SC[cc * 4 + 2], Mend = SC[cc * 4 + 1];
#pragma unroll
            for (int et = 0; et < 9; ++et) accC[et] = accC[et] * decay;
#pragma unroll
            for (int ks = 0; ks < 2; ++ks) {
                const bf16x8 kx = tr_frag(L + O_KI, lane, w, ks, zv);
                const f32x4 a0 = *(const LAS f32x4*)(vb + 32 * ks + 8 * fq), a1 = *(const LAS f32x4*)(vb + 32 * ks + 8 * fq + 4);
                u32x4 ax;
#pragma unroll
                for (int j = 0; j < 4; ++j) { const float w0 = __expf((j < 2 ? a0[2 * j] : a1[2 * j - 4]) - Mend), w1 = __expf((j < 2 ? a0[2 * j + 1] : a1[2 * j - 3]) - Mend);
                    ax[j] = pk2(bf2f((unsigned short)kx[2 * j]) * w0, bf2f((unsigned short)kx[2 * j + 1]) * w1); }
                const bf16x8 axf = __builtin_bit_cast(bf16x8, ax);
#pragma unroll
                for (int et = 0; et < 8; ++et) { const bf16x8 fv = tr_frag(L + O_VI, lane, et, ks, zv); accC[et] = SC_MFMA(axf, fv, accC[et]); }
                accC[8] = SC_MFMA(axf, ONES, accC[8]);
            }
        }
        f32x4 num[4];
        if (want_out) {
            bf16x8 ac[4], av[2];
#pragma unroll
            for (int ks = 0; ks < 4; ++ks) ac[ks] = *(const LAS bf16x8*)(L + O_CL + img256(w * 16 + fr, ks * 4 + fq));
#pragma unroll
            for (int ks = 0; ks < 2; ++ks) av[ks] = tr_frag(L + O_VI, lane, w, ks, zv);
#pragma unroll
            for (int tb = 0; tb < 4; ++tb) {
                f32x4 nI = (f32x4){0.f, 0.f, 0.f, 0.f}, nS = nI;
#pragma unroll
                for (int ks = 0; ks < 4; ++ks) { const bf16x8 fy = *(const LAS bf16x8*)(L + O_QI + img256(tb * 16 + fr, ks * 4 + fq)); nI = SC_MFMA(ac[ks], fy, nI); }
#pragma unroll
                for (int ks = 0; ks < 2; ++ks) { const bf16x8 fs = *(const LAS bf16x8*)(L + O_ST + img128(tb * 16 + fr, ks * 4 + fq)); nS = SC_MFMA(av[ks], fs, nS); }
                num[tb] = nI * __expf(m_in - fmaxf(m_in, vb[128 + tb * 16 + fr])) + nS;
            }
            if (w < 4) {
                f32x4 dI = (f32x4){0.f, 0.f, 0.f, 0.f}, dS = dI;
#pragma unroll
                for (int ks = 0; ks < 4; ++ks) { const bf16x8 a8 = *(const LAS bf16x8*)(L + O_CL + img256(128 + fr, ks * 4 + fq)); const bf16x8 fy = *(const LAS bf16x8*)(L + O_QI + img256(w * 16 + fr, ks * 4 + fq)); dI = SC_MFMA(a8, fy, dI); }
#pragma unroll
                for (int ks = 0; ks < 2; ++ks) { const bf16x8 fs = *(const LAS bf16x8*)(L + O_ST + img128(w * 16 + fr, ks * 4 + fq)); dS = SC_MFMA(ONES, fs, dS); }
                const int t = w * 16 + fr; const float Mt = fmaxf(m_in, vb[128 + t]); const float den = __expf(m_in - Mt) * dI[0] + dS[0];
                if (lane < 16) DEN[t] = fmaxf(fabsf(den), __expf(-(vb[64 + t] + Mt)));
            }
        }
        SC_BAR();
        if (want_out) {
#pragma unroll
            for (int tb = 0; tb < 4; ++tb) { const int t = tb * 16 + fr, e0 = w * 16 + 4 * fq; const float rd = 1.0f / DEN[t];
                *(LAS u32x2*)(L + O_HO + img256(t, e0 >> 3) + (e0 & 7) * 2) = pk4(num[tb] * rd); }
        }
#pragma unroll
        for (int et = 0; et < 9; ++et) { const int d0 = w * 16 + 4 * fq; *(LAS u32x2*)(L + O_CL + img256(et * 16 + fr, d0 >> 3) + (d0 & 7) * 2) = pk4(accC[et]); }
        if (more) SC_WRITE();
        SC_BAR();
        if (want_out) {
            const int t = tid >> 3; bf16_t* hp = H + (size_t)scan_tok(isctx, b, h, c, t) * 512 + h * 128;
#pragma unroll
            for (int i = 0; i < 2; ++i) { const int ch = (tid & 7) * 2 + i; *(u32x4*)(hp + ch * 8) = *(const LAS u32x4*)(L + O_HO + img256(t, ch)); }
        }
    }
#undef SC_LOAD
#undef SC_WRITE
#undef SC_MFMA
#undef SC_BAR
}

__device__ __forceinline__ void helper_barrier(Frame& F, unsigned* cnt, unsigned nhelpers) {
    asm volatile("s_waitcnt vmcnt(0)" ::: "memory");
    __syncthreads();
    if (F.tid == 0) {
        __builtin_amdgcn_fence(__ATOMIC_RELEASE, "agent");
        asm volatile("s_waitcnt vmcnt(0)" ::: "memory");
        __hip_atomic_fetch_add(cnt, 1u, __ATOMIC_RELAXED, __HIP_MEMORY_SCOPE_AGENT);
        unsigned sp = 0;
        while (__hip_atomic_load(cnt, __ATOMIC_RELAXED, __HIP_MEMORY_SCOPE_AGENT) < nhelpers) { __builtin_amdgcn_s_sleep(2); if (++sp > (1u << 22)) break; }
        __builtin_amdgcn_fence(__ATOMIC_ACQUIRE, "agent");
        asm volatile("s_waitcnt vmcnt(0)" ::: "memory");
    }
    __syncthreads();
}

constexpr int NPHASES = 20;
enum { K_PREP = 0, K_NORM1, K_INPROJ, K_MIX1, K_MIX2, K_OUTPROJ, K_NORM2, K_TOPK, K_MOE1, K_MOE2, K_COMBINE };

__global__ void __launch_bounds__(NTHR, 2) fwd_kernel(Args args) {
    extern __shared__ __attribute__((aligned(16))) unsigned char lds_raw[];
    Frame F{(LAS unsigned char*)lds_raw, (int)threadIdx.x, (int)(threadIdx.x & 63), __builtin_amdgcn_readfirstlane((int)(threadIdx.x >> 6)), (int)gridDim.x, (int)blockIdx.x, args.ws, args};
    volatile LAS unsigned* MISC = (volatile LAS unsigned*)(F.lds + LDSCTL_OFF);
    if (F.tid < 16) MISC[F.tid] = 0u;
    __syncthreads();
    XcdBarrier bar; bar.bar = (unsigned*)(F.ws + WS_CTL); bar.x = 0; bar.st = MISC;
    const int lo = args.ph_lo, hi = args.ph_hi;
    if (hi - lo > 1) bar = xcd_barrier_post((unsigned*)(F.ws + WS_CTL), MISC);
    for (int ph = lo; ph < hi; ++ph) {
        int l, kind;
        if (ph == 0) { l = 0; kind = K_PREP; } else if (ph == 1) { l = 0; kind = K_NORM1; } else if (ph < 11) { l = 0; kind = K_INPROJ + (ph - 2); } else { l = 1; kind = K_INPROJ + (ph - 11); }
#ifndef PHMASK
#define PHMASK 0xFFFF
#endif
#define PHON(k) ((PHMASK >> (k)) & 1)
#ifndef REPMASK
#define REPMASK 0
#endif
        int nrep_ = 1 + ((REPMASK >> kind) & 1); asm volatile("" : "+s"(nrep_));
        for (int rep_ = 0; rep_ < nrep_; ++rep_) {
        if (rep_) xcd_barrier(bar);
        { int t_ = threadIdx.x, b_ = blockIdx.x; unsigned char* w_ = args.ws; asm volatile("" : "+v"(t_)); asm volatile("" : "+s"(b_)); asm volatile("" : "+s"(w_));
          F.tid = t_; F.lane = t_ & 63; F.wave = __builtin_amdgcn_readfirstlane(t_ >> 6); F.bid = b_; F.ws = w_; }
        l = __builtin_amdgcn_readfirstlane(l); kind = __builtin_amdgcn_readfirstlane(kind); asm volatile("" : "+s"(l)); asm volatile("" : "+s"(kind));
        unsigned char* ws = F.ws;
        bool run_gemm = (kind == K_INPROJ || kind == K_OUTPROJ || kind == K_MOE1 || kind == K_MOE2);
        int gm = kind == K_INPROJ ? GM_INPROJ : kind == K_OUTPROJ ? GM_OUT : kind == K_MOE1 ? GM_MOE1 : GM_MOE2, gc = F.bid, gG = F.G;
        const bool helper = (kind == K_MIX1) && (F.bid >= 64);
        switch (kind) {
        case K_PREP: if (PHON(0)) phase_prep(F); break;
        case K_NORM1: if (PHON(1)) phase_norm1_l0(F); break;
        case K_MIX1: if (PHON(3)) {
            if (!helper) scan_mfma(F, l);
            else { const int hb = F.bid - 64, hg = F.G - 64;
                conv_items(F, l, hb, hg);
                ztrans_items(F, l, hb * NWAVES + F.wave, hg * NWAVES);
                helper_barrier(F, (unsigned*)(ws + WS_CTL) + 8192 + 64 * l + 64 * 2 * rep_, (unsigned)hg);
                run_gemm = true; gm = GM_DFT; gc = hb; gG = hg; }
        } break;
        case K_MIX2: if (PHON(4)) finalize_h(F, l); break;
        case K_NORM2: if (PHON(6)) phase_norm2(F, l); break;
        case K_TOPK: if (PHON(7)) phase_topk(F, l); break;
        case K_COMBINE: if (PHON(10)) phase_combine(F, l); break;
        default: break;
        }
        if (run_gemm && PHON(2)) {
            GemmCtl S{gm, l, gG, gc, ws, F.A};
            const int ld = gm == GM_DFT ? SEQ : gm == GM_OUT ? KOUT : D;
            GEMM_PHASE(F.lds, ld, ld, S, S);
        }
        if (helper && PHON(3)) convert_moe_weights(F, l, (F.bid - 64) * NWAVES + F.wave, (F.G - 64) * NWAVES);
        }
        if (ph + 1 < hi) xcd_barrier(bar);
    }
}

extern "C" void kernel_launch(void* const* d_in, const int* in_sizes, int n_in, void* d_out, int out_size, void* d_ws, size_t ws_size, hipStream_t stream) {
    static int grid = 0;
    if (grid == 0) {
        if (n_in != 21 || out_size != NLAT * D || ws_size < WS_END) { fprintf(stderr, "kernel_launch: unexpected shapes (n_in %d out %d ws %zu need %zu)\n", n_in, out_size, ws_size, (size_t)WS_END); grid = -1; return; }
        int dev = 0, cus = 0, per_cu = 0;
        hipGetDevice(&dev); hipDeviceGetAttribute(&cus, hipDeviceAttributeMultiprocessorCount, dev);
        if (hipFuncSetAttribute((const void*)fwd_kernel, hipFuncAttributeMaxDynamicSharedMemorySize, LDS_BYTES) != hipSuccess) { fprintf(stderr, "kernel_launch: hipFuncSetAttribute failed\n"); grid = -1; return; }
        hipOccupancyMaxActiveBlocksPerMultiprocessor(&per_cu, (const void*)fwd_kernel, NTHR, LDS_BYTES);
        (void)hipGetLastError();
        if (per_cu < 1) fprintf(stderr, "kernel_launch: occupancy query reports %d\n", per_cu);
        grid = cus;
    }
    if (grid < 0) return;
    hipMemsetAsync((char*)d_ws + WS_CTL, 0, 65536, stream);
    Args a{};
    for (int i = 0; i < 21; ++i) a.in[i] = (const float*)d_in[i];
    a.out = (float*)d_out; a.ws = (unsigned char*)d_ws;
#if N_LAUNCHES == 1
    a.ph_lo = 0; a.ph_hi = NPHASES;
    void* kargs[] = {&a};
    hipError_t e = hipLaunchCooperativeKernel((const void*)fwd_kernel, dim3(grid), dim3(NTHR), kargs, LDS_BYTES, stream);
    if (e != hipSuccess) fprintf(stderr, "kernel_launch: cooperative launch failed: %s (grid %d)\n", hipGetErrorString(e), grid);
#else
#ifndef MAXPH
#define MAXPH NPHASES
#endif
    for (int ph = 0; ph < MAXPH; ++ph) { a.ph_lo = ph; a.ph_hi = ph + 1; hipLaunchKernelGGL(fwd_kernel, dim3(grid), dim3(NTHR), LDS_BYTES, stream, a); }
#endif
}
```

```cpp
#include <hip/hip_runtime.h>
#include <cstdio>
#include <cstdint>

#ifndef N_LAUNCHES
#define N_LAUNCHES 1
#endif
#ifndef USE_MFMA_GEMM
#define USE_MFMA_GEMM 1
#endif

#define LAS __attribute__((address_space(3)))
#define GAS __attribute__((address_space(1)))
typedef unsigned short bf16_t;
typedef short bf16x8 __attribute__((ext_vector_type(8)));
typedef float f32x4 __attribute__((ext_vector_type(4)));
typedef float f32x2 __attribute__((ext_vector_type(2)));
typedef unsigned u32x4 __attribute__((ext_vector_type(4)));
typedef unsigned u32x2 __attribute__((ext_vector_type(2)));
typedef GAS unsigned gu32;
#define RLX_AGENT __ATOMIC_RELAXED, __HIP_MEMORY_SCOPE_AGENT
#define LDS_WAIT() asm volatile("s_waitcnt lgkmcnt(0)" ::: "memory")
#define VM_WAIT() asm volatile("s_waitcnt vmcnt(0)" ::: "memory")

constexpr int D = 1024, NB = 8, SEQ = 2048, CTXL = 256;
constexpr int NLAT = NB * SEQ, NCTX = NB * CTXL, NTOK = NLAT + NCTX;
constexpr int INC = 2832, NIN = 2816;
constexpr int KOUT = 1280;
constexpr int NE = 16, RPE = 2304;
constexpr float EPS = 1e-6f;
constexpr int NTHR = 512, NWAVES = 8;

constexpr size_t al256(size_t x) { return (x + 255) & ~(size_t)255; }
constexpr size_t WS_CTL = 0;
constexpr size_t WS_MOD = WS_CTL + 65536;
constexpr size_t WS_WIN = WS_MOD + al256((size_t)2 * 9 * 6144 * 4);
constexpr size_t WS_WOUT = WS_WIN + (size_t)2 * NIN * D * 2;
constexpr size_t WS_WGU = WS_WOUT + (size_t)2 * D * KOUT * 2;
constexpr size_t WS_WD = WS_WGU + (size_t)NE * 2048 * D * 2;
constexpr size_t WS_FL = WS_WD + (size_t)NE * D * D * 2;
constexpr size_t WS_FC = WS_FL + (size_t)4096 * 2048 * 2;
constexpr size_t WS_X = WS_FC + (size_t)512 * 2048 * 2;
constexpr size_t WS_XN = WS_X + (size_t)NTOK * D * 4;
constexpr size_t WS_GATES = WS_XN + (size_t)NTOK * D * 2;
constexpr size_t WS_AFF = WS_GATES + (size_t)NTOK * 16 * 4;
constexpr size_t WS_INV = WS_AFF + (size_t)NTOK * 16 * 4;
constexpr size_t WS_ROWTOK = WS_INV + (size_t)NTOK * 16 * 4;
constexpr size_t WS_GATEV = WS_ROWTOK + (size_t)NE * RPE * 4;
constexpr size_t WS_R1 = WS_GATEV + (size_t)NE * RPE * 4;
constexpr size_t SZ_QKV = (size_t)NTOK * 512 * 2;
constexpr size_t WS_Q = WS_R1, WS_K = WS_Q + SZ_QKV, WS_V = WS_K + SZ_QKV, WS_O = WS_V + SZ_QKV;
constexpr size_t WS_HID = WS_R1;
constexpr size_t WS_R2 = WS_R1 + 4 * SZ_QKV;
constexpr size_t SZ_C = (size_t)NTOK * 256 * 2;
constexpr size_t WS_CA = WS_R2, WS_CG = WS_CA + SZ_C, WS_FR = WS_CG + SZ_C, WS_ZT = WS_FR + SZ_C;
constexpr size_t WS_ZTC = WS_ZT + (size_t)2048 * 2048 * 2;
constexpr size_t WS_HF = WS_ZT + 2 * (size_t)2048 * 2048 * 2, WS_HB = WS_HF + SZ_QKV, WS_Y = WS_HB + SZ_QKV;
constexpr size_t WS_YS = WS_R2;
constexpr size_t WS_END = WS_Y + (size_t)NTOK * KOUT * 2;
static_assert((size_t)NE * RPE * D * 2 <= 4 * SZ_QKV, "HID alias");
static_assert(WS_YS + (size_t)NE * RPE * D * 2 <= WS_END, "YS alias");

constexpr int RING_BYTES = 139264;
constexpr int LDSCTL_OFF = RING_BYTES;
constexpr int LDS_BYTES = RING_BYTES + 1024;

__device__ __forceinline__ unsigned f2bf(float f) { unsigned u = __float_as_uint(f); u += 0x7FFFu + ((u >> 16) & 1u); return u >> 16; }
typedef __bf16 bf16x2_t __attribute__((ext_vector_type(2)));
__device__ __forceinline__ unsigned pk2(float lo, float hi) { const bf16x2_t r = __builtin_convertvector((f32x2){lo, hi}, bf16x2_t); return __builtin_bit_cast(unsigned, r); }
__device__ __forceinline__ float bf2f(unsigned b) { return __uint_as_float(b << 16); }
__device__ __forceinline__ float bflo(unsigned w) { return __uint_as_float(w << 16); }
__device__ __forceinline__ float bfhi(unsigned w) { return __uint_as_float(w & 0xffff0000u); }
__device__ __forceinline__ float sigmoidf_(float x) { return 1.0f / (1.0f + __expf(-x)); }
__device__ __forceinline__ float siluf_(float x) { return x / (1.0f + __expf(-x)); }
__device__ __forceinline__ float logsigmoidf_(float x) { return x >= 0.f ? -log1pf(expf(-x)) : x - log1pf(expf(x)); }
__device__ __forceinline__ float wave_sum(float v) {
#pragma unroll
    for (int o = 1; o < 64; o <<= 1) v += __shfl_xor(v, o);
    return v;
}
__device__ __forceinline__ u32x2 pk4(f32x4 v) { u32x2 w; w.x = pk2(v[0], v[1]); w.y = pk2(v[2], v[3]); return w; }

#define XB_TMO      128
#define XB_XCNT(j)  (256  + 64 * (j))
#define XB_XSUB(j)  (1280 + 64 * (j))
#define XB_XGEN(j)  (2304 + 64 * (j))
#define XB_TOP      3328
#define XB_TOPGEN   3392
#define XCD_BAR_WORDS 3456
#define XB_SPIN_CAP (1u << 22)
__device__ __forceinline__ unsigned xb_ld(unsigned* p)              { return __hip_atomic_load(p, __ATOMIC_RELAXED, __HIP_MEMORY_SCOPE_AGENT); }
__device__ __forceinline__ unsigned xb_add(unsigned* p, unsigned v) { return __hip_atomic_fetch_add(p, v, __ATOMIC_RELAXED, __HIP_MEMORY_SCOPE_AGENT); }
__device__ __forceinline__ unsigned xb_xcc_id() { return (unsigned)__builtin_amdgcn_s_getreg((3 << 11) | 20) & 0xFu; }
#define XB_SPIN(cond, bar) do { unsigned _sp = 0; while (cond) { __builtin_amdgcn_s_sleep(1); \
    if ((++_sp & 255u) == 0u) { if (xb_ld(&(bar)[XB_TMO])) break; if (_sp > XB_SPIN_CAP) { atomicAdd(&(bar)[XB_TMO], 1u); break; } } } } while (0)
struct XcdBarrier { unsigned* bar; unsigned x; volatile LAS unsigned* st; };
__device__ __forceinline__ XcdBarrier xcd_barrier_post(unsigned* bar, volatile LAS unsigned* st) {
    XcdBarrier b; b.bar = bar; b.x = xb_xcc_id(); b.st = st;
    if (threadIdx.x == 0) (void)xb_add(&bar[XB_XCNT(b.x)], 1u);
    return b;
}
__device__ __forceinline__ void xcd_barrier_complete(unsigned* bar, unsigned x, unsigned& nloc, unsigned& nx) {
    const unsigned G = gridDim.x * gridDim.y * gridDim.z;
    unsigned sum, cnt, mine, sp = 0u;
    for (;;) {
        sum = 0u; cnt = 0u; mine = 0u;
#pragma unroll
        for (unsigned j = 0; j < 16; ++j) { const unsigned c = xb_ld(&bar[XB_XCNT(j)]); sum += c; cnt += (c > 0u) ? 1u : 0u; mine = (j == x) ? c : mine; }
        if (sum == G) break;
        __builtin_amdgcn_s_sleep(1);
        if ((++sp & 255u) == 0u) { if (xb_ld(&bar[XB_TMO])) break; if (sp > XB_SPIN_CAP) { atomicAdd(&bar[XB_TMO], 1u); break; } }
    }
    nloc = mine > 0u ? mine : 1u; nx = cnt > 0u ? cnt : 1u;
}
__device__ __forceinline__ void xcd_barrier(const XcdBarrier& b) {
    asm volatile("s_waitcnt vmcnt(0)" ::: "memory");
    __syncthreads();
    if (threadIdx.x == 0) {
        unsigned* bar = b.bar;
        __builtin_amdgcn_s_waitcnt(0);
        unsigned nloc = b.st[0], nx = b.st[1];
        if (nloc == 0u) { xcd_barrier_complete(bar, b.x, nloc, nx); b.st[0] = nloc; b.st[1] = nx; }
        const unsigned old = xb_add(&bar[XB_XSUB(b.x)], 1u);
        const unsigned gen = old / nloc;
        if (old + 1u == (gen + 1u) * nloc) {
            __builtin_amdgcn_fence(__ATOMIC_RELEASE, "agent");
            asm volatile("s_waitcnt vmcnt(0)" ::: "memory");
            const unsigned og = xb_add(&bar[XB_TOP], 1u);
            const unsigned tg = og / nx;
            if (og + 1u == (tg + 1u) * nx) xb_add(&bar[XB_TOPGEN], 1u);
            else XB_SPIN(xb_ld(&bar[XB_TOPGEN]) == tg, bar);
            __builtin_amdgcn_fence(__ATOMIC_ACQUIRE, "agent");
            xb_add(&bar[XB_XGEN(b.x)], 1u);
            asm volatile("s_waitcnt vmcnt(0)" ::: "memory");
        } else {
            XB_SPIN(xb_ld(&bar[XB_XGEN(b.x)]) == gen, bar);
            __builtin_amdgcn_fence(__ATOMIC_ACQUIRE, "agent");
            asm volatile("s_waitcnt vmcnt(0)" ::: "memory");
        }
    }
    __syncthreads();
}

namespace pg8 {
constexpr int BM = 256, BK = 64, HALF = 128, HTB = HALF * BK * 2, STAGE_BYTES = 8 * HTB, NXCD = 8, WGM = 8;
__host__ __device__ __forceinline__ int lds_byte(int r, int c) { const int st = (r >> 4) * 2 + (c >> 5), rr = r & 15, cc = c & 31, ob = rr * 64 + cc * 2; return st * 1024 + (ob ^ (((ob >> 9) & 1) << 5)); }
__host__ __device__ __forceinline__ void stage_rc(int b, int& R, int& C) { const int st = b / 1024, sb = b % 1024, swz = sb ^ (((sb >> 9) & 1) << 5); R = (st >> 1) * 16 + swz / 64; C = (st & 1) * 32 + (swz % 64) / 2; }

struct Unit { const char* A; const char* B; const int* rows; int K, pm, pn, ex; };

__device__ __forceinline__ void map_tile(int L, int nM, int nN, int& pm, int& pn) {
    const int nwg = nM * nN; int wgid = L;
    { const int q = nwg / NXCD, r = nwg % NXCD, xcd = wgid % NXCD, off = wgid / NXCD; wgid = (xcd < r ? xcd * (q + 1) : r * (q + 1) + (xcd - r) * q) + off; }
    const int nig = WGM * nN, gid = wgid / nig, fm = gid * WGM, gsz = (nM - fm) < WGM ? (nM - fm) : WGM;
    pm = fm + ((wgid % nig) % gsz); pn = (wgid % nig) / gsz;
}
__device__ __forceinline__ void a_offs(const Unit& u, int lda, int tid, unsigned (&vA)[2][2]) {
#pragma unroll
    for (int h = 0; h < 2; ++h)
#pragma unroll
        for (int i = 0; i < 2; ++i) { int R, C; stage_rc(tid * 16 + i * 8192, R, C); const int r = h * HALF + R; const int ar = u.rows ? u.rows[r] : r; vA[h][i] = (unsigned)(ar * lda + C) * 2u; }
}

template <class Epi, class Sched>
__device__ __forceinline__ void gemm_phase(LAS unsigned char* lds, const int tid, const int lda, const int ldb, const Sched& S, const Epi& E) {
    const int wid = __builtin_amdgcn_readfirstlane(tid >> 6), lane = tid & 63, wr = wid >> 2, wc = wid & 3, fr = lane & 15, fq = lane >> 4;
    unsigned voffB[2];
#pragma unroll
    for (int i = 0; i < 2; ++i) { int R, C; stage_rc(tid * 16 + i * 8192, R, C); voffB[i] = (unsigned)(R * ldb + C) * 2u; }
    const size_t kstep = (size_t)(BK * 2);
    const size_t hsB = (size_t)HALF * ldb * 2;
    const unsigned ldsw = (unsigned)wid * 1024u;
    const int aoff = lds_byte(wr * 64 + fr, fq * 8), boff = lds_byte(wc * 32 + fr, fq * 8);
#define PG8_SA(b, h) (((b) * 2 + (h)) * HTB)
#define PG8_SB(b, h) ((4 + (b) * 2 + (h)) * HTB)
#define PG8_STAGE(bufoff, gbase, voff) do { _Pragma("unroll") for (int _i = 0; _i < 2; ++_i) \
        __builtin_amdgcn_global_load_lds((const unsigned*)((const char*)(gbase) + (voff)[_i]), (LAS unsigned*)(lds + (bufoff) + ldsw + _i * 8192), 16, 0, 0); } while (0)
#define PG8_LDA(dst, b, h) do { _Pragma("unroll") for (int m = 0; m < 4; ++m) _Pragma("unroll") for (int k = 0; k < 2; ++k) dst[m][k] = *(const LAS bf16x8*)(lds + PG8_SA(b, h) + aoff + m * 2048 + k * 1024); } while (0)
#define PG8_LDB(dst, b, h) do { _Pragma("unroll") for (int n = 0; n < 2; ++n) _Pragma("unroll") for (int k = 0; k < 2; ++k) dst[n][k] = *(const LAS bf16x8*)(lds + PG8_SB(b, h) + boff + n * 2048 + k * 1024); } while (0)
#define PG8_MMA(ai, bj, At, Bt) do { __builtin_amdgcn_s_setprio(1); _Pragma("unroll") for (int m = 0; m < 4; ++m) _Pragma("unroll") for (int n = 0; n < 2; ++n) _Pragma("unroll") for (int k = 0; k < 2; ++k) \
        acc[ai][bj][m][n] = __builtin_amdgcn_mfma_f32_16x16x32_bf16(Bt[n][k], At[m][k], acc[ai][bj][m][n], 0, 0, 0); __builtin_amdgcn_s_setprio(0); } while (0)
#define PG8_WAIT_V(n) asm volatile("s_waitcnt vmcnt(" #n ")" ::: "memory")
#define PG8_WAIT_L(n) asm volatile("s_waitcnt lgkmcnt(" #n ")" ::: "memory")
#define PG8_BAR __builtin_amdgcn_s_barrier()
#define PG8_SCHED __builtin_amdgcn_sched_barrier(0)
    Unit cur, nxt; int ui = 0;
    if (!S.next(0, cur)) return;
    f32x4 acc[2][2][4][2];
#pragma unroll
    for (int a = 0; a < 2; ++a)
#pragma unroll
        for (int b = 0; b < 2; ++b)
#pragma unroll
            for (int m = 0; m < 4; ++m)
#pragma unroll
                for (int n = 0; n < 2; ++n) acc[a][b][m][n] = (f32x4){0.f, 0.f, 0.f, 0.f};
    bf16x8 At[4][2], B0[2][2], B1[2][2];
    unsigned vA[2][2], wA[2][2];
    a_offs(cur, lda, tid, vA);
    const char* cA = cur.A; const char* cB = cur.B;
    PG8_STAGE(PG8_SB(0, 0), cB, voffB); PG8_STAGE(PG8_SB(0, 1), cB + hsB, voffB); PG8_STAGE(PG8_SA(0, 0), cA, vA[0]); PG8_STAGE(PG8_SA(0, 1), cA, vA[1]);
    if (wr == 1) PG8_BAR;
    PG8_WAIT_V(2); PG8_BAR;
    PG8_STAGE(PG8_SB(1, 0), cB + kstep, voffB); PG8_STAGE(PG8_SA(1, 0), cA + kstep, vA[0]); PG8_STAGE(PG8_SB(1, 1), cB + hsB + kstep, voffB);
    PG8_WAIT_V(6); PG8_BAR;
    for (;;) {
        const bool has_next = S.next(ui + 1, nxt);
        if (!has_next) nxt = cur;
        const char* nA = nxt.A; const char* nB = nxt.B;
        a_offs(nxt, lda, tid, wA);
        const int nt = cur.K / BK;
        for (int t = 0; t < nt; t += 2) {
            const bool last = (t == nt - 2);
            const char* a1 = cA + (size_t)(t + 1) * kstep;
            const char* a2 = last ? nA : cA + (size_t)(t + 2) * kstep; const char* b2 = last ? nB : cB + (size_t)(t + 2) * kstep;
            const char* a3 = a2 + kstep; const char* b3 = b2 + kstep;
            PG8_LDB(B0, 0, 0); PG8_LDB(B1, 0, 1); PG8_SCHED; PG8_LDA(At, 0, 0); PG8_STAGE(PG8_SA(1, 1), a1, vA[1]);
            if (last) {
#pragma unroll
                for (int h = 0; h < 2; ++h)
#pragma unroll
                    for (int i = 0; i < 2; ++i) vA[h][i] = wA[h][i];
            }
            PG8_WAIT_V(8); PG8_WAIT_L(0); PG8_BAR; PG8_MMA(0, 0, At, B0); PG8_MMA(0, 1, At, B1); PG8_BAR; PG8_SCHED;
            PG8_LDA(At, 0, 1); PG8_STAGE(PG8_SB(0, 0), b2, voffB); PG8_STAGE(PG8_SB(0, 1), b2 + hsB, voffB); PG8_STAGE(PG8_SA(0, 0), a2, vA[0]);
            PG8_WAIT_V(8); PG8_WAIT_L(0); PG8_BAR; PG8_MMA(1, 0, At, B0); PG8_MMA(1, 1, At, B1); PG8_BAR; PG8_SCHED;
            PG8_LDB(B0, 1, 0); PG8_LDB(B1, 1, 1); PG8_SCHED; PG8_LDA(At, 1, 0); PG8_STAGE(PG8_SA(0, 1), a2, vA[1]);
            PG8_WAIT_V(8); PG8_WAIT_L(0); PG8_BAR; PG8_MMA(0, 0, At, B0); PG8_MMA(0, 1, At, B1); PG8_BAR; PG8_SCHED;
            PG8_LDA(At, 1, 1); PG8_STAGE(PG8_SB(1, 0), b3, voffB); PG8_STAGE(PG8_SB(1, 1), b3 + hsB, voffB); PG8_STAGE(PG8_SA(1, 0), a3, vA[0]);
            PG8_WAIT_V(8); PG8_WAIT_L(0); PG8_BAR; PG8_MMA(1, 0, At, B0); PG8_MMA(1, 1, At, B1); PG8_BAR; PG8_SCHED;
        }
        if (wr == 0) PG8_BAR;
        { int fr_ = fr, fq_ = fq; asm volatile("" : "+v"(fr_), "+v"(fq_));
          E.run(acc, cur, wr, wc, fr_, fq_); }
        if (!has_next) break;
#pragma unroll
        for (int a = 0; a < 2; ++a)
#pragma unroll
            for (int b = 0; b < 2; ++b)
#pragma unroll
                for (int m = 0; m < 4; ++m)
#pragma unroll
                    for (int n = 0; n < 2; ++n) acc[a][b][m][n] = (f32x4){0.f, 0.f, 0.f, 0.f};
        cur = nxt; cA = nA; cB = nB; ++ui;
        if (wr == 1) PG8_BAR;
    }
    PG8_WAIT_V(0);
    PG8_BAR;
#undef PG8_SA
#undef PG8_SB
#undef PG8_STAGE
#undef PG8_LDA
#undef PG8_LDB
#undef PG8_MMA
#undef PG8_WAIT_V
#undef PG8_WAIT_L
#undef PG8_BAR
#undef PG8_SCHED
}
template <class Epi, class Sched>
__device__ __forceinline__ void gemm_phase_simt(LAS unsigned char* lds, const int tid, const int lda, const int ldb, const Sched& S, const Epi& E) {
    LAS float* As = (LAS float*)lds;
    LAS float* Bs = (LAS float*)(lds + 32 * 132 * 4);
    const int ty = tid >> 4, tx = tid & 15, c0 = (tx >> 2) * 32 + (tx & 3) * 4;
    const int lr = tid >> 2, lk = (tid & 3) * 8;
    Unit u;
    for (int ui = 0; S.next(ui, u); ++ui) {
        for (int sub = 0; sub < 4; ++sub) {
            const int sr = sub >> 1, sc = sub & 1;
            float acc[4][8];
#pragma unroll
            for (int i = 0; i < 4; ++i)
#pragma unroll
                for (int j = 0; j < 8; ++j) acc[i][j] = 0.f;
            const int arow = sr * 128 + lr, brow = sc * 128 + lr;
            const int ar = u.rows ? u.rows[arow] : arow;
            const bf16_t* ap = (const bf16_t*)u.A + (size_t)ar * lda + lk;
            const bf16_t* bp = (const bf16_t*)u.B + (size_t)brow * ldb + lk;
            for (int k0 = 0; k0 < u.K; k0 += 32) {
                const u32x4 av = *(const u32x4*)(ap + k0), bv = *(const u32x4*)(bp + k0);
                __syncthreads();
#pragma unroll
                for (int j = 0; j < 4; ++j) {
                    As[(lk + 2 * j) * 132 + lr] = bflo(av[j]); As[(lk + 2 * j + 1) * 132 + lr] = bfhi(av[j]);
                    Bs[(lk + 2 * j) * 132 + lr] = bflo(bv[j]); Bs[(lk + 2 * j + 1) * 132 + lr] = bfhi(bv[j]);
                }
                __syncthreads();
#pragma unroll 4
                for (int k = 0; k < 32; ++k) {
                    const f32x4 a4 = *(const LAS f32x4*)(As + k * 132 + ty * 4);
                    const f32x4 b0 = *(const LAS f32x4*)(Bs + k * 132 + c0), b1 = *(const LAS f32x4*)(Bs + k * 132 + c0 + 16);
#pragma unroll
                    for (int i = 0; i < 4; ++i)
#pragma unroll
                        for (int j = 0; j < 4; ++j) { acc[i][j] += a4[i] * b0[j]; acc[i][4 + j] += a4[i] * b1[j]; }
                }
            }
#pragma unroll
            for (int i = 0; i < 4; ++i)
                E.store1(u, sr * 128 + ty * 4 + i, sc * 128 + c0, (f32x4){acc[i][0], acc[i][1], acc[i][2], acc[i][3]}, (f32x4){acc[i][4], acc[i][5], acc[i][6], acc[i][7]});
        }
    }
    __syncthreads();
}
}

#if USE_MFMA_GEMM
#define GEMM_PHASE(lds, lda, ldb, S, E) pg8::gemm_phase(lds, F.tid, lda, ldb, S, E)
#else
#define GEMM_PHASE(lds, lda, ldb, S, E) pg8::gemm_phase_simt(lds, F.tid, lda, ldb, S, E)
#endif

struct Args { const float* in[21]; float* out; unsigned char* ws; int ph_lo, ph_hi; };
enum { I_X = 0, I_C, I_CTX, I_CCTX, I_WADA, I_BADA, I_GN1, I_WIN, I_BG, I_GH, I_CW, I_CB, I_CLG, I_CLB, I_WOUT, I_GN2, I_WR, I_WEG, I_WEU, I_WED, I_GF };
__device__ __forceinline__ const float* arg_in(const Args& a, int i) { asm volatile("" : "+s"(i)); return a.in[i]; }
struct Frame {
    LAS unsigned char* lds;
    int tid, lane, wave, G, bid;
    unsigned char* ws;
    const Args& A;
};
#define FIN(i) arg_in(F.A, (i))
#define WSP(T, off) ((T*)(F.ws + (off)))

template <class Src>
__device__ __forceinline__ void tr_item(const Src& src, bf16_t* dst, int ldd, int n0, int k0, LAS float* scr, int lane) {
    f32x4 v[8];
#pragma unroll
    for (int i = 0; i < 8; ++i) v[i] = src.ld4(k0 + i * 8 + (lane >> 3), n0 + (lane & 7) * 4);
#pragma unroll
    for (int i = 0; i < 8; ++i) { LAS float* p = scr + (i * 8 + (lane >> 3)) * 33 + (lane & 7) * 4; p[0] = v[i][0]; p[1] = v[i][1]; p[2] = v[i][2]; p[3] = v[i][3]; }
    LDS_WAIT(); asm volatile("" ::: "memory");
    const int c = lane & 7;
#pragma unroll
    for (int j = 0; j < 4; ++j) { const int n = (lane >> 3) + 8 * j; const LAS float* s = scr + (8 * c) * 33 + n;
        u32x4 o; o.x = pk2(s[0 * 33], s[1 * 33]); o.y = pk2(s[2 * 33], s[3 * 33]); o.z = pk2(s[4 * 33], s[5 * 33]); o.w = pk2(s[6 * 33], s[7 * 33]);
        *(u32x4*)(dst + (size_t)(n0 + n) * ldd + k0 + 8 * c) = o; }
    LDS_WAIT(); asm volatile("" ::: "memory");
}
struct SrcWin { const float* w; __device__ __forceinline__ f32x4 ld4(int k, int n) const { return *(const f32x4*)(w + (size_t)k * INC + (n < 1536 ? n : n + 16)); } };
struct SrcPlain { const float* w; int ld; __device__ __forceinline__ f32x4 ld4(int k, int n) const { return *(const f32x4*)(w + (size_t)k * ld + n); } };
struct SrcGU { const float* wg; const float* wu; __device__ __forceinline__ f32x4 ld4(int k, int n) const { const int grp = n >> 5, i = n & 31;
    const uintptr_t base = (uintptr_t)wg + ((i < 16) ? (uintptr_t)0 : ((uintptr_t)wu - (uintptr_t)wg));
    return *(const f32x4*)((const float*)base + (size_t)k * D + grp * 16 + (i & 15)); } };

__device__ __forceinline__ void convert_moe_weights(Frame& F, int l, int gw, int ngw) {
    LAS float* scr = (LAS float*)(F.lds + F.wave * 8448);
    bf16_t* WGU = WSP(bf16_t, WS_WGU); bf16_t* WD = WSP(bf16_t, WS_WD);
    const float* w_e_gate = FIN(I_WEG); const float* w_e_up = FIN(I_WEU); const float* w_e_down = FIN(I_WED);
    constexpr int I_GU = NE * 64 * 16, I_D = NE * 32 * 16;
    for (int it = gw; it < I_GU + I_D; it += ngw) {
        if (it < I_GU) { const int e = it / 1024, r = it % 1024, nb = r / 16, kb = r % 16;
            SrcGU s{w_e_gate + ((size_t)l * NE + e) * D * D, w_e_up + ((size_t)l * NE + e) * D * D};
            tr_item(s, WGU + (size_t)e * 2048 * D, D, nb * 32, kb * 64, scr, F.lane);
        } else { const int r0 = it - I_GU, e = r0 / 512, r = r0 % 512, nb = r / 16, kb = r % 16;
            SrcPlain s{w_e_down + ((size_t)l * NE + e) * D * D, D};
            tr_item(s, WD + (size_t)e * D * D, D, nb * 32, kb * 64, scr, F.lane);
        }
    }
}

__device__ __forceinline__ void phase_prep(Frame& F) {
    const int tid = F.tid;
    {
        LAS float* s = (LAS float*)F.lds;
        LAS float* red = (LAS float*)(F.lds + 9 * 1024 * 4);
        float* MOD = WSP(float, WS_MOD);
        const float* c_in = FIN(I_C); const float* c_ctx = FIN(I_CCTX); const float* w_ada = FIN(I_WADA); const float* b_ada = FIN(I_BADA);
        bool staged = false;
        for (int it = F.bid; it < 192; it += F.G) {
            if (!staged) { for (int i = tid; i < 9 * 1024; i += NTHR) { const int r = i >> 10, k = i & 1023; const float cv = (r < 8) ? c_in[r * 1024 + k] : c_ctx[k]; s[i] = siluf_(cv); } staged = true; }
            __syncthreads();
            const int l = it / 96, cgp = it % 96, col = cgp * 64 + (tid & 63), kq = tid >> 6;
            float acc[9];
#pragma unroll
            for (int r = 0; r < 9; ++r) acc[r] = 0.f;
            const float* w = w_ada + ((size_t)l * 1024 + kq * 128) * 6144 + col;
            for (int k0 = 0; k0 < 128; k0 += 32) {
                float wv[32];
#pragma unroll
                for (int k = 0; k < 32; ++k) wv[k] = w[(size_t)(k0 + k) * 6144];
#pragma unroll
                for (int k = 0; k < 32; ++k)
#pragma unroll
                    for (int r = 0; r < 9; ++r) acc[r] += s[r * 1024 + kq * 128 + k0 + k] * wv[k];
            }
#pragma unroll
            for (int r = 0; r < 9; ++r) red[(kq * 9 + r) * 64 + (tid & 63)] = acc[r];
            __syncthreads();
            for (int o = tid; o < 576; o += NTHR) { const int r = o >> 6, cc = o & 63; float sum = 0.f;
#pragma unroll
                for (int q = 0; q < 8; ++q) sum += red[(q * 9 + r) * 64 + cc];
                MOD[((size_t)l * 9 + r) * 6144 + cgp * 64 + cc] = sum + b_ada[l * 6144 + cgp * 64 + cc]; }
            __syncthreads();
        }
        __syncthreads();
    }
    {
        bf16_t* FL = WSP(bf16_t, WS_FL); bf16_t* FC = WSP(bf16_t, WS_FC);
        const size_t gth = (size_t)F.bid * NTHR + tid, nth = (size_t)F.G * NTHR;
        for (size_t it = gth; it < (size_t)4096 * 2048 / 8; it += nth) {
            const int r = (int)(it / 256), t0 = (int)(it % 256) * 8, part = r >> 11, k = r & 2047; unsigned w[4];
#pragma unroll
            for (int j = 0; j < 4; ++j) { float v[2];
#pragma unroll
                for (int q = 0; q < 2; ++q) { const int ph = (k * (t0 + 2 * j + q)) & 2047; const float ang = (float)ph * (6.283185307179586f / 2048.f); v[q] = (part ? sinf(ang) : cosf(ang)) * 0.022097086912079608f; }
                w[j] = pk2(v[0], v[1]); }
            *(u32x4*)(FL + (size_t)r * 2048 + t0) = (u32x4){w[0], w[1], w[2], w[3]};
        }
        for (size_t it = gth; it < (size_t)512 * 256 / 8; it += nth) {
            const int r = (int)(it / 32), t0 = (int)(it % 32) * 8, part = r >> 8, k = r & 255; unsigned w[4];
#pragma unroll
            for (int j = 0; j < 4; ++j) { float v[2];
#pragma unroll
                for (int q = 0; q < 2; ++q) { const int ph = (k * (t0 + 2 * j + q)) & 255; const float ang = (float)ph * (6.283185307179586f / 256.f); v[q] = (part ? sinf(ang) : cosf(ang)) * 0.0625f; }
                w[j] = pk2(v[0], v[1]); }
            *(u32x4*)(FC + (size_t)r * SEQ + t0) = (u32x4){w[0], w[1], w[2], w[3]};
        }
    }
    const int gw = F.bid * NWAVES + F.wave, ngw = F.G * NWAVES;
    {
        LAS float* scr = (LAS float*)(F.lds + F.wave * 8448);
        bf16_t* WIN = WSP(bf16_t, WS_WIN); bf16_t* WOUT = WSP(bf16_t, WS_WOUT);
        const float* w_in = FIN(I_WIN); const float* w_out = FIN(I_WOUT);
        constexpr int I_IN = 2 * 88 * 16, I_OP = 2 * 32 * 12, I_PQ = 2 * 32 * 8;
        for (int it = gw; it < I_IN + I_OP + I_PQ; it += ngw) {
            if (it < I_IN) { const int l = it / 1408, r = it % 1408, nb = r / 16, kb = r % 16;
                SrcWin s{w_in + (size_t)l * D * INC};
                tr_item(s, WIN + (size_t)l * NIN * D, D, nb * 32, kb * 64, scr, F.lane);
            } else if (it < I_IN + I_OP) { const int r0 = it - I_IN, l = r0 / 384, r = r0 % 384, nb = r / 12, kb = r % 12;
                SrcPlain s{w_out + (size_t)l * D * D, D};
                tr_item(s, WOUT + (size_t)l * D * KOUT, KOUT, nb * 32, kb * 64, scr, F.lane);
            } else { const int r0 = it - I_IN - I_OP, l = r0 / 256, r = r0 % 256, nb = r / 8, gp = r % 8, g = gp & 3, part = gp >> 2;
                const float* wsrc = w_out + (size_t)l * D * D + (size_t)(768 + g * 64) * D + nb * 32;
#pragma unroll 8
                for (int i = 0; i < 32; ++i) { const int kk = 2 * i + (F.lane >> 5), nn = F.lane & 31; scr[kk * 33 + nn] = wsrc[(size_t)kk * D + nn]; }
                LDS_WAIT(); asm volatile("" ::: "memory");
                const int c8 = F.lane & 7;
                float o[4][8];
#pragma unroll
                for (int j = 0; j < 4; ++j)
#pragma unroll
                    for (int q = 0; q < 8; ++q) o[j][q] = 0.f;
                for (int m = 0; m < 64; ++m) {
                    float twd[8];
#pragma unroll
                    for (int q = 0; q < 8; ++q) { const float ang = (float)((m * (c8 * 8 + q)) & 63) * (6.283185307179586f / 64.f); twd[q] = part ? -__sinf(ang) : __cosf(ang); }
#pragma unroll
                    for (int j = 0; j < 4; ++j) { const float bv = scr[m * 33 + (F.lane >> 3) + 8 * j];
#pragma unroll
                        for (int q = 0; q < 8; ++q) o[j][q] += twd[q] * bv; }
                }
#pragma unroll
                for (int j = 0; j < 4; ++j) { const int n = (F.lane >> 3) + 8 * j;
                    u32x4 ov; ov.x = pk2(o[j][0] * 0.125f, o[j][1] * 0.125f); ov.y = pk2(o[j][2] * 0.125f, o[j][3] * 0.125f); ov.z = pk2(o[j][4] * 0.125f, o[j][5] * 0.125f); ov.w = pk2(o[j][6] * 0.125f, o[j][7] * 0.125f);
                    *(u32x4*)(WOUT + (size_t)l * D * KOUT + (size_t)(nb * 32 + n) * KOUT + 768 + part * 256 + g * 64 + c8 * 8) = ov; }
                LDS_WAIT(); asm volatile("" ::: "memory");
            }
        }
    }
}

__device__ __forceinline__ void stage_small_w(Frame& F, LAS float* wT, const float* src, int ld, int coloff) {
    for (int i = F.tid; i < 16 * 1024; i += NTHR) { const int k = i >> 4, c = i & 15; wT[c * 1024 + k] = src[(size_t)k * ld + coloff + c]; }
    __syncthreads();
}
__device__ __forceinline__ float reduce16(float (&acc)[16], int lane) {
    float v8[8], v4[4], v2[2], v1;
#pragma unroll
    for (int i = 0; i < 8; ++i) { const float snd = (lane & 32) ? acc[i] : acc[i + 8], kp = (lane & 32) ? acc[i + 8] : acc[i]; v8[i] = kp + __shfl_xor(snd, 32); }
#pragma unroll
    for (int i = 0; i < 4; ++i) { const float snd = (lane & 16) ? v8[i] : v8[i + 4], kp = (lane & 16) ? v8[i + 4] : v8[i]; v4[i] = kp + __shfl_xor(snd, 16); }
#pragma unroll
    for (int i = 0; i < 2; ++i) { const float snd = (lane & 8) ? v4[i] : v4[i + 2], kp = (lane & 8) ? v4[i + 2] : v4[i]; v2[i] = kp + __shfl_xor(snd, 8); }
    { const float snd = (lane & 4) ? v2[0] : v2[1], kp = (lane & 4) ? v2[1] : v2[0]; v1 = kp + __shfl_xor(snd, 4); }
    v1 += __shfl_xor(v1, 2); v1 += __shfl_xor(v1, 1);
    return v1;
}
__device__ __forceinline__ float norm_row(const f32x4 (&v)[4], const float* gain, const float* shift, const float* scale, bf16_t* xn_row, const LAS float* wT, int lane) {
    float ss = 0.f;
#pragma unroll
    for (int j = 0; j < 4; ++j) ss += (v[j][0] * v[j][0] + v[j][1] * v[j][1]) + (v[j][2] * v[j][2] + v[j][3] * v[j][3]);
    ss = wave_sum(ss);
    const float r = 1.0f / sqrtf(ss * (1.0f / D) + EPS);
    float acc[16];
#pragma unroll
    for (int c = 0; c < 16; ++c) acc[c] = 0.f;
#pragma unroll
    for (int j = 0; j < 4; ++j) {
        const int o = 4 * lane + 256 * j;
        const f32x4 g = *(const f32x4*)(gain + o), sh = *(const f32x4*)(shift + o), sc = *(const f32x4*)(scale + o);
        f32x4 y;
#pragma unroll
        for (int q = 0; q < 4; ++q) y[q] = v[j][q] * r * g[q] * (1.0f + sc[q]) + sh[q];
        *(u32x2*)(xn_row + o) = pk4(y);
#pragma unroll
        for (int c = 0; c < 16; ++c) { const f32x4 w = *(const LAS f32x4*)(wT + c * 1024 + o); acc[c] += (y[0] * w[0] + y[1] * w[1]) + (y[2] * w[2] + y[3] * w[3]); }
        asm volatile("" ::: "memory");
    }
    return reduce16(acc, lane);
}
__device__ __forceinline__ void row_tail_gates(float myv, const float* b_gates_l, float* gates_row, int lane) {
    if ((lane & 3) == 0) { const int c = lane >> 2; gates_row[c] = myv + b_gates_l[c]; }
}
__device__ __forceinline__ void row_tail_router(float myv, float* aff_row, int lane) {
    float mx = myv;
#pragma unroll
    for (int o = 4; o < 64; o <<= 1) mx = fmaxf(mx, __shfl_xor(mx, o));
    const float e = expf(myv - mx); float s = e;
#pragma unroll
    for (int o = 4; o < 64; o <<= 1) s += __shfl_xor(s, o);
    if ((lane & 3) == 0) aff_row[lane >> 2] = e / s;
}
__device__ __forceinline__ int mod_row(int tok) { return tok < NLAT ? (tok >> 11) : 8; }

__device__ __forceinline__ void phase_norm1_l0(Frame& F) {
    LAS float* wT = (LAS float*)F.lds;
    stage_small_w(F, wT, FIN(I_WIN), INC, 1536);
    const float* MOD = WSP(float, WS_MOD); bf16_t* XN = WSP(bf16_t, WS_XN); float* GATES = WSP(float, WS_GATES);
    const float* x_in = FIN(I_X); const float* ctx_in = FIN(I_CTX); const float* g_norm1 = FIN(I_GN1); const float* b_gates = FIN(I_BG);
    const int gw = F.bid * NWAVES + F.wave, ngw = F.G * NWAVES;
    for (int tok = gw; tok < NTOK; tok += ngw) {
        const float* src = tok < NLAT ? x_in + (size_t)tok * D : ctx_in + (size_t)(tok - NLAT) * D;
        f32x4 v[4];
#pragma unroll
        for (int j = 0; j < 4; ++j) v[j] = *(const f32x4*)(src + 4 * F.lane + 256 * j);
        const float* md = MOD + (size_t)mod_row(tok) * 6144;
        const float myv = norm_row(v, g_norm1, md, md + 1024, XN + (size_t)tok * D, wT, F.lane);
        row_tail_gates(myv, b_gates, GATES + (size_t)tok * 16, F.lane);
    }
    __syncthreads();
}
__device__ __forceinline__ void phase_norm2(Frame& F, int l) {
    LAS float* wT = (LAS float*)F.lds;
    stage_small_w(F, wT, FIN(I_WR) + (size_t)l * D * 16, 16, 0);
    const float* g_norm2 = FIN(I_GN2);
    const float* MOD = WSP(float, WS_MOD); bf16_t* XN = WSP(bf16_t, WS_XN); float* AFF = WSP(float, WS_AFF); const float* X = WSP(float, WS_X);
    const int gw = F.bid * NWAVES + F.wave, ngw = F.G * NWAVES;
    const int ntok = (l == 0) ? NTOK : NLAT;
    for (int tok = gw; tok < ntok; tok += ngw) {
        f32x4 v[4];
#pragma unroll
        for (int j = 0; j < 4; ++j) v[j] = *(const f32x4*)(X + (size_t)tok * D + 4 * F.lane + 256 * j);
        const float* md = MOD + ((size_t)l * 9 + mod_row(tok)) * 6144;
        const float myv = norm_row(v, g_norm2 + l * D, md + 3 * 1024, md + 4 * 1024, XN + (size_t)tok * D, wT, F.lane);
        row_tail_router(myv, AFF + (size_t)tok * 16, F.lane);
    }
    __syncthreads();
}
__device__ __forceinline__ void phase_combine(Frame& F, int l) {
    LAS float* wT = (LAS float*)F.lds;
    if (l == 0) stage_small_w(F, wT, FIN(I_WIN) + (size_t)1 * D * INC, INC, 1536);
    const float* g_norm1 = FIN(I_GN1); const float* b_gates = FIN(I_BG); const float* g_final = FIN(I_GF); float* outp = F.A.out;
    const float* MOD = WSP(float, WS_MOD); bf16_t* XN = WSP(bf16_t, WS_XN); float* GATES = WSP(float, WS_GATES); float* X = WSP(float, WS_X);
    const int* INV = WSP(int, WS_INV); const bf16_t* YS = WSP(bf16_t, WS_YS);
    const int gw = F.bid * NWAVES + F.wave, ngw = F.G * NWAVES;
    const int ntok = (l == 0) ? NTOK : NLAT;
    for (int tok = gw; tok < ntok; tok += ngw) {
        f32x4 v[4], a[4];
#pragma unroll
        for (int j = 0; j < 4; ++j) { v[j] = *(const f32x4*)(X + (size_t)tok * D + 4 * F.lane + 256 * j); a[j] = (f32x4){0.f, 0.f, 0.f, 0.f}; }
        for (int e = 0; e < NE; ++e) {
            const int r = __builtin_amdgcn_readfirstlane(INV[(size_t)tok * 16 + e]);
            if (r >= 0) { const bf16_t* yr = YS + ((size_t)e * RPE + r) * D;
#pragma unroll
                for (int j = 0; j < 4; ++j) { const u32x2 w = *(const u32x2*)(yr + 4 * F.lane + 256 * j); a[j][0] += bflo(w.x); a[j][1] += bfhi(w.x); a[j][2] += bflo(w.y); a[j][3] += bfhi(w.y); } }
        }
        const float* md = MOD + ((size_t)l * 9 + mod_row(tok)) * 6144;
#pragma unroll
        for (int j = 0; j < 4; ++j) { const f32x4 gt = *(const f32x4*)(md + 5 * 1024 + 4 * F.lane + 256 * j); v[j] = v[j] + gt * a[j]; }
        if (l == 0) {
#pragma unroll
            for (int j = 0; j < 4; ++j) *(f32x4*)(X + (size_t)tok * D + 4 * F.lane + 256 * j) = v[j];
            const float* md1 = MOD + ((size_t)9 + mod_row(tok)) * 6144;
            const float myv = norm_row(v, g_norm1 + D, md1, md1 + 1024, XN + (size_t)tok * D, wT, F.lane);
            row_tail_gates(myv, b_gates + 16, GATES + (size_t)tok * 16, F.lane);
        } else {
            float ss = 0.f;
#pragma unroll
            for (int j = 0; j < 4; ++j) ss += (v[j][0] * v[j][0] + v[j][1] * v[j][1]) + (v[j][2] * v[j][2] + v[j][3] * v[j][3]);
            ss = wave_sum(ss);
            const float r = 1.0f / sqrtf(ss * (1.0f / D) + EPS);
#pragma unroll
            for (int j = 0; j < 4; ++j) { const f32x4 g = *(const f32x4*)(g_final + 4 * F.lane + 256 * j); *(f32x4*)(outp + (size_t)tok * D + 4 * F.lane + 256 * j) = v[j] * r * g; }
        }
    }
    __syncthreads();
}

__device__ __forceinline__ int block_count(LAS int* cbuf, int par, int wave, int lane, int c_wave  ) {
    if (lane == 0) cbuf[par * 8 + wave] = c_wave;
    __syncthreads();
    int t = 0;
#pragma unroll
    for (int q = 0; q < 8; ++q) t += cbuf[par * 8 + q];
    return t;
}
__device__ __forceinline__ void phase_topk(Frame& F, int l) {
    LAS int* cbuf = (LAS int*)F.lds;
    const float* AFF = WSP(float, WS_AFF); int* INV = WSP(int, WS_INV); int* ROWTOK = WSP(int, WS_ROWTOK); float* GATEV = WSP(float, WS_GATEV);
    const int nitems = (l == 0) ? 256 : 128;
    for (int it = F.bid; it < nitems; it += F.G) {
        const int s = it >> 4, e = it & 15;
        const bool lat = s < 8;
        const int n = lat ? SEQ : CTXL, cap = lat ? 256 : 32, tok0 = lat ? s * SEQ : NLAT + (s - 8) * CTXL, rowbase = lat ? s * 256 : 2048 + (s - 8) * 32;
        const bool active = 4 * F.tid < n;
        unsigned k[4];
#pragma unroll
        for (int q = 0; q < 4; ++q) k[q] = active ? __float_as_uint(AFF[(size_t)(tok0 + 4 * F.tid + q) * 16 + e]) : 0u;
        __syncthreads();
        unsigned T = 0u; int par = 0;
        for (int bit = 30; bit >= 0; --bit) {
            const unsigned cand = T | (1u << bit);
            int cw = 0;
#pragma unroll
            for (int q = 0; q < 4; ++q) cw += __popcll(__ballot(k[q] >= cand));
            const int tot = block_count(cbuf, par, F.wave, F.lane, cw); par ^= 1;
            if (tot >= cap) T = cand;
        }
        int cw = 0;
#pragma unroll
        for (int q = 0; q < 4; ++q) cw += __popcll(__ballot(k[q] > T));
        const int c_gt = block_count(cbuf, par, F.wave, F.lane, cw); par ^= 1;
        int mg = 0, me = 0;
#pragma unroll
        for (int q = 0; q < 4; ++q) { mg += (k[q] > T) ? 1 : 0; me += (k[q] == T && active) ? 1 : 0; }
        int pk_ = mg | (me << 16), inc = pk_;
#pragma unroll
        for (int o = 1; o < 64; o <<= 1) { const int y = __shfl_up(inc, o); if (F.lane >= o) inc += y; }
        if (F.lane == 63) cbuf[16 + F.wave] = inc;
        __syncthreads();
        int base = 0;
#pragma unroll
        for (int q = 0; q < 8; ++q) base += (q < F.wave) ? cbuf[16 + q] : 0;
        int pre = base + inc - pk_; int pg = pre & 0xffff, pe = pre >> 16;
        if (active) {
#pragma unroll
            for (int q = 0; q < 4; ++q) {
                const int tok = tok0 + 4 * F.tid + q; int slot = -1;
                if (k[q] > T) { slot = pg; ++pg; }
                else if (k[q] == T) { if (c_gt + pe < cap) slot = c_gt + pe; ++pe; }
                if (slot >= 0) { ROWTOK[e * RPE + rowbase + slot] = tok; GATEV[e * RPE + rowbase + slot] = __uint_as_float(k[q]); }
                INV[(size_t)tok * 16 + e] = slot >= 0 ? rowbase + slot : -1;
            }
        }
        __syncthreads();
    }
    __syncthreads();
}

__device__ __forceinline__ void conv_items(Frame& F, int l, int first, int stride) {
    LAS float* gl = (LAS float*)F.lds;
    LAS float* ob = gl + 62 * 256;
    const bf16_t* CA = WSP(bf16_t, WS_CA); const bf16_t* CG = WSP(bf16_t, WS_CG); bf16_t* Y = WSP(bf16_t, WS_Y);
    const int nitems = (l == 0) ? 512 + 64 : 512;
    const int ch = F.tid & 255, th = F.tid >> 8;
    const float* conv_w = FIN(I_CW); const float* conv_b = FIN(I_CB); const float* conv_ln_g = FIN(I_CLG); const float* conv_ln_b = FIN(I_CLB);
    float w[31];
#pragma unroll
    for (int j = 0; j < 31; ++j) w[j] = conv_w[((size_t)l * 31 + j) * 256 + ch];
    const float cb = conv_b[l * 256 + ch];
    for (int it = first; it < nitems; it += stride) {
        const bool lat = it < 512;
        const int seqlen = lat ? SEQ : CTXL;
        const int b = lat ? it >> 6 : (it - 512) >> 3, t0 = lat ? (it & 63) * 32 : ((it - 512) & 7) * 32;
        const int tokb = lat ? b * SEQ : NLAT + b * CTXL;
        __syncthreads();
        for (int i = F.tid; i < 62 * 64; i += NTHR) {
            const int rr = i >> 6, c4 = (i & 63) * 4, t = t0 - 15 + rr;
            f32x4 g = (f32x4){0.f, 0.f, 0.f, 0.f};
            if (t >= 0 && t < seqlen) { const size_t o = (size_t)(tokb + t) * 256 + c4; const u32x2 a = *(const u32x2*)(CA + o), gg = *(const u32x2*)(CG + o);
                g[0] = bflo(a.x) * sigmoidf_(bflo(gg.x)); g[1] = bfhi(a.x) * sigmoidf_(bfhi(gg.x)); g[2] = bflo(a.y) * sigmoidf_(bflo(gg.y)); g[3] = bfhi(a.y) * sigmoidf_(bfhi(gg.y)); }
            *(LAS f32x4*)(gl + rr * 256 + c4) = g;
        }
        __syncthreads();
        for (int tt = 0; tt < 16; ++tt) {
            const LAS float* gp = gl + (th * 16 + tt) * 256 + ch;
            float o = cb;
#pragma unroll
            for (int j = 0; j < 31; ++j) o += w[j] * gp[j * 256];
            ob[(th * 16 + tt) * 256 + ch] = o;
        }
        __syncthreads();
        for (int tt = F.wave; tt < 32; tt += NWAVES) {
            const f32x4 v = *(const LAS f32x4*)(ob + tt * 256 + 4 * F.lane);
            const float mean = wave_sum((v[0] + v[1]) + (v[2] + v[3])) * (1.0f / 256.f);
            const f32x4 d = v - mean;
            const float var = wave_sum((d[0] * d[0] + d[1] * d[1]) + (d[2] * d[2] + d[3] * d[3])) * (1.0f / 256.f);
            const float rs = 1.0f / sqrtf(var + EPS);
            const f32x4 lg = *(const f32x4*)(conv_ln_g + l * 256 + 4 * F.lane), lb = *(const f32x4*)(conv_ln_b + l * 256 + 4 * F.lane);
            f32x4 y;
#pragma unroll
            for (int q = 0; q < 4; ++q) y[q] = siluf_(d[q] * rs * lg[q] + lb[q]);
            *(u32x2*)(Y + (size_t)(tokb + t0 + tt) * KOUT + 512 + 4 * F.lane) = pk4(y);
        }
    }
    __syncthreads();
}
__device__ __forceinline__ void ztrans_items(Frame& F, int l, int first, int stride) {
    LAS unsigned short* tl = (LAS unsigned short*)(F.lds + F.wave * (64 * 66 * 2));
    const bf16_t* FR = WSP(bf16_t, WS_FR); bf16_t* ZTL = WSP(bf16_t, WS_ZT); bf16_t* ZTC = WSP(bf16_t, WS_ZTC);
    const int nlat = 8 * 32 * 4, nctx = (l == 0) ? 8 * 4 * 4 : 0;
    for (int it = first; it < nlat + nctx; it += stride) {
        const bool lat = it < nlat; const int r = lat ? it : it - nlat;
        const int b = lat ? r >> 7 : r >> 4, tb = lat ? (r >> 2) & 31 : (r >> 2) & 3, cb = r & 3;
        const int tokb = (lat ? b * SEQ : NLAT + b * CTXL) + tb * 64;
#pragma unroll
        for (int i = 0; i < 8; ++i) { const int tt = (F.lane >> 3) + 8 * i, c8 = (F.lane & 7) * 8;
            const u32x4 v = *(const u32x4*)(FR + (size_t)(tokb + tt) * 256 + cb * 64 + c8);
#pragma unroll
            for (int q = 0; q < 4; ++q) { tl[(c8 + 2 * q) * 66 + tt] = (unsigned short)(v[q] & 0xffffu); tl[(c8 + 2 * q + 1) * 66 + tt] = (unsigned short)(v[q] >> 16); } }
        LDS_WAIT(); asm volatile("" ::: "memory");
        bf16_t* dst = lat ? ZTL + (size_t)(b * 256 + cb * 64) * SEQ + tb * 64 : ZTC + (size_t)(b * 256 + cb * 64) * SEQ + tb * 64;
        const int ldz = SEQ;
#pragma unroll
        for (int i = 0; i < 8; ++i) { const int cc = (F.lane >> 3) + 8 * i, t8 = (F.lane & 7) * 8; u32x4 o;
#pragma unroll
            for (int q = 0; q < 4; ++q) o[q] = (unsigned)tl[cc * 66 + t8 + 2 * q] | ((unsigned)tl[cc * 66 + t8 + 2 * q + 1] << 16);
            *(u32x4*)(dst + (size_t)cc * ldz + t8) = o; }
        LDS_WAIT(); asm volatile("" ::: "memory");
    }
}
__device__ __forceinline__ void finalize_h(Frame& F, int l) {
    const bf16_t* HF = WSP(bf16_t, WS_HF); const bf16_t* HB = WSP(bf16_t, WS_HB); const bf16_t* O = WSP(bf16_t, WS_O); bf16_t* Y = WSP(bf16_t, WS_Y);
    const int gw = F.bid * NWAVES + F.wave, ngw = F.G * NWAVES;
    const int ntok = (l == 0) ? NTOK : NLAT;
    float gh[8];
    const float* g_hnorm = FIN(I_GH);
#pragma unroll
    for (int q = 0; q < 8; ++q) gh[q] = g_hnorm[l * 512 + 8 * F.lane + q];
    for (int tok = gw; tok < ntok; tok += ngw) {
        const size_t o = (size_t)tok * 512 + 8 * F.lane;
        const u32x4 a = *(const u32x4*)(HF + o), b = *(const u32x4*)(HB + o), og = *(const u32x4*)(O + o);
        float h[8]; float ss = 0.f;
#pragma unroll
        for (int q = 0; q < 4; ++q) { h[2 * q] = bflo(a[q]) + bflo(b[q]); h[2 * q + 1] = bfhi(a[q]) + bfhi(b[q]); ss += h[2 * q] * h[2 * q] + h[2 * q + 1] * h[2 * q + 1]; }
#pragma unroll
        for (int s = 1; s < 16; s <<= 1) ss += __shfl_xor(ss, s);
        const float r = 1.0f / sqrtf(ss * (1.0f / 128.f) + EPS);
        u32x4 w;
#pragma unroll
        for (int q = 0; q < 4; ++q) w[q] = pk2(h[2 * q] * r * gh[2 * q] * bflo(og[q]), h[2 * q + 1] * r * gh[2 * q + 1] * bfhi(og[q]));
        *(u32x4*)(Y + (size_t)tok * KOUT + 8 * F.lane) = w;
    }
}

using pg8::Unit;
enum { GM_INPROJ = 0, GM_DFT, GM_OUT, GM_MOE1, GM_MOE2 };
struct GemmCtl {
    int mode, l, G, c; unsigned char* ws; const Args& A;
    __device__ __forceinline__ unsigned char* W() const { unsigned char* p = ws; asm volatile("" : "+s"(p)); return p; }
    __device__ __forceinline__ bool next(int i, Unit& u) const {
        const int L = i * G + c; int pm, pn;
        u.rows = nullptr; u.ex = 0;
        switch (mode) {
        case GM_INPROJ: {
            const int n0 = 64 * 11, npn = (l == 0) ? 11 : 6;
            if (L >= n0 + 8 * npn) return false;
            if (L < n0) pg8::map_tile(L, 64, 11, pm, pn); else { pg8::map_tile(L - n0, 8, npn, pm, pn); pm += 64; }
            u.A = (const char*)(W() + WS_XN) + (size_t)pm * 256 * D * 2; u.B = (const char*)(W() + WS_WIN) + ((size_t)l * NIN + pn * 256) * D * 2; u.K = D;
        } break;
        case GM_DFT: {
            const int nctx = (l == 0) ? 16 : 0;
            if (L >= 128 + nctx) return false;
            if (L < 128) { pg8::map_tile(L, 16, 8, pm, pn); u.A = (const char*)(W() + WS_FL) + (size_t)pm * 256 * SEQ * 2; u.B = (const char*)(W() + WS_ZT) + (size_t)pn * 256 * SEQ * 2; u.K = SEQ; }
            else { const int r = L - 128; pm = r & 1; pn = r >> 1; u.A = (const char*)(W() + WS_FC) + (size_t)pm * 256 * SEQ * 2; u.B = (const char*)(W() + WS_ZTC) + (size_t)pn * 256 * SEQ * 2; u.K = CTXL; u.ex = 1; }
        } break;
        case GM_OUT: {
            const int nM = (l == 0) ? 72 : 64;
            if (L >= nM * 4) return false;
            pg8::map_tile(L, nM, 4, pm, pn);
            u.A = (const char*)(W() + WS_Y) + (size_t)pm * 256 * KOUT * 2; u.B = (const char*)(W() + WS_WOUT) + ((size_t)l * D + pn * 256) * KOUT * 2; u.K = KOUT;
        } break;
        case GM_MOE1: {
            const int nMe = (l == 0) ? 9 : 8; int pmg;
            if (L >= NE * nMe * 8) return false;
            pg8::map_tile(L, NE * nMe, 8, pmg, pn);
            const int e = pmg / nMe; pm = pmg % nMe;
            u.A = (const char*)(W() + WS_XN); u.rows = (const int*)(W() + WS_ROWTOK) + e * RPE + pm * 256; u.B = (const char*)(W() + WS_WGU) + ((size_t)e * 2048 + pn * 256) * D * 2; u.K = D; u.ex = e;
        } break;
        default: {
            const int nMe = (l == 0) ? 9 : 8; int pmg;
            if (L >= NE * nMe * 4) return false;
            pg8::map_tile(L, NE * nMe, 4, pmg, pn);
            const int e = pmg / nMe; pm = pmg % nMe;
            u.A = (const char*)(W() + WS_HID) + ((size_t)e * RPE + pm * 256) * D * 2; u.B = (const char*)(W() + WS_WD) + ((size_t)e * D + pn * 256) * D * 2; u.K = D; u.ex = e;
        } break;
        }
        u.pm = pm; u.pn = pn;
        return true;
    }
    struct CxIn { bf16_t* dst; int ld; float sc; int act; };
    __device__ __forceinline__ CxIn prep_in(const Unit& u) const {
        CxIn c; const int pn = u.pn; c.sc = 1.f; c.act = 0; size_t off; int cb;
        if (pn < 2) { off = WS_Q; c.ld = 512; cb = pn * 256; }
        else if (pn < 4) { off = WS_K; c.ld = 512; cb = (pn - 2) * 256; c.sc = 0.08838834764831845f; }
        else if (pn < 6) { off = WS_V; c.ld = 512; cb = (pn - 4) * 256; }
        else if (pn < 8) { off = WS_O; c.ld = 512; cb = (pn - 6) * 256; c.act = 1; }
        else if (pn == 8) { off = WS_CA; c.ld = 256; cb = 0; }
        else if (pn == 9) { off = WS_CG; c.ld = 256; cb = 0; }
        else { off = WS_FR; c.ld = 256; cb = 0; }
        c.dst = (bf16_t*)(W() + off) + (size_t)u.pm * 256 * c.ld + cb;
        return c;
    }
    __device__ __forceinline__ void store_in(const CxIn& c, int r, int col, f32x4 v0, f32x4 v1) const {
        if (c.act) {
#pragma unroll
            for (int q = 0; q < 4; ++q) { v0[q] = sigmoidf_(v0[q]); v1[q] = sigmoidf_(v1[q]); }
        } else { v0 = v0 * c.sc; v1 = v1 * c.sc; }
        bf16_t* p = c.dst + (size_t)r * c.ld + col;
        *(u32x2*)p = pk4(v0); *(u32x2*)(p + 16) = pk4(v1);
    }
    __device__ __forceinline__ bf16_t* prep_dft(const Unit& u) const {
        int part, tokb;
        if (u.ex == 0) { part = u.pm >> 3; tokb = u.pn * SEQ + (u.pm & 7) * 256; } else { part = u.pm; tokb = NLAT + u.pn * CTXL; }
        return (bf16_t*)(W() + WS_Y) + (size_t)tokb * KOUT + 768 + part * 256;
    }
    __device__ __forceinline__ void store_dft(bf16_t* dst, int r, int col, f32x4 v0, f32x4 v1) const {
        bf16_t* p = dst + (size_t)r * KOUT + col;
        *(u32x2*)p = pk4(v0); *(u32x2*)(p + 16) = pk4(v1);
    }
    struct CxOut { const float* src; float* dst; const float* gt; };
    __device__ __forceinline__ CxOut prep_out(const Unit& u) const {
        CxOut c; const int tok0 = u.pm * 256, col0 = u.pn * 256;
        if (l == 0) c.src = (tok0 < NLAT ? arg_in(A, I_X) + (size_t)tok0 * D : arg_in(A, I_CTX) + (size_t)(tok0 - NLAT) * D) + col0;
        else c.src = (const float*)(W() + WS_X) + (size_t)tok0 * D + col0;
        c.dst = (float*)(W() + WS_X) + (size_t)tok0 * D + col0;
        c.gt = (const float*)(W() + WS_MOD) + ((size_t)l * 9 + mod_row(tok0)) * 6144 + 2 * 1024 + col0;
        return c;
    }
    __device__ __forceinline__ void store_out(const CxOut& c, int r, int col, f32x4 v0, f32x4 v1) const {
        const size_t o = (size_t)r * D + col;
        const f32x4 g0 = *(const f32x4*)(c.gt + col), g1 = *(const f32x4*)(c.gt + col + 16);
        const f32x4 s0 = *(const f32x4*)(c.src + o), s1 = *(const f32x4*)(c.src + o + 16);
        *(f32x4*)(c.dst + o) = s0 + g0 * v0; *(f32x4*)(c.dst + o + 16) = s1 + g1 * v1;
    }
    __device__ __forceinline__ bf16_t* prep_m1(const Unit& u) const { return (bf16_t*)(W() + WS_HID) + ((size_t)u.ex * RPE + u.pm * 256) * D + u.pn * 128; }
    __device__ __forceinline__ void store_m1(bf16_t* dst, int r, int col, f32x4 v0, f32x4 v1) const {
        f32x4 h;
#pragma unroll
        for (int q = 0; q < 4; ++q) h[q] = siluf_(v0[q]) * v1[q];
        *(u32x2*)(dst + (size_t)r * D + (col >> 5) * 16 + (col & 15)) = pk4(h);
    }
    struct CxM2 { bf16_t* dst; const float* g; };
    __device__ __forceinline__ CxM2 prep_m2(const Unit& u) const { CxM2 c; c.dst = (bf16_t*)(W() + WS_YS) + ((size_t)u.ex * RPE + u.pm * 256) * D + u.pn * 256; c.g = (const float*)(W() + WS_GATEV) + u.ex * RPE + u.pm * 256; return c; }
    __device__ __forceinline__ void store_m2(const CxM2& c, int r, int col, f32x4 v0, f32x4 v1) const {
        const float g = c.g[r];
        bf16_t* p = c.dst + (size_t)r * D + col;
        *(u32x2*)p = pk4(v0 * g); *(u32x2*)(p + 16) = pk4(v1 * g);
    }
#define EPI_WALK(PREP, STORE) do { const auto cx = PREP(u); _Pragma("unroll") for (int ai = 0; ai < 2; ++ai) _Pragma("unroll") for (int m = 0; m < 4; ++m) _Pragma("unroll") for (int bj = 0; bj < 2; ++bj) \
        STORE(cx, ai * 128 + wr * 64 + m * 16 + fr, bj * 128 + wc * 32 + 4 * fq, acc[ai][bj][m][0], acc[ai][bj][m][1]); } while (0)
    __device__ __forceinline__ void run(const f32x4 (&acc)[2][2][4][2], const Unit& u, int wr, int wc, int fr, int fq) const {
        switch (mode) {
        case GM_INPROJ: EPI_WALK(prep_in, store_in); break;
        case GM_DFT: EPI_WALK(prep_dft, store_dft); break;
        case GM_OUT: EPI_WALK(prep_out, store_out); break;
        case GM_MOE1: EPI_WALK(prep_m1, store_m1); break;
        default: EPI_WALK(prep_m2, store_m2); break;
        }
    }
    __device__ __forceinline__ void store1(const Unit& u, int r, int c, f32x4 v0, f32x4 v1) const {
        switch (mode) {
        case GM_INPROJ: store_in(prep_in(u), r, c, v0, v1); break;
        case GM_DFT: store_dft(prep_dft(u), r, c, v0, v1); break;
        case GM_OUT: store_out(prep_out(u), r, c, v0, v1); break;
        case GM_MOE1: store_m1(prep_m1(u), r, c, v0, v1); break;
        default: store_m2(prep_m2(u), r, c, v0, v1); break;
        }
    }
};

__device__ __forceinline__ void scan_simt(Frame& F, int l) {
    if (F.bid >= 64) return;
    const int b = F.bid >> 3, h = (F.bid >> 1) & 3, dir = F.bid & 1;
    LAS float* qs = (LAS float*)F.lds; LAS float* ks = qs + 64 * 132; LAS float* vs = ks + 64 * 132; LAS float* st = vs + 64 * 132;
    LAS float* sm = st + 64 * 65;
    LAS float* as_ = sm; LAS float* Ms = sm + 64; LAS float* wint = sm + 128; LAS float* enm = sm + 192; LAS float* wst = sm + 256; LAS float* denom = sm + 320;
    LAS float* nvec = sm + 384; LAS float* ig = sm + 512; LAS float* lf = sm + 576; LAS int* toks = (LAS int*)(sm + 640); LAS float* scal = sm + 704;
    const bf16_t* Q = WSP(bf16_t, WS_Q); const bf16_t* K = WSP(bf16_t, WS_K); const bf16_t* V = WSP(bf16_t, WS_V); const float* GATES = WSP(float, WS_GATES);
    bf16_t* H = dir ? WSP(bf16_t, WS_HB) : WSP(bf16_t, WS_HF);
    float Creg[32];
#pragma unroll
    for (int i = 0; i < 32; ++i) Creg[i] = 0.f;
    float m_st = 0.f;
    if (F.tid < 128) nvec[F.tid] = 0.f;
    __syncthreads();
    for (int cc = 0; cc < 36; ++cc) {
        int tid = F.tid; asm volatile("" : "+v"(tid));
        const int lane = tid & 63, e = tid >> 2, dq = tid & 3;
        const bool isctx = cc < 4;
        const int c = isctx ? (dir ? 3 - cc : cc) : (dir ? 35 - cc : cc - 4);
        const bool want_out = !(isctx && l == 1);
        if (tid < 64) { const int j = tid;
            const int tok = isctx ? NLAT + b * CTXL + c * 64 + j : (h < 2 ? b * SEQ + c * 64 + j : b * SEQ + (j & 31) * 64 + 2 * c + (j >> 5));
            toks[j] = tok; const float* g = GATES + (size_t)tok * 16 + h * 4 + 2 * dir; ig[j] = g[0]; lf[j] = logsigmoidf_(g[1]); }
        __syncthreads();
        for (int it = tid; it < 1024; it += NTHR) { const int j = it >> 4, c8 = (it & 15) * 8; const size_t o = (size_t)toks[j] * 512 + h * 128 + c8;
            const u32x4 qv = *(const u32x4*)(Q + o), kv = *(const u32x4*)(K + o), vv = *(const u32x4*)(V + o);
#pragma unroll
            for (int q = 0; q < 4; ++q) { qs[j * 132 + c8 + 2 * q] = bflo(qv[q]); qs[j * 132 + c8 + 2 * q + 1] = bfhi(qv[q]); ks[j * 132 + c8 + 2 * q] = bflo(kv[q]); ks[j * 132 + c8 + 2 * q + 1] = bfhi(kv[q]);
                vs[j * 132 + c8 + 2 * q] = bflo(vv[q]); vs[j * 132 + c8 + 2 * q + 1] = bfhi(vv[q]); } }
        if (F.wave == 0) {
            const int p = dir ? 63 - lane : lane;
            float x = lf[p];
#pragma unroll
            for (int o = 1; o < 64; o <<= 1) { const float y = __shfl_up(x, o); if (lane >= o) x += y; }
            const float a = ig[p] - x; float cm = a;
#pragma unroll
            for (int o = 1; o < 64; o <<= 1) { const float y = __shfl_up(cm, o); if (lane >= o) cm = fmaxf(cm, y); }
            const float M = fmaxf(m_st, cm), Mend = __shfl(M, 63), blast = __shfl(x, 63);
            as_[p] = a; Ms[p] = M; wint[p] = expf(m_st - M); enm[p] = expf(-(x + M)); wst[p] = expf(a - Mend);
            if (lane == 0) { scal[0] = Mend; scal[1] = blast; }
        }
        __syncthreads();
        const float Mend = scal[0], blast = scal[1], decay = expf(m_st - Mend);
        if (want_out) {
            { const int t = tid >> 3, sg = tid & 7; float sacc[8];
#pragma unroll
                for (int i = 0; i < 8; ++i) sacc[i] = 0.f;
                for (int d4 = 0; d4 < 32; ++d4) { const f32x4 q4 = *(const LAS f32x4*)(qs + t * 132 + d4 * 4);
#pragma unroll
                    for (int i = 0; i < 8; ++i) { const f32x4 k4 = *(const LAS f32x4*)(ks + (i * 8 + sg) * 132 + d4 * 4); sacc[i] += (q4[0] * k4[0] + q4[1] * k4[1]) + (q4[2] * k4[2] + q4[3] * k4[3]); } }
#pragma unroll
                for (int i = 0; i < 8; ++i) { const int s = i * 8 + sg; const bool valid = dir ? (s >= t) : (s <= t); st[t * 65 + s] = valid ? sacc[i] * expf(as_[s] - Ms[t]) : 0.f; } }
            __syncthreads();
            if (tid < 64) { const int t = tid; float qn = 0.f, ssum = 0.f;
                for (int d = 0; d < 128; ++d) qn += qs[t * 132 + d] * nvec[d];
                for (int s = 0; s < 64; ++s) ssum += st[t * 65 + s];
                const float den = wint[t] * qn + ssum; denom[t] = fmaxf(fabsf(den), enm[t]); }
            float mine[16];
#pragma unroll
            for (int tt = 0; tt < 16; ++tt) {
                mine[tt] = 0.f;
#pragma unroll
                for (int u = 0; u < 4; ++u) { const int t = 4 * tt + u; float p = 0.f;
#pragma unroll
                    for (int i4 = 0; i4 < 8; ++i4) { const f32x4 q4 = *(const LAS f32x4*)(qs + t * 132 + dq * 32 + i4 * 4); p += (Creg[4 * i4] * q4[0] + Creg[4 * i4 + 1] * q4[1]) + (Creg[4 * i4 + 2] * q4[2] + Creg[4 * i4 + 3] * q4[3]); }
                    p += __shfl_xor(p, 1); p += __shfl_xor(p, 2);
                    mine[tt] = (u == dq) ? p : mine[tt]; asm volatile("" ::: "memory"); }
            }
#pragma unroll
            for (int tt = 0; tt < 16; ++tt) { const int t = 4 * tt + dq; float intra = 0.f;
#pragma unroll 8
                for (int s = 0; s < 64; ++s) intra += st[t * 65 + s] * vs[s * 132 + e];
                mine[tt] = wint[t] * mine[tt] + intra; asm volatile("" ::: "memory"); }
            __syncthreads();
#pragma unroll
            for (int tt = 0; tt < 16; ++tt) { const int t = 4 * tt + dq; H[(size_t)toks[t] * 512 + h * 128 + e] = (bf16_t)f2bf(mine[tt] / denom[t]); }
        }
#pragma unroll
        for (int i = 0; i < 32; ++i) Creg[i] *= decay;
#pragma unroll 2
        for (int s = 0; s < 64; ++s) { const float wv = wst[s] * vs[s * 132 + e];
#pragma unroll
            for (int i4 = 0; i4 < 8; ++i4) { const f32x4 k4 = *(const LAS f32x4*)(ks + s * 132 + dq * 32 + i4 * 4); Creg[4 * i4] += wv * k4[0]; Creg[4 * i4 + 1] += wv * k4[1]; Creg[4 * i4 + 2] += wv * k4[2]; Creg[4 * i4 + 3] += wv * k4[3]; } }
        float nn = 0.f;
        if (tid < 128) { nn = decay * nvec[tid]; for (int s = 0; s < 64; ++s) nn += wst[s] * ks[s * 132 + tid]; }
        __syncthreads();
        if (tid < 128) nvec[tid] = nn;
        m_st = blast + Mend;
        __syncthreads();
    }
}

__device__ __forceinline__ int scan_tok(bool isctx, int b, int h, int c, int j) {
    return isctx ? NLAT + b * CTXL + c * 64 + j : (h < 2 ? b * SEQ + c * 64 + j : b * SEQ + (j & 31) * 64 + 2 * c + (j >> 5));
}
__device__ __forceinline__ int img256(int row, int chunk) { return row * 256 + ((chunk ^ (row & 15)) << 4); }
__device__ __forceinline__ int img128(int row, int chunk) { return row * 128 + ((chunk ^ ((row >> 1) & 7)) << 4); }
__device__ __forceinline__ int off_b(int row, int ch) { return 256 * row + 16 * (ch ^ (((row & 3) << 2) | ((row >> 2) & 3))); }
__device__ __forceinline__ int rowrd16(int lane, int rb, int ks) { return off_b((lane & 15) + 16 * rb, 4 * ks + (lane >> 4)); }
__device__ __forceinline__ int trrd16(int lane, int c, int ks, int t) { const int g = lane >> 4, q = (lane & 15) >> 2, p = lane & 3;
    return off_b(32 * ks + 8 * g + 4 * t + q, 2 * c + (p >> 1)) + 8 * (p & 1); }
typedef short s16x4 __attribute__((ext_vector_type(4)));
__device__ __forceinline__ bf16x8 tr_frag(LAS unsigned char* img, int lane, int c, int ks, unsigned zv) {
    const s16x4 lo = __builtin_amdgcn_ds_read_tr16_b64_v4i16((LAS s16x4*)(img + trrd16(lane, c, ks, 0)));
    const s16x4 hi = __builtin_amdgcn_ds_read_tr16_b64_v4i16((LAS s16x4*)(img + trrd16(lane, c, ks, 1)));
    u32x2 a = __builtin_bit_cast(u32x2, lo), b = __builtin_bit_cast(u32x2, hi);
    a.x ^= zv; a.y ^= zv; b.x ^= zv; b.y ^= zv;
    const u32x4 r = (u32x4){a.x, a.y, b.x, b.y};
    return __builtin_bit_cast(bf16x8, r);
}
__device__ __forceinline__ void scan_mfma(Frame& F, int l) {
    if (F.bid >= 64) return;
    const int b = F.bid >> 3, h = (F.bid >> 1) & 3, dir = F.bid & 1;
    LAS unsigned char* L = F.lds;
    constexpr int O_QI = 0, O_KI = 16384, O_VI = 32768, O_ST = 49152, O_CL = 57344, O_HO = 94208, O_SM = 110592;
    LAS float* GV = (LAS float*)(L + O_SM);
    LAS float* SC = GV + 36 * 192;
    LAS float* DEN = SC + 36 * 4;
    const bf16_t* Q = WSP(bf16_t, WS_Q); const bf16_t* K = WSP(bf16_t, WS_K); const bf16_t* V = WSP(bf16_t, WS_V); const float* GATES = WSP(float, WS_GATES);
    bf16_t* H = dir ? WSP(bf16_t, WS_HB) : WSP(bf16_t, WS_HF);
    const int w = F.wave;
    { unsigned z0 = 0u; asm volatile("" : "+v"(z0));
      for (int i = F.tid; i < 36864 / 16; i += NTHR) *(LAS u32x4*)(L + O_CL + i * 16) = (u32x4){z0, z0, z0, z0}; }
    for (int cc = w; cc < 36; cc += NWAVES) {
        const bool ic = cc < 4; const int c_ = ic ? (dir ? 3 - cc : cc) : (dir ? 35 - cc : cc - 4), p_ = dir ? 63 - F.lane : F.lane;
        const f32x2 g = *(const f32x2*)(GATES + (size_t)scan_tok(ic, b, h, c_, p_) * 16 + h * 4 + 2 * dir);
        float x = logsigmoidf_(g[1]);
#pragma unroll
        for (int o = 1; o < 64; o <<= 1) { const float y = __shfl_up(x, o); if (F.lane >= o) x += y; }
        const float a = g[0] - x; float cm = a;
#pragma unroll
        for (int o = 1; o < 64; o <<= 1) { const float y = __shfl_up(cm, o); if (F.lane >= o) cm = fmaxf(cm, y); }
        GV[cc * 192 + p_] = a; GV[cc * 192 + 64 + p_] = x; GV[cc * 192 + 128 + p_] = cm;
        if (F.lane == 63) { SC[cc * 4 + 3] = x; SC[cc * 4 + 1] = cm; }
    }
    __syncthreads();
    if (F.tid == 0) { float m = 0.f;
        for (int cc = 0; cc < 36; ++cc) { const float Mend = fmaxf(m, SC[cc * 4 + 1]); SC[cc * 4 + 0] = m; SC[cc * 4 + 1] = Mend; SC[cc * 4 + 2] = expf(m - Mend); m = SC[cc * 4 + 3] + Mend; } }
    f32x4 accC[9];
#pragma unroll
    for (int i = 0; i < 9; ++i) accC[i] = (f32x4){0.f, 0.f, 0.f, 0.f};
    u32x4 pq[2], pk[2], pv[2];
#define SC_LOAD(CC) do { const int cc_ = (CC); const bool ic_ = cc_ < 4; const int c_ = ic_ ? (dir ? 3 - cc_ : cc_) : (dir ? 35 - cc_ : cc_ - 4); \
        _Pragma("unroll") for (int i_ = 0; i_ < 2; ++i_) { const int it_ = tid + NTHR * i_, s_ = it_ >> 4, c8_ = it_ & 15; const size_t o_ = (size_t)scan_tok(ic_, b, h, c_, s_) * 512 + h * 128 + c8_ * 8; \
            pq[i_] = *(const u32x4*)(Q + o_); pk[i_] = *(const u32x4*)(K + o_); pv[i_] = *(const u32x4*)(V + o_); } } while (0)
#define SC_WRITE() do { _Pragma("unroll") for (int i_ = 0; i_ < 2; ++i_) { const int it_ = tid + NTHR * i_, s_ = it_ >> 4, c8_ = it_ & 15; \
            *(LAS u32x4*)(L + O_QI + img256(s_, c8_)) = pq[i_]; *(LAS u32x4*)(L + O_KI + off_b(s_, c8_)) = pk[i_]; *(LAS u32x4*)(L + O_VI + off_b(s_, c8_)) = pv[i_]; } } while (0)
#define SC_MFMA(A, B, C) __builtin_amdgcn_mfma_f32_16x16x32_bf16((A), (B), (C), 0, 0, 0)
#define SC_BAR() do { asm volatile("s_waitcnt lgkmcnt(0)" ::: "memory"); __builtin_amdgcn_s_barrier(); asm volatile("" ::: "memory"); } while (0)
    {
        const int tid = F.tid;
        SC_LOAD(0);
        __syncthreads();
        SC_WRITE();
        __syncthreads();
    }
    for (int cc = 0; cc < 36; ++cc) {
        int tid = F.tid; asm volatile("" : "+v"(tid));
        const int lane = tid & 63, fr = lane & 15, fq = lane >> 4;
        const bool isctx = cc < 4, want_out = !(isctx && l == 1), more = cc + 1 < 36;
        const int c = isctx ? (dir ? 3 - cc : cc) : (dir ? 35 - cc : cc - 4);
        const LAS float* vb = GV + cc * 192; const float m_in = SC[cc * 4 + 0];
        unsigned zv = 0u; asm volatile("" : "+v"(zv));
        const short one_ = (fr == 0) ? (short)0x3F80 : (short)0;
        const bf16x8 ONES = (bf16x8){one_, one_, one_, one_, one_, one_, one_, one_};
        if (more) SC_LOAD(cc + 1);
        if (want_out) {
            const int tb = w >> 1, sb = 2 * (w & 1);
            f32x4 s0 = (f32x4){0.f, 0.f, 0.f, 0.f}, s1 = s0;
#pragma unroll
            for (int ks = 0; ks < 4; ++ks) {
                const bf16x8 fy = *(const LAS bf16x8*)(L + O_QI + img256(tb * 16 + fr, ks * 4 + fq));
                const bf16x8 fx0 = *(const LAS bf16x8*)(L + O_KI + rowrd16(lane, sb, ks)), fx1 = *(const LAS bf16x8*)(L + O_KI + rowrd16(lane, sb + 1, ks));
                s0 = SC_MFMA(fx0, fy, s0); s1 = SC_MFMA(fx1, fy, s1); }
            const int t = tb * 16 + fr; const float Mt = fmaxf(m_in, vb[128 + t]);
#pragma unroll
            for (int i = 0; i < 2; ++i) { const int sr0 = (sb + i) * 16 + 4 * fq; const f32x4 a4 = *(const LAS f32x4*)(vb + sr0); const f32x4 sv = i ? s1 : s0; f32x4 o;
#pragma unroll
                for (int r = 0; r < 4; ++r) { const int sI = sr0 + r; const bool valid = dir ? (sI >= t) : (sI <= t); o[r] = valid ? sv[r] * __expf(a4[r] - Mt) : 0.f; }
                *(LAS u32x2*)(L + O_ST + img128(t, sr0 >> 3) + (sr0 & 7) * 2) = pk4(o); }
        }
        SC_BAR();
        {
            const float decay = SC[cc * 4 + 2], Mend = SC[cc * 4 + 1];
#pragma unroll
            for (int et = 0; et < 9; ++et) accC[et] = accC[et] * decay;
#pragma unroll
            for (int ks = 0; ks < 2; ++ks) {
                const bf16x8 kx = tr_frag(L + O_KI, lane, w, ks, zv);
                const f32x4 a0 = *(const LAS f32x4*)(vb + 32 * ks + 8 * fq), a1 = *(const LAS f32x4*)(vb + 32 * ks + 8 * fq + 4);
                u32x4 ax;
#pragma unroll
                for (int j = 0; j < 4; ++j) { const float w0 = __expf((j < 2 ? a0[2 * j] : a1[2 * j - 4]) - Mend), w1 = __expf((j < 2 ? a0[2 * j + 1] : a1[2 * j - 3]) - Mend);
                    ax[j] = pk2(bf2f((unsigned short)kx[2 * j]) * w0, bf2f((unsigned short)kx[2 * j + 1]) * w1); }
                const bf16x8 axf = __builtin_bit_cast(bf16x8, ax);
#pragma unroll
                for (int et = 0; et < 8; ++et) { const bf16x8 fv = tr_frag(L + O_VI, lane, et, ks, zv); accC[et] = SC_MFMA(axf, fv, accC[et]); }
                accC[8] = SC_MFMA(axf, ONES, accC[8]);
            }
        }
        f32x4 num[4];
        if (want_out) {
            bf16x8 ac[4], av[2];
#pragma unroll
            for (int ks = 0; ks < 4; ++ks) ac[ks] = *(const LAS bf16x8*)(L + O_CL + img256(w * 16 + fr, ks * 4 + fq));
#pragma unroll
            for (int ks = 0; ks < 2; ++ks) av[ks] = tr_frag(L + O_VI, lane, w, ks, zv);
#pragma unroll
            for (int tb = 0; tb < 4; ++tb) {
                f32x4 nI = (f32x4){0.f, 0.f, 0.f, 0.f}, nS = nI;
#pragma unroll
                for (int ks = 0; ks < 4; ++ks) { const bf16x8 fy = *(const LAS bf16x8*)(L + O_QI + img256(tb * 16 + fr, ks * 4 + fq)); nI = SC_MFMA(ac[ks], fy, nI); }
#pragma unroll
                for (int ks = 0; ks < 2; ++ks) { const bf16x8 fs = *(const LAS bf16x8*)(L + O_ST + img128(tb * 16 + fr, ks * 4 + fq)); nS = SC_MFMA(av[ks], fs, nS); }
                num[tb] = nI * __expf(m_in - fmaxf(m_in, vb[128 + tb * 16 + fr])) + nS;
            }
            if (w < 4) {
                f32x4 dI = (f32x4){0.f, 0.f, 0.f, 0.f}, dS = dI;
#pragma unroll
                for (int ks = 0; ks < 4; ++ks) { const bf16x8 a8 = *(const LAS bf16x8*)(L + O_CL + img256(128 + fr, ks * 4 + fq)); const bf16x8 fy = *(const LAS bf16x8*)(L + O_QI + img256(w * 16 + fr, ks * 4 + fq)); dI = SC_MFMA(a8, fy, dI); }
#pragma unroll
                for (int ks = 0; ks < 2; ++ks) { const bf16x8 fs = *(const LAS bf16x8*)(L + O_ST + img128(w * 16 + fr, ks * 4 + fq)); dS = SC_MFMA(ONES, fs, dS); }
                const int t = w * 16 + fr; const float Mt = fmaxf(m_in, vb[128 + t]); const float den = __expf(m_in - Mt) * dI[0] + dS[0];
                if (lane < 16) DEN[t] = fmaxf(fabsf(den), __expf(-(vb[64 + t] + Mt)));
            }
        }
        SC_BAR();
        if (want_out) {
#pragma unroll
            for (int tb = 0; tb < 4; ++tb) { const int t = tb * 16 + fr, e0 = w * 16 + 4 * fq; const float rd = 1.0f / DEN[t];
                *(LAS u32x2*)(L + O_HO + img256(t, e0 >> 3) + (e0 & 7) * 2) = pk4(num[tb] * rd); }
        }
#pragma unroll
        for (int et = 0; et < 9; ++et) { const int d0 = w * 16 + 4 * fq; *(LAS u32x2*)(L + O_CL + img256(et * 16 + fr, d0 >> 3) + (d0 & 7) * 2) = pk4(accC[et]); }
        if (more) SC_WRITE();
        SC_BAR();
        if (want_out) {
            const int t = tid >> 3; bf16_t* hp = H + (size_t)scan_tok(isctx, b, h, c, t) * 512 + h * 128;
#pragma unroll
            for (int i = 0; i < 2; ++i) { const int ch = (tid & 7) * 2 + i; *(u32x4*)(hp + ch * 8) = *(const LAS u32x4*)(L + O_HO + img256(t, ch)); }
        }
    }
#undef SC_LOAD
#undef SC_WRITE
#undef SC_MFMA
#undef SC_BAR
}

constexpr int NPHASES = 20;
enum { K_PREP = 0, K_NORM1, K_INPROJ, K_MIX1, K_MIX2, K_OUTPROJ, K_NORM2, K_TOPK, K_MOE1, K_MOE2, K_COMBINE };

__global__ void __launch_bounds__(NTHR, 2) fwd_kernel(Args args) {
    extern __shared__ __attribute__((aligned(16))) unsigned char lds_raw[];
    Frame F{(LAS unsigned char*)lds_raw, (int)threadIdx.x, (int)(threadIdx.x & 63), __builtin_amdgcn_readfirstlane((int)(threadIdx.x >> 6)), (int)gridDim.x, (int)blockIdx.x, args.ws, args};
    volatile LAS unsigned* MISC = (volatile LAS unsigned*)(F.lds + LDSCTL_OFF);
    if (F.tid < 16) MISC[F.tid] = 0u;
    __syncthreads();
    XcdBarrier bar; bar.bar = (unsigned*)(F.ws + WS_CTL); bar.x = 0; bar.st = MISC;
    const int lo = args.ph_lo, hi = args.ph_hi;
    if (hi - lo > 1) bar = xcd_barrier_post((unsigned*)(F.ws + WS_CTL), MISC);
    for (int ph = lo; ph < hi; ++ph) {
        int l, kind;
        if (ph == 0) { l = 0; kind = K_PREP; } else if (ph == 1) { l = 0; kind = K_NORM1; } else if (ph < 11) { l = 0; kind = K_INPROJ + (ph - 2); } else { l = 1; kind = K_INPROJ + (ph - 11); }
#ifndef PHMASK
#define PHMASK 0xFFFF
#endif
#define PHON(k) ((PHMASK >> (k)) & 1)
#ifndef REPMASK
#define REPMASK 0
#endif
        int nrep_ = 1 + ((REPMASK >> kind) & 1); asm volatile("" : "+s"(nrep_));
        for (int rep_ = 0; rep_ < nrep_; ++rep_) {
        if (rep_) xcd_barrier(bar);
        { int t_ = threadIdx.x, b_ = blockIdx.x; unsigned char* w_ = args.ws; asm volatile("" : "+v"(t_)); asm volatile("" : "+s"(b_)); asm volatile("" : "+s"(w_));
          F.tid = t_; F.lane = t_ & 63; F.wave = __builtin_amdgcn_readfirstlane(t_ >> 6); F.bid = b_; F.ws = w_; }
        l = __builtin_amdgcn_readfirstlane(l); kind = __builtin_amdgcn_readfirstlane(kind); asm volatile("" : "+s"(l)); asm volatile("" : "+s"(kind));
        unsigned char* ws = F.ws;
        const bool is_gemm = (kind == K_INPROJ || kind == K_MIX2 || kind == K_OUTPROJ || kind == K_MOE1 || kind == K_MOE2);
        switch (kind) {
        case K_PREP: if (PHON(0)) phase_prep(F); break;
        case K_NORM1: if (PHON(1)) phase_norm1_l0(F); break;
        case K_MIX1: if (PHON(3)) {
#ifndef MIXSEL
#define MIXSEL 7
#endif
            if (F.bid < 64) scan_mfma(F, l);
            else { const int hb = F.bid - 64, hg = F.G - 64;
                conv_items(F, l, hb, hg);
                ztrans_items(F, l, hb * NWAVES + F.wave, hg * NWAVES);
                __syncthreads();
                convert_moe_weights(F, l, hb * NWAVES + F.wave, hg * NWAVES); }
        } break;
        case K_MIX2: if (PHON(4)) finalize_h(F, l); break;
        case K_NORM2: if (PHON(6)) phase_norm2(F, l); break;
        case K_TOPK: if (PHON(7)) phase_topk(F, l); break;
        case K_COMBINE: if (PHON(10)) phase_combine(F, l); break;
        default: break;
        }
        if (is_gemm && PHON(2)) {
            const int gm = kind == K_INPROJ ? GM_INPROJ : kind == K_MIX2 ? GM_DFT : kind == K_OUTPROJ ? GM_OUT : kind == K_MOE1 ? GM_MOE1 : GM_MOE2;
            GemmCtl S{gm, l, F.G, F.bid, ws, F.A};
            const int ld = gm == GM_DFT ? SEQ : gm == GM_OUT ? KOUT : D;
            GEMM_PHASE(F.lds, ld, ld, S, S);
        }
        }
        if (ph + 1 < hi) xcd_barrier(bar);
    }
}

extern "C" void kernel_launch(void* const* d_in, const int* in_sizes, int n_in, void* d_out, int out_size, void* d_ws, size_t ws_size, hipStream_t stream) {
    static int grid = 0;
    if (grid == 0) {
        if (n_in != 21 || out_size != NLAT * D || ws_size < WS_END) { fprintf(stderr, "kernel_launch: unexpected shapes (n_in %d out %d ws %zu need %zu)\n", n_in, out_size, ws_size, (size_t)WS_END); grid = -1; return; }
        int dev = 0, cus = 0, per_cu = 0;
        hipGetDevice(&dev); hipDeviceGetAttribute(&cus, hipDeviceAttributeMultiprocessorCount, dev);
        if (hipFuncSetAttribute((const void*)fwd_kernel, hipFuncAttributeMaxDynamicSharedMemorySize, LDS_BYTES) != hipSuccess) { fprintf(stderr, "kernel_launch: hipFuncSetAttribute failed\n"); grid = -1; return; }
        hipOccupancyMaxActiveBlocksPerMultiprocessor(&per_cu, (const void*)fwd_kernel, NTHR, LDS_BYTES);
        (void)hipGetLastError();
        if (per_cu < 1) fprintf(stderr, "kernel_launch: occupancy query reports %d\n", per_cu);
        grid = cus;
    }
    if (grid < 0) return;
    hipMemsetAsync((char*)d_ws + WS_CTL, 0, 65536, stream);
    Args a{};
    for (int i = 0; i < 21; ++i) a.in[i] = (const float*)d_in[i];
    a.out = (float*)d_out; a.ws = (unsigned char*)d_ws;
#if N_LAUNCHES == 1
    a.ph_lo = 0; a.ph_hi = NPHASES;
    void* kargs[] = {&a};
    hipError_t e = hipLaunchCooperativeKernel((const void*)fwd_kernel, dim3(grid), dim3(NTHR), kargs, LDS_BYTES, stream);
    if (e != hipSuccess) fprintf(stderr, "kernel_launch: cooperative launch failed: %s (grid %d)\n", hipGetErrorString(e), grid);
#else
#ifndef MAXPH
#define MAXPH NPHASES
#endif
    for (int ph = 0; ph < MAXPH; ++ph) { a.ph_lo = ph; a.ph_hi = ph + 1; hipLaunchKernelGGL(fwd_kernel, dim3(grid), dim3(NTHR), LDS_BYTES, stream, a); }
#endif
}
```

```cpp
#include <hip/hip_runtime.h>
#include <cstdio>
#include <cstdint>

#ifndef N_LAUNCHES
#define N_LAUNCHES 1
#endif
#ifndef USE_MFMA_GEMM
#define USE_MFMA_GEMM 1
#endif

#define LAS __attribute__((address_space(3)))
#define GAS __attribute__((address_space(1)))
typedef unsigned short bf16_t;
typedef short bf16x8 __attribute__((ext_vector_type(8)));
typedef float f32x4 __attribute__((ext_vector_type(4)));
typedef float f32x2 __attribute__((ext_vector_type(2)));
typedef unsigned u32x4 __attribute__((ext_vector_type(4)));
typedef unsigned u32x2 __attribute__((ext_vector_type(2)));
typedef GAS unsigned gu32;
#define RLX_AGENT __ATOMIC_RELAXED, __HIP_MEMORY_SCOPE_AGENT
#define LDS_WAIT() asm volatile("s_waitcnt lgkmcnt(0)" ::: "memory")
#define VM_WAIT() asm volatile("s_waitcnt vmcnt(0)" ::: "memory")

constexpr int D = 1024, NB = 8, SEQ = 2048, CTXL = 256;
constexpr int NLAT = NB * SEQ, NCTX = NB * CTXL, NTOK = NLAT + NCTX;
constexpr int INC = 2832, NIN = 2816;
constexpr int KOUT = 1280;
constexpr int NE = 16, RPE = 2304;
constexpr float EPS = 1e-6f;
constexpr int NTHR = 512, NWAVES = 8;

constexpr size_t al256(size_t x) { return (x + 255) & ~(size_t)255; }
constexpr size_t WS_CTL = 0;
constexpr size_t WS_MOD = WS_CTL + 65536;
constexpr size_t WS_WIN = WS_MOD + al256((size_t)2 * 9 * 6144 * 4);
constexpr size_t WS_WOUT = WS_WIN + (size_t)2 * NIN * D * 2;
constexpr size_t WS_WGU = WS_WOUT + (size_t)2 * D * KOUT * 2;
constexpr size_t WS_WD = WS_WGU + (size_t)NE * 2048 * D * 2;
constexpr size_t WS_FL = WS_WD + (size_t)NE * D * D * 2;
constexpr size_t WS_FC = WS_FL + (size_t)4096 * 1024 * 2;
constexpr size_t WS_X = WS_FL + (size_t)4096 * 2048 * 2 + (size_t)512 * 2048 * 2;
constexpr size_t WS_XN = WS_X + (size_t)NTOK * D * 4;
constexpr size_t WS_GATES = WS_XN + (size_t)NTOK * D * 2;
constexpr size_t WS_AFF = WS_GATES + (size_t)NTOK * 16 * 4;
constexpr size_t WS_INV = WS_AFF + (size_t)NTOK * 16 * 4;
constexpr size_t WS_ROWTOK = WS_INV + (size_t)NTOK * 16 * 4;
constexpr size_t WS_GATEV = WS_ROWTOK + (size_t)NE * RPE * 4;
constexpr size_t WS_R1 = WS_GATEV + (size_t)NE * RPE * 4;
constexpr size_t SZ_QKV = (size_t)NTOK * 512 * 2;
constexpr size_t WS_Q = WS_R1, WS_K = WS_Q + SZ_QKV, WS_V = WS_K + SZ_QKV, WS_O = WS_V + SZ_QKV;
constexpr size_t WS_HID = WS_R1;
constexpr size_t WS_R2 = WS_R1 + 4 * SZ_QKV;
constexpr size_t SZ_C = (size_t)NTOK * 256 * 2;
constexpr size_t WS_CA = WS_R2, WS_CG = WS_CA + SZ_C, WS_FR = WS_CG + SZ_C, WS_ZT = WS_FR + SZ_C;
constexpr size_t WS_ZO = WS_ZT + (size_t)2048 * 1024 * 2;
constexpr size_t WS_ZTC = WS_ZT + (size_t)2048 * 2048 * 2;
constexpr size_t WS_HF = WS_ZT + 2 * (size_t)2048 * 2048 * 2, WS_HB = WS_HF + SZ_QKV, WS_Y = WS_HB + SZ_QKV;
constexpr size_t WS_YS = WS_R2;
constexpr size_t WS_END = WS_Y + (size_t)NTOK * KOUT * 2;
static_assert((size_t)NE * RPE * D * 2 <= 4 * SZ_QKV, "HID alias");
static_assert(WS_YS + (size_t)NE * RPE * D * 2 <= WS_END, "YS alias");

constexpr int RING_BYTES = 139264;
constexpr int LDSCTL_OFF = RING_BYTES;
constexpr int LDS_BYTES = RING_BYTES + 1024;

__device__ __forceinline__ unsigned f2bf(float f) { unsigned u = __float_as_uint(f); u += 0x7FFFu + ((u >> 16) & 1u); return u >> 16; }
typedef __bf16 bf16x2_t __attribute__((ext_vector_type(2)));
__device__ __forceinline__ unsigned pk2(float lo, float hi) { const bf16x2_t r = __builtin_convertvector((f32x2){lo, hi}, bf16x2_t); return __builtin_bit_cast(unsigned, r); }
__device__ __forceinline__ float bf2f(unsigned b) { return __uint_as_float(b << 16); }
__device__ __forceinline__ float bflo(unsigned w) { return __uint_as_float(w << 16); }
__device__ __forceinline__ float bfhi(unsigned w) { return __uint_as_float(w & 0xffff0000u); }
__device__ __forceinline__ float sigmoidf_(float x) { return 1.0f / (1.0f + __expf(-x)); }
__device__ __forceinline__ float siluf_(float x) { return x / (1.0f + __expf(-x)); }
__device__ __forceinline__ float logsigmoidf_(float x) { return x >= 0.f ? -log1pf(expf(-x)) : x - log1pf(expf(x)); }
__device__ __forceinline__ float wave_sum(float v) {
#pragma unroll
    for (int o = 1; o < 64; o <<= 1) v += __shfl_xor(v, o);
    return v;
}
__device__ __forceinline__ u32x2 pk4(f32x4 v) { u32x2 w; w.x = pk2(v[0], v[1]); w.y = pk2(v[2], v[3]); return w; }

#define XB_TMO      128
#define XB_XCNT(j)  (256  + 64 * (j))
#define XB_XSUB(j)  (1280 + 64 * (j))
#define XB_XGEN(j)  (2304 + 64 * (j))
#define XB_TOP      3328
#define XB_TOPGEN   3392
#define XCD_BAR_WORDS 3456
#define XB_SPIN_CAP (1u << 22)
__device__ __forceinline__ unsigned xb_ld(unsigned* p)              { return __hip_atomic_load(p, __ATOMIC_RELAXED, __HIP_MEMORY_SCOPE_AGENT); }
__device__ __forceinline__ unsigned xb_add(unsigned* p, unsigned v) { return __hip_atomic_fetch_add(p, v, __ATOMIC_RELAXED, __HIP_MEMORY_SCOPE_AGENT); }
__device__ __forceinline__ unsigned xb_xcc_id() { return (unsigned)__builtin_amdgcn_s_getreg((3 << 11) | 20) & 0xFu; }
#define XB_SPIN(cond, bar) do { unsigned _sp = 0; while (cond) { __builtin_amdgcn_s_sleep(1); \
    if ((++_sp & 255u) == 0u) { if (xb_ld(&(bar)[XB_TMO])) break; if (_sp > XB_SPIN_CAP) { atomicAdd(&(bar)[XB_TMO], 1u); break; } } } } while (0)
struct XcdBarrier { unsigned* bar; unsigned x; volatile LAS unsigned* st; };
__device__ __forceinline__ XcdBarrier xcd_barrier_post(unsigned* bar, volatile LAS unsigned* st) {
    XcdBarrier b; b.bar = bar; b.x = xb_xcc_id(); b.st = st;
    if (threadIdx.x == 0) (void)xb_add(&bar[XB_XCNT(b.x)], 1u);
    return b;
}
__device__ __forceinline__ void xcd_barrier_complete(unsigned* bar, unsigned x, unsigned& nloc, unsigned& nx) {
    const unsigned G = gridDim.x * gridDim.y * gridDim.z;
    unsigned sum, cnt, mine, sp = 0u;
    for (;;) {
        sum = 0u; cnt = 0u; mine = 0u;
#pragma unroll
        for (unsigned j = 0; j < 16; ++j) { const unsigned c = xb_ld(&bar[XB_XCNT(j)]); sum += c; cnt += (c > 0u) ? 1u : 0u; mine = (j == x) ? c : mine; }
        if (sum == G) break;
        __builtin_amdgcn_s_sleep(1);
        if ((++sp & 255u) == 0u) { if (xb_ld(&bar[XB_TMO])) break; if (sp > XB_SPIN_CAP) { atomicAdd(&bar[XB_TMO], 1u); break; } }
    }
    nloc = mine > 0u ? mine : 1u; nx = cnt > 0u ? cnt : 1u;
}
__device__ __forceinline__ void xcd_barrier(const XcdBarrier& b) {
    asm volatile("s_waitcnt vmcnt(0)" ::: "memory");
    __syncthreads();
    if (threadIdx.x == 0) {
        unsigned* bar = b.bar;
        __builtin_amdgcn_s_waitcnt(0);
        unsigned nloc = b.st[0], nx = b.st[1];
        if (nloc == 0u) { xcd_barrier_complete(bar, b.x, nloc, nx); b.st[0] = nloc; b.st[1] = nx; }
        const unsigned old = xb_add(&bar[XB_XSUB(b.x)], 1u);
        const unsigned gen = old / nloc;
        if (old + 1u == (gen + 1u) * nloc) {
            __builtin_amdgcn_fence(__ATOMIC_RELEASE, "agent");
            asm volatile("s_waitcnt vmcnt(0)" ::: "memory");
            const unsigned og = xb_add(&bar[XB_TOP], 1u);
            const unsigned tg = og / nx;
            if (og + 1u == (tg + 1u) * nx) xb_add(&bar[XB_TOPGEN], 1u);
            else XB_SPIN(xb_ld(&bar[XB_TOPGEN]) == tg, bar);
            __builtin_amdgcn_fence(__ATOMIC_ACQUIRE, "agent");
            xb_add(&bar[XB_XGEN(b.x)], 1u);
            asm volatile("s_waitcnt vmcnt(0)" ::: "memory");
        } else {
            XB_SPIN(xb_ld(&bar[XB_XGEN(b.x)]) == gen, bar);
            __builtin_amdgcn_fence(__ATOMIC_ACQUIRE, "agent");
            asm volatile("s_waitcnt vmcnt(0)" ::: "memory");
        }
    }
    __syncthreads();
}

namespace pg8 {
constexpr int BM = 256, BK = 64, HALF = 128, HTB = HALF * BK * 2, STAGE_BYTES = 8 * HTB, NXCD = 8, WGM = 8;
__host__ __device__ __forceinline__ int lds_byte(int r, int c) { const int st = (r >> 4) * 2 + (c >> 5), rr = r & 15, cc = c & 31, ob = rr * 64 + cc * 2; return st * 1024 + (ob ^ (((ob >> 9) & 1) << 5)); }
__host__ __device__ __forceinline__ void stage_rc(int b, int& R, int& C) { const int st = b / 1024, sb = b % 1024, swz = sb ^ (((sb >> 9) & 1) << 5); R = (st >> 1) * 16 + swz / 64; C = (st & 1) * 32 + (swz % 64) / 2; }

struct Unit { const char* A; const char* B; const int* rows; int K, pm, pn, ex; };

__device__ __forceinline__ void map_tile(int L, int nM, int nN, int& pm, int& pn) {
    const int nwg = nM * nN; int wgid = L;
    { const int q = nwg / NXCD, r = nwg % NXCD, xcd = wgid % NXCD, off = wgid / NXCD; wgid = (xcd < r ? xcd * (q + 1) : r * (q + 1) + (xcd - r) * q) + off; }
    const int nig = WGM * nN, gid = wgid / nig, fm = gid * WGM, gsz = (nM - fm) < WGM ? (nM - fm) : WGM;
    pm = fm + ((wgid % nig) % gsz); pn = (wgid % nig) / gsz;
}
__device__ __forceinline__ void a_offs(const Unit& u, int lda, int tid, unsigned (&vA)[2][2]) {
#pragma unroll
    for (int h = 0; h < 2; ++h)
#pragma unroll
        for (int i = 0; i < 2; ++i) { int R, C; stage_rc(tid * 16 + i * 8192, R, C); const int r = h * HALF + R; const int ar = u.rows ? u.rows[r] : r; vA[h][i] = (unsigned)(ar * lda + C) * 2u; }
}

template <class Epi, class Sched>
__device__ __forceinline__ void gemm_phase(LAS unsigned char* lds, const int tid, const int lda, const int ldb, const Sched& S, const Epi& E) {
    const int wid = __builtin_amdgcn_readfirstlane(tid >> 6), lane = tid & 63, wr = wid >> 2, wc = wid & 3, fr = lane & 15, fq = lane >> 4;
    unsigned voffB[2];
#pragma unroll
    for (int i = 0; i < 2; ++i) { int R, C; stage_rc(tid * 16 + i * 8192, R, C); voffB[i] = (unsigned)(R * ldb + C) * 2u; }
    const size_t kstep = (size_t)(BK * 2);
    const size_t hsB = (size_t)HALF * ldb * 2;
    const unsigned ldsw = (unsigned)wid * 1024u;
    const int aoff = lds_byte(wr * 64 + fr, fq * 8), boff = lds_byte(wc * 32 + fr, fq * 8);
#define PG8_SA(b, h) (((b) * 2 + (h)) * HTB)
#define PG8_SB(b, h) ((4 + (b) * 2 + (h)) * HTB)
#define PG8_STAGE(bufoff, gbase, voff) do { _Pragma("unroll") for (int _i = 0; _i < 2; ++_i) \
        __builtin_amdgcn_global_load_lds((const unsigned*)((const char*)(gbase) + (voff)[_i]), (LAS unsigned*)(lds + (bufoff) + ldsw + _i * 8192), 16, 0, 0); } while (0)
#define PG8_LDA(dst, b, h) do { _Pragma("unroll") for (int m = 0; m < 4; ++m) _Pragma("unroll") for (int k = 0; k < 2; ++k) dst[m][k] = *(const LAS bf16x8*)(lds + PG8_SA(b, h) + aoff + m * 2048 + k * 1024); } while (0)
#define PG8_LDB(dst, b, h) do { _Pragma("unroll") for (int n = 0; n < 2; ++n) _Pragma("unroll") for (int k = 0; k < 2; ++k) dst[n][k] = *(const LAS bf16x8*)(lds + PG8_SB(b, h) + boff + n * 2048 + k * 1024); } while (0)
#define PG8_MMA(ai, bj, At, Bt) do { __builtin_amdgcn_s_setprio(1); _Pragma("unroll") for (int m = 0; m < 4; ++m) _Pragma("unroll") for (int n = 0; n < 2; ++n) _Pragma("unroll") for (int k = 0; k < 2; ++k) \
        acc[ai][bj][m][n] = __builtin_amdgcn_mfma_f32_16x16x32_bf16(Bt[n][k], At[m][k], acc[ai][bj][m][n], 0, 0, 0); __builtin_amdgcn_s_setprio(0); } while (0)
#define PG8_WAIT_V(n) asm volatile("s_waitcnt vmcnt(" #n ")" ::: "memory")
#define PG8_WAIT_L(n) asm volatile("s_waitcnt lgkmcnt(" #n ")" ::: "memory")
#define PG8_BAR __builtin_amdgcn_s_barrier()
#define PG8_SCHED __builtin_amdgcn_sched_barrier(0)
    Unit cur, nxt; int ui = 0;
    if (!S.next(0, cur)) return;
    f32x4 acc[2][2][4][2];
#pragma unroll
    for (int a = 0; a < 2; ++a)
#pragma unroll
        for (int b = 0; b < 2; ++b)
#pragma unroll
            for (int m = 0; m < 4; ++m)
#pragma unroll
                for (int n = 0; n < 2; ++n) acc[a][b][m][n] = (f32x4){0.f, 0.f, 0.f, 0.f};
    bf16x8 At[4][2], B0[2][2], B1[2][2];
    unsigned vA[2][2], wA[2][2];
    a_offs(cur, lda, tid, vA);
    const char* cA = cur.A; const char* cB = cur.B;
    PG8_STAGE(PG8_SB(0, 0), cB, voffB); PG8_STAGE(PG8_SB(0, 1), cB + hsB, voffB); PG8_STAGE(PG8_SA(0, 0), cA, vA[0]); PG8_STAGE(PG8_SA(0, 1), cA, vA[1]);
    if (wr == 1) PG8_BAR;
    PG8_WAIT_V(2); PG8_BAR;
    PG8_STAGE(PG8_SB(1, 0), cB + kstep, voffB); PG8_STAGE(PG8_SA(1, 0), cA + kstep, vA[0]); PG8_STAGE(PG8_SB(1, 1), cB + hsB + kstep, voffB);
    PG8_WAIT_V(6); PG8_BAR;
    for (;;) {
        const bool has_next = S.next(ui + 1, nxt);
        if (!has_next) nxt = cur;
        const char* nA = nxt.A; const char* nB = nxt.B;
        a_offs(nxt, lda, tid, wA);
        const int nt = cur.K / BK;
        asm volatile(".p2align 8" ::: "memory");
        for (int t = 0; t < nt; t += 2) {
            const bool last = (t == nt - 2);
            const char* a1 = cA + (size_t)(t + 1) * kstep;
            const char* a2 = last ? nA : cA + (size_t)(t + 2) * kstep; const char* b2 = last ? nB : cB + (size_t)(t + 2) * kstep;
            const char* a3 = a2 + kstep; const char* b3 = b2 + kstep;
            PG8_LDB(B0, 0, 0); PG8_LDB(B1, 0, 1); PG8_SCHED; PG8_LDA(At, 0, 0); PG8_STAGE(PG8_SA(1, 1), a1, vA[1]);
            if (last) {
#pragma unroll
                for (int h = 0; h < 2; ++h)
#pragma unroll
                    for (int i = 0; i < 2; ++i) vA[h][i] = wA[h][i];
            }
            PG8_WAIT_V(8); PG8_WAIT_L(0); PG8_BAR; PG8_MMA(0, 0, At, B0); PG8_MMA(0, 1, At, B1); PG8_BAR; PG8_SCHED;
            PG8_LDA(At, 0, 1); PG8_STAGE(PG8_SB(0, 0), b2, voffB); PG8_STAGE(PG8_SB(0, 1), b2 + hsB, voffB); PG8_STAGE(PG8_SA(0, 0), a2, vA[0]);
            PG8_WAIT_V(8); PG8_WAIT_L(0); PG8_BAR; PG8_MMA(1, 0, At, B0); PG8_MMA(1, 1, At, B1); PG8_BAR; PG8_SCHED;
            PG8_LDB(B0, 1, 0); PG8_LDB(B1, 1, 1); PG8_SCHED; PG8_LDA(At, 1, 0); PG8_STAGE(PG8_SA(0, 1), a2, vA[1]);
            PG8_WAIT_V(8); PG8_WAIT_L(0); PG8_BAR; PG8_MMA(0, 0, At, B0); PG8_MMA(0, 1, At, B1); PG8_BAR; PG8_SCHED;
            PG8_LDA(At, 1, 1); PG8_STAGE(PG8_SB(1, 0), b3, voffB); PG8_STAGE(PG8_SB(1, 1), b3 + hsB, voffB); PG8_STAGE(PG8_SA(1, 0), a3, vA[0]);
            PG8_WAIT_V(8); PG8_WAIT_L(0); PG8_BAR; PG8_MMA(1, 0, At, B0); PG8_MMA(1, 1, At, B1); PG8_BAR; PG8_SCHED;
        }
        if (wr == 0) PG8_BAR;
        { int fr_ = fr, fq_ = fq; asm volatile("" : "+v"(fr_), "+v"(fq_));
          E.run(acc, cur, wr, wc, fr_, fq_); }
        if (!has_next) break;
#pragma unroll
        for (int a = 0; a < 2; ++a)
#pragma unroll
            for (int b = 0; b < 2; ++b)
#pragma unroll
                for (int m = 0; m < 4; ++m)
#pragma unroll
                    for (int n = 0; n < 2; ++n) acc[a][b][m][n] = (f32x4){0.f, 0.f, 0.f, 0.f};
        cur = nxt; cA = nA; cB = nB; ++ui;
        if (wr == 1) PG8_BAR;
    }
    PG8_WAIT_V(0);
    PG8_BAR;
#undef PG8_SA
#undef PG8_SB
#undef PG8_STAGE
#undef PG8_LDA
#undef PG8_LDB
#undef PG8_MMA
#undef PG8_WAIT_V
#undef PG8_WAIT_L
#undef PG8_BAR
#undef PG8_SCHED
}
template <class Epi, class Sched>
__device__ __forceinline__ void gemm_phase_simt(LAS unsigned char* lds, const int tid, const int lda, const int ldb, const Sched& S, const Epi& E) {
    LAS float* As = (LAS float*)lds;
    LAS float* Bs = (LAS float*)(lds + 32 * 132 * 4);
    const int ty = tid >> 4, tx = tid & 15, c0 = (tx >> 2) * 32 + (tx & 3) * 4;
    const int lr = tid >> 2, lk = (tid & 3) * 8;
    Unit u;
    for (int ui = 0; S.next(ui, u); ++ui) {
        for (int sub = 0; sub < 4; ++sub) {
            const int sr = sub >> 1, sc = sub & 1;
            float acc[4][8];
#pragma unroll
            for (int i = 0; i < 4; ++i)
#pragma unroll
                for (int j = 0; j < 8; ++j) acc[i][j] = 0.f;
            const int arow = sr * 128 + lr, brow = sc * 128 + lr;
            const int ar = u.rows ? u.rows[arow] : arow;
            const bf16_t* ap = (const bf16_t*)u.A + (size_t)ar * lda + lk;
            const bf16_t* bp = (const bf16_t*)u.B + (size_t)brow * ldb + lk;
            for (int k0 = 0; k0 < u.K; k0 += 32) {
                const u32x4 av = *(const u32x4*)(ap + k0), bv = *(const u32x4*)(bp + k0);
                __syncthreads();
#pragma unroll
                for (int j = 0; j < 4; ++j) {
                    As[(lk + 2 * j) * 132 + lr] = bflo(av[j]); As[(lk + 2 * j + 1) * 132 + lr] = bfhi(av[j]);
                    Bs[(lk + 2 * j) * 132 + lr] = bflo(bv[j]); Bs[(lk + 2 * j + 1) * 132 + lr] = bfhi(bv[j]);
                }
                __syncthreads();
#pragma unroll 4
                for (int k = 0; k < 32; ++k) {
                    const f32x4 a4 = *(const LAS f32x4*)(As + k * 132 + ty * 4);
                    const f32x4 b0 = *(const LAS f32x4*)(Bs + k * 132 + c0), b1 = *(const LAS f32x4*)(Bs + k * 132 + c0 + 16);
#pragma unroll
                    for (int i = 0; i < 4; ++i)
#pragma unroll
                        for (int j = 0; j < 4; ++j) { acc[i][j] += a4[i] * b0[j]; acc[i][4 + j] += a4[i] * b1[j]; }
                }
            }
#pragma unroll
            for (int i = 0; i < 4; ++i)
                E.store1(u, sr * 128 + ty * 4 + i, sc * 128 + c0, (f32x4){acc[i][0], acc[i][1], acc[i][2], acc[i][3]}, (f32x4){acc[i][4], acc[i][5], acc[i][6], acc[i][7]});
        }
    }
    __syncthreads();
}
}

#if USE_MFMA_GEMM
#define GEMM_PHASE(lds, lda, ldb, S, E) pg8::gemm_phase(lds, F.tid, lda, ldb, S, E)
#else
#define GEMM_PHASE(lds, lda, ldb, S, E) pg8::gemm_phase_simt(lds, F.tid, lda, ldb, S, E)
#endif

struct Args { const float* in[21]; float* out; unsigned char* ws; int ph_lo, ph_hi; };
enum { I_X = 0, I_C, I_CTX, I_CCTX, I_WADA, I_BADA, I_GN1, I_WIN, I_BG, I_GH, I_CW, I_CB, I_CLG, I_CLB, I_WOUT, I_GN2, I_WR, I_WEG, I_WEU, I_WED, I_GF };
__device__ __forceinline__ const float* arg_in(const Args& a, int i) { asm volatile("" : "+s"(i)); return a.in[i]; }
struct Frame {
    LAS unsigned char* lds;
    int tid, lane, wave, G, bid;
    unsigned char* ws;
    const Args& A;
};
#define FIN(i) arg_in(F.A, (i))
#define WSP(T, off) ((T*)(F.ws + (off)))

template <class Src>
__device__ __forceinline__ void tr_item(const Src& src, bf16_t* dst, int ldd, int n0, int k0, LAS float* scr, int lane) {
    f32x4 v[8];
#pragma unroll
    for (int i = 0; i < 8; ++i) v[i] = src.ld4(k0 + i * 8 + (lane >> 3), n0 + (lane & 7) * 4);
#pragma unroll
    for (int i = 0; i < 8; ++i) { LAS float* p = scr + (i * 8 + (lane >> 3)) * 33 + (lane & 7) * 4; p[0] = v[i][0]; p[1] = v[i][1]; p[2] = v[i][2]; p[3] = v[i][3]; }
    LDS_WAIT(); asm volatile("" ::: "memory");
    const int c = lane & 7;
#pragma unroll
    for (int j = 0; j < 4; ++j) { const int n = (lane >> 3) + 8 * j; const LAS float* s = scr + (8 * c) * 33 + n;
        u32x4 o; o.x = pk2(s[0 * 33], s[1 * 33]); o.y = pk2(s[2 * 33], s[3 * 33]); o.z = pk2(s[4 * 33], s[5 * 33]); o.w = pk2(s[6 * 33], s[7 * 33]);
        *(u32x4*)(dst + (size_t)(n0 + n) * ldd + k0 + 8 * c) = o; }
    LDS_WAIT(); asm volatile("" ::: "memory");
}
struct SrcWin { const float* w; __device__ __forceinline__ f32x4 ld4(int k, int n) const { return *(const f32x4*)(w + (size_t)k * INC + (n < 1536 ? n : n + 16)); } };
struct SrcPlain { const float* w; int ld; __device__ __forceinline__ f32x4 ld4(int k, int n) const { return *(const f32x4*)(w + (size_t)k * ld + n); } };
struct SrcGU { const float* wg; const float* wu; __device__ __forceinline__ f32x4 ld4(int k, int n) const { const int grp = n >> 5, i = n & 31;
    const uintptr_t base = (uintptr_t)wg + ((i < 16) ? (uintptr_t)0 : ((uintptr_t)wu - (uintptr_t)wg));
    return *(const f32x4*)((const float*)base + (size_t)k * D + grp * 16 + (i & 15)); } };

__device__ __forceinline__ void convert_moe_weights(Frame& F, int l, int gw, int ngw) {
    LAS float* scr = (LAS float*)(F.lds + F.wave * 8448);
    bf16_t* WGU = WSP(bf16_t, WS_WGU); bf16_t* WD = WSP(bf16_t, WS_WD);
    const float* w_e_gate = FIN(I_WEG); const float* w_e_up = FIN(I_WEU); const float* w_e_down = FIN(I_WED);
    constexpr int I_GU = NE * 64 * 16, I_D = NE * 32 * 16;
    for (int it = gw; it < I_GU + I_D; it += ngw) {
        if (it < I_GU) { const int e = it / 1024, r = it % 1024, nb = r / 16, kb = r % 16;
            SrcGU s{w_e_gate + ((size_t)l * NE + e) * D * D, w_e_up + ((size_t)l * NE + e) * D * D};
            tr_item(s, WGU + (size_t)e * 2048 * D, D, nb * 32, kb * 64, scr, F.lane);
        } else { const int r0 = it - I_GU, e = r0 / 512, r = r0 % 512, nb = r / 16, kb = r % 16;
            SrcPlain s{w_e_down + ((size_t)l * NE + e) * D * D, D};
            tr_item(s, WD + (size_t)e * D * D, D, nb * 32, kb * 64, scr, F.lane);
        }
    }
}

__device__ __forceinline__ void phase_prep(Frame& F) {
    const int tid = F.tid;
    {
        LAS float* s = (LAS float*)F.lds;
        LAS float* red = (LAS float*)(F.lds + 9 * 1024 * 4);
        float* MOD = WSP(float, WS_MOD);
        const float* c_in = FIN(I_C); const float* c_ctx = FIN(I_CCTX); const float* w_ada = FIN(I_WADA); const float* b_ada = FIN(I_BADA);
        bool staged = false;
        for (int it = F.bid; it < 192; it += F.G) {
            if (!staged) { for (int i = tid; i < 9 * 1024; i += NTHR) { const int r = i >> 10, k = i & 1023; const float cv = (r < 8) ? c_in[r * 1024 + k] : c_ctx[k]; s[i] = siluf_(cv); } staged = true; }
            __syncthreads();
            const int l = it / 96, cgp = it % 96, col = cgp * 64 + (tid & 63), kq = tid >> 6;
            float acc[9];
#pragma unroll
            for (int r = 0; r < 9; ++r) acc[r] = 0.f;
            const float* w = w_ada + ((size_t)l * 1024 + kq * 128) * 6144 + col;
            for (int k0 = 0; k0 < 128; k0 += 32) {
                float wv[32];
#pragma unroll
                for (int k = 0; k < 32; ++k) wv[k] = w[(size_t)(k0 + k) * 6144];
#pragma unroll
                for (int k = 0; k < 32; ++k)
#pragma unroll
                    for (int r = 0; r < 9; ++r) acc[r] += s[r * 1024 + kq * 128 + k0 + k] * wv[k];
            }
#pragma unroll
            for (int r = 0; r < 9; ++r) red[(kq * 9 + r) * 64 + (tid & 63)] = acc[r];
            __syncthreads();
            for (int o = tid; o < 576; o += NTHR) { const int r = o >> 6, cc = o & 63; float sum = 0.f;
#pragma unroll
                for (int q = 0; q < 8; ++q) sum += red[(q * 9 + r) * 64 + cc];
                MOD[((size_t)l * 9 + r) * 6144 + cgp * 64 + cc] = sum + b_ada[l * 6144 + cgp * 64 + cc]; }
            __syncthreads();
        }
        __syncthreads();
    }
    {
        bf16_t* FL = WSP(bf16_t, WS_FL); bf16_t* FC = WSP(bf16_t, WS_FC);
        const size_t gth = (size_t)F.bid * NTHR + tid, nth = (size_t)F.G * NTHR;
        for (size_t it = gth; it < (size_t)4096 * 1024 / 8; it += nth) {
            const int r = (int)(it / 128), t0 = (int)(it % 128) * 8, part = r >> 11, k = r & 2047; unsigned w[4];
#pragma unroll
            for (int j = 0; j < 4; ++j) { float v[2];
#pragma unroll
                for (int q = 0; q < 2; ++q) { const int ph = (k * (t0 + 2 * j + q)) & 2047; const float ang = (float)ph * (6.283185307179586f / 2048.f); v[q] = (part ? sinf(ang) : cosf(ang)) * 0.022097086912079608f; }
                w[j] = pk2(v[0], v[1]); }
            *(u32x4*)(FL + (size_t)r * 1024 + t0) = (u32x4){w[0], w[1], w[2], w[3]};
        }
        for (size_t it = gth; it < (size_t)512 * 256 / 8; it += nth) {
            const int r = (int)(it / 32), t0 = (int)(it % 32) * 8, part = r >> 8, k = r & 255; unsigned w[4];
#pragma unroll
            for (int j = 0; j < 4; ++j) { float v[2];
#pragma unroll
                for (int q = 0; q < 2; ++q) { const int ph = (k * (t0 + 2 * j + q)) & 255; const float ang = (float)ph * (6.283185307179586f / 256.f); v[q] = (part ? sinf(ang) : cosf(ang)) * 0.0625f; }
                w[j] = pk2(v[0], v[1]); }
            *(u32x4*)(FC + (size_t)r * 1024 + t0) = (u32x4){w[0], w[1], w[2], w[3]};
        }
    }
    const int gw = F.bid * NWAVES + F.wave, ngw = F.G * NWAVES;
    {
        LAS float* scr = (LAS float*)(F.lds + F.wave * 8448);
        bf16_t* WIN = WSP(bf16_t, WS_WIN); bf16_t* WOUT = WSP(bf16_t, WS_WOUT);
        const float* w_in = FIN(I_WIN); const float* w_out = FIN(I_WOUT);
        constexpr int I_IN = 2 * 88 * 16, I_OP = 2 * 32 * 12, I_PQ = 2 * 32 * 8;
        for (int it = gw; it < I_IN + I_OP + I_PQ; it += ngw) {
            if (it < I_IN) { const int l = it / 1408, r = it % 1408, nb = r / 16, kb = r % 16;
                SrcWin s{w_in + (size_t)l * D * INC};
                tr_item(s, WIN + (size_t)l * NIN * D, D, nb * 32, kb * 64, scr, F.lane);
            } else if (it < I_IN + I_OP) { const int r0 = it - I_IN, l = r0 / 384, r = r0 % 384, nb = r / 12, kb = r % 12;
                SrcPlain s{w_out + (size_t)l * D * D, D};
                tr_item(s, WOUT + (size_t)l * D * KOUT, KOUT, nb * 32, kb * 64, scr, F.lane);
            } else { const int r0 = it - I_IN - I_OP, l = r0 / 256, r = r0 % 256, nb = r / 8, gp = r % 8, g = gp & 3, part = gp >> 2;
                const float* wsrc = w_out + (size_t)l * D * D + (size_t)(768 + g * 64) * D + nb * 32;
#pragma unroll 8
                for (int i = 0; i < 32; ++i) { const int kk = 2 * i + (F.lane >> 5), nn = F.lane & 31; scr[kk * 33 + nn] = wsrc[(size_t)kk * D + nn]; }
                LDS_WAIT(); asm volatile("" ::: "memory");
                const int c8 = F.lane & 7;
                float o[4][8];
#pragma unroll
                for (int j = 0; j < 4; ++j)
#pragma unroll
                    for (int q = 0; q < 8; ++q) o[j][q] = 0.f;
                for (int m = 0; m < 64; ++m) {
                    float twd[8];
#pragma unroll
                    for (int q = 0; q < 8; ++q) { const float ang = (float)((m * (c8 * 8 + q)) & 63) * (6.283185307179586f / 64.f); twd[q] = part ? -__sinf(ang) : __cosf(ang); }
#pragma unroll
                    for (int j = 0; j < 4; ++j) { const float bv = scr[m * 33 + (F.lane >> 3) + 8 * j];
#pragma unroll
                        for (int q = 0; q < 8; ++q) o[j][q] += twd[q] * bv; }
                }
#pragma unroll
                for (int j = 0; j < 4; ++j) { const int n = (F.lane >> 3) + 8 * j;
                    u32x4 ov; ov.x = pk2(o[j][0] * 0.125f, o[j][1] * 0.125f); ov.y = pk2(o[j][2] * 0.125f, o[j][3] * 0.125f); ov.z = pk2(o[j][4] * 0.125f, o[j][5] * 0.125f); ov.w = pk2(o[j][6] * 0.125f, o[j][7] * 0.125f);
                    *(u32x4*)(WOUT + (size_t)l * D * KOUT + (size_t)(nb * 32 + n) * KOUT + 768 + part * 256 + g * 64 + c8 * 8) = ov; }
                LDS_WAIT(); asm volatile("" ::: "memory");
            }
        }
    }
}

__device__ __forceinline__ void stage_small_w(Frame& F, LAS float* wT, const float* src, int ld, int coloff) {
    for (int i = F.tid; i < 16 * 1024; i += NTHR) { const int k = i >> 4, c = i & 15; wT[c * 1024 + k] = src[(size_t)k * ld + coloff + c]; }
    __syncthreads();
}
__device__ __forceinline__ float reduce16(float (&acc)[16], int lane) {
    float v8[8], v4[4], v2[2], v1;
#pragma unroll
    for (int i = 0; i < 8; ++i) { const float snd = (lane & 32) ? acc[i] : acc[i + 8], kp = (lane & 32) ? acc[i + 8] : acc[i]; v8[i] = kp + __shfl_xor(snd, 32); }
#pragma unroll
    for (int i = 0; i < 4; ++i) { const float snd = (lane & 16) ? v8[i] : v8[i + 4], kp = (lane & 16) ? v8[i + 4] : v8[i]; v4[i] = kp + __shfl_xor(snd, 16); }
#pragma unroll
    for (int i = 0; i < 2; ++i) { const float snd = (lane & 8) ? v4[i] : v4[i + 2], kp = (lane & 8) ? v4[i + 2] : v4[i]; v2[i] = kp + __shfl_xor(snd, 8); }
    { const float snd = (lane & 4) ? v2[0] : v2[1], kp = (lane & 4) ? v2[1] : v2[0]; v1 = kp + __shfl_xor(snd, 4); }
    v1 += __shfl_xor(v1, 2); v1 += __shfl_xor(v1, 1);
    return v1;
}
__device__ __forceinline__ float norm_row(const f32x4 (&v)[4], const float* gain, const float* shift, const float* scale, bf16_t* xn_row, const LAS float* wT, int lane) {
    float ss = 0.f;
#pragma unroll
    for (int j = 0; j < 4; ++j) ss += (v[j][0] * v[j][0] + v[j][1] * v[j][1]) + (v[j][2] * v[j][2] + v[j][3] * v[j][3]);
    ss = wave_sum(ss);
    const float r = 1.0f / sqrtf(ss * (1.0f / D) + EPS);
    float acc[16];
#pragma unroll
    for (int c = 0; c < 16; ++c) acc[c] = 0.f;
#pragma unroll
    for (int j = 0; j < 4; ++j) {
        const int o = 4 * lane + 256 * j;
        const f32x4 g = *(const f32x4*)(gain + o), sh = *(const f32x4*)(shift + o), sc = *(const f32x4*)(scale + o);
        f32x4 y;
#pragma unroll
        for (int q = 0; q < 4; ++q) y[q] = v[j][q] * r * g[q] * (1.0f + sc[q]) + sh[q];
        *(u32x2*)(xn_row + o) = pk4(y);
        f32x4 wv[16];
#pragma unroll
        for (int c = 0; c < 16; ++c) wv[c] = *(const LAS f32x4*)(wT + c * 1024 + o);
        __builtin_amdgcn_sched_barrier(0);
#pragma unroll
        for (int c = 0; c < 16; ++c) acc[c] += (y[0] * wv[c][0] + y[1] * wv[c][1]) + (y[2] * wv[c][2] + y[3] * wv[c][3]);
        __builtin_amdgcn_sched_barrier(0);
        asm volatile("" ::: "memory");
    }
    return reduce16(acc, lane);
}
__device__ __forceinline__ void row_tail_gates(float myv, const float* b_gates_l, float* gates_row, int lane) {
    if ((lane & 3) == 0) { const int c = lane >> 2; gates_row[c] = myv + b_gates_l[c]; }
}
__device__ __forceinline__ void row_tail_router(float myv, float* aff_row, int lane) {
    float mx = myv;
#pragma unroll
    for (int o = 4; o < 64; o <<= 1) mx = fmaxf(mx, __shfl_xor(mx, o));
    const float e = expf(myv - mx); float s = e;
#pragma unroll
    for (int o = 4; o < 64; o <<= 1) s += __shfl_xor(s, o);
    if ((lane & 3) == 0) aff_row[lane >> 2] = e / s;
}
__device__ __forceinline__ int mod_row(int tok) { return tok < NLAT ? (tok >> 11) : 8; }

__device__ __forceinline__ void phase_norm1_l0(Frame& F) {
    LAS float* wT = (LAS float*)F.lds;
    stage_small_w(F, wT, FIN(I_WIN), INC, 1536);
    const float* MOD = WSP(float, WS_MOD); bf16_t* XN = WSP(bf16_t, WS_XN); float* GATES = WSP(float, WS_GATES);
    const float* x_in = FIN(I_X); const float* ctx_in = FIN(I_CTX); const float* g_norm1 = FIN(I_GN1); const float* b_gates = FIN(I_BG);
    const int gw = F.bid * NWAVES + F.wave, ngw = F.G * NWAVES;
    f32x4 vn[4];
    { const float* src = gw < NLAT ? x_in + (size_t)gw * D : ctx_in + (size_t)(gw - NLAT) * D;
#pragma unroll
      for (int j = 0; j < 4; ++j) vn[j] = *(const f32x4*)(src + 4 * F.lane + 256 * j); }
    for (int tok = gw; tok < NTOK; tok += ngw) {
        f32x4 v[4];
#pragma unroll
        for (int j = 0; j < 4; ++j) v[j] = vn[j];
        const int tn = tok + ngw;
        if (tn < NTOK) { const float* src = tn < NLAT ? x_in + (size_t)tn * D : ctx_in + (size_t)(tn - NLAT) * D;
#pragma unroll
            for (int j = 0; j < 4; ++j) vn[j] = *(const f32x4*)(src + 4 * F.lane + 256 * j); }
        const float* md = MOD + (size_t)mod_row(tok) * 6144;
        const float myv = norm_row(v, g_norm1, md, md + 1024, XN + (size_t)tok * D, wT, F.lane);
        row_tail_gates(myv, b_gates, GATES + (size_t)tok * 16, F.lane);
    }
    __syncthreads();
}
__device__ __forceinline__ void phase_norm2(Frame& F, int l) {
    LAS float* wT = (LAS float*)F.lds;
    stage_small_w(F, wT, FIN(I_WR) + (size_t)l * D * 16, 16, 0);
    const float* g_norm2 = FIN(I_GN2);
    const float* MOD = WSP(float, WS_MOD); bf16_t* XN = WSP(bf16_t, WS_XN); float* AFF = WSP(float, WS_AFF); const float* X = WSP(float, WS_X);
    const int gw = F.bid * NWAVES + F.wave, ngw = F.G * NWAVES;
    const int ntok = (l == 0) ? NTOK : NLAT;
    f32x4 vn[4];
#pragma unroll
    for (int j = 0; j < 4; ++j) vn[j] = *(const f32x4*)(X + (size_t)gw * D + 4 * F.lane + 256 * j);
    for (int tok = gw; tok < ntok; tok += ngw) {
        f32x4 v[4];
#pragma unroll
        for (int j = 0; j < 4; ++j) v[j] = vn[j];
        const int tn = tok + ngw;
        if (tn < ntok) {
#pragma unroll
            for (int j = 0; j < 4; ++j) vn[j] = *(const f32x4*)(X + (size_t)tn * D + 4 * F.lane + 256 * j); }
        const float* md = MOD + ((size_t)l * 9 + mod_row(tok)) * 6144;
        const float myv = norm_row(v, g_norm2 + l * D, md + 3 * 1024, md + 4 * 1024, XN + (size_t)tok * D, wT, F.lane);
        row_tail_router(myv, AFF + (size_t)tok * 16, F.lane);
    }
    __syncthreads();
}
__device__ __forceinline__ void phase_combine(Frame& F, int l) {
    LAS float* wT = (LAS float*)F.lds;
    if (l == 0) stage_small_w(F, wT, FIN(I_WIN) + (size_t)1 * D * INC, INC, 1536);
    const float* g_norm1 = FIN(I_GN1); const float* b_gates = FIN(I_BG); const float* g_final = FIN(I_GF); float* outp = F.A.out;
    const float* MOD = WSP(float, WS_MOD); bf16_t* XN = WSP(bf16_t, WS_XN); float* GATES = WSP(float, WS_GATES); float* X = WSP(float, WS_X);
    const int* INV = WSP(int, WS_INV); const bf16_t* YS = WSP(bf16_t, WS_YS);
    const int gw = F.bid * NWAVES + F.wave, ngw = F.G * NWAVES;
    const int ntok = (l == 0) ? NTOK : NLAT;
    f32x4 vn[4]; int invn = INV[(size_t)gw * 16 + (F.lane & 15)];
#pragma unroll
    for (int j = 0; j < 4; ++j) vn[j] = *(const f32x4*)(X + (size_t)gw * D + 4 * F.lane + 256 * j);
    for (int tok = gw; tok < ntok; tok += ngw) {
        f32x4 v[4], a[4];
#pragma unroll
        for (int j = 0; j < 4; ++j) { v[j] = vn[j]; a[j] = (f32x4){0.f, 0.f, 0.f, 0.f}; }
        const int myinv = invn;
        { const int tn = tok + ngw;
          if (tn < ntok) { invn = INV[(size_t)tn * 16 + (F.lane & 15)];
#pragma unroll
              for (int j = 0; j < 4; ++j) vn[j] = *(const f32x4*)(X + (size_t)tn * D + 4 * F.lane + 256 * j); } }
        {
            unsigned long long mask = __ballot(myinv >= 0) & 0xffffull;
            while (mask) { const int e = __builtin_ctzll(mask); mask &= mask - 1;
                const int r = __builtin_amdgcn_readlane(myinv, e);
                const bf16_t* yr = YS + ((size_t)e * RPE + r) * D;
#pragma unroll
                for (int j = 0; j < 4; ++j) { const u32x2 w = *(const u32x2*)(yr + 4 * F.lane + 256 * j); a[j][0] += bflo(w.x); a[j][1] += bfhi(w.x); a[j][2] += bflo(w.y); a[j][3] += bfhi(w.y); } }
        }
        const float* md = MOD + ((size_t)l * 9 + mod_row(tok)) * 6144;
#pragma unroll
        for (int j = 0; j < 4; ++j) { const f32x4 gt = *(const f32x4*)(md + 5 * 1024 + 4 * F.lane + 256 * j); v[j] = v[j] + gt * a[j]; }
        if (l == 0) {
#pragma unroll
            for (int j = 0; j < 4; ++j) *(f32x4*)(X + (size_t)tok * D + 4 * F.lane + 256 * j) = v[j];
            const float* md1 = MOD + ((size_t)9 + mod_row(tok)) * 6144;
            const float myv = norm_row(v, g_norm1 + D, md1, md1 + 1024, XN + (size_t)tok * D, wT, F.lane);
            row_tail_gates(myv, b_gates + 16, GATES + (size_t)tok * 16, F.lane);
        } else {
            float ss = 0.f;
#pragma unroll
            for (int j = 0; j < 4; ++j) ss += (v[j][0] * v[j][0] + v[j][1] * v[j][1]) + (v[j][2] * v[j][2] + v[j][3] * v[j][3]);
            ss = wave_sum(ss);
            const float r = 1.0f / sqrtf(ss * (1.0f / D) + EPS);
#pragma unroll
            for (int j = 0; j < 4; ++j) { const f32x4 g = *(const f32x4*)(g_final + 4 * F.lane + 256 * j); *(f32x4*)(outp + (size_t)tok * D + 4 * F.lane + 256 * j) = v[j] * r * g; }
        }
    }
    __syncthreads();
}

__device__ __forceinline__ int block_count(LAS int* cbuf, int par, int wave, int lane, int c_wave  ) {
    if (lane == 0) cbuf[par * 8 + wave] = c_wave;
    __syncthreads();
    int t = 0;
#pragma unroll
    for (int q = 0; q < 8; ++q) t += cbuf[par * 8 + q];
    return t;
}
__device__ __forceinline__ void phase_topk(Frame& F, int l) {
    LAS int* cbuf = (LAS int*)F.lds;
    const float* AFF = WSP(float, WS_AFF); int* INV = WSP(int, WS_INV); int* ROWTOK = WSP(int, WS_ROWTOK); float* GATEV = WSP(float, WS_GATEV);
    const int nitems = (l == 0) ? 256 : 128;
    for (int it = F.bid; it < nitems; it += F.G) {
        const int s = it >> 4, e = it & 15;
        const bool lat = s < 8;
        const int n = lat ? SEQ : CTXL, cap = lat ? 256 : 32, tok0 = lat ? s * SEQ : NLAT + (s - 8) * CTXL, rowbase = lat ? s * 256 : 2048 + (s - 8) * 32;
        const bool active = 4 * F.tid < n;
        unsigned k[4];
#pragma unroll
        for (int q = 0; q < 4; ++q) k[q] = active ? __float_as_uint(AFF[(size_t)(tok0 + 4 * F.tid + q) * 16 + e]) : 0u;
        __syncthreads();
        unsigned T = 0u; int par = 0;
        for (int bit = 30; bit >= 0; --bit) {
            const unsigned cand = T | (1u << bit);
            int cw = 0;
#pragma unroll
            for (int q = 0; q < 4; ++q) cw += __popcll(__ballot(k[q] >= cand));
            const int tot = block_count(cbuf, par, F.wave, F.lane, cw); par ^= 1;
            if (tot >= cap) T = cand;
        }
        int cw = 0;
#pragma unroll
        for (int q = 0; q < 4; ++q) cw += __popcll(__ballot(k[q] > T));
        const int c_gt = block_count(cbuf, par, F.wave, F.lane, cw); par ^= 1;
        int mg = 0, me = 0;
#pragma unroll
        for (int q = 0; q < 4; ++q) { mg += (k[q] > T) ? 1 : 0; me += (k[q] == T && active) ? 1 : 0; }
        int pk_ = mg | (me << 16), inc = pk_;
#pragma unroll
        for (int o = 1; o < 64; o <<= 1) { const int y = __shfl_up(inc, o); if (F.lane >= o) inc += y; }
        if (F.lane == 63) cbuf[16 + F.wave] = inc;
        __syncthreads();
        int base = 0;
#pragma unroll
        for (int q = 0; q < 8; ++q) base += (q < F.wave) ? cbuf[16 + q] : 0;
        int pre = base + inc - pk_; int pg = pre & 0xffff, pe = pre >> 16;
        if (active) {
#pragma unroll
            for (int q = 0; q < 4; ++q) {
                const int tok = tok0 + 4 * F.tid + q; int slot = -1;
                if (k[q] > T) { slot = pg; ++pg; }
                else if (k[q] == T) { if (c_gt + pe < cap) slot = c_gt + pe; ++pe; }
                if (slot >= 0) { ROWTOK[e * RPE + rowbase + slot] = tok; GATEV[e * RPE + rowbase + slot] = __uint_as_float(k[q]); }
                INV[(size_t)tok * 16 + e] = slot >= 0 ? rowbase + slot : -1;
            }
        }
        __syncthreads();
    }
    __syncthreads();
}

__device__ __forceinline__ void conv_items(Frame& F, int l, int first, int stride) {
    LAS float* gl = (LAS float*)F.lds;
    LAS float* ob = gl + 62 * 256;
    const bf16_t* CA = WSP(bf16_t, WS_CA); const bf16_t* CG = WSP(bf16_t, WS_CG); bf16_t* Y = WSP(bf16_t, WS_Y);
    const int nitems = (l == 0) ? 512 + 64 : 512;
    const int ch = F.tid & 255, th = F.tid >> 8;
    const float* conv_w = FIN(I_CW); const float* conv_b = FIN(I_CB); const float* conv_ln_g = FIN(I_CLG); const float* conv_ln_b = FIN(I_CLB);
    float w[31];
#pragma unroll
    for (int j = 0; j < 31; ++j) w[j] = conv_w[((size_t)l * 31 + j) * 256 + ch];
    const float cb = conv_b[l * 256 + ch];
    for (int it = first; it < nitems; it += stride) {
        const bool lat = it < 512;
        const int seqlen = lat ? SEQ : CTXL;
        const int b = lat ? it >> 6 : (it - 512) >> 3, t0 = lat ? (it & 63) * 32 : ((it - 512) & 7) * 32;
        const int tokb = lat ? b * SEQ : NLAT + b * CTXL;
        __syncthreads();
        for (int i = F.tid; i < 62 * 64; i += NTHR) {
            const int rr = i >> 6, c4 = (i & 63) * 4, t = t0 - 15 + rr;
            f32x4 g = (f32x4){0.f, 0.f, 0.f, 0.f};
            if (t >= 0 && t < seqlen) { const size_t o = (size_t)(tokb + t) * 256 + c4; const u32x2 a = *(const u32x2*)(CA + o), gg = *(const u32x2*)(CG + o);
                g[0] = bflo(a.x) * sigmoidf_(bflo(gg.x)); g[1] = bfhi(a.x) * sigmoidf_(bfhi(gg.x)); g[2] = bflo(a.y) * sigmoidf_(bflo(gg.y)); g[3] = bfhi(a.y) * sigmoidf_(bfhi(gg.y)); }
            *(LAS f32x4*)(gl + rr * 256 + c4) = g;
        }
        __syncthreads();
        for (int tt = 0; tt < 16; ++tt) {
            const LAS float* gp = gl + (th * 16 + tt) * 256 + ch;
            float gv[31];
#pragma unroll
            for (int j = 0; j < 31; ++j) gv[j] = gp[j * 256];
            __builtin_amdgcn_sched_barrier(0);
            float o = cb;
#pragma unroll
            for (int j = 0; j < 31; ++j) o += w[j] * gv[j];
            __builtin_amdgcn_sched_barrier(0);
            ob[(th * 16 + tt) * 256 + ch] = o;
        }
        __syncthreads();
        for (int tt = F.wave; tt < 32; tt += NWAVES) {
            const f32x4 v = *(const LAS f32x4*)(ob + tt * 256 + 4 * F.lane);
            const float mean = wave_sum((v[0] + v[1]) + (v[2] + v[3])) * (1.0f / 256.f);
            const f32x4 d = v - mean;
            const float var = wave_sum((d[0] * d[0] + d[1] * d[1]) + (d[2] * d[2] + d[3] * d[3])) * (1.0f / 256.f);
            const float rs = 1.0f / sqrtf(var + EPS);
            const f32x4 lg = *(const f32x4*)(conv_ln_g + l * 256 + 4 * F.lane), lb = *(const f32x4*)(conv_ln_b + l * 256 + 4 * F.lane);
            f32x4 y;
#pragma unroll
            for (int q = 0; q < 4; ++q) y[q] = siluf_(d[q] * rs * lg[q] + lb[q]);
            *(u32x2*)(Y + (size_t)(tokb + t0 + tt) * KOUT + 512 + 4 * F.lane) = pk4(y);
        }
    }
    __syncthreads();
}
__device__ __forceinline__ void ztrans_items(Frame& F, int l, int first, int stride) {
    LAS unsigned short* te = (LAS unsigned short*)(F.lds + F.wave * (2 * 64 * 66 * 2));
    LAS unsigned short* to = te + 64 * 66;
    const bf16_t* FR = WSP(bf16_t, WS_FR); bf16_t* ZE = WSP(bf16_t, WS_ZT); bf16_t* ZO = WSP(bf16_t, WS_ZO); bf16_t* ZTC = WSP(bf16_t, WS_ZTC);
    const int nlat = 8 * 16 * 4, nctx = (l == 0) ? 8 * 4 * 4 : 0;
    for (int it = first; it < nlat + nctx; it += stride) {
        const bool lat = it < nlat; const int r = lat ? it : it - nlat;
        const int b = lat ? r >> 6 : r >> 4, tb = lat ? (r >> 2) & 15 : (r >> 2) & 3, cb = r & 3;
        const int tokb = lat ? b * SEQ : NLAT + b * CTXL;
#pragma unroll
        for (int i = 0; i < 8; ++i) { const int tt = (F.lane >> 3) + 8 * i, c8 = (F.lane & 7) * 8, t = tb * 64 + tt;
            const u32x4 v = *(const u32x4*)(FR + (size_t)(tokb + t) * 256 + cb * 64 + c8);
            u32x4 m = (u32x4){0u, 0u, 0u, 0u};
            if (lat && t > 0) m = *(const u32x4*)(FR + (size_t)(tokb + SEQ - t) * 256 + cb * 64 + c8);
#pragma unroll
            for (int q = 0; q < 4; ++q) {
                if (lat) { const float a0 = bflo(v[q]), a1 = bfhi(v[q]), m0 = bflo(m[q]), m1 = bfhi(m[q]); const unsigned e_ = pk2(a0 + m0, a1 + m1), o_ = (t > 0) ? pk2(a0 - m0, a1 - m1) : 0u;
                    te[(c8 + 2 * q) * 66 + tt] = (unsigned short)(e_ & 0xffffu); te[(c8 + 2 * q + 1) * 66 + tt] = (unsigned short)(e_ >> 16);
                    to[(c8 + 2 * q) * 66 + tt] = (unsigned short)(o_ & 0xffffu); to[(c8 + 2 * q + 1) * 66 + tt] = (unsigned short)(o_ >> 16); }
                else { te[(c8 + 2 * q) * 66 + tt] = (unsigned short)(v[q] & 0xffffu); te[(c8 + 2 * q + 1) * 66 + tt] = (unsigned short)(v[q] >> 16); } } }
        LDS_WAIT(); asm volatile("" ::: "memory");
        const size_t drow = (size_t)(b * 256 + cb * 64) * 1024 + tb * 64;
#pragma unroll
        for (int i = 0; i < 8; ++i) { const int cc = (F.lane >> 3) + 8 * i, t8 = (F.lane & 7) * 8; u32x4 o;
#pragma unroll
            for (int q = 0; q < 4; ++q) o[q] = (unsigned)te[cc * 66 + t8 + 2 * q] | ((unsigned)te[cc * 66 + t8 + 2 * q + 1] << 16);
            *(u32x4*)((lat ? ZE : ZTC) + drow + (size_t)cc * 1024 + t8) = o;
            if (lat) {
#pragma unroll
                for (int q = 0; q < 4; ++q) o[q] = (unsigned)to[cc * 66 + t8 + 2 * q] | ((unsigned)to[cc * 66 + t8 + 2 * q + 1] << 16);
                *(u32x4*)(ZO + drow + (size_t)cc * 1024 + t8) = o; } }
        LDS_WAIT(); asm volatile("" ::: "memory");
    }
}
__device__ __forceinline__ void finalize_h(Frame& F, int l) {
    const bf16_t* HF = WSP(bf16_t, WS_HF); const bf16_t* HB = WSP(bf16_t, WS_HB); const bf16_t* O = WSP(bf16_t, WS_O); bf16_t* Y = WSP(bf16_t, WS_Y);
    const int gw = F.bid * NWAVES + F.wave, ngw = F.G * NWAVES;
    const int ntok = (l == 0) ? NTOK : NLAT;
    float gh[8];
    const float* g_hnorm = FIN(I_GH);
#pragma unroll
    for (int q = 0; q < 8; ++q) gh[q] = g_hnorm[l * 512 + 8 * F.lane + q];
    for (int tok = gw; tok < ntok; tok += ngw) {
        const size_t o = (size_t)tok * 512 + 8 * F.lane;
        const u32x4 a = *(const u32x4*)(HF + o), b = *(const u32x4*)(HB + o), og = *(const u32x4*)(O + o);
        float h[8]; float ss = 0.f;
#pragma unroll
        for (int q = 0; q < 4; ++q) { h[2 * q] = bflo(a[q]) + bflo(b[q]); h[2 * q + 1] = bfhi(a[q]) + bfhi(b[q]); ss += h[2 * q] * h[2 * q] + h[2 * q + 1] * h[2 * q + 1]; }
#pragma unroll
        for (int s = 1; s < 16; s <<= 1) ss += __shfl_xor(ss, s);
        const float r = 1.0f / sqrtf(ss * (1.0f / 128.f) + EPS);
        u32x4 w;
#pragma unroll
        for (int q = 0; q < 4; ++q) w[q] = pk2(h[2 * q] * r * gh[2 * q] * bflo(og[q]), h[2 * q + 1] * r * gh[2 * q + 1] * bfhi(og[q]));
        *(u32x4*)(Y + (size_t)tok * KOUT + 8 * F.lane) = w;
    }
}

using pg8::Unit;
enum { GM_INPROJ = 0, GM_DFT, GM_OUT, GM_MOE1, GM_MOE2 };
struct GemmCtl {
    int mode, l, G, c; unsigned char* ws; const Args& A;
    __device__ __forceinline__ unsigned char* W() const { unsigned char* p = ws; asm volatile("" : "+s"(p)); return p; }
    __device__ __forceinline__ bool next(int i, Unit& u) const {
        const int L = i * G + c; int pm, pn;
        u.rows = nullptr; u.ex = 0;
        switch (mode) {
        case GM_INPROJ: {
            const int n0 = 64 * 11, npn = (l == 0) ? 11 : 6;
            if (L >= n0 + 8 * npn) return false;
            if (L < n0) pg8::map_tile(L, 64, 11, pm, pn); else { pg8::map_tile(L - n0, 8, npn, pm, pn); pm += 64; }
            u.A = (const char*)(W() + WS_XN) + (size_t)pm * 256 * D * 2; u.B = (const char*)(W() + WS_WIN) + ((size_t)l * NIN + pn * 256) * D * 2; u.K = D;
        } break;
        case GM_DFT: {
            const int nctx = (l == 0) ? 16 : 0;
            if (L >= 128 + nctx) return false;
            if (L < 128) { pg8::map_tile(L, 16, 8, pm, pn); u.A = (const char*)(W() + WS_FL) + (size_t)pm * 256 * 1024 * 2; u.B = (const char*)(W() + ((pm >> 3) ? WS_ZO : WS_ZT)) + (size_t)pn * 256 * 1024 * 2; u.K = 1024; }
            else { const int r = L - 128; pm = r & 1; pn = r >> 1; u.A = (const char*)(W() + WS_FC) + (size_t)pm * 256 * 1024 * 2; u.B = (const char*)(W() + WS_ZTC) + (size_t)pn * 256 * 1024 * 2; u.K = CTXL; u.ex = 1; }
        } break;
        case GM_OUT: {
            const int nM = (l == 0) ? 72 : 64;
            if (L >= nM * 4) return false;
            pg8::map_tile(L, nM, 4, pm, pn);
            u.A = (const char*)(W() + WS_Y) + (size_t)pm * 256 * KOUT * 2; u.B = (const char*)(W() + WS_WOUT) + ((size_t)l * D + pn * 256) * KOUT * 2; u.K = KOUT;
        } break;
        case GM_MOE1: {
            const int nMe = (l == 0) ? 9 : 8; int pmg;
            if (L >= NE * nMe * 8) return false;
            pg8::map_tile(L, NE * nMe, 8, pmg, pn);
            const int e = pmg / nMe; pm = pmg % nMe;
            u.A = (const char*)(W() + WS_XN); u.rows = (const int*)(W() + WS_ROWTOK) + e * RPE + pm * 256; u.B = (const char*)(W() + WS_WGU) + ((size_t)e * 2048 + pn * 256) * D * 2; u.K = D; u.ex = e;
        } break;
        default: {
            const int nMe = (l == 0) ? 9 : 8; int pmg;
            if (L >= NE * nMe * 4) return false;
            pg8::map_tile(L, NE * nMe, 4, pmg, pn);
            const int e = pmg / nMe; pm = pmg % nMe;
            u.A = (const char*)(W() + WS_HID) + ((size_t)e * RPE + pm * 256) * D * 2; u.B = (const char*)(W() + WS_WD) + ((size_t)e * D + pn * 256) * D * 2; u.K = D; u.ex = e;
        } break;
        }
        u.pm = pm; u.pn = pn;
        return true;
    }
    struct CxIn { bf16_t* dst; int ld; float sc; int act; };
    __device__ __forceinline__ CxIn prep_in(const Unit& u) const {
        CxIn c; const int pn = u.pn; c.sc = 1.f; c.act = 0; size_t off; int cb;
        if (pn < 2) { off = WS_Q; c.ld = 512; cb = pn * 256; }
        else if (pn < 4) { off = WS_K; c.ld = 512; cb = (pn - 2) * 256; c.sc = 0.08838834764831845f; }
        else if (pn < 6) { off = WS_V; c.ld = 512; cb = (pn - 4) * 256; }
        else if (pn < 8) { off = WS_O; c.ld = 512; cb = (pn - 6) * 256; c.act = 1; }
        else if (pn == 8) { off = WS_CA; c.ld = 256; cb = 0; }
        else if (pn == 9) { off = WS_CG; c.ld = 256; cb = 0; }
        else { off = WS_FR; c.ld = 256; cb = 0; }
        c.dst = (bf16_t*)(W() + off) + (size_t)u.pm * 256 * c.ld + cb;
        return c;
    }
    __device__ __forceinline__ void store_in(const CxIn& c, int r, int col, f32x4 v0, f32x4 v1) const {
        if (c.act) {
#pragma unroll
            for (int q = 0; q < 4; ++q) { v0[q] = sigmoidf_(v0[q]); v1[q] = sigmoidf_(v1[q]); }
        } else { v0 = v0 * c.sc; v1 = v1 * c.sc; }
        bf16_t* p = c.dst + (size_t)r * c.ld + col;
        *(u32x2*)p = pk4(v0); *(u32x2*)(p + 16) = pk4(v1);
    }
    struct CxDft { bf16_t* dst; const bf16_t* z1024; };
    __device__ __forceinline__ CxDft prep_dft(const Unit& u) const {
        CxDft c; int part, tokb; c.z1024 = nullptr;
        if (u.ex == 0) { part = u.pm >> 3; tokb = u.pn * SEQ + (u.pm & 7) * 256; if (part == 0) c.z1024 = (const bf16_t*)(W() + WS_FR) + (size_t)(u.pn * SEQ + 1024) * 256; }
        else { part = u.pm; tokb = NLAT + u.pn * CTXL; }
        c.dst = (bf16_t*)(W() + WS_Y) + (size_t)tokb * KOUT + 768 + part * 256; return c;
    }
    __device__ __forceinline__ void store_dft(const CxDft& c, int r, int col, f32x4 v0, f32x4 v1) const {
        if (c.z1024) { const float sg = (r & 1) ? -0.022097086912079608f : 0.022097086912079608f; const u32x2 z0 = *(const u32x2*)(c.z1024 + col), z1 = *(const u32x2*)(c.z1024 + col + 16);
            v0[0] += sg * bflo(z0.x); v0[1] += sg * bfhi(z0.x); v0[2] += sg * bflo(z0.y); v0[3] += sg * bfhi(z0.y);
            v1[0] += sg * bflo(z1.x); v1[1] += sg * bfhi(z1.x); v1[2] += sg * bflo(z1.y); v1[3] += sg * bfhi(z1.y); }
        bf16_t* p = c.dst + (size_t)r * KOUT + col;
        *(u32x2*)p = pk4(v0); *(u32x2*)(p + 16) = pk4(v1);
    }
    struct CxOut { const float* src; float* dst; const float* gt; };
    __device__ __forceinline__ CxOut prep_out(const Unit& u) const {
        CxOut c; const int tok0 = u.pm * 256, col0 = u.pn * 256;
        if (l == 0) c.src = (tok0 < NLAT ? arg_in(A, I_X) + (size_t)tok0 * D : arg_in(A, I_CTX) + (size_t)(tok0 - NLAT) * D) + col0;
        else c.src = (const float*)(W() + WS_X) + (size_t)tok0 * D + col0;
        c.dst = (float*)(W() + WS_X) + (size_t)tok0 * D + col0;
        c.gt = (const float*)(W() + WS_MOD) + ((size_t)l * 9 + mod_row(tok0)) * 6144 + 2 * 1024 + col0;
        return c;
    }
    __device__ __forceinline__ void store_out(const CxOut& c, int r, int col, f32x4 v0, f32x4 v1) const {
        const size_t o = (size_t)r * D + col;
        const f32x4 g0 = *(const f32x4*)(c.gt + col), g1 = *(const f32x4*)(c.gt + col + 16);
        const f32x4 s0 = *(const f32x4*)(c.src + o), s1 = *(const f32x4*)(c.src + o + 16);
        *(f32x4*)(c.dst + o) = s0 + g0 * v0; *(f32x4*)(c.dst + o + 16) = s1 + g1 * v1;
    }
    __device__ __forceinline__ bf16_t* prep_m1(const Unit& u) const { return (bf16_t*)(W() + WS_HID) + ((size_t)u.ex * RPE + u.pm * 256) * D + u.pn * 128; }
    __device__ __forceinline__ void store_m1(bf16_t* dst, int r, int col, f32x4 v0, f32x4 v1) const {
        f32x4 h;
#pragma unroll
        for (int q = 0; q < 4; ++q) h[q] = siluf_(v0[q]) * v1[q];
        *(u32x2*)(dst + (size_t)r * D + (col >> 5) * 16 + (col & 15)) = pk4(h);
    }
    struct CxM2 { bf16_t* dst; const float* g; };
    __device__ __forceinline__ CxM2 prep_m2(const Unit& u) const { CxM2 c; c.dst = (bf16_t*)(W() + WS_YS) + ((size_t)u.ex * RPE + u.pm * 256) * D + u.pn * 256; c.g = (const float*)(W() + WS_GATEV) + u.ex * RPE + u.pm * 256; return c; }
    __device__ __forceinline__ void store_m2(const CxM2& c, int r, int col, f32x4 v0, f32x4 v1) const {
        const float g = c.g[r];
        bf16_t* p = c.dst + (size_t)r * D + col;
        *(u32x2*)p = pk4(v0 * g); *(u32x2*)(p + 16) = pk4(v1 * g);
    }
#define EPI_WALK(PREP, STORE) do { const auto cx = PREP(u); _Pragma("unroll") for (int ai = 0; ai < 2; ++ai) _Pragma("unroll") for (int m = 0; m < 4; ++m) _Pragma("unroll") for (int bj = 0; bj < 2; ++bj) \
        STORE(cx, ai * 128 + wr * 64 + m * 16 + fr, bj * 128 + wc * 32 + 4 * fq, acc[ai][bj][m][0], acc[ai][bj][m][1]); } while (0)
    __device__ __forceinline__ void run(const f32x4 (&acc)[2][2][4][2], const Unit& u, int wr, int wc, int fr, int fq) const {
        switch (mode) {
        case GM_INPROJ: EPI_WALK(prep_in, store_in); break;
        case GM_DFT: EPI_WALK(prep_dft, store_dft); break;
        case GM_OUT: EPI_WALK(prep_out, store_out); break;
        case GM_MOE1: EPI_WALK(prep_m1, store_m1); break;
        default: EPI_WALK(prep_m2, store_m2); break;
        }
    }
    __device__ __forceinline__ void store1(const Unit& u, int r, int c, f32x4 v0, f32x4 v1) const {
        switch (mode) {
        case GM_INPROJ: store_in(prep_in(u), r, c, v0, v1); break;
        case GM_DFT: store_dft(prep_dft(u), r, c, v0, v1); break;
        case GM_OUT: store_out(prep_out(u), r, c, v0, v1); break;
        case GM_MOE1: store_m1(prep_m1(u), r, c, v0, v1); break;
        default: store_m2(prep_m2(u), r, c, v0, v1); break;
        }
    }
};

__device__ __forceinline__ void scan_simt(Frame& F, int l) {
    if (F.bid >= 64) return;
    const int b = F.bid >> 3, h = (F.bid >> 1) & 3, dir = F.bid & 1;
    LAS float* qs = (LAS float*)F.lds; LAS float* ks = qs + 64 * 132; LAS float* vs = ks + 64 * 132; LAS float* st = vs + 64 * 132;
    LAS float* sm = st + 64 * 65;
    LAS float* as_ = sm; LAS float* Ms = sm + 64; LAS float* wint = sm + 128; LAS float* enm = sm + 192; LAS float* wst = sm + 256; LAS float* denom = sm + 320;
    LAS float* nvec = sm + 384; LAS float* ig = sm + 512; LAS float* lf = sm + 576; LAS int* toks = (LAS int*)(sm + 640); LAS float* scal = sm + 704;
    const bf16_t* Q = WSP(bf16_t, WS_Q); const bf16_t* K = WSP(bf16_t, WS_K); const bf16_t* V = WSP(bf16_t, WS_V); const float* GATES = WSP(float, WS_GATES);
    bf16_t* H = dir ? WSP(bf16_t, WS_HB) : WSP(bf16_t, WS_HF);
    float Creg[32];
#pragma unroll
    for (int i = 0; i < 32; ++i) Creg[i] = 0.f;
    float m_st = 0.f;
    if (F.tid < 128) nvec[F.tid] = 0.f;
    __syncthreads();
    for (int cc = 0; cc < 36; ++cc) {
        int tid = F.tid; asm volatile("" : "+v"(tid));
        const int lane = tid & 63, e = tid >> 2, dq = tid & 3;
        const bool isctx = cc < 4;
        const int c = isctx ? (dir ? 3 - cc : cc) : (dir ? 35 - cc : cc - 4);
        const bool want_out = !(isctx && l == 1);
        if (tid < 64) { const int j = tid;
            const int tok = isctx ? NLAT + b * CTXL + c * 64 + j : (h < 2 ? b * SEQ + c * 64 + j : b * SEQ + (j & 31) * 64 + 2 * c + (j >> 5));
            toks[j] = tok; const float* g = GATES + (size_t)tok * 16 + h * 4 + 2 * dir; ig[j] = g[0]; lf[j] = logsigmoidf_(g[1]); }
        __syncthreads();
        for (int it = tid; it < 1024; it += NTHR) { const int j = it >> 4, c8 = (it & 15) * 8; const size_t o = (size_t)toks[j] * 512 + h * 128 + c8;
            const u32x4 qv = *(const u32x4*)(Q + o), kv = *(const u32x4*)(K + o), vv = *(const u32x4*)(V + o);
#pragma unroll
            for (int q = 0; q < 4; ++q) { qs[j * 132 + c8 + 2 * q] = bflo(qv[q]); qs[j * 132 + c8 + 2 * q + 1] = bfhi(qv[q]); ks[j * 132 + c8 + 2 * q] = bflo(kv[q]); ks[j * 132 + c8 + 2 * q + 1] = bfhi(kv[q]);
                vs[j * 132 + c8 + 2 * q] = bflo(vv[q]); vs[j * 132 + c8 + 2 * q + 1] = bfhi(vv[q]); } }
        if (F.wave == 0) {
            const int p = dir ? 63 - lane : lane;
            float x = lf[p];
#pragma unroll
            for (int o = 1; o < 64; o <<= 1) { const float y = __shfl_up(x, o); if (lane >= o) x += y; }
            const float a = ig[p] - x; float cm = a;
#pragma unroll
            for (int o = 1; o < 64; o <<= 1) { const float y = __shfl_up(cm, o); if (lane >= o) cm = fmaxf(cm, y); }
            const float M = fmaxf(m_st, cm), Mend = __shfl(M, 63), blast = __shfl(x, 63);
            as_[p] = a; Ms[p] = M; wint[p] = expf(m_st - M); enm[p] = expf(-(x + M)); wst[p] = expf(a - Mend);
            if (lane == 0) { scal[0] = Mend; scal[1] = blast; }
        }
        __syncthreads();
        const float Mend = scal[0], blast = scal[1], decay = expf(m_st - Mend);
        if (want_out) {
            { const int t = tid >> 3, sg = tid & 7; float sacc[8];
#pragma unroll
                for (int i = 0; i < 8; ++i) sacc[i] = 0.f;
                for (int d4 = 0; d4 < 32; ++d4) { const f32x4 q4 = *(const LAS f32x4*)(qs + t * 132 + d4 * 4);
#pragma unroll
                    for (int i = 0; i < 8; ++i) { const f32x4 k4 = *(const LAS f32x4*)(ks + (i * 8 + sg) * 132 + d4 * 4); sacc[i] += (q4[0] * k4[0] + q4[1] * k4[1]) + (q4[2] * k4[2] + q4[3] * k4[3]); } }
#pragma unroll
                for (int i = 0; i < 8; ++i) { const int s = i * 8 + sg; const bool valid = dir ? (s >= t) : (s <= t); st[t * 65 + s] = valid ? sacc[i] * expf(as_[s] - Ms[t]) : 0.f; } }
            __syncthreads();
            if (tid < 64) { const int t = tid; float qn = 0.f, ssum = 0.f;
                for (int d = 0; d < 128; ++d) qn += qs[t * 132 + d] * nvec[d];
                for (int s = 0; s < 64; ++s) ssum += st[t * 65 + s];
                const float den = wint[t] * qn + ssum; denom[t] = fmaxf(fabsf(den), enm[t]); }
            float mine[16];
#pragma unroll
            for (int tt = 0; tt < 16; ++tt) {
                mine[tt] = 0.f;
#pragma unroll
                for (int u = 0; u < 4; ++u) { const int t = 4 * tt + u; float p = 0.f;
#pragma unroll
                    for (int i4 = 0; i4 < 8; ++i4) { const f32x4 q4 = *(const LAS f32x4*)(qs + t * 132 + dq * 32 + i4 * 4); p += (Creg[4 * i4] * q4[0] + Creg[4 * i4 + 1] * q4[1]) + (Creg[4 * i4 + 2] * q4[2] + Creg[4 * i4 + 3] * q4[3]); }
                    p += __shfl_xor(p, 1); p += __shfl_xor(p, 2);
                    mine[tt] = (u == dq) ? p : mine[tt]; asm volatile("" ::: "memory"); }
            }
#pragma unroll
            for (int tt = 0; tt < 16; ++tt) { const int t = 4 * tt + dq; float intra = 0.f;
#pragma unroll 8
                for (int s = 0; s < 64; ++s) intra += st[t * 65 + s] * vs[s * 132 + e];
                mine[tt] = wint[t] * mine[tt] + intra; asm volatile("" ::: "memory"); }
            __syncthreads();
#pragma unroll
            for (int tt = 0; tt < 16; ++tt) { const int t = 4 * tt + dq; H[(size_t)toks[t] * 512 + h * 128 + e] = (bf16_t)f2bf(mine[tt] / denom[t]); }
        }
#pragma unroll
        for (int i = 0; i < 32; ++i) Creg[i] *= decay;
#pragma unroll 2
        for (int s = 0; s < 64; ++s) { const float wv = wst[s] * vs[s * 132 + e];
#pragma unroll
            for (int i4 = 0; i4 < 8; ++i4) { const f32x4 k4 = *(const LAS f32x4*)(ks + s * 132 + dq * 32 + i4 * 4); Creg[4 * i4] += wv * k4[0]; Creg[4 * i4 + 1] += wv * k4[1]; Creg[4 * i4 + 2] += wv * k4[2]; Creg[4 * i4 + 3] += wv * k4[3]; } }
        float nn = 0.f;
        if (tid < 128) { nn = decay * nvec[tid]; for (int s = 0; s < 64; ++s) nn += wst[s] * ks[s * 132 + tid]; }
        __syncthreads();
        if (tid < 128) nvec[tid] = nn;
        m_st = blast + Mend;
        __syncthreads();
    }
}

__device__ __forceinline__ int scan_tok(bool isctx, int b, int h, int c, int j) {
    return isctx ? NLAT + b * CTXL + c * 64 + j : (h < 2 ? b * SEQ + c * 64 + j : b * SEQ + (j & 31) * 64 + 2 * c + (j >> 5));
}
__device__ __forceinline__ int img256(int row, int chunk) { return row * 256 + ((chunk ^ (row & 15)) << 4); }
__device__ __forceinline__ int img128(int row, int chunk) { return row * 128 + ((chunk ^ ((row >> 1) & 7)) << 4); }
__device__ __forceinline__ int off_b(int row, int ch) { return 256 * row + 16 * (ch ^ (((row & 3) << 2) | ((row >> 2) & 3))); }
__device__ __forceinline__ int rowrd16(int lane, int rb, int ks) { return off_b((lane & 15) + 16 * rb, 4 * ks + (lane >> 4)); }
__device__ __forceinline__ int trrd16(int lane, int c, int ks, int t) { const int g = lane >> 4, q = (lane & 15) >> 2, p = lane & 3;
    return off_b(32 * ks + 8 * g + 4 * t + q, 2 * c + (p >> 1)) + 8 * (p & 1); }
typedef short s16x4 __attribute__((ext_vector_type(4)));
__device__ __forceinline__ bf16x8 tr_frag(LAS unsigned char* img, int lane, int c, int ks, unsigned zv) {
    const s16x4 lo = __builtin_amdgcn_ds_read_tr16_b64_v4i16((LAS s16x4*)(img + trrd16(lane, c, ks, 0)));
    const s16x4 hi = __builtin_amdgcn_ds_read_tr16_b64_v4i16((LAS s16x4*)(img + trrd16(lane, c, ks, 1)));
    u32x2 a = __builtin_bit_cast(u32x2, lo), b = __builtin_bit_cast(u32x2, hi);
    a.x ^= zv; a.y ^= zv; b.x ^= zv; b.y ^= zv;
    const u32x4 r = (u32x4){a.x, a.y, b.x, b.y};
    return __builtin_bit_cast(bf16x8, r);
}
__device__ __forceinline__ void scan_mfma(Frame& F, int l) {
    if (F.bid >= 64) return;
    const int b = F.bid >> 3, h = (F.bid >> 1) & 3, dir = F.bid & 1;
    LAS unsigned char* L = F.lds;
    constexpr int O_QI = 0, O_KI = 16384, O_VI = 32768, O_ST = 49152, O_CL = 57344, O_HO = 94208, O_SM = 110592;
    LAS float* GV = (LAS float*)(L + O_SM);
    LAS float* SC = GV + 36 * 192;
    LAS float* DEN = SC + 36 * 4;
    const bf16_t* Q = WSP(bf16_t, WS_Q); const bf16_t* K = WSP(bf16_t, WS_K); const bf16_t* V = WSP(bf16_t, WS_V); const float* GATES = WSP(float, WS_GATES);
    bf16_t* H = dir ? WSP(bf16_t, WS_HB) : WSP(bf16_t, WS_HF);
    const int w = F.wave;
    { unsigned z0 = 0u; asm volatile("" : "+v"(z0));
      for (int i = F.tid; i < 36864 / 16; i += NTHR) *(LAS u32x4*)(L + O_CL + i * 16) = (u32x4){z0, z0, z0, z0}; }
    for (int cc = w; cc < 36; cc += NWAVES) {
        const bool ic = cc < 4; const int c_ = ic ? (dir ? 3 - cc : cc) : (dir ? 35 - cc : cc - 4), p_ = dir ? 63 - F.lane : F.lane;
        const f32x2 g = *(const f32x2*)(GATES + (size_t)scan_tok(ic, b, h, c_, p_) * 16 + h * 4 + 2 * dir);
        float x = logsigmoidf_(g[1]);
#pragma unroll
        for (int o = 1; o < 64; o <<= 1) { const float y = __shfl_up(x, o); if (F.lane >= o) x += y; }
        const float a = g[0] - x; float cm = a;
#pragma unroll
        for (int o = 1; o < 64; o <<= 1) { const float y = __shfl_up(cm, o); if (F.lane >= o) cm = fmaxf(cm, y); }
        GV[cc * 192 + p_] = a; GV[cc * 192 + 64 + p_] = x; GV[cc * 192 + 128 + p_] = cm;
        if (F.lane == 63) { SC[cc * 4 + 3] = x; SC[cc * 4 + 1] = cm; }
    }
    __syncthreads();
    if (F.tid == 0) { float m = 0.f;
        for (int cc = 0; cc < 36; ++cc) { const float Mend = fmaxf(m, SC[cc * 4 + 1]); SC[cc * 4 + 0] = m; SC[cc * 4 + 1] = Mend; SC[cc * 4 + 2] = expf(m - Mend); m = SC[cc * 4 + 3] + Mend; } }
    f32x4 accC[9];
#pragma unroll
    for (int i = 0; i < 9; ++i) accC[i] = (f32x4){0.f, 0.f, 0.f, 0.f};
    u32x4 pq[2], pk[2], pv[2];
#define SC_LOAD(CC) do { const int cc_ = (CC); const bool ic_ = cc_ < 4; const int c_ = ic_ ? (dir ? 3 - cc_ : cc_) : (dir ? 35 - cc_ : cc_ - 4); \
        _Pragma("unroll") for (int i_ = 0; i_ < 2; ++i_) { const int it_ = tid + NTHR * i_, s_ = it_ >> 4, c8_ = it_ & 15; const size_t o_ = (size_t)scan_tok(ic_, b, h, c_, s_) * 512 + h * 128 + c8_ * 8; \
            pq[i_] = *(const u32x4*)(Q + o_); pk[i_] = *(const u32x4*)(K + o_); pv[i_] = *(const u32x4*)(V + o_); } } while (0)
#define SC_WRITE() do { _Pragma("unroll") for (int i_ = 0; i_ < 2; ++i_) { const int it_ = tid + NTHR * i_, s_ = it_ >> 4, c8_ = it_ & 15; \
            *(LAS u32x4*)(L + O_QI + img256(s_, c8_)) = pq[i_]; *(LAS u32x4*)(L + O_KI + off_b(s_, c8_)) = pk[i_]; *(LAS u32x4*)(L + O_VI + off_b(s_, c8_)) = pv[i_]; } } while (0)
#define SC_MFMA(A, B, C) __builtin_amdgcn_mfma_f32_16x16x32_bf16((A), (B), (C), 0, 0, 0)
#define SC_BAR() do { asm volatile("s_waitcnt lgkmcnt(0)" ::: "memory"); __builtin_amdgcn_s_barrier(); asm volatile("" ::: "memory"); } while (0)
    {
        const int tid = F.tid;
        SC_LOAD(0);
        __syncthreads();
        SC_WRITE();
        __syncthreads();
    }
    for (int cc = 0; cc < 36; ++cc) {
        int tid = F.tid; asm volatile("" : "+v"(tid));
        const int lane = tid & 63, fr = lane & 15, fq = lane >> 4;
        const bool isctx = cc < 4, want_out = !(isctx && l == 1), more = cc + 1 < 36;
        const int c = isctx ? (dir ? 3 - cc : cc) : (dir ? 35 - cc : cc - 4);
        const LAS float* vb = GV + cc * 192; const float m_in = SC[cc * 4 + 0];
        unsigned zv = 0u; asm volatile("" : "+v"(zv));
        const short one_ = (fr == 0) ? (short)0x3F80 : (short)0;
        const bf16x8 ONES = (bf16x8){one_, one_, one_, one_, one_, one_, one_, one_};
        if (more) SC_LOAD(cc + 1);
        if (want_out) {
            const int tb = w >> 1, sb = 2 * (w & 1);
            f32x4 s0 = (f32x4){0.f, 0.f, 0.f, 0.f}, s1 = s0;
#pragma unroll
            for (int ks = 0; ks < 4; ++ks) {
                const bf16x8 fy = *(const LAS bf16x8*)(L + O_QI + img256(tb * 16 + fr, ks * 4 + fq));
                const bf16x8 fx0 = *(const LAS bf16x8*)(L + O_KI + rowrd16(lane, sb, ks)), fx1 = *(const LAS bf16x8*)(L + O_KI + rowrd16(lane, sb + 1, ks));
                s0 = SC_MFMA(fx0, fy, s0); s1 = SC_MFMA(fx1, fy, s1); }
            const int t = tb * 16 + fr; const float Mt = fmaxf(m_in, vb[128 + t]);
#pragma unroll
            for (int i = 0; i < 2; ++i) { const int sr0 = (sb + i) * 16 + 4 * fq; const f32x4 a4 = *(const LAS f32x4*)(vb + sr0); const f32x4 sv = i ? s1 : s0; f32x4 o;
#pragma unroll
                for (int r = 0; r < 4; ++r) { const int sI = sr0 + r; const bool valid = dir ? (sI >= t) : (sI <= t); o[r] = valid ? sv[r] * __expf(a4[r] - Mt) : 0.f; }
                *(LAS u32x2*)(L + O_ST + img128(t, sr0 >> 3) + (sr0 & 7) * 2) = pk4(o); }
        }
        SC_BAR();
        {
            const float decay = SC[cc * 4 + 2], Mend = SC[cc * 4 + 1];
#pragma unroll
            for (int et = 0; et < 9; ++et) accC[et] = accC[et] * decay;
#pragma unroll
            for (int ks = 0; ks < 2; ++ks) {
                const bf16x8 kx = tr_frag(L + O_KI, lane, w, ks, zv);
                const f32x4 a0 = *(const LAS f32x4*)(vb + 32 * ks + 8 * fq), a1 = *(const LAS f32x4*)(vb + 32 * ks + 8 * fq + 4);
                u32x4 ax;
#pragma unroll
                for (int j = 0; j < 4; ++j) { const float w0 = __expf((j < 2 ? a0[2 * j] : a1[2 * j - 4]) - Mend), w1 = __expf((j < 2 ? a0[2 * j + 1] : a1[2 * j - 3]) - Mend);
                    ax[j] = pk2(bf2f((unsigned short)kx[2 * j]) * w0, bf2f((unsigned short)kx[2 * j + 1]) * w1); }
                const bf16x8 axf = __builtin_bit_cast(bf16x8, ax);
#pragma unroll
                for (int et = 0; et < 8; ++et) { const bf16x8 fv = tr_frag(L + O_VI, lane, et, ks, zv); accC[et] = SC_MFMA(axf, fv, accC[et]); }
                accC[8] = SC_MFMA(axf, ONES, accC[8]);
            }
        }
        f32x4 num[4];
        if (want_out) {
            bf16x8 ac[4], av[2];
#pragma unroll
            for (int ks = 0; ks < 4; ++ks) ac[ks] = *(const LAS bf16x8*)(L + O_CL + img256(w * 16 + fr, ks * 4 + fq));
#pragma unroll
            for (int ks = 0; ks < 2; ++ks) av[ks] = tr_frag(L + O_VI, lane, w, ks, zv);
#pragma unroll
            for (int tb = 0; tb < 4; ++tb) {
                f32x4 nI = (f32x4){0.f, 0.f, 0.f, 0.f}, nS = nI;
#pragma unroll
                for (int ks = 0; ks < 4; ++ks) { const bf16x8 fy = *(const LAS bf16x8*)(L + O_QI + img256(tb * 16 + fr, ks * 4 + fq)); nI = SC_MFMA(ac[ks], fy, nI); }
#pragma unroll
                for (int ks = 0; ks < 2; ++ks) { const bf16x8 fs = *(const LAS bf16x8*)(L + O_ST + img128(tb * 16 + fr, ks * 4 + fq)); nS = SC_MFMA(av[ks], fs, nS); }
                num[tb] = nI * __expf(m_in - fmaxf(m_in, vb[128 + tb * 16 + fr])) + nS;
            }
            if (w < 4) {
                f32x4 dI = (f32x4){0.f, 0.f, 0.f, 0.f}, dS = dI;
#pragma unroll
                for (int ks = 0; ks < 4; ++ks) { const bf16x8 a8 = *(const LAS bf16x8*)(L + O_CL + img256(128 + fr, ks * 4 + fq)); const bf16x8 fy = *(const LAS bf16x8*)(L + O_QI + img256(w * 16 + fr, ks * 4 + fq)); dI = SC_MFMA(a8, fy, dI); }
#pragma unroll
                for (int ks = 0; ks < 2; ++ks) { const bf16x8 fs = *(const LAS bf16x8*)(L + O_ST + img128(w * 16 + fr, ks * 4 + fq)); dS = SC_MFMA(ONES, fs, dS); }
                const int t = w * 16 + fr; const float Mt = fmaxf(m_in, vb[128 + t]); const float den = __expf(m_in - Mt) * dI[0] + dS[0];
                if (lane < 16) DEN[t] = fmaxf(fabsf(den), __expf(-(vb[64 + t] + Mt)));
            }
        }
        SC_BAR();
        if (want_out) {
#pragma unroll
            for (int tb = 0; tb < 4; ++tb) { const int t = tb * 16 + fr, e0 = w * 16 + 4 * fq; const float rd = 1.0f / DEN[t];
                *(LAS u32x2*)(L + O_HO + img256(t, e0 >> 3) + (e0 & 7) * 2) = pk4(num[tb] * rd); }
        }
#pragma unroll
        for (int et = 0; et < 9; ++et) { const int d0 = w * 16 + 4 * fq; *(LAS u32x2*)(L + O_CL + img256(et * 16 + fr, d0 >> 3) + (d0 & 7) * 2) = pk4(accC[et]); }
        if (more) SC_WRITE();
        SC_BAR();
        if (want_out) {
            const int t = tid >> 3; bf16_t* hp = H + (size_t)scan_tok(isctx, b, h, c, t) * 512 + h * 128;
#pragma unroll
            for (int i = 0; i < 2; ++i) { const int ch = (tid & 7) * 2 + i; *(u32x4*)(hp + ch * 8) = *(const LAS u32x4*)(L + O_HO + img256(t, ch)); }
        }
    }
#undef SC_LOAD
#undef SC_WRITE
#undef SC_MFMA
#undef SC_BAR
}

__device__ __forceinline__ void helper_barrier(Frame& F, unsigned* cnt, unsigned nhelpers) {
    asm volatile("s_waitcnt vmcnt(0)" ::: "memory");
    __syncthreads();
    if (F.tid == 0) {
        __builtin_amdgcn_fence(__ATOMIC_RELEASE, "agent");
        asm volatile("s_waitcnt vmcnt(0)" ::: "memory");
        __hip_atomic_fetch_add(cnt, 1u, __ATOMIC_RELAXED, __HIP_MEMORY_SCOPE_AGENT);
        unsigned sp = 0;
        while (__hip_atomic_load(cnt, __ATOMIC_RELAXED, __HIP_MEMORY_SCOPE_AGENT) < nhelpers) { __builtin_amdgcn_s_sleep(2); if (++sp > (1u << 22)) break; }
        __builtin_amdgcn_fence(__ATOMIC_ACQUIRE, "agent");
        asm volatile("s_waitcnt vmcnt(0)" ::: "memory");
    }
    __syncthreads();
}

constexpr int NPHASES = 20;
enum { K_PREP = 0, K_NORM1, K_INPROJ, K_MIX1, K_MIX2, K_OUTPROJ, K_NORM2, K_TOPK, K_MOE1, K_MOE2, K_COMBINE };

__global__ void __launch_bounds__(NTHR, 2) fwd_kernel(Args args) {
    extern __shared__ __attribute__((aligned(16))) unsigned char lds_raw[];
    Frame F{(LAS unsigned char*)lds_raw, (int)threadIdx.x, (int)(threadIdx.x & 63), __builtin_amdgcn_readfirstlane((int)(threadIdx.x >> 6)), (int)gridDim.x, (int)blockIdx.x, args.ws, args};
    volatile LAS unsigned* MISC = (volatile LAS unsigned*)(F.lds + LDSCTL_OFF);
    if (F.tid < 16) MISC[F.tid] = 0u;
    __syncthreads();
    XcdBarrier bar; bar.bar = (unsigned*)(F.ws + WS_CTL); bar.x = 0; bar.st = MISC;
    const int lo = args.ph_lo, hi = args.ph_hi;
    if (hi - lo > 1) bar = xcd_barrier_post((unsigned*)(F.ws + WS_CTL), MISC);
    for (int ph = lo; ph < hi; ++ph) {
        int l, kind;
        if (ph == 0) { l = 0; kind = K_PREP; } else if (ph == 1) { l = 0; kind = K_NORM1; } else if (ph < 11) { l = 0; kind = K_INPROJ + (ph - 2); } else { l = 1; kind = K_INPROJ + (ph - 11); }
#ifndef PHMASK
#define PHMASK 0xFFFF
#endif
#define PHON(k) ((PHMASK >> (k)) & 1)
#ifndef REPMASK
#define REPMASK 0
#endif
        int nrep_ = 1 + ((REPMASK >> kind) & 1); asm volatile("" : "+s"(nrep_));
        for (int rep_ = 0; rep_ < nrep_; ++rep_) {
        if (rep_) xcd_barrier(bar);
        { int t_ = threadIdx.x, b_ = blockIdx.x; unsigned char* w_ = args.ws; asm volatile("" : "+v"(t_)); asm volatile("" : "+s"(b_)); asm volatile("" : "+s"(w_));
          F.tid = t_; F.lane = t_ & 63; F.wave = __builtin_amdgcn_readfirstlane(t_ >> 6); F.bid = b_; F.ws = w_; }
        l = __builtin_amdgcn_readfirstlane(l); kind = __builtin_amdgcn_readfirstlane(kind); asm volatile("" : "+s"(l)); asm volatile("" : "+s"(kind));
        unsigned char* ws = F.ws;
        bool run_gemm = (kind == K_INPROJ || kind == K_OUTPROJ || kind == K_MOE1 || kind == K_MOE2);
        int gm = kind == K_INPROJ ? GM_INPROJ : kind == K_OUTPROJ ? GM_OUT : kind == K_MOE1 ? GM_MOE1 : GM_MOE2, gc = F.bid, gG = F.G;
        const bool helper = (kind == K_MIX1) && (F.bid >= 64);
        switch (kind) {
        case K_PREP: if (PHON(0)) phase_prep(F); break;
        case K_NORM1: if (PHON(1)) phase_norm1_l0(F); break;
        case K_MIX1: if (PHON(3)) {
            if (!helper) scan_mfma(F, l);
            else { const int hb = F.bid - 64, hg = F.G - 64;
                conv_items(F, l, hb, hg);
                ztrans_items(F, l, hb * NWAVES + F.wave, hg * NWAVES);
                helper_barrier(F, (unsigned*)(ws + WS_CTL) + 8192 + 64 * l + 64 * 2 * rep_, (unsigned)hg);
                run_gemm = true; gm = GM_DFT; gc = hb; gG = hg; }
        } break;
        case K_MIX2: if (PHON(4)) finalize_h(F, l); break;
        case K_NORM2: if (PHON(6)) phase_norm2(F, l); break;
        case K_TOPK: if (PHON(7)) phase_topk(F, l); break;
        case K_COMBINE: if (PHON(10)) phase_combine(F, l); break;
        default: break;
        }
        if (run_gemm && PHON(2)) {
            GemmCtl S{gm, l, gG, gc, ws, F.A};
            const int ld = gm == GM_OUT ? KOUT : D;
            GEMM_PHASE(F.lds, ld, ld, S, S);
        }
        if (helper && PHON(3)) convert_moe_weights(F, l, (F.bid - 64) * NWAVES + F.wave, (F.G - 64) * NWAVES);
        }
        if (ph + 1 < hi) xcd_barrier(bar);
    }
}

extern "C" void kernel_launch(void* const* d_in, const int* in_sizes, int n_in, void* d_out, int out_size, void* d_ws, size_t ws_size, hipStream_t stream) {
    static int grid = 0;
    if (grid == 0) {
        if (n_in != 21 || out_size != NLAT * D || ws_size < WS_END) { fprintf(stderr, "kernel_launch: unexpected shapes (n_in %d out %d ws %zu need %zu)\n", n_in, out_size, ws_size, (size_t)WS_END); grid = -1; return; }
        int dev = 0, cus = 0, per_cu = 0;
        hipGetDevice(&dev); hipDeviceGetAttribute(&cus, hipDeviceAttributeMultiprocessorCount, dev);
        if (hipFuncSetAttribute((const void*)fwd_kernel, hipFuncAttributeMaxDynamicSharedMemorySize, LDS_BYTES) != hipSuccess) { fprintf(stderr, "kernel_launch: hipFuncSetAttribute failed\n"); grid = -1; return; }
        hipOccupancyMaxActiveBlocksPerMultiprocessor(&per_cu, (const void*)fwd_kernel, NTHR, LDS_BYTES);
        (void)hipGetLastError();
        if (per_cu < 1) fprintf(stderr, "kernel_launch: occupancy query reports %d\n", per_cu);
        grid = cus;
    }
    if (grid < 0) return;
    hipMemsetAsync((char*)d_ws + WS_CTL, 0, 65536, stream);
    Args a{};
    for (int i = 0; i < 21; ++i) a.in[i] = (const float*)d_in[i];
    a.out = (float*)d_out; a.ws = (unsigned char*)d_ws;
#if N_LAUNCHES == 1
    a.ph_lo = 0; a.ph_hi = NPHASES;
    void* kargs[] = {&a};
    hipError_t e = hipLaunchCooperativeKernel((const void*)fwd_kernel, dim3(grid), dim3(NTHR), kargs, LDS_BYTES, stream);
    if (e != hipSuccess) fprintf(stderr, "kernel_launch: cooperative launch failed: %s (grid %d)\n", hipGetErrorString(e), grid);
#else
#ifndef MAXPH
#define MAXPH NPHASES
#endif
    for (int ph = 0; ph < MAXPH; ++ph) { a.ph_lo = ph; a.ph_hi = ph + 1; hipLaunchKernelGGL(fwd_kernel, dim3(grid), dim3(NTHR), LDS_BYTES, stream, a); }
#endif
}
```

```cpp
#include <hip/hip_runtime.h>
#include <cstdio>
#include <cstdint>

#ifndef N_LAUNCHES
#define N_LAUNCHES 1
#endif
#ifndef USE_MFMA_GEMM
#define USE_MFMA_GEMM 1
#endif

#define LAS __attribute__((address_space(3)))
#define GAS __attribute__((address_space(1)))
typedef unsigned short bf16_t;
typedef short bf16x8 __attribute__((ext_vector_type(8)));
typedef float f32x4 __attribute__((ext_vector_type(4)));
typedef float f32x2 __attribute__((ext_vector_type(2)));
typedef unsigned u32x4 __attribute__((ext_vector_type(4)));
typedef unsigned u32x2 __attribute__((ext_vector_type(2)));
typedef GAS unsigned gu32;
#define RLX_AGENT __ATOMIC_RELAXED, __HIP_MEMORY_SCOPE_AGENT
#define LDS_WAIT() asm volatile("s_waitcnt lgkmcnt(0)" ::: "memory")
#define VM_WAIT() asm volatile("s_waitcnt vmcnt(0)" ::: "memory")

constexpr int D = 1024, NB = 8, SEQ = 2048, CTXL = 256;
constexpr int NLAT = NB * SEQ, NCTX = NB * CTXL, NTOK = NLAT + NCTX;
constexpr int INC = 2832, NIN = 2816;
constexpr int KOUT = 1280;
constexpr int NE = 16, RPE = 2304;
constexpr float EPS = 1e-6f;
constexpr int NTHR = 512, NWAVES = 8;

constexpr size_t al256(size_t x) { return (x + 255) & ~(size_t)255; }
constexpr size_t WS_CTL = 0;
constexpr size_t WS_MOD = WS_CTL + 65536;
constexpr size_t WS_WIN = WS_MOD + al256((size_t)2 * 9 * 6144 * 4);
constexpr size_t WS_WOUT = WS_WIN + (size_t)2 * NIN * D * 2;
constexpr size_t WS_WGU = WS_WOUT + (size_t)2 * D * KOUT * 2;
constexpr size_t WS_WD = WS_WGU + (size_t)NE * 2048 * D * 2;
constexpr size_t WS_FL = WS_WD + (size_t)NE * D * D * 2;
constexpr size_t WS_FC = WS_FL + (size_t)4096 * 1024 * 2;
constexpr size_t WS_X = WS_FL + (size_t)4096 * 2048 * 2 + (size_t)512 * 2048 * 2;
constexpr size_t WS_XN = WS_X + (size_t)NTOK * D * 4;
constexpr size_t WS_GATES = WS_XN + (size_t)NTOK * D * 2;
constexpr size_t WS_AFF = WS_GATES + (size_t)NTOK * 16 * 4;
constexpr size_t WS_INV = WS_AFF + (size_t)NTOK * 16 * 4;
constexpr size_t WS_ROWTOK = WS_INV + (size_t)NTOK * 16 * 4;
constexpr size_t WS_GATEV = WS_ROWTOK + (size_t)NE * RPE * 4;
constexpr size_t WS_R1 = WS_GATEV + (size_t)NE * RPE * 4;
constexpr size_t SZ_QKV = (size_t)NTOK * 512 * 2;
constexpr size_t WS_Q = WS_R1, WS_K = WS_Q + SZ_QKV, WS_V = WS_K + SZ_QKV, WS_O = WS_V + SZ_QKV;
constexpr size_t WS_HID = WS_R1;
constexpr size_t WS_R2 = WS_R1 + 4 * SZ_QKV;
constexpr size_t SZ_C = (size_t)NTOK * 256 * 2;
constexpr size_t WS_CA = WS_R2, WS_CG = WS_CA + SZ_C, WS_FR = WS_CG + SZ_C, WS_ZT = WS_FR + SZ_C;
constexpr size_t WS_ZO = WS_ZT + (size_t)2048 * 1024 * 2;
constexpr size_t WS_ZTC = WS_ZT + (size_t)2048 * 2048 * 2;
constexpr size_t WS_HF = WS_ZT + 2 * (size_t)2048 * 2048 * 2, WS_HB = WS_HF + SZ_QKV, WS_Y = WS_HB + SZ_QKV;
constexpr size_t WS_YS = WS_R2;
constexpr size_t WS_END = WS_Y + (size_t)NTOK * KOUT * 2;
static_assert((size_t)NE * RPE * D * 2 <= 4 * SZ_QKV, "HID alias");
static_assert(WS_YS + (size_t)NE * RPE * D * 2 <= WS_END, "YS alias");

constexpr int RING_BYTES = 139264;
constexpr int LDSCTL_OFF = RING_BYTES;
constexpr int LDS_BYTES = RING_BYTES + 1024;

__device__ __forceinline__ unsigned f2bf(float f) { unsigned u = __float_as_uint(f); u += 0x7FFFu + ((u >> 16) & 1u); return u >> 16; }
typedef __bf16 bf16x2_t __attribute__((ext_vector_type(2)));
__device__ __forceinline__ unsigned pk2(float lo, float hi) { const bf16x2_t r = __builtin_convertvector((f32x2){lo, hi}, bf16x2_t); return __builtin_bit_cast(unsigned, r); }
__device__ __forceinline__ float bf2f(unsigned b) { return __uint_as_float(b << 16); }
__device__ __forceinline__ float bflo(unsigned w) { return __uint_as_float(w << 16); }
__device__ __forceinline__ float bfhi(unsigned w) { return __uint_as_float(w & 0xffff0000u); }
__device__ __forceinline__ float sigmoidf_(float x) { return 1.0f / (1.0f + __expf(-x)); }
__device__ __forceinline__ float siluf_(float x) { return x / (1.0f + __expf(-x)); }
__device__ __forceinline__ float logsigmoidf_(float x) { return x >= 0.f ? -log1pf(expf(-x)) : x - log1pf(expf(x)); }
__device__ __forceinline__ float wave_sum(float v) {
#pragma unroll
    for (int o = 1; o < 64; o <<= 1) v += __shfl_xor(v, o);
    return v;
}
__device__ __forceinline__ u32x2 pk4(f32x4 v) { u32x2 w; w.x = pk2(v[0], v[1]); w.y = pk2(v[2], v[3]); return w; }

#define XB_TMO      128
#define XB_XCNT(j)  (256  + 64 * (j))
#define XB_XSUB(j)  (1280 + 64 * (j))
#define XB_XGEN(j)  (2304 + 64 * (j))
#define XB_TOP      3328
#define XB_TOPGEN   3392
#define XCD_BAR_WORDS 3456
#define XB_SPIN_CAP (1u << 22)
__device__ __forceinline__ unsigned xb_ld(unsigned* p)              { return __hip_atomic_load(p, __ATOMIC_RELAXED, __HIP_MEMORY_SCOPE_AGENT); }
__device__ __forceinline__ unsigned xb_add(unsigned* p, unsigned v) { return __hip_atomic_fetch_add(p, v, __ATOMIC_RELAXED, __HIP_MEMORY_SCOPE_AGENT); }
__device__ __forceinline__ unsigned xb_xcc_id() { return (unsigned)__builtin_amdgcn_s_getreg((3 << 11) | 20) & 0xFu; }
#define XB_SPIN(cond, bar) do { unsigned _sp = 0; while (cond) { __builtin_amdgcn_s_sleep(1); \
    if ((++_sp & 255u) == 0u) { if (xb_ld(&(bar)[XB_TMO])) break; if (_sp > XB_SPIN_CAP) { atomicAdd(&(bar)[XB_TMO], 1u); break; } } } } while (0)
struct XcdBarrier { unsigned* bar; unsigned x; volatile LAS unsigned* st; };
__device__ __forceinline__ XcdBarrier xcd_barrier_post(unsigned* bar, volatile LAS unsigned* st) {
    XcdBarrier b; b.bar = bar; b.x = xb_xcc_id(); b.st = st;
    if (threadIdx.x == 0) (void)xb_add(&bar[XB_XCNT(b.x)], 1u);
    return b;
}
__device__ __forceinline__ void xcd_barrier_complete(unsigned* bar, unsigned x, unsigned& nloc, unsigned& nx) {
    const unsigned G = gridDim.x * gridDim.y * gridDim.z;
    unsigned sum, cnt, mine, sp = 0u;
    for (;;) {
        sum = 0u; cnt = 0u; mine = 0u;
#pragma unroll
        for (unsigned j = 0; j < 16; ++j) { const unsigned c = xb_ld(&bar[XB_XCNT(j)]); sum += c; cnt += (c > 0u) ? 1u : 0u; mine = (j == x) ? c : mine; }
        if (sum == G) break;
        __builtin_amdgcn_s_sleep(1);
        if ((++sp & 255u) == 0u) { if (xb_ld(&bar[XB_TMO])) break; if (sp > XB_SPIN_CAP) { atomicAdd(&bar[XB_TMO], 1u); break; } }
    }
    nloc = mine > 0u ? mine : 1u; nx = cnt > 0u ? cnt : 1u;
}
__device__ __forceinline__ void xcd_barrier(const XcdBarrier& b) {
    asm volatile("s_waitcnt vmcnt(0)" ::: "memory");
    __syncthreads();
    if (threadIdx.x == 0) {
        unsigned* bar = b.bar;
        __builtin_amdgcn_s_waitcnt(0);
        unsigned nloc = b.st[0], nx = b.st[1];
        if (nloc == 0u) { xcd_barrier_complete(bar, b.x, nloc, nx); b.st[0] = nloc; b.st[1] = nx; }
        const unsigned old = xb_add(&bar[XB_XSUB(b.x)], 1u);
        const unsigned gen = old / nloc;
        if (old + 1u == (gen + 1u) * nloc) {
            __builtin_amdgcn_fence(__ATOMIC_RELEASE, "agent");
            asm volatile("s_waitcnt vmcnt(0)" ::: "memory");
            const unsigned og = xb_add(&bar[XB_TOP], 1u);
            const unsigned tg = og / nx;
            if (og + 1u == (tg + 1u) * nx) xb_add(&bar[XB_TOPGEN], 1u);
            else XB_SPIN(xb_ld(&bar[XB_TOPGEN]) == tg, bar);
            __builtin_amdgcn_fence(__ATOMIC_ACQUIRE, "agent");
            xb_add(&bar[XB_XGEN(b.x)], 1u);
            asm volatile("s_waitcnt vmcnt(0)" ::: "memory");
        } else {
            XB_SPIN(xb_ld(&bar[XB_XGEN(b.x)]) == gen, bar);
            __builtin_amdgcn_fence(__ATOMIC_ACQUIRE, "agent");
            asm volatile("s_waitcnt vmcnt(0)" ::: "memory");
        }
    }
    __syncthreads();
}

namespace pg8 {
constexpr int BM = 256, BK = 64, HALF = 128, HTB = HALF * BK * 2, STAGE_BYTES = 8 * HTB, NXCD = 8, WGM = 8;
__host__ __device__ __forceinline__ int lds_byte(int r, int c) { const int st = (r >> 4) * 2 + (c >> 5), rr = r & 15, cc = c & 31, ob = rr * 64 + cc * 2; return st * 1024 + (ob ^ (((ob >> 9) & 1) << 5)); }
__host__ __device__ __forceinline__ void stage_rc(int b, int& R, int& C) { const int st = b / 1024, sb = b % 1024, swz = sb ^ (((sb >> 9) & 1) << 5); R = (st >> 1) * 16 + swz / 64; C = (st & 1) * 32 + (swz % 64) / 2; }

struct Unit { const char* A; const char* B; const int* rows; int K, pm, pn, ex; };

__device__ __forceinline__ void map_tile(int L, int nM, int nN, int& pm, int& pn) {
    const int nwg = nM * nN; int wgid = L;
    { const int q = nwg / NXCD, r = nwg % NXCD, xcd = wgid % NXCD, off = wgid / NXCD; wgid = (xcd < r ? xcd * (q + 1) : r * (q + 1) + (xcd - r) * q) + off; }
    const int nig = WGM * nN, gid = wgid / nig, fm = gid * WGM, gsz = (nM - fm) < WGM ? (nM - fm) : WGM;
    pm = fm + ((wgid % nig) % gsz); pn = (wgid % nig) / gsz;
}
__device__ __forceinline__ void a_offs(const Unit& u, int lda, int tid, unsigned (&vA)[2][2]) {
#pragma unroll
    for (int h = 0; h < 2; ++h)
#pragma unroll
        for (int i = 0; i < 2; ++i) { int R, C; stage_rc(tid * 16 + i * 8192, R, C); const int r = h * HALF + R; const int ar = u.rows ? u.rows[r] : r; vA[h][i] = (unsigned)(ar * lda + C) * 2u; }
}

template <class Epi, class Sched>
__device__ __forceinline__ void gemm_phase(LAS unsigned char* lds, const int tid, const int lda, const int ldb, const Sched& S, const Epi& E) {
    const int wid = __builtin_amdgcn_readfirstlane(tid >> 6), lane = tid & 63, wr = wid >> 2, wc = wid & 3, fr = lane & 15, fq = lane >> 4;
    unsigned voffB[2];
#pragma unroll
    for (int i = 0; i < 2; ++i) { int R, C; stage_rc(tid * 16 + i * 8192, R, C); voffB[i] = (unsigned)(R * ldb + C) * 2u; }
    const size_t kstep = (size_t)(BK * 2);
    const size_t hsB = (size_t)HALF * ldb * 2;
    const unsigned ldsw = (unsigned)wid * 1024u;
    const int aoff = lds_byte(wr * 64 + fr, fq * 8), boff = lds_byte(wc * 32 + fr, fq * 8);
#define PG8_SA(b, h) (((b) * 2 + (h)) * HTB)
#define PG8_SB(b, h) ((4 + (b) * 2 + (h)) * HTB)
#define PG8_STAGE(bufoff, gbase, voff) do { _Pragma("unroll") for (int _i = 0; _i < 2; ++_i) \
        __builtin_amdgcn_global_load_lds((const unsigned*)((const char*)(gbase) + (voff)[_i]), (LAS unsigned*)(lds + (bufoff) + ldsw + _i * 8192), 16, 0, 0); } while (0)
#define PG8_LDA(dst, b, h) do { _Pragma("unroll") for (int m = 0; m < 4; ++m) _Pragma("unroll") for (int k = 0; k < 2; ++k) dst[m][k] = *(const LAS bf16x8*)(lds + PG8_SA(b, h) + aoff + m * 2048 + k * 1024); } while (0)
#define PG8_LDB(dst, b, h) do { _Pragma("unroll") for (int n = 0; n < 2; ++n) _Pragma("unroll") for (int k = 0; k < 2; ++k) dst[n][k] = *(const LAS bf16x8*)(lds + PG8_SB(b, h) + boff + n * 2048 + k * 1024); } while (0)
#define PG8_MMA(ai, bj, At, Bt) do { __builtin_amdgcn_s_setprio(1); _Pragma("unroll") for (int m = 0; m < 4; ++m) _Pragma("unroll") for (int n = 0; n < 2; ++n) _Pragma("unroll") for (int k = 0; k < 2; ++k) \
        acc[ai][bj][m][n] = __builtin_amdgcn_mfma_f32_16x16x32_bf16(Bt[n][k], At[m][k], acc[ai][bj][m][n], 0, 0, 0); __builtin_amdgcn_s_setprio(0); } while (0)
#define PG8_WAIT_V(n) asm volatile("s_waitcnt vmcnt(" #n ")" ::: "memory")
#define PG8_WAIT_L(n) asm volatile("s_waitcnt lgkmcnt(" #n ")" ::: "memory")
#define PG8_BAR __builtin_amdgcn_s_barrier()
#define PG8_SCHED __builtin_amdgcn_sched_barrier(0)
    Unit cur, nxt; int ui = 0;
    if (!S.next(0, cur)) return;
    f32x4 acc[2][2][4][2];
#pragma unroll
    for (int a = 0; a < 2; ++a)
#pragma unroll
        for (int b = 0; b < 2; ++b)
#pragma unroll
            for (int m = 0; m < 4; ++m)
#pragma unroll
                for (int n = 0; n < 2; ++n) acc[a][b][m][n] = (f32x4){0.f, 0.f, 0.f, 0.f};
    bf16x8 At[4][2], B0[2][2], B1[2][2];
    unsigned vA[2][2], wA[2][2];
    a_offs(cur, lda, tid, vA);
    const char* cA = cur.A; const char* cB = cur.B;
    PG8_STAGE(PG8_SB(0, 0), cB, voffB); PG8_STAGE(PG8_SB(0, 1), cB + hsB, voffB); PG8_STAGE(PG8_SA(0, 0), cA, vA[0]); PG8_STAGE(PG8_SA(0, 1), cA, vA[1]);
    if (wr == 1) PG8_BAR;
    PG8_WAIT_V(2); PG8_BAR;
    PG8_STAGE(PG8_SB(1, 0), cB + kstep, voffB); PG8_STAGE(PG8_SA(1, 0), cA + kstep, vA[0]); PG8_STAGE(PG8_SB(1, 1), cB + hsB + kstep, voffB);
    PG8_WAIT_V(6); PG8_BAR;
    for (;;) {
        const bool has_next = S.next(ui + 1, nxt);
        if (!has_next) nxt = cur;
        const char* nA = nxt.A; const char* nB = nxt.B;
        a_offs(nxt, lda, tid, wA);
        const int nt = cur.K / BK;
        asm volatile(".p2align 8" ::: "memory");
        for (int t = 0; t < nt; t += 2) {
            const bool last = (t == nt - 2);
            const char* a1 = cA + (size_t)(t + 1) * kstep;
            const char* a2 = last ? nA : cA + (size_t)(t + 2) * kstep; const char* b2 = last ? nB : cB + (size_t)(t + 2) * kstep;
            const char* a3 = a2 + kstep; const char* b3 = b2 + kstep;
            PG8_LDB(B0, 0, 0); PG8_LDB(B1, 0, 1); PG8_SCHED; PG8_LDA(At, 0, 0); PG8_STAGE(PG8_SA(1, 1), a1, vA[1]);
            if (last) {
#pragma unroll
                for (int h = 0; h < 2; ++h)
#pragma unroll
                    for (int i = 0; i < 2; ++i) vA[h][i] = wA[h][i];
            }
            PG8_WAIT_V(8); PG8_WAIT_L(0); PG8_BAR; PG8_MMA(0, 0, At, B0); PG8_MMA(0, 1, At, B1); PG8_BAR; PG8_SCHED;
            PG8_LDA(At, 0, 1); PG8_STAGE(PG8_SB(0, 0), b2, voffB); PG8_STAGE(PG8_SB(0, 1), b2 + hsB, voffB); PG8_STAGE(PG8_SA(0, 0), a2, vA[0]);
            PG8_WAIT_V(8); PG8_WAIT_L(0); PG8_BAR; PG8_MMA(1, 0, At, B0); PG8_MMA(1, 1, At, B1); PG8_BAR; PG8_SCHED;
            PG8_LDB(B0, 1, 0); PG8_LDB(B1, 1, 1); PG8_SCHED; PG8_LDA(At, 1, 0); PG8_STAGE(PG8_SA(0, 1), a2, vA[1]);
            PG8_WAIT_V(8); PG8_WAIT_L(0); PG8_BAR; PG8_MMA(0, 0, At, B0); PG8_MMA(0, 1, At, B1); PG8_BAR; PG8_SCHED;
            PG8_LDA(At, 1, 1); PG8_STAGE(PG8_SB(1, 0), b3, voffB); PG8_STAGE(PG8_SB(1, 1), b3 + hsB, voffB); PG8_STAGE(PG8_SA(1, 0), a3, vA[0]);
            PG8_WAIT_V(8); PG8_WAIT_L(0); PG8_BAR; PG8_MMA(1, 0, At, B0); PG8_MMA(1, 1, At, B1); PG8_BAR; PG8_SCHED;
        }
        if (wr == 0) PG8_BAR;
        { int fr_ = fr, fq_ = fq; asm volatile("" : "+v"(fr_), "+v"(fq_));
          E.run(acc, cur, wr, wc, fr_, fq_); }
        if (!has_next) break;
#pragma unroll
        for (int a = 0; a < 2; ++a)
#pragma unroll
            for (int b = 0; b < 2; ++b)
#pragma unroll
                for (int m = 0; m < 4; ++m)
#pragma unroll
                    for (int n = 0; n < 2; ++n) acc[a][b][m][n] = (f32x4){0.f, 0.f, 0.f, 0.f};
        cur = nxt; cA = nA; cB = nB; ++ui;
        if (wr == 1) PG8_BAR;
    }
    PG8_WAIT_V(0);
    PG8_BAR;
#undef PG8_SA
#undef PG8_SB
#undef PG8_STAGE
#undef PG8_LDA
#undef PG8_LDB
#undef PG8_MMA
#undef PG8_WAIT_V
#undef PG8_WAIT_L
#undef PG8_BAR
#undef PG8_SCHED
}
template <class Epi, class Sched>
__device__ __forceinline__ void gemm_phase_simt(LAS unsigned char* lds, const int tid, const int lda, const int ldb, const Sched& S, const Epi& E) {
    LAS float* As = (LAS float*)lds;
    LAS float* Bs = (LAS float*)(lds + 32 * 132 * 4);
    const int ty = tid >> 4, tx = tid & 15, c0 = (tx >> 2) * 32 + (tx & 3) * 4;
    const int lr = tid >> 2, lk = (tid & 3) * 8;
    Unit u;
    for (int ui = 0; S.next(ui, u); ++ui) {
        for (int sub = 0; sub < 4; ++sub) {
            const int sr = sub >> 1, sc = sub & 1;
            float acc[4][8];
#pragma unroll
            for (int i = 0; i < 4; ++i)
#pragma unroll
                for (int j = 0; j < 8; ++j) acc[i][j] = 0.f;
            const int arow = sr * 128 + lr, brow = sc * 128 + lr;
            const int ar = u.rows ? u.rows[arow] : arow;
            const bf16_t* ap = (const bf16_t*)u.A + (size_t)ar * lda + lk;
            const bf16_t* bp = (const bf16_t*)u.B + (size_t)brow * ldb + lk;
            for (int k0 = 0; k0 < u.K; k0 += 32) {
                const u32x4 av = *(const u32x4*)(ap + k0), bv = *(const u32x4*)(bp + k0);
                __syncthreads();
#pragma unroll
                for (int j = 0; j < 4; ++j) {
                    As[(lk + 2 * j) * 132 + lr] = bflo(av[j]); As[(lk + 2 * j + 1) * 132 + lr] = bfhi(av[j]);
                    Bs[(lk + 2 * j) * 132 + lr] = bflo(bv[j]); Bs[(lk + 2 * j + 1) * 132 + lr] = bfhi(bv[j]);
                }
                __syncthreads();
#pragma unroll 4
                for (int k = 0; k < 32; ++k) {
                    const f32x4 a4 = *(const LAS f32x4*)(As + k * 132 + ty * 4);
                    const f32x4 b0 = *(const LAS f32x4*)(Bs + k * 132 + c0), b1 = *(const LAS f32x4*)(Bs + k * 132 + c0 + 16);
#pragma unroll
                    for (int i = 0; i < 4; ++i)
#pragma unroll
                        for (int j = 0; j < 4; ++j) { acc[i][j] += a4[i] * b0[j]; acc[i][4 + j] += a4[i] * b1[j]; }
                }
            }
#pragma unroll
            for (int i = 0; i < 4; ++i)
                E.store1(u, sr * 128 + ty * 4 + i, sc * 128 + c0, (f32x4){acc[i][0], acc[i][1], acc[i][2], acc[i][3]}, (f32x4){acc[i][4], acc[i][5], acc[i][6], acc[i][7]});
        }
    }
    __syncthreads();
}
}

#if USE_MFMA_GEMM
#define GEMM_PHASE(lds, lda, ldb, S, E) pg8::gemm_phase(lds, F.tid, lda, ldb, S, E)
#else
#define GEMM_PHASE(lds, lda, ldb, S, E) pg8::gemm_phase_simt(lds, F.tid, lda, ldb, S, E)
#endif

struct Args { const float* in[21]; float* out; unsigned char* ws; int ph_lo, ph_hi; };
enum { I_X = 0, I_C, I_CTX, I_CCTX, I_WADA, I_BADA, I_GN1, I_WIN, I_BG, I_GH, I_CW, I_CB, I_CLG, I_CLB, I_WOUT, I_GN2, I_WR, I_WEG, I_WEU, I_WED, I_GF };
__device__ __forceinline__ const float* arg_in(const Args& a, int i) { asm volatile("" : "+s"(i)); return a.in[i]; }
struct Frame {
    LAS unsigned char* lds;
    int tid, lane, wave, G, bid;
    unsigned char* ws;
    const Args& A;
};
#define FIN(i) arg_in(F.A, (i))
#define WSP(T, off) ((T*)(F.ws + (off)))

template <class Src>
__device__ __forceinline__ void tr_item(const Src& src, bf16_t* dst, int ldd, int n0, int k0, LAS float* scr, int lane) {
    f32x4 v[8];
#pragma unroll
    for (int i = 0; i < 8; ++i) v[i] = src.ld4(k0 + i * 8 + (lane >> 3), n0 + (lane & 7) * 4);
#pragma unroll
    for (int i = 0; i < 8; ++i) { LAS float* p = scr + (i * 8 + (lane >> 3)) * 33 + (lane & 7) * 4; p[0] = v[i][0]; p[1] = v[i][1]; p[2] = v[i][2]; p[3] = v[i][3]; }
    LDS_WAIT(); asm volatile("" ::: "memory");
    const int c = lane & 7;
#pragma unroll
    for (int j = 0; j < 4; ++j) { const int n = (lane >> 3) + 8 * j; const LAS float* s = scr + (8 * c) * 33 + n;
        u32x4 o; o.x = pk2(s[0 * 33], s[1 * 33]); o.y = pk2(s[2 * 33], s[3 * 33]); o.z = pk2(s[4 * 33], s[5 * 33]); o.w = pk2(s[6 * 33], s[7 * 33]);
        *(u32x4*)(dst + (size_t)(n0 + n) * ldd + k0 + 8 * c) = o; }
    LDS_WAIT(); asm volatile("" ::: "memory");
}
struct SrcWin { const float* w; __device__ __forceinline__ f32x4 ld4(int k, int n) const { return *(const f32x4*)(w + (size_t)k * INC + (n < 1536 ? n : n + 16)); } };
struct SrcPlain { const float* w; int ld; __device__ __forceinline__ f32x4 ld4(int k, int n) const { return *(const f32x4*)(w + (size_t)k * ld + n); } };
struct SrcGU { const float* wg; const float* wu; __device__ __forceinline__ f32x4 ld4(int k, int n) const { const int grp = n >> 5, i = n & 31;
    const uintptr_t base = (uintptr_t)wg + ((i < 16) ? (uintptr_t)0 : ((uintptr_t)wu - (uintptr_t)wg));
    return *(const f32x4*)((const float*)base + (size_t)k * D + grp * 16 + (i & 15)); } };

__device__ __forceinline__ void tr_store(const f32x4 (&v)[8], bf16_t* dst, int ldd, int n0, int k0, LAS float* scr, int lane) {
#pragma unroll
    for (int i = 0; i < 8; ++i) { LAS float* p = scr + (i * 8 + (lane >> 3)) * 33 + (lane & 7) * 4; p[0] = v[i][0]; p[1] = v[i][1]; p[2] = v[i][2]; p[3] = v[i][3]; }
    LDS_WAIT(); asm volatile("" ::: "memory");
    const int c = lane & 7;
#pragma unroll
    for (int j = 0; j < 4; ++j) { const int n = (lane >> 3) + 8 * j; const LAS float* s = scr + (8 * c) * 33 + n;
        u32x4 o; o.x = pk2(s[0 * 33], s[1 * 33]); o.y = pk2(s[2 * 33], s[3 * 33]); o.z = pk2(s[4 * 33], s[5 * 33]); o.w = pk2(s[6 * 33], s[7 * 33]);
        *(u32x4*)(dst + (size_t)(n0 + n) * ldd + k0 + 8 * c) = o; }
    LDS_WAIT(); asm volatile("" ::: "memory");
}
struct MoeItem { bf16_t* dst; int n0, k0; };
__device__ __forceinline__ MoeItem moe_item_load(Frame& F, int l, int it, const float* wg, const float* wu, const float* wd, f32x4 (&v)[8]) {
    constexpr int I_GU = NE * 64 * 16;
    MoeItem m; const int lane = F.lane;
    if (it < I_GU) { const int e = it / 1024, r = it % 1024, sup = r >> 3, wv = r & 7, nb = (sup & 15) * 4 + (wv & 3), kb = (sup >> 4) * 2 + (wv >> 2);
        SrcGU s{wg + ((size_t)l * NE + e) * D * D, wu + ((size_t)l * NE + e) * D * D};
        m.dst = WSP(bf16_t, WS_WGU) + (size_t)e * 2048 * D; m.n0 = nb * 32; m.k0 = kb * 64;
#pragma unroll
        for (int i = 0; i < 8; ++i) v[i] = s.ld4(m.k0 + i * 8 + (lane >> 3), m.n0 + (lane & 7) * 4);
    } else { const int r0 = it - I_GU, e = r0 / 512, r = r0 % 512, sup = r >> 3, wv = r & 7, nb = (sup & 7) * 4 + (wv & 3), kb = (sup >> 3) * 2 + (wv >> 2);
        SrcPlain s{wd + ((size_t)l * NE + e) * D * D, D};
        m.dst = WSP(bf16_t, WS_WD) + (size_t)e * D * D; m.n0 = nb * 32; m.k0 = kb * 64;
#pragma unroll
        for (int i = 0; i < 8; ++i) v[i] = s.ld4(m.k0 + i * 8 + (lane >> 3), m.n0 + (lane & 7) * 4);
    }
    return m;
}
__device__ __forceinline__ void convert_moe_weights(Frame& F, int l, int gw, int ngw) {
    LAS float* scr = (LAS float*)(F.lds + F.wave * 8448);
    const float* w_e_gate = FIN(I_WEG); const float* w_e_up = FIN(I_WEU); const float* w_e_down = FIN(I_WED);
    constexpr int NIT = NE * 64 * 16 + NE * 32 * 16;
    if (gw >= NIT) return;
    f32x4 va[8], vb[8];
    MoeItem ma = moe_item_load(F, l, gw, w_e_gate, w_e_up, w_e_down, va), mb = ma;
    for (int it = gw; it < NIT; it += 2 * ngw) {
        const int i1 = it + ngw, i2 = it + 2 * ngw;
        if (i1 < NIT) mb = moe_item_load(F, l, i1, w_e_gate, w_e_up, w_e_down, vb);
        tr_store(va, ma.dst, D, ma.n0, ma.k0, scr, F.lane);
        if (i1 < NIT) {
            if (i2 < NIT) ma = moe_item_load(F, l, i2, w_e_gate, w_e_up, w_e_down, va);
            tr_store(vb, mb.dst, D, mb.n0, mb.k0, scr, F.lane);
        }
    }
}

__device__ __forceinline__ void phase_prep(Frame& F) {
    const int tid = F.tid;
    {
        LAS float* s = (LAS float*)F.lds;
        LAS float* red = (LAS float*)(F.lds + 9 * 1024 * 4);
        float* MOD = WSP(float, WS_MOD);
        const float* c_in = FIN(I_C); const float* c_ctx = FIN(I_CCTX); const float* w_ada = FIN(I_WADA); const float* b_ada = FIN(I_BADA);
        bool staged = false;
        for (int it = F.bid; it < 192; it += F.G) {
            if (!staged) { for (int i = tid; i < 9 * 1024; i += NTHR) { const int r = i >> 10, k = i & 1023; const float cv = (r < 8) ? c_in[r * 1024 + k] : c_ctx[k]; s[i] = siluf_(cv); } staged = true; }
            __syncthreads();
            const int l = it / 96, cgp = it % 96, col = cgp * 64 + (tid & 63), kq = tid >> 6;
            float acc[9];
#pragma unroll
            for (int r = 0; r < 9; ++r) acc[r] = 0.f;
            const float* w = w_ada + ((size_t)l * 1024 + kq * 128) * 6144 + col;
            for (int k0 = 0; k0 < 128; k0 += 32) {
                float wv[32];
#pragma unroll
                for (int k = 0; k < 32; ++k) wv[k] = w[(size_t)(k0 + k) * 6144];
#pragma unroll
                for (int k = 0; k < 32; ++k)
#pragma unroll
                    for (int r = 0; r < 9; ++r) acc[r] += s[r * 1024 + kq * 128 + k0 + k] * wv[k];
            }
#pragma unroll
            for (int r = 0; r < 9; ++r) red[(kq * 9 + r) * 64 + (tid & 63)] = acc[r];
            __syncthreads();
            for (int o = tid; o < 576; o += NTHR) { const int r = o >> 6, cc = o & 63; float sum = 0.f;
#pragma unroll
                for (int q = 0; q < 8; ++q) sum += red[(q * 9 + r) * 64 + cc];
                MOD[((size_t)l * 9 + r) * 6144 + cgp * 64 + cc] = sum + b_ada[l * 6144 + cgp * 64 + cc]; }
            __syncthreads();
        }
        __syncthreads();
    }
    {
        bf16_t* FL = WSP(bf16_t, WS_FL); bf16_t* FC = WSP(bf16_t, WS_FC);
        const size_t gth = (size_t)F.bid * NTHR + tid, nth = (size_t)F.G * NTHR;
        for (size_t it = gth; it < (size_t)4096 * 1024 / 8; it += nth) {
            const int r = (int)(it / 128), t0 = (int)(it % 128) * 8, part = r >> 11, k = r & 2047; unsigned w[4];
#pragma unroll
            for (int j = 0; j < 4; ++j) { float v[2];
#pragma unroll
                for (int q = 0; q < 2; ++q) { const int ph = (k * (t0 + 2 * j + q)) & 2047; const float ang = (float)ph * (6.283185307179586f / 2048.f); v[q] = (part ? sinf(ang) : cosf(ang)) * 0.022097086912079608f; }
                w[j] = pk2(v[0], v[1]); }
            *(u32x4*)(FL + (size_t)r * 1024 + t0) = (u32x4){w[0], w[1], w[2], w[3]};
        }
        for (size_t it = gth; it < (size_t)512 * 256 / 8; it += nth) {
            const int r = (int)(it / 32), t0 = (int)(it % 32) * 8, part = r >> 8, k = r & 255; unsigned w[4];
#pragma unroll
            for (int j = 0; j < 4; ++j) { float v[2];
#pragma unroll
                for (int q = 0; q < 2; ++q) { const int ph = (k * (t0 + 2 * j + q)) & 255; const float ang = (float)ph * (6.283185307179586f / 256.f); v[q] = (part ? sinf(ang) : cosf(ang)) * 0.0625f; }
                w[j] = pk2(v[0], v[1]); }
            *(u32x4*)(FC + (size_t)r * 1024 + t0) = (u32x4){w[0], w[1], w[2], w[3]};
        }
    }
    const int gw = F.bid * NWAVES + F.wave, ngw = F.G * NWAVES;
    {
        LAS float* scr = (LAS float*)(F.lds + F.wave * 8448);
        bf16_t* WIN = WSP(bf16_t, WS_WIN); bf16_t* WOUT = WSP(bf16_t, WS_WOUT);
        const float* w_in = FIN(I_WIN); const float* w_out = FIN(I_WOUT);
        constexpr int I_IN = 2 * 88 * 16, I_OP = 2 * 32 * 12, I_PQ = 2 * 32 * 8;
        for (int it = gw; it < I_IN + I_OP + I_PQ; it += ngw) {
            if (it < I_IN) { const int l = it / 1408, r = it % 1408, nb = r / 16, kb = r % 16;
                SrcWin s{w_in + (size_t)l * D * INC};
                tr_item(s, WIN + (size_t)l * NIN * D, D, nb * 32, kb * 64, scr, F.lane);
            } else if (it < I_IN + I_OP) { const int r0 = it - I_IN, l = r0 / 384, r = r0 % 384, nb = r / 12, kb = r % 12;
                SrcPlain s{w_out + (size_t)l * D * D, D};
                tr_item(s, WOUT + (size_t)l * D * KOUT, KOUT, nb * 32, kb * 64, scr, F.lane);
            } else { const int r0 = it - I_IN - I_OP, l = r0 / 256, r = r0 % 256, nb = r / 8, gp = r % 8, g = gp & 3, part = gp >> 2;
                const float* wsrc = w_out + (size_t)l * D * D + (size_t)(768 + g * 64) * D + nb * 32;
#pragma unroll 8
                for (int i = 0; i < 32; ++i) { const int kk = 2 * i + (F.lane >> 5), nn = F.lane & 31; scr[kk * 33 + nn] = wsrc[(size_t)kk * D + nn]; }
                LDS_WAIT(); asm volatile("" ::: "memory");
                const int c8 = F.lane & 7;
                float o[4][8];
#pragma unroll
                for (int j = 0; j < 4; ++j)
#pragma unroll
                    for (int q = 0; q < 8; ++q) o[j][q] = 0.f;
                for (int m = 0; m < 64; ++m) {
                    float twd[8];
#pragma unroll
                    for (int q = 0; q < 8; ++q) { const float ang = (float)((m * (c8 * 8 + q)) & 63) * (6.283185307179586f / 64.f); twd[q] = part ? -__sinf(ang) : __cosf(ang); }
#pragma unroll
                    for (int j = 0; j < 4; ++j) { const float bv = scr[m * 33 + (F.lane >> 3) + 8 * j];
#pragma unroll
                        for (int q = 0; q < 8; ++q) o[j][q] += twd[q] * bv; }
                }
#pragma unroll
                for (int j = 0; j < 4; ++j) { const int n = (F.lane >> 3) + 8 * j;
                    u32x4 ov; ov.x = pk2(o[j][0] * 0.125f, o[j][1] * 0.125f); ov.y = pk2(o[j][2] * 0.125f, o[j][3] * 0.125f); ov.z = pk2(o[j][4] * 0.125f, o[j][5] * 0.125f); ov.w = pk2(o[j][6] * 0.125f, o[j][7] * 0.125f);
                    *(u32x4*)(WOUT + (size_t)l * D * KOUT + (size_t)(nb * 32 + n) * KOUT + 768 + part * 256 + g * 64 + c8 * 8) = ov; }
                LDS_WAIT(); asm volatile("" ::: "memory");
            }
        }
    }
}

__device__ __forceinline__ void stage_small_w(Frame& F, LAS float* wT, const float* src, int ld, int coloff) {
    for (int i = F.tid; i < 16 * 1024; i += NTHR) { const int k = i >> 4, c = i & 15; wT[c * 1024 + k] = src[(size_t)k * ld + coloff + c]; }
    __syncthreads();
}
__device__ __forceinline__ float reduce16(float (&acc)[16], int lane) {
    float v8[8], v4[4], v2[2], v1;
#pragma unroll
    for (int i = 0; i < 8; ++i) { const float snd = (lane & 32) ? acc[i] : acc[i + 8], kp = (lane & 32) ? acc[i + 8] : acc[i]; v8[i] = kp + __shfl_xor(snd, 32); }
#pragma unroll
    for (int i = 0; i < 4; ++i) { const float snd = (lane & 16) ? v8[i] : v8[i + 4], kp = (lane & 16) ? v8[i + 4] : v8[i]; v4[i] = kp + __shfl_xor(snd, 16); }
#pragma unroll
    for (int i = 0; i < 2; ++i) { const float snd = (lane & 8) ? v4[i] : v4[i + 2], kp = (lane & 8) ? v4[i + 2] : v4[i]; v2[i] = kp + __shfl_xor(snd, 8); }
    { const float snd = (lane & 4) ? v2[0] : v2[1], kp = (lane & 4) ? v2[1] : v2[0]; v1 = kp + __shfl_xor(snd, 4); }
    v1 += __shfl_xor(v1, 2); v1 += __shfl_xor(v1, 1);
    return v1;
}
__device__ __forceinline__ float norm_row(const f32x4 (&v)[4], const float* gain, const float* shift, const float* scale, bf16_t* xn_row, const LAS float* wT, int lane) {
    float ss = 0.f;
#pragma unroll
    for (int j = 0; j < 4; ++j) ss += (v[j][0] * v[j][0] + v[j][1] * v[j][1]) + (v[j][2] * v[j][2] + v[j][3] * v[j][3]);
    ss = wave_sum(ss);
    const float r = 1.0f / sqrtf(ss * (1.0f / D) + EPS);
    float acc[16];
#pragma unroll
    for (int c = 0; c < 16; ++c) acc[c] = 0.f;
#pragma unroll
    for (int j = 0; j < 4; ++j) {
        const int o = 4 * lane + 256 * j;
        const f32x4 g = *(const f32x4*)(gain + o), sh = *(const f32x4*)(shift + o), sc = *(const f32x4*)(scale + o);
        f32x4 y;
#pragma unroll
        for (int q = 0; q < 4; ++q) y[q] = v[j][q] * r * g[q] * (1.0f + sc[q]) + sh[q];
        *(u32x2*)(xn_row + o) = pk4(y);
        f32x4 wv[16];
#pragma unroll
        for (int c = 0; c < 16; ++c) wv[c] = *(const LAS f32x4*)(wT + c * 1024 + o);
        __builtin_amdgcn_sched_barrier(0);
#pragma unroll
        for (int c = 0; c < 16; ++c) acc[c] += (y[0] * wv[c][0] + y[1] * wv[c][1]) + (y[2] * wv[c][2] + y[3] * wv[c][3]);
        __builtin_amdgcn_sched_barrier(0);
        asm volatile("" ::: "memory");
    }
    return reduce16(acc, lane);
}
__device__ __forceinline__ void row_tail_gates(float myv, const float* b_gates_l, float* gates_row, int lane) {
    if ((lane & 3) == 0) { const int c = lane >> 2; gates_row[c] = myv + b_gates_l[c]; }
}
__device__ __forceinline__ void row_tail_router(float myv, float* aff_row, int lane) {
    float mx = myv;
#pragma unroll
    for (int o = 4; o < 64; o <<= 1) mx = fmaxf(mx, __shfl_xor(mx, o));
    const float e = expf(myv - mx); float s = e;
#pragma unroll
    for (int o = 4; o < 64; o <<= 1) s += __shfl_xor(s, o);
    if ((lane & 3) == 0) aff_row[lane >> 2] = e / s;
}
__device__ __forceinline__ int mod_row(int tok) { return tok < NLAT ? (tok >> 11) : 8; }

__device__ __forceinline__ void phase_norm1_l0(Frame& F) {
    LAS float* wT = (LAS float*)F.lds;
    stage_small_w(F, wT, FIN(I_WIN), INC, 1536);
    const float* MOD = WSP(float, WS_MOD); bf16_t* XN = WSP(bf16_t, WS_XN); float* GATES = WSP(float, WS_GATES);
    const float* x_in = FIN(I_X); const float* ctx_in = FIN(I_CTX); const float* g_norm1 = FIN(I_GN1); const float* b_gates = FIN(I_BG);
    const int gw = F.bid * NWAVES + F.wave, ngw = F.G * NWAVES;
    f32x4 vn[4];
    { const float* src = gw < NLAT ? x_in + (size_t)gw * D : ctx_in + (size_t)(gw - NLAT) * D;
#pragma unroll
      for (int j = 0; j < 4; ++j) vn[j] = *(const f32x4*)(src + 4 * F.lane + 256 * j); }
    for (int tok = gw; tok < NTOK; tok += ngw) {
        f32x4 v[4];
#pragma unroll
        for (int j = 0; j < 4; ++j) v[j] = vn[j];
        const int tn = tok + ngw;
        if (tn < NTOK) { const float* src = tn < NLAT ? x_in + (size_t)tn * D : ctx_in + (size_t)(tn - NLAT) * D;
#pragma unroll
            for (int j = 0; j < 4; ++j) vn[j] = *(const f32x4*)(src + 4 * F.lane + 256 * j); }
        const float* md = MOD + (size_t)mod_row(tok) * 6144;
        const float myv = norm_row(v, g_norm1, md, md + 1024, XN + (size_t)tok * D, wT, F.lane);
        row_tail_gates(myv, b_gates, GATES + (size_t)tok * 16, F.lane);
    }
    __syncthreads();
}
__device__ __forceinline__ void phase_norm2(Frame& F, int l) {
    LAS float* wT = (LAS float*)F.lds;
    stage_small_w(F, wT, FIN(I_WR) + (size_t)l * D * 16, 16, 0);
    const float* g_norm2 = FIN(I_GN2);
    const float* MOD = WSP(float, WS_MOD); bf16_t* XN = WSP(bf16_t, WS_XN); float* AFF = WSP(float, WS_AFF); const float* X = WSP(float, WS_X);
    const int gw = F.bid * NWAVES + F.wave, ngw = F.G * NWAVES;
    const int ntok = (l == 0) ? NTOK : NLAT;
    f32x4 vn[4];
#pragma unroll
    for (int j = 0; j < 4; ++j) vn[j] = *(const f32x4*)(X + (size_t)gw * D + 4 * F.lane + 256 * j);
    for (int tok = gw; tok < ntok; tok += ngw) {
        f32x4 v[4];
#pragma unroll
        for (int j = 0; j < 4; ++j) v[j] = vn[j];
        const int tn = tok + ngw;
        if (tn < ntok) {
#pragma unroll
            for (int j = 0; j < 4; ++j) vn[j] = *(const f32x4*)(X + (size_t)tn * D + 4 * F.lane + 256 * j); }
        const float* md = MOD + ((size_t)l * 9 + mod_row(tok)) * 6144;
        const float myv = norm_row(v, g_norm2 + l * D, md + 3 * 1024, md + 4 * 1024, XN + (size_t)tok * D, wT, F.lane);
        row_tail_router(myv, AFF + (size_t)tok * 16, F.lane);
    }
    __syncthreads();
}
__device__ __forceinline__ void phase_combine(Frame& F, int l) {
    LAS float* wT = (LAS float*)F.lds;
    if (l == 0) stage_small_w(F, wT, FIN(I_WIN) + (size_t)1 * D * INC, INC, 1536);
    const float* g_norm1 = FIN(I_GN1); const float* b_gates = FIN(I_BG); const float* g_final = FIN(I_GF); float* outp = F.A.out;
    const float* MOD = WSP(float, WS_MOD); bf16_t* XN = WSP(bf16_t, WS_XN); float* GATES = WSP(float, WS_GATES); float* X = WSP(float, WS_X);
    const int* INV = WSP(int, WS_INV); const bf16_t* YS = WSP(bf16_t, WS_YS);
    const int gw = F.bid * NWAVES + F.wave, ngw = F.G * NWAVES;
    const int ntok = (l == 0) ? NTOK : NLAT;
    f32x4 vn[4]; int invn = INV[(size_t)gw * 16 + (F.lane & 15)];
#pragma unroll
    for (int j = 0; j < 4; ++j) vn[j] = *(const f32x4*)(X + (size_t)gw * D + 4 * F.lane + 256 * j);
    for (int tok = gw; tok < ntok; tok += ngw) {
        f32x4 v[4], a[4];
#pragma unroll
        for (int j = 0; j < 4; ++j) { v[j] = vn[j]; a[j] = (f32x4){0.f, 0.f, 0.f, 0.f}; }
        const int myinv = invn;
        { const int tn = tok + ngw;
          if (tn < ntok) { invn = INV[(size_t)tn * 16 + (F.lane & 15)];
#pragma unroll
              for (int j = 0; j < 4; ++j) vn[j] = *(const f32x4*)(X + (size_t)tn * D + 4 * F.lane + 256 * j); } }
        {
            unsigned long long mask = __ballot(myinv >= 0) & 0xffffull;
            while (mask) { const int e = __builtin_ctzll(mask); mask &= mask - 1;
                const int r = __builtin_amdgcn_readlane(myinv, e);
                const bf16_t* yr = YS + ((size_t)e * RPE + r) * D;
#pragma unroll
                for (int j = 0; j < 4; ++j) { const u32x2 w = *(const u32x2*)(yr + 4 * F.lane + 256 * j); a[j][0] += bflo(w.x); a[j][1] += bfhi(w.x); a[j][2] += bflo(w.y); a[j][3] += bfhi(w.y); } }
        }
        const float* md = MOD + ((size_t)l * 9 + mod_row(tok)) * 6144;
#pragma unroll
        for (int j = 0; j < 4; ++j) { const f32x4 gt = *(const f32x4*)(md + 5 * 1024 + 4 * F.lane + 256 * j); v[j] = v[j] + gt * a[j]; }
        if (l == 0) {
#pragma unroll
            for (int j = 0; j < 4; ++j) *(f32x4*)(X + (size_t)tok * D + 4 * F.lane + 256 * j) = v[j];
            const float* md1 = MOD + ((size_t)9 + mod_row(tok)) * 6144;
            const float myv = norm_row(v, g_norm1 + D, md1, md1 + 1024, XN + (size_t)tok * D, wT, F.lane);
            row_tail_gates(myv, b_gates + 16, GATES + (size_t)tok * 16, F.lane);
        } else {
            float ss = 0.f;
#pragma unroll
            for (int j = 0; j < 4; ++j) ss += (v[j][0] * v[j][0] + v[j][1] * v[j][1]) + (v[j][2] * v[j][2] + v[j][3] * v[j][3]);
            ss = wave_sum(ss);
            const float r = 1.0f / sqrtf(ss * (1.0f / D) + EPS);
#pragma unroll
            for (int j = 0; j < 4; ++j) { const f32x4 g = *(const f32x4*)(g_final + 4 * F.lane + 256 * j); *(f32x4*)(outp + (size_t)tok * D + 4 * F.lane + 256 * j) = v[j] * r * g; }
        }
    }
    __syncthreads();
}

__device__ __forceinline__ int block_count(LAS int* cbuf, int par, int wave, int lane, int c_wave  ) {
    if (lane == 0) cbuf[par * 8 + wave] = c_wave;
    __syncthreads();
    int t = 0;
#pragma unroll
    for (int q = 0; q < 8; ++q) t += cbuf[par * 8 + q];
    return t;
}
__device__ __forceinline__ void phase_topk(Frame& F, int l) {
    LAS int* cbuf = (LAS int*)F.lds;
    const float* AFF = WSP(float, WS_AFF); int* INV = WSP(int, WS_INV); int* ROWTOK = WSP(int, WS_ROWTOK); float* GATEV = WSP(float, WS_GATEV);
    const int nitems = (l == 0) ? 256 : 128;
    for (int it = F.bid; it < nitems; it += F.G) {
        const int s = it >> 4, e = it & 15;
        const bool lat = s < 8;
        const int n = lat ? SEQ : CTXL, cap = lat ? 256 : 32, tok0 = lat ? s * SEQ : NLAT + (s - 8) * CTXL, rowbase = lat ? s * 256 : 2048 + (s - 8) * 32;
        const bool active = 4 * F.tid < n;
        unsigned k[4];
#pragma unroll
        for (int q = 0; q < 4; ++q) k[q] = active ? __float_as_uint(AFF[(size_t)(tok0 + 4 * F.tid + q) * 16 + e]) : 0u;
        __syncthreads();
        unsigned T = 0u; int par = 0;
        for (int bit = 30; bit >= 0; --bit) {
            const unsigned cand = T | (1u << bit);
            int cw = 0;
#pragma unroll
            for (int q = 0; q < 4; ++q) cw += __popcll(__ballot(k[q] >= cand));
            const int tot = block_count(cbuf, par, F.wave, F.lane, cw); par ^= 1;
            if (tot >= cap) T = cand;
        }
        int cw = 0;
#pragma unroll
        for (int q = 0; q < 4; ++q) cw += __popcll(__ballot(k[q] > T));
        const int c_gt = block_count(cbuf, par, F.wave, F.lane, cw); par ^= 1;
        int mg = 0, me = 0;
#pragma unroll
        for (int q = 0; q < 4; ++q) { mg += (k[q] > T) ? 1 : 0; me += (k[q] == T && active) ? 1 : 0; }
        int pk_ = mg | (me << 16), inc = pk_;
#pragma unroll
        for (int o = 1; o < 64; o <<= 1) { const int y = __shfl_up(inc, o); if (F.lane >= o) inc += y; }
        if (F.lane == 63) cbuf[16 + F.wave] = inc;
        __syncthreads();
        int base = 0;
#pragma unroll
        for (int q = 0; q < 8; ++q) base += (q < F.wave) ? cbuf[16 + q] : 0;
        int pre = base + inc - pk_; int pg = pre & 0xffff, pe = pre >> 16;
        if (active) {
#pragma unroll
            for (int q = 0; q < 4; ++q) {
                const int tok = tok0 + 4 * F.tid + q; int slot = -1;
                if (k[q] > T) { slot = pg; ++pg; }
                else if (k[q] == T) { if (c_gt + pe < cap) slot = c_gt + pe; ++pe; }
                if (slot >= 0) { ROWTOK[e * RPE + rowbase + slot] = tok; GATEV[e * RPE + rowbase + slot] = __uint_as_float(k[q]); }
                INV[(size_t)tok * 16 + e] = slot >= 0 ? rowbase + slot : -1;
            }
        }
        __syncthreads();
    }
    __syncthreads();
}

__device__ __forceinline__ void conv_items(Frame& F, int l, int first, int stride) {
    LAS float* gl = (LAS float*)F.lds;
    LAS float* ob = gl + 62 * 256;
    const bf16_t* CA = WSP(bf16_t, WS_CA); const bf16_t* CG = WSP(bf16_t, WS_CG); bf16_t* Y = WSP(bf16_t, WS_Y);
    const int nitems = (l == 0) ? 512 + 64 : 512;
    const int ch = F.tid & 255, th = F.tid >> 8;
    const float* conv_w = FIN(I_CW); const float* conv_b = FIN(I_CB); const float* conv_ln_g = FIN(I_CLG); const float* conv_ln_b = FIN(I_CLB);
    float w[31];
#pragma unroll
    for (int j = 0; j < 31; ++j) w[j] = conv_w[((size_t)l * 31 + j) * 256 + ch];
    const float cb = conv_b[l * 256 + ch];
    for (int it = first; it < nitems; it += stride) {
        const bool lat = it < 512;
        const int seqlen = lat ? SEQ : CTXL;
        const int b = lat ? it >> 6 : (it - 512) >> 3, t0 = lat ? (it & 63) * 32 : ((it - 512) & 7) * 32;
        const int tokb = lat ? b * SEQ : NLAT + b * CTXL;
        __syncthreads();
        for (int i = F.tid; i < 62 * 64; i += NTHR) {
            const int rr = i >> 6, c4 = (i & 63) * 4, t = t0 - 15 + rr;
            f32x4 g = (f32x4){0.f, 0.f, 0.f, 0.f};
            if (t >= 0 && t < seqlen) { const size_t o = (size_t)(tokb + t) * 256 + c4; const u32x2 a = *(const u32x2*)(CA + o), gg = *(const u32x2*)(CG + o);
                g[0] = bflo(a.x) * sigmoidf_(bflo(gg.x)); g[1] = bfhi(a.x) * sigmoidf_(bfhi(gg.x)); g[2] = bflo(a.y) * sigmoidf_(bflo(gg.y)); g[3] = bfhi(a.y) * sigmoidf_(bfhi(gg.y)); }
            *(LAS f32x4*)(gl + rr * 256 + c4) = g;
        }
        __syncthreads();
        for (int tt = 0; tt < 16; ++tt) {
            const LAS float* gp = gl + (th * 16 + tt) * 256 + ch;
            float gv[31];
#pragma unroll
            for (int j = 0; j < 31; ++j) gv[j] = gp[j * 256];
            __builtin_amdgcn_sched_barrier(0);
            float o = cb;
#pragma unroll
            for (int j = 0; j < 31; ++j) o += w[j] * gv[j];
            __builtin_amdgcn_sched_barrier(0);
            ob[(th * 16 + tt) * 256 + ch] = o;
        }
        __syncthreads();
        for (int tt = F.wave; tt < 32; tt += NWAVES) {
            const f32x4 v = *(const LAS f32x4*)(ob + tt * 256 + 4 * F.lane);
            const float mean = wave_sum((v[0] + v[1]) + (v[2] + v[3])) * (1.0f / 256.f);
            const f32x4 d = v - mean;
            const float var = wave_sum((d[0] * d[0] + d[1] * d[1]) + (d[2] * d[2] + d[3] * d[3])) * (1.0f / 256.f);
            const float rs = 1.0f / sqrtf(var + EPS);
            const f32x4 lg = *(const f32x4*)(conv_ln_g + l * 256 + 4 * F.lane), lb = *(const f32x4*)(conv_ln_b + l * 256 + 4 * F.lane);
            f32x4 y;
#pragma unroll
            for (int q = 0; q < 4; ++q) y[q] = siluf_(d[q] * rs * lg[q] + lb[q]);
            *(u32x2*)(Y + (size_t)(tokb + t0 + tt) * KOUT + 512 + 4 * F.lane) = pk4(y);
        }
    }
    __syncthreads();
}
__device__ __forceinline__ void ztrans_items(Frame& F, int l, int first, int stride) {
    LAS unsigned short* te = (LAS unsigned short*)(F.lds + F.wave * (2 * 64 * 66 * 2));
    LAS unsigned short* to = te + 64 * 66;
    const bf16_t* FR = WSP(bf16_t, WS_FR); bf16_t* ZE = WSP(bf16_t, WS_ZT); bf16_t* ZO = WSP(bf16_t, WS_ZO); bf16_t* ZTC = WSP(bf16_t, WS_ZTC);
    const int nlat = 8 * 16 * 4, nctx = (l == 0) ? 8 * 4 * 4 : 0;
    for (int it = first; it < nlat + nctx; it += stride) {
        const bool lat = it < nlat; const int r = lat ? it : it - nlat;
        const int b = lat ? r >> 6 : r >> 4, tb = lat ? (r >> 2) & 15 : (r >> 2) & 3, cb = r & 3;
        const int tokb = lat ? b * SEQ : NLAT + b * CTXL;
#pragma unroll
        for (int i = 0; i < 8; ++i) { const int tt = (F.lane >> 3) + 8 * i, c8 = (F.lane & 7) * 8, t = tb * 64 + tt;
            const u32x4 v = *(const u32x4*)(FR + (size_t)(tokb + t) * 256 + cb * 64 + c8);
            u32x4 m = (u32x4){0u, 0u, 0u, 0u};
            if (lat && t > 0) m = *(const u32x4*)(FR + (size_t)(tokb + SEQ - t) * 256 + cb * 64 + c8);
#pragma unroll
            for (int q = 0; q < 4; ++q) {
                if (lat) { const float a0 = bflo(v[q]), a1 = bfhi(v[q]), m0 = bflo(m[q]), m1 = bfhi(m[q]); const unsigned e_ = pk2(a0 + m0, a1 + m1), o_ = (t > 0) ? pk2(a0 - m0, a1 - m1) : 0u;
                    te[(c8 + 2 * q) * 66 + tt] = (unsigned short)(e_ & 0xffffu); te[(c8 + 2 * q + 1) * 66 + tt] = (unsigned short)(e_ >> 16);
                    to[(c8 + 2 * q) * 66 + tt] = (unsigned short)(o_ & 0xffffu); to[(c8 + 2 * q + 1) * 66 + tt] = (unsigned short)(o_ >> 16); }
                else { te[(c8 + 2 * q) * 66 + tt] = (unsigned short)(v[q] & 0xffffu); te[(c8 + 2 * q + 1) * 66 + tt] = (unsigned short)(v[q] >> 16); } } }
        LDS_WAIT(); asm volatile("" ::: "memory");
        const size_t drow = (size_t)(b * 256 + cb * 64) * 1024 + tb * 64;
#pragma unroll
        for (int i = 0; i < 8; ++i) { const int cc = (F.lane >> 3) + 8 * i, t8 = (F.lane & 7) * 8; u32x4 o;
#pragma unroll
            for (int q = 0; q < 4; ++q) o[q] = (unsigned)te[cc * 66 + t8 + 2 * q] | ((unsigned)te[cc * 66 + t8 + 2 * q + 1] << 16);
            *(u32x4*)((lat ? ZE : ZTC) + drow + (size_t)cc * 1024 + t8) = o;
            if (lat) {
#pragma unroll
                for (int q = 0; q < 4; ++q) o[q] = (unsigned)to[cc * 66 + t8 + 2 * q] | ((unsigned)to[cc * 66 + t8 + 2 * q + 1] << 16);
                *(u32x4*)(ZO + drow + (size_t)cc * 1024 + t8) = o; } }
        LDS_WAIT(); asm volatile("" ::: "memory");
    }
}
__device__ __forceinline__ void finalize_h(Frame& F, int l) {
    const bf16_t* HF = WSP(bf16_t, WS_HF); const bf16_t* HB = WSP(bf16_t, WS_HB); const bf16_t* O = WSP(bf16_t, WS_O); bf16_t* Y = WSP(bf16_t, WS_Y);
    const int gw = F.bid * NWAVES + F.wave, ngw = F.G * NWAVES;
    const int ntok = (l == 0) ? NTOK : NLAT;
    float gh[8];
    const float* g_hnorm = FIN(I_GH);
#pragma unroll
    for (int q = 0; q < 8; ++q) gh[q] = g_hnorm[l * 512 + 8 * F.lane + q];
    for (int tok = gw; tok < ntok; tok += ngw) {
        const size_t o = (size_t)tok * 512 + 8 * F.lane;
        const u32x4 a = *(const u32x4*)(HF + o), b = *(const u32x4*)(HB + o), og = *(const u32x4*)(O + o);
        float h[8]; float ss = 0.f;
#pragma unroll
        for (int q = 0; q < 4; ++q) { h[2 * q] = bflo(a[q]) + bflo(b[q]); h[2 * q + 1] = bfhi(a[q]) + bfhi(b[q]); ss += h[2 * q] * h[2 * q] + h[2 * q + 1] * h[2 * q + 1]; }
#pragma unroll
        for (int s = 1; s < 16; s <<= 1) ss += __shfl_xor(ss, s);
        const float r = 1.0f / sqrtf(ss * (1.0f / 128.f) + EPS);
        u32x4 w;
#pragma unroll
        for (int q = 0; q < 4; ++q) w[q] = pk2(h[2 * q] * r * gh[2 * q] * bflo(og[q]), h[2 * q + 1] * r * gh[2 * q + 1] * bfhi(og[q]));
        *(u32x4*)(Y + (size_t)tok * KOUT + 8 * F.lane) = w;
    }
}

using pg8::Unit;
enum { GM_INPROJ = 0, GM_DFT, GM_OUT, GM_MOE1, GM_MOE2 };
struct GemmCtl {
    int mode, l, G, c; unsigned char* ws; const Args& A;
    __device__ __forceinline__ unsigned char* W() const { unsigned char* p = ws; asm volatile("" : "+s"(p)); return p; }
    __device__ __forceinline__ bool next(int i, Unit& u) const {
        const int L = i * G + c; int pm, pn;
        u.rows = nullptr; u.ex = 0;
        switch (mode) {
        case GM_INPROJ: {
            const int n0 = 64 * 11, npn = (l == 0) ? 11 : 6;
            if (L >= n0 + 8 * npn) return false;
            if (L < n0) pg8::map_tile(L, 64, 11, pm, pn); else { pg8::map_tile(L - n0, 8, npn, pm, pn); pm += 64; }
            u.A = (const char*)(W() + WS_XN) + (size_t)pm * 256 * D * 2; u.B = (const char*)(W() + WS_WIN) + ((size_t)l * NIN + pn * 256) * D * 2; u.K = D;
        } break;
        case GM_DFT: {
            const int nctx = (l == 0) ? 16 : 0;
            if (L >= 128 + nctx) return false;
            if (L < 128) { pg8::map_tile(L, 16, 8, pm, pn); u.A = (const char*)(W() + WS_FL) + (size_t)pm * 256 * 1024 * 2; u.B = (const char*)(W() + ((pm >> 3) ? WS_ZO : WS_ZT)) + (size_t)pn * 256 * 1024 * 2; u.K = 1024; }
            else { const int r = L - 128; pm = r & 1; pn = r >> 1; u.A = (const char*)(W() + WS_FC) + (size_t)pm * 256 * 1024 * 2; u.B = (const char*)(W() + WS_ZTC) + (size_t)pn * 256 * 1024 * 2; u.K = CTXL; u.ex = 1; }
        } break;
        case GM_OUT: {
            const int nM = (l == 0) ? 72 : 64;
            if (L >= nM * 4) return false;
            pg8::map_tile(L, nM, 4, pm, pn);
            u.A = (const char*)(W() + WS_Y) + (size_t)pm * 256 * KOUT * 2; u.B = (const char*)(W() + WS_WOUT) + ((size_t)l * D + pn * 256) * KOUT * 2; u.K = KOUT;
        } break;
        case GM_MOE1: {
            const int nMe = (l == 0) ? 9 : 8; int pmg;
            if (L >= NE * nMe * 8) return false;
            pg8::map_tile(L, NE * nMe, 8, pmg, pn);
            const int e = pmg / nMe; pm = pmg % nMe;
            u.A = (const char*)(W() + WS_XN); u.rows = (const int*)(W() + WS_ROWTOK) + e * RPE + pm * 256; u.B = (const char*)(W() + WS_WGU) + ((size_t)e * 2048 + pn * 256) * D * 2; u.K = D; u.ex = e;
        } break;
        default: {
            const int nMe = (l == 0) ? 9 : 8; int pmg;
            if (L >= NE * nMe * 4) return false;
            pg8::map_tile(L, NE * nMe, 4, pmg, pn);
            const int e = pmg / nMe; pm = pmg % nMe;
            u.A = (const char*)(W() + WS_HID) + ((size_t)e * RPE + pm * 256) * D * 2; u.B = (const char*)(W() + WS_WD) + ((size_t)e * D + pn * 256) * D * 2; u.K = D; u.ex = e;
        } break;
        }
        u.pm = pm; u.pn = pn;
        return true;
    }
    struct CxIn { bf16_t* dst; int ld; float sc; int act; };
    __device__ __forceinline__ CxIn prep_in(const Unit& u) const {
        CxIn c; const int pn = u.pn; c.sc = 1.f; c.act = 0; size_t off; int cb;
        if (pn < 2) { off = WS_Q; c.ld = 512; cb = pn * 256; }
        else if (pn < 4) { off = WS_K; c.ld = 512; cb = (pn - 2) * 256; c.sc = 0.08838834764831845f; }
        else if (pn < 6) { off = WS_V; c.ld = 512; cb = (pn - 4) * 256; }
        else if (pn < 8) { off = WS_O; c.ld = 512; cb = (pn - 6) * 256; c.act = 1; }
        else if (pn == 8) { off = WS_CA; c.ld = 256; cb = 0; }
        else if (pn == 9) { off = WS_CG; c.ld = 256; cb = 0; }
        else { off = WS_FR; c.ld = 256; cb = 0; }
        c.dst = (bf16_t*)(W() + off) + (size_t)u.pm * 256 * c.ld + cb;
        return c;
    }
    __device__ __forceinline__ void store_in(const CxIn& c, int r, int col, f32x4 v0, f32x4 v1) const {
        if (c.act) {
#pragma unroll
            for (int q = 0; q < 4; ++q) { v0[q] = sigmoidf_(v0[q]); v1[q] = sigmoidf_(v1[q]); }
        } else { v0 = v0 * c.sc; v1 = v1 * c.sc; }
        bf16_t* p = c.dst + (size_t)r * c.ld + col;
        *(u32x2*)p = pk4(v0); *(u32x2*)(p + 16) = pk4(v1);
    }
    struct CxDft { bf16_t* dst; const bf16_t* z1024; };
    __device__ __forceinline__ CxDft prep_dft(const Unit& u) const {
        CxDft c; int part, tokb; c.z1024 = nullptr;
        if (u.ex == 0) { part = u.pm >> 3; tokb = u.pn * SEQ + (u.pm & 7) * 256; if (part == 0) c.z1024 = (const bf16_t*)(W() + WS_FR) + (size_t)(u.pn * SEQ + 1024) * 256; }
        else { part = u.pm; tokb = NLAT + u.pn * CTXL; }
        c.dst = (bf16_t*)(W() + WS_Y) + (size_t)tokb * KOUT + 768 + part * 256; return c;
    }
    __device__ __forceinline__ void store_dft(const CxDft& c, int r, int col, f32x4 v0, f32x4 v1) const {
        if (c.z1024) { const float sg = (r & 1) ? -0.022097086912079608f : 0.022097086912079608f; const u32x2 z0 = *(const u32x2*)(c.z1024 + col), z1 = *(const u32x2*)(c.z1024 + col + 16);
            v0[0] += sg * bflo(z0.x); v0[1] += sg * bfhi(z0.x); v0[2] += sg * bflo(z0.y); v0[3] += sg * bfhi(z0.y);
            v1[0] += sg * bflo(z1.x); v1[1] += sg * bfhi(z1.x); v1[2] += sg * bflo(z1.y); v1[3] += sg * bfhi(z1.y); }
        bf16_t* p = c.dst + (size_t)r * KOUT + col;
        *(u32x2*)p = pk4(v0); *(u32x2*)(p + 16) = pk4(v1);
    }
    struct CxOut { const float* src; float* dst; const float* gt; };
    __device__ __forceinline__ CxOut prep_out(const Unit& u) const {
        CxOut c; const int tok0 = u.pm * 256, col0 = u.pn * 256;
        if (l == 0) c.src = (tok0 < NLAT ? arg_in(A, I_X) + (size_t)tok0 * D : arg_in(A, I_CTX) + (size_t)(tok0 - NLAT) * D) + col0;
        else c.src = (const float*)(W() + WS_X) + (size_t)tok0 * D + col0;
        c.dst = (float*)(W() + WS_X) + (size_t)tok0 * D + col0;
        c.gt = (const float*)(W() + WS_MOD) + ((size_t)l * 9 + mod_row(tok0)) * 6144 + 2 * 1024 + col0;
        return c;
    }
    __device__ __forceinline__ void store_out(const CxOut& c, int r, int col, f32x4 v0, f32x4 v1) const {
        const size_t o = (size_t)r * D + col;
        const f32x4 g0 = *(const f32x4*)(c.gt + col), g1 = *(const f32x4*)(c.gt + col + 16);
        const f32x4 s0 = *(const f32x4*)(c.src + o), s1 = *(const f32x4*)(c.src + o + 16);
        *(f32x4*)(c.dst + o) = s0 + g0 * v0; *(f32x4*)(c.dst + o + 16) = s1 + g1 * v1;
    }
    __device__ __forceinline__ bf16_t* prep_m1(const Unit& u) const { return (bf16_t*)(W() + WS_HID) + ((size_t)u.ex * RPE + u.pm * 256) * D + u.pn * 128; }
    __device__ __forceinline__ void store_m1(bf16_t* dst, int r, int col, f32x4 v0, f32x4 v1) const {
        f32x4 h;
#pragma unroll
        for (int q = 0; q < 4; ++q) h[q] = siluf_(v0[q]) * v1[q];
        *(u32x2*)(dst + (size_t)r * D + (col >> 5) * 16 + (col & 15)) = pk4(h);
    }
    struct CxM2 { bf16_t* dst; const float* g; };
    __device__ __forceinline__ CxM2 prep_m2(const Unit& u) const { CxM2 c; c.dst = (bf16_t*)(W() + WS_YS) + ((size_t)u.ex * RPE + u.pm * 256) * D + u.pn * 256; c.g = (const float*)(W() + WS_GATEV) + u.ex * RPE + u.pm * 256; return c; }
    __device__ __forceinline__ void store_m2(const CxM2& c, int r, int col, f32x4 v0, f32x4 v1) const {
        const float g = c.g[r];
        bf16_t* p = c.dst + (size_t)r * D + col;
        *(u32x2*)p = pk4(v0 * g); *(u32x2*)(p + 16) = pk4(v1 * g);
    }
#define EPI_WALK(PREP, STORE) do { const auto cx = PREP(u); _Pragma("unroll") for (int ai = 0; ai < 2; ++ai) _Pragma("unroll") for (int m = 0; m < 4; ++m) _Pragma("unroll") for (int bj = 0; bj < 2; ++bj) \
        STORE(cx, ai * 128 + wr * 64 + m * 16 + fr, bj * 128 + wc * 32 + 4 * fq, acc[ai][bj][m][0], acc[ai][bj][m][1]); } while (0)
    __device__ __forceinline__ void run(const f32x4 (&acc)[2][2][4][2], const Unit& u, int wr, int wc, int fr, int fq) const {
        switch (mode) {
        case GM_INPROJ: EPI_WALK(prep_in, store_in); break;
        case GM_DFT: EPI_WALK(prep_dft, store_dft); break;
        case GM_OUT: EPI_WALK(prep_out, store_out); break;
        case GM_MOE1: EPI_WALK(prep_m1, store_m1); break;
        default: EPI_WALK(prep_m2, store_m2); break;
        }
    }
    __device__ __forceinline__ void store1(const Unit& u, int r, int c, f32x4 v0, f32x4 v1) const {
        switch (mode) {
        case GM_INPROJ: store_in(prep_in(u), r, c, v0, v1); break;
        case GM_DFT: store_dft(prep_dft(u), r, c, v0, v1); break;
        case GM_OUT: store_out(prep_out(u), r, c, v0, v1); break;
        case GM_MOE1: store_m1(prep_m1(u), r, c, v0, v1); break;
        default: store_m2(prep_m2(u), r, c, v0, v1); break;
        }
    }
};

__device__ __forceinline__ void scan_simt(Frame& F, int l) {
    if (F.bid >= 64) return;
    const int b = F.bid >> 3, h = (F.bid >> 1) & 3, dir = F.bid & 1;
    LAS float* qs = (LAS float*)F.lds; LAS float* ks = qs + 64 * 132; LAS float* vs = ks + 64 * 132; LAS float* st = vs + 64 * 132;
    LAS float* sm = st + 64 * 65;
    LAS float* as_ = sm; LAS float* Ms = sm + 64; LAS float* wint = sm + 128; LAS float* enm = sm + 192; LAS float* wst = sm + 256; LAS float* denom = sm + 320;
    LAS float* nvec = sm + 384; LAS float* ig = sm + 512; LAS float* lf = sm + 576; LAS int* toks = (LAS int*)(sm + 640); LAS float* scal = sm + 704;
    const bf16_t* Q = WSP(bf16_t, WS_Q); const bf16_t* K = WSP(bf16_t, WS_K); const bf16_t* V = WSP(bf16_t, WS_V); const float* GATES = WSP(float, WS_GATES);
    bf16_t* H = dir ? WSP(bf16_t, WS_HB) : WSP(bf16_t, WS_HF);
    float Creg[32];
#pragma unroll
    for (int i = 0; i < 32; ++i) Creg[i] = 0.f;
    float m_st = 0.f;
    if (F.tid < 128) nvec[F.tid] = 0.f;
    __syncthreads();
    for (int cc = 0; cc < 36; ++cc) {
        int tid = F.tid; asm volatile("" : "+v"(tid));
        const int lane = tid & 63, e = tid >> 2, dq = tid & 3;
        const bool isctx = cc < 4;
        const int c = isctx ? (dir ? 3 - cc : cc) : (dir ? 35 - cc : cc - 4);
        const bool want_out = !(isctx && l == 1);
        if (tid < 64) { const int j = tid;
            const int tok = isctx ? NLAT + b * CTXL + c * 64 + j : (h < 2 ? b * SEQ + c * 64 + j : b * SEQ + (j & 31) * 64 + 2 * c + (j >> 5));
            toks[j] = tok; const float* g = GATES + (size_t)tok * 16 + h * 4 + 2 * dir; ig[j] = g[0]; lf[j] = logsigmoidf_(g[1]); }
        __syncthreads();
        for (int it = tid; it < 1024; it += NTHR) { const int j = it >> 4, c8 = (it & 15) * 8; const size_t o = (size_t)toks[j] * 512 + h * 128 + c8;
            const u32x4 qv = *(const u32x4*)(Q + o), kv = *(const u32x4*)(K + o), vv = *(const u32x4*)(V + o);
#pragma unroll
            for (int q = 0; q < 4; ++q) { qs[j * 132 + c8 + 2 * q] = bflo(qv[q]); qs[j * 132 + c8 + 2 * q + 1] = bfhi(qv[q]); ks[j * 132 + c8 + 2 * q] = bflo(kv[q]); ks[j * 132 + c8 + 2 * q + 1] = bfhi(kv[q]);
                vs[j * 132 + c8 + 2 * q] = bflo(vv[q]); vs[j * 132 + c8 + 2 * q + 1] = bfhi(vv[q]); } }
        if (F.wave == 0) {
            const int p = dir ? 63 - lane : lane;
            float x = lf[p];
#pragma unroll
            for (int o = 1; o < 64; o <<= 1) { const float y = __shfl_up(x, o); if (lane >= o) x += y; }
            const float a = ig[p] - x; float cm = a;
#pragma unroll
            for (int o = 1; o < 64; o <<= 1) { const float y = __shfl_up(cm, o); if (lane >= o) cm = fmaxf(cm, y); }
            const float M = fmaxf(m_st, cm), Mend = __shfl(M, 63), blast = __shfl(x, 63);
            as_[p] = a; Ms[p] = M; wint[p] = expf(m_st - M); enm[p] = expf(-(x + M)); wst[p] = expf(a - Mend);
            if (lane == 0) { scal[0] = Mend; scal[1] = blast; }
        }
        __syncthreads();
        const float Mend = scal[0], blast = scal[1], decay = expf(m_st - Mend);
        if (want_out) {
            { const int t = tid >> 3, sg = tid & 7; float sacc[8];
#pragma unroll
                for (int i = 0; i < 8; ++i) sacc[i] = 0.f;
                for (int d4 = 0; d4 < 32; ++d4) { const f32x4 q4 = *(const LAS f32x4*)(qs + t * 132 + d4 * 4);
#pragma unroll
                    for (int i = 0; i < 8; ++i) { const f32x4 k4 = *(const LAS f32x4*)(ks + (i * 8 + sg) * 132 + d4 * 4); sacc[i] += (q4[0] * k4[0] + q4[1] * k4[1]) + (q4[2] * k4[2] + q4[3] * k4[3]); } }
#pragma unroll
                for (int i = 0; i < 8; ++i) { const int s = i * 8 + sg; const bool valid = dir ? (s >= t) : (s <= t); st[t * 65 + s] = valid ? sacc[i] * expf(as_[s] - Ms[t]) : 0.f; } }
            __syncthreads();
            if (tid < 64) { const int t = tid; float qn = 0.f, ssum = 0.f;
                for (int d = 0; d < 128; ++d) qn += qs[t * 132 + d] * nvec[d];
                for (int s = 0; s < 64; ++s) ssum += st[t * 65 + s];
                const float den = wint[t] * qn + ssum; denom[t] = fmaxf(fabsf(den), enm[t]); }
            float mine[16];
#pragma unroll
            for (int tt = 0; tt < 16; ++tt) {
                mine[tt] = 0.f;
#pragma unroll
                for (int u = 0; u < 4; ++u) { const int t = 4 * tt + u; float p = 0.f;
#pragma unroll
                    for (int i4 = 0; i4 < 8; ++i4) { const f32x4 q4 = *(const LAS f32x4*)(qs + t * 132 + dq * 32 + i4 * 4); p += (Creg[4 * i4] * q4[0] + Creg[4 * i4 + 1] * q4[1]) + (Creg[4 * i4 + 2] * q4[2] + Creg[4 * i4 + 3] * q4[3]); }
                    p += __shfl_xor(p, 1); p += __shfl_xor(p, 2);
                    mine[tt] = (u == dq) ? p : mine[tt]; asm volatile("" ::: "memory"); }
            }
#pragma unroll
            for (int tt = 0; tt < 16; ++tt) { const int t = 4 * tt + dq; float intra = 0.f;
#pragma unroll 8
                for (int s = 0; s < 64; ++s) intra += st[t * 65 + s] * vs[s * 132 + e];
                mine[tt] = wint[t] * mine[tt] + intra; asm volatile("" ::: "memory"); }
            __syncthreads();
#pragma unroll
            for (int tt = 0; tt < 16; ++tt) { const int t = 4 * tt + dq; H[(size_t)toks[t] * 512 + h * 128 + e] = (bf16_t)f2bf(mine[tt] / denom[t]); }
        }
#pragma unroll
        for (int i = 0; i < 32; ++i) Creg[i] *= decay;
#pragma unroll 2
        for (int s = 0; s < 64; ++s) { const float wv = wst[s] * vs[s * 132 + e];
#pragma unroll
            for (int i4 = 0; i4 < 8; ++i4) { const f32x4 k4 = *(const LAS f32x4*)(ks + s * 132 + dq * 32 + i4 * 4); Creg[4 * i4] += wv * k4[0]; Creg[4 * i4 + 1] += wv * k4[1]; Creg[4 * i4 + 2] += wv * k4[2]; Creg[4 * i4 + 3] += wv * k4[3]; } }
        float nn = 0.f;
        if (tid < 128) { nn = decay * nvec[tid]; for (int s = 0; s < 64; ++s) nn += wst[s] * ks[s * 132 + tid]; }
        __syncthreads();
        if (tid < 128) nvec[tid] = nn;
        m_st = blast + Mend;
        __syncthreads();
    }
}

__device__ __forceinline__ int scan_tok(bool isctx, int b, int h, int c, int j) {
    return isctx ? NLAT + b * CTXL + c * 64 + j : (h < 2 ? b * SEQ + c * 64 + j : b * SEQ + (j & 31) * 64 + 2 * c + (j >> 5));
}
__device__ __forceinline__ int img256(int row, int chunk) { return row * 256 + ((chunk ^ (row & 15)) << 4); }
__device__ __forceinline__ int img128(int row, int chunk) { return row * 128 + ((chunk ^ ((row >> 1) & 7)) << 4); }
__device__ __forceinline__ int off_b(int row, int ch) { return 256 * row + 16 * (ch ^ (((row & 3) << 2) | ((row >> 2) & 3))); }
__device__ __forceinline__ int rowrd16(int lane, int rb, int ks) { return off_b((lane & 15) + 16 * rb, 4 * ks + (lane >> 4)); }
__device__ __forceinline__ int trrd16(int lane, int c, int ks, int t) { const int g = lane >> 4, q = (lane & 15) >> 2, p = lane & 3;
    return off_b(32 * ks + 8 * g + 4 * t + q, 2 * c + (p >> 1)) + 8 * (p & 1); }
typedef short s16x4 __attribute__((ext_vector_type(4)));
__device__ __forceinline__ bf16x8 tr_frag(LAS unsigned char* img, int lane, int c, int ks, unsigned zv) {
    const s16x4 lo = __builtin_amdgcn_ds_read_tr16_b64_v4i16((LAS s16x4*)(img + trrd16(lane, c, ks, 0)));
    const s16x4 hi = __builtin_amdgcn_ds_read_tr16_b64_v4i16((LAS s16x4*)(img + trrd16(lane, c, ks, 1)));
    u32x2 a = __builtin_bit_cast(u32x2, lo), b = __builtin_bit_cast(u32x2, hi);
    a.x ^= zv; a.y ^= zv; b.x ^= zv; b.y ^= zv;
    const u32x4 r = (u32x4){a.x, a.y, b.x, b.y};
    return __builtin_bit_cast(bf16x8, r);
}
__device__ __forceinline__ void scan_mfma(Frame& F, int l) {
    if (F.bid >= 64) return;
    const int b = F.bid >> 3, h = (F.bid >> 1) & 3, dir = F.bid & 1;
    LAS unsigned char* L = F.lds;
    constexpr int O_QI = 0, O_KI = 16384, O_VI = 32768, O_ST = 49152, O_CL = 57344, O_HO = 94208, O_SM = 110592;
    LAS float* GV = (LAS float*)(L + O_SM);
    LAS float* SC = GV + 36 * 192;
    LAS float* DEN = SC + 36 * 4;
    const bf16_t* Q = WSP(bf16_t, WS_Q); const bf16_t* K = WSP(bf16_t, WS_K); const bf16_t* V = WSP(bf16_t, WS_V); const float* GATES = WSP(float, WS_GATES);
    bf16_t* H = dir ? WSP(bf16_t, WS_HB) : WSP(bf16_t, WS_HF);
    const int w = F.wave;
    { unsigned z0 = 0u; asm volatile("" : "+v"(z0));
      for (int i = F.tid; i < 36864 / 16; i += NTHR) *(LAS u32x4*)(L + O_CL + i * 16) = (u32x4){z0, z0, z0, z0}; }
    for (int cc = w; cc < 36; cc += NWAVES) {
        const bool ic = cc < 4; const int c_ = ic ? (dir ? 3 - cc : cc) : (dir ? 35 - cc : cc - 4), p_ = dir ? 63 - F.lane : F.lane;
        const f32x2 g = *(const f32x2*)(GATES + (size_t)scan_tok(ic, b, h, c_, p_) * 16 + h * 4 + 2 * dir);
        float x = logsigmoidf_(g[1]);
#pragma unroll
        for (int o = 1; o < 64; o <<= 1) { const float y = __shfl_up(x, o); if (F.lane >= o) x += y; }
        const float a = g[0] - x; float cm = a;
#pragma unroll
        for (int o = 1; o < 64; o <<= 1) { const float y = __shfl_up(cm, o); if (F.lane >= o) cm = fmaxf(cm, y); }
        GV[cc * 192 + p_] = a; GV[cc * 192 + 64 + p_] = x; GV[cc * 192 + 128 + p_] = cm;
        if (F.lane == 63) { SC[cc * 4 + 3] = x; SC[cc * 4 + 1] = cm; }
    }
    __syncthreads();
    if (F.tid == 0) { float m = 0.f;
        for (int cc = 0; cc < 36; ++cc) { const float Mend = fmaxf(m, SC[cc * 4 + 1]); SC[cc * 4 + 0] = m; SC[cc * 4 + 1] = Mend; SC[cc * 4 + 2] = expf(m - Mend); m = SC[cc * 4 + 3] + Mend; } }
    f32x4 accC[9];
#pragma unroll
    for (int i = 0; i < 9; ++i) accC[i] = (f32x4){0.f, 0.f, 0.f, 0.f};
    u32x4 pq[2], pk[2], pv[2];
#define SC_LOAD(CC) do { const int cc_ = (CC); const bool ic_ = cc_ < 4; const int c_ = ic_ ? (dir ? 3 - cc_ : cc_) : (dir ? 35 - cc_ : cc_ - 4); \
        _Pragma("unroll") for (int i_ = 0; i_ < 2; ++i_) { const int it_ = tid + NTHR * i_, s_ = it_ >> 4, c8_ = it_ & 15; const size_t o_ = (size_t)scan_tok(ic_, b, h, c_, s_) * 512 + h * 128 + c8_ * 8; \
            pq[i_] = *(const u32x4*)(Q + o_); pk[i_] = *(const u32x4*)(K + o_); pv[i_] = *(const u32x4*)(V + o_); } } while (0)
#define SC_WRITE() do { _Pragma("unroll") for (int i_ = 0; i_ < 2; ++i_) { const int it_ = tid + NTHR * i_, s_ = it_ >> 4, c8_ = it_ & 15; \
            *(LAS u32x4*)(L + O_QI + img256(s_, c8_)) = pq[i_]; *(LAS u32x4*)(L + O_KI + off_b(s_, c8_)) = pk[i_]; *(LAS u32x4*)(L + O_VI + off_b(s_, c8_)) = pv[i_]; } } while (0)
#define SC_MFMA(A, B, C) __builtin_amdgcn_mfma_f32_16x16x32_bf16((A), (B), (C), 0, 0, 0)
#define SC_BAR() do { asm volatile("s_waitcnt lgkmcnt(0)" ::: "memory"); __builtin_amdgcn_s_barrier(); asm volatile("" ::: "memory"); } while (0)
    {
        const int tid = F.tid;
        SC_LOAD(0);
        __syncthreads();
        SC_WRITE();
        __syncthreads();
    }
    for (int cc = 0; cc < 36; ++cc) {
        int tid = F.tid; asm volatile("" : "+v"(tid));
        const int lane = tid & 63, fr = lane & 15, fq = lane >> 4;
        const bool isctx = cc < 4, want_out = !(isctx && l == 1), more = cc + 1 < 36;
        const int c = isctx ? (dir ? 3 - cc : cc) : (dir ? 35 - cc : cc - 4);
        const LAS float* vb = GV + cc * 192; const float m_in = SC[cc * 4 + 0];
        unsigned zv = 0u; asm volatile("" : "+v"(zv));
        const short one_ = (fr == 0) ? (short)0x3F80 : (short)0;
        const bf16x8 ONES = (bf16x8){one_, one_, one_, one_, one_, one_, one_, one_};
        if (more) SC_LOAD(cc + 1);
        if (want_out) {
            const int tb = w >> 1, sb = 2 * (w & 1);
            f32x4 s0 = (f32x4){0.f, 0.f, 0.f, 0.f}, s1 = s0;
#pragma unroll
            for (int ks = 0; ks < 4; ++ks) {
                const bf16x8 fy = *(const LAS bf16x8*)(L + O_QI + img256(tb * 16 + fr, ks * 4 + fq));
                const bf16x8 fx0 = *(const LAS bf16x8*)(L + O_KI + rowrd16(lane, sb, ks)), fx1 = *(const LAS bf16x8*)(L + O_KI + rowrd16(lane, sb + 1, ks));
                s0 = SC_MFMA(fx0, fy, s0); s1 = SC_MFMA(fx1, fy, s1); }
            const int t = tb * 16 + fr; const float Mt = fmaxf(m_in, vb[128 + t]);
#pragma unroll
            for (int i = 0; i < 2; ++i) { const int sr0 = (sb + i) * 16 + 4 * fq; const f32x4 a4 = *(const LAS f32x4*)(vb + sr0); const f32x4 sv = i ? s1 : s0; f32x4 o;
#pragma unroll
                for (int r = 0; r < 4; ++r) { const int sI = sr0 + r; const bool valid = dir ? (sI >= t) : (sI <= t); o[r] = valid ? sv[r] * __expf(a4[r] - Mt) : 0.f; }
                *(LAS u32x2*)(L + O_ST + img128(t, sr0 >> 3) + (sr0 & 7) * 2) = pk4(o); }
        }
        SC_BAR();
        {
            const float decay = SC[cc * 4 + 2], Mend = SC[cc * 4 + 1];
#pragma unroll
            for (int et = 0; et < 9; ++et) accC[et] = accC[et] * decay;
#pragma unroll
            for (int ks = 0; ks < 2; ++ks) {
                const bf16x8 kx = tr_frag(L + O_KI, lane, w, ks, zv);
                const f32x4 a0 = *(const LAS f32x4*)(vb + 32 * ks + 8 * fq), a1 = *(const LAS f32x4*)(vb + 32 * ks + 8 * fq + 4);
                u32x4 ax;
#pragma unroll
                for (int j = 0; j < 4; ++j) { const float w0 = __expf((j < 2 ? a0[2 * j] : a1[2 * j - 4]) - Mend), w1 = __expf((j < 2 ? a0[2 * j + 1] : a1[2 * j - 3]) - Mend);
                    ax[j] = pk2(bf2f((unsigned short)kx[2 * j]) * w0, bf2f((unsigned short)kx[2 * j + 1]) * w1); }
                const bf16x8 axf = __builtin_bit_cast(bf16x8, ax);
#pragma unroll
                for (int et = 0; et < 8; ++et) { const bf16x8 fv = tr_frag(L + O_VI, lane, et, ks, zv); accC[et] = SC_MFMA(axf, fv, accC[et]); }
                accC[8] = SC_MFMA(axf, ONES, accC[8]);
            }
        }
        f32x4 num[4];
        if (want_out) {
            bf16x8 ac[4], av[2];
#pragma unroll
            for (int ks = 0; ks < 4; ++ks) ac[ks] = *(const LAS bf16x8*)(L + O_CL + img256(w * 16 + fr, ks * 4 + fq));
#pragma unroll
            for (int ks = 0; ks < 2; ++ks) av[ks] = tr_frag(L + O_VI, lane, w, ks, zv);
#pragma unroll
            for (int tb = 0; tb < 4; ++tb) {
                f32x4 nI = (f32x4){0.f, 0.f, 0.f, 0.f}, nS = nI;
#pragma unroll
                for (int ks = 0; ks < 4; ++ks) { const bf16x8 fy = *(const LAS bf16x8*)(L + O_QI + img256(tb * 16 + fr, ks * 4 + fq)); nI = SC_MFMA(ac[ks], fy, nI); }
#pragma unroll
                for (int ks = 0; ks < 2; ++ks) { const bf16x8 fs = *(const LAS bf16x8*)(L + O_ST + img128(tb * 16 + fr, ks * 4 + fq)); nS = SC_MFMA(av[ks], fs, nS); }
                num[tb] = nI * __expf(m_in - fmaxf(m_in, vb[128 + tb * 16 + fr])) + nS;
            }
            if (w < 4) {
                f32x4 dI = (f32x4){0.f, 0.f, 0.f, 0.f}, dS = dI;
#pragma unroll
                for (int ks = 0; ks < 4; ++ks) { const bf16x8 a8 = *(const LAS bf16x8*)(L + O_CL + img256(128 + fr, ks * 4 + fq)); const bf16x8 fy = *(const LAS bf16x8*)(L + O_QI + img256(w * 16 + fr, ks * 4 + fq)); dI = SC_MFMA(a8, fy, dI); }
#pragma unroll
                for (int ks = 0; ks < 2; ++ks) { const bf16x8 fs = *(const LAS bf16x8*)(L + O_ST + img128(w * 16 + fr, ks * 4 + fq)); dS = SC_MFMA(ONES, fs, dS); }
                const int t = w * 16 + fr; const float Mt = fmaxf(m_in, vb[128 + t]); const float den = __expf(m_in - Mt) * dI[0] + dS[0];
                if (lane < 16) DEN[t] = fmaxf(fabsf(den), __expf(-(vb[64 + t] + Mt)));
            }
        }
        SC_BAR();
        if (want_out) {
#pragma unroll
            for (int tb = 0; tb < 4; ++tb) { const int t = tb * 16 + fr, e0 = w * 16 + 4 * fq; const float rd = 1.0f / DEN[t];
                *(LAS u32x2*)(L + O_HO + img256(t, e0 >> 3) + (e0 & 7) * 2) = pk4(num[tb] * rd); }
        }
#pragma unroll
        for (int et = 0; et < 9; ++et) { const int d0 = w * 16 + 4 * fq; *(LAS u32x2*)(L + O_CL + img256(et * 16 + fr, d0 >> 3) + (d0 & 7) * 2) = pk4(accC[et]); }
        if (more) SC_WRITE();
        SC_BAR();
        if (want_out) {
            const int t = tid >> 3; bf16_t* hp = H + (size_t)scan_tok(isctx, b, h, c, t) * 512 + h * 128;
#pragma unroll
            for (int i = 0; i < 2; ++i) { const int ch = (tid & 7) * 2 + i; *(u32x4*)(hp + ch * 8) = *(const LAS u32x4*)(L + O_HO + img256(t, ch)); }
        }
    }
#undef SC_LOAD
#undef SC_WRITE
#undef SC_MFMA
#undef SC_BAR
}

__device__ __forceinline__ void helper_barrier(Frame& F, unsigned* cnt, unsigned nhelpers) {
    asm volatile("s_waitcnt vmcnt(0)" ::: "memory");
    __syncthreads();
    if (F.tid == 0) {
        __builtin_amdgcn_fence(__ATOMIC_RELEASE, "agent");
        asm volatile("s_waitcnt vmcnt(0)" ::: "memory");
        __hip_atomic_fetch_add(cnt, 1u, __ATOMIC_RELAXED, __HIP_MEMORY_SCOPE_AGENT);
        unsigned sp = 0;
        while (__hip_atomic_load(cnt, __ATOMIC_RELAXED, __HIP_MEMORY_SCOPE_AGENT) < nhelpers) { __builtin_amdgcn_s_sleep(2); if (++sp > (1u << 22)) break; }
        __builtin_amdgcn_fence(__ATOMIC_ACQUIRE, "agent");
        asm volatile("s_waitcnt vmcnt(0)" ::: "memory");
    }
    __syncthreads();
}

constexpr int NPHASES = 20;
enum { K_PREP = 0, K_NORM1, K_INPROJ, K_MIX1, K_MIX2, K_OUTPROJ, K_NORM2, K_TOPK, K_MOE1, K_MOE2, K_COMBINE };

__global__ void __launch_bounds__(NTHR, 2) fwd_kernel(Args args) {
    extern __shared__ __attribute__((aligned(16))) unsigned char lds_raw[];
    Frame F{(LAS unsigned char*)lds_raw, (int)threadIdx.x, (int)(threadIdx.x & 63), __builtin_amdgcn_readfirstlane((int)(threadIdx.x >> 6)), (int)gridDim.x, (int)blockIdx.x, args.ws, args};
    volatile LAS unsigned* MISC = (volatile LAS unsigned*)(F.lds + LDSCTL_OFF);
    if (F.tid < 16) MISC[F.tid] = 0u;
    __syncthreads();
    XcdBarrier bar; bar.bar = (unsigned*)(F.ws + WS_CTL); bar.x = 0; bar.st = MISC;
    const int lo = args.ph_lo, hi = args.ph_hi;
    if (hi - lo > 1) bar = xcd_barrier_post((unsigned*)(F.ws + WS_CTL), MISC);
    for (int ph = lo; ph < hi; ++ph) {
        int l, kind;
        if (ph == 0) { l = 0; kind = K_PREP; } else if (ph == 1) { l = 0; kind = K_NORM1; } else if (ph < 11) { l = 0; kind = K_INPROJ + (ph - 2); } else { l = 1; kind = K_INPROJ + (ph - 11); }
#ifndef PHMASK
#define PHMASK 0xFFFF
#endif
#define PHON(k) ((PHMASK >> (k)) & 1)
#ifndef REPMASK
#define REPMASK 0
#endif
        int nrep_ = 1 + ((REPMASK >> kind) & 1); asm volatile("" : "+s"(nrep_));
        for (int rep_ = 0; rep_ < nrep_; ++rep_) {
        if (rep_) xcd_barrier(bar);
        { int t_ = threadIdx.x, b_ = blockIdx.x; unsigned char* w_ = args.ws; asm volatile("" : "+v"(t_)); asm volatile("" : "+s"(b_)); asm volatile("" : "+s"(w_));
          F.tid = t_; F.lane = t_ & 63; F.wave = __builtin_amdgcn_readfirstlane(t_ >> 6); F.bid = b_; F.ws = w_; }
        l = __builtin_amdgcn_readfirstlane(l); kind = __builtin_amdgcn_readfirstlane(kind); asm volatile("" : "+s"(l)); asm volatile("" : "+s"(kind));
        unsigned char* ws = F.ws;
        bool run_gemm = (kind == K_INPROJ || kind == K_OUTPROJ || kind == K_MOE1 || kind == K_MOE2);
        int gm = kind == K_INPROJ ? GM_INPROJ : kind == K_OUTPROJ ? GM_OUT : kind == K_MOE1 ? GM_MOE1 : GM_MOE2, gc = F.bid, gG = F.G;
        const bool helper = (kind == K_MIX1) && (F.bid >= 64);
        switch (kind) {
        case K_PREP: if (PHON(0)) phase_prep(F); break;
        case K_NORM1: if (PHON(1)) phase_norm1_l0(F); break;
        case K_MIX1: if (PHON(3)) {
            if (!helper) scan_mfma(F, l);
            else { const int hb = F.bid - 64, hg = F.G - 64;
                conv_items(F, l, hb, hg);
                ztrans_items(F, l, hb * NWAVES + F.wave, hg * NWAVES);
                helper_barrier(F, (unsigned*)(ws + WS_CTL) + 8192 + 64 * l + 64 * 2 * rep_, (unsigned)hg);
                run_gemm = true; gm = GM_DFT; gc = hb; gG = hg; }
        } break;
        case K_MIX2: if (PHON(4)) finalize_h(F, l); break;
        case K_NORM2: if (PHON(6)) phase_norm2(F, l); break;
        case K_TOPK: if (PHON(7)) phase_topk(F, l); break;
        case K_COMBINE: if (PHON(10)) phase_combine(F, l); break;
        default: break;
        }
        if (run_gemm && PHON(2)) {
            GemmCtl S{gm, l, gG, gc, ws, F.A};
            const int ld = gm == GM_OUT ? KOUT : D;
            GEMM_PHASE(F.lds, ld, ld, S, S);
        }
        if (helper && PHON(3)) convert_moe_weights(F, l, (F.bid - 64) * NWAVES + F.wave, (F.G - 64) * NWAVES);
        }
        if (ph + 1 < hi) xcd_barrier(bar);
    }
}

extern "C" void kernel_launch(void* const* d_in, const int* in_sizes, int n_in, void* d_out, int out_size, void* d_ws, size_t ws_size, hipStream_t stream) {
    static int grid = 0;
    if (grid == 0) {
        if (n_in != 21 || out_size != NLAT * D || ws_size < WS_END) { fprintf(stderr, "kernel_launch: unexpected shapes (n_in %d out %d ws %zu need %zu)\n", n_in, out_size, ws_size, (size_t)WS_END); grid = -1; return; }
        int dev = 0, cus = 0, per_cu = 0;
        hipGetDevice(&dev); hipDeviceGetAttribute(&cus, hipDeviceAttributeMultiprocessorCount, dev);
        if (hipFuncSetAttribute((const void*)fwd_kernel, hipFuncAttributeMaxDynamicSharedMemorySize, LDS_BYTES) != hipSuccess) { fprintf(stderr, "kernel_launch: hipFuncSetAttribute failed\n"); grid = -1; return; }
        hipOccupancyMaxActiveBlocksPerMultiprocessor(&per_cu, (const void*)fwd_kernel, NTHR, LDS_BYTES);
        (void)hipGetLastError();
        if (per_cu < 1) fprintf(stderr, "kernel_launch: occupancy query reports %d\n", per_cu);
        grid = cus;
    }
    if (grid < 0) return;
    hipMemsetAsync((char*)d_ws + WS_CTL, 0, 65536, stream);
    Args a{};
    for (int i = 0; i < 21; ++i) a.in[i] = (const float*)d_in[i];
    a.out = (float*)d_out; a.ws = (unsigned char*)d_ws;
#if N_LAUNCHES == 1
    a.ph_lo = 0; a.ph_hi = NPHASES;
    void* kargs[] = {&a};
    hipError_t e = hipLaunchCooperativeKernel((const void*)fwd_kernel, dim3(grid), dim3(NTHR), kargs, LDS_BYTES, stream);
    if (e != hipSuccess) fprintf(stderr, "kernel_launch: cooperative launch failed: %s (grid %d)\n", hipGetErrorString(e), grid);
#else
#ifndef MAXPH
#define MAXPH NPHASES
#endif
    for (int ph = 0; ph < MAXPH; ++ph) { a.ph_lo = ph; a.ph_hi = ph + 1; hipLaunchKernelGGL(fwd_kernel, dim3(grid), dim3(NTHR), LDS_BYTES, stream, a); }
#endif
}
```

```cpp
#include <hip/hip_runtime.h>
#include <cstdio>
#include <cstdint>

#ifndef N_LAUNCHES
#define N_LAUNCHES 1
#endif
#ifndef USE_MFMA_GEMM
#define USE_MFMA_GEMM 1
#endif

#define LAS __attribute__((address_space(3)))
#define GAS __attribute__((address_space(1)))
typedef unsigned short bf16_t;
typedef short bf16x8 __attribute__((ext_vector_type(8)));
typedef float f32x4 __attribute__((ext_vector_type(4)));
typedef float f32x2 __attribute__((ext_vector_type(2)));
typedef unsigned u32x4 __attribute__((ext_vector_type(4)));
typedef unsigned u32x2 __attribute__((ext_vector_type(2)));
typedef GAS unsigned gu32;
#define RLX_AGENT __ATOMIC_RELAXED, __HIP_MEMORY_SCOPE_AGENT
#define LDS_WAIT() asm volatile("s_waitcnt lgkmcnt(0)" ::: "memory")
#define VM_WAIT() asm volatile("s_waitcnt vmcnt(0)" ::: "memory")

constexpr int D = 1024, NB = 8, SEQ = 2048, CTXL = 256;
constexpr int NLAT = NB * SEQ, NCTX = NB * CTXL, NTOK = NLAT + NCTX;
constexpr int INC = 2832, NIN = 2816;
constexpr int KOUT = 1280;
constexpr int NE = 16, RPE = 2304;
constexpr float EPS = 1e-6f;
constexpr int NTHR = 512, NWAVES = 8;

constexpr size_t al256(size_t x) { return (x + 255) & ~(size_t)255; }
constexpr size_t WS_CTL = 0;
constexpr size_t WS_MOD = WS_CTL + 65536;
constexpr size_t WS_WIN = WS_MOD + al256((size_t)2 * 9 * 6144 * 4);
constexpr size_t WS_WOUT = WS_WIN + (size_t)2 * NIN * D * 2;
constexpr size_t WS_WGU = WS_WOUT + (size_t)2 * D * KOUT * 2;
constexpr size_t WS_WD = WS_WGU + (size_t)NE * 2048 * D * 2;
constexpr size_t WS_FL = WS_WD + (size_t)NE * D * D * 2;
constexpr size_t WS_FC = WS_FL + (size_t)4096 * 1024 * 2;
constexpr size_t WS_X = WS_FL + (size_t)4096 * 2048 * 2 + (size_t)512 * 2048 * 2;
constexpr size_t WS_XN = WS_X + (size_t)NTOK * D * 4;
constexpr size_t WS_GATES = WS_XN + (size_t)NTOK * D * 2;
constexpr size_t WS_AFF = WS_GATES + (size_t)NTOK * 16 * 4;
constexpr size_t WS_INV = WS_AFF + (size_t)NTOK * 16 * 4;
constexpr size_t WS_ROWTOK = WS_INV + (size_t)NTOK * 16 * 4;
constexpr size_t WS_GATEV = WS_ROWTOK + (size_t)NE * RPE * 4;
constexpr size_t WS_R1 = WS_GATEV + (size_t)NE * RPE * 4;
constexpr size_t SZ_QKV = (size_t)NTOK * 512 * 2;
constexpr size_t WS_Q = WS_R1, WS_K = WS_Q + SZ_QKV, WS_V = WS_K + SZ_QKV, WS_O = WS_V + SZ_QKV;
constexpr size_t WS_HID = WS_R1;
constexpr size_t WS_R2 = WS_R1 + 4 * SZ_QKV;
constexpr size_t SZ_C = (size_t)NTOK * 256 * 2;
constexpr size_t WS_CA = WS_R2, WS_CG = WS_CA + SZ_C, WS_FR = WS_CG + SZ_C, WS_ZT = WS_FR + SZ_C;
constexpr size_t WS_ZO = WS_ZT + (size_t)2048 * 1024 * 2;
constexpr size_t WS_ZTC = WS_ZT + (size_t)2048 * 2048 * 2;
constexpr size_t WS_HF = WS_ZT + 2 * (size_t)2048 * 2048 * 2, WS_HB = WS_HF + SZ_QKV, WS_Y = WS_HB + SZ_QKV;
constexpr size_t WS_YS = WS_R2;
constexpr size_t WS_END = WS_Y + (size_t)NTOK * KOUT * 2;
static_assert((size_t)NE * RPE * D * 2 <= 4 * SZ_QKV, "HID alias");
static_assert(WS_YS + (size_t)NE * RPE * D * 2 <= WS_END, "YS alias");

constexpr int RING_BYTES = 139264;
constexpr int LDSCTL_OFF = RING_BYTES;
constexpr int LDS_BYTES = RING_BYTES + 1024;

__device__ __forceinline__ unsigned f2bf(float f) { unsigned u = __float_as_uint(f); u += 0x7FFFu + ((u >> 16) & 1u); return u >> 16; }
typedef __bf16 bf16x2_t __attribute__((ext_vector_type(2)));
__device__ __forceinline__ unsigned pk2(float lo, float hi) { const bf16x2_t r = __builtin_convertvector((f32x2){lo, hi}, bf16x2_t); return __builtin_bit_cast(unsigned, r); }
__device__ __forceinline__ float bf2f(unsigned b) { return __uint_as_float(b << 16); }
__device__ __forceinline__ float bflo(unsigned w) { return __uint_as_float(w << 16); }
__device__ __forceinline__ float bfhi(unsigned w) { return __uint_as_float(w & 0xffff0000u); }
__device__ __forceinline__ float sigmoidf_(float x) { return __builtin_amdgcn_rcpf(1.0f + __expf(-x)); }
__device__ __forceinline__ float siluf_(float x) { return x * __builtin_amdgcn_rcpf(1.0f + __expf(-x)); }
__device__ __forceinline__ float logsigmoidf_(float x) { return x >= 0.f ? -log1pf(expf(-x)) : x - log1pf(expf(x)); }
__device__ __forceinline__ float wave_sum(float v) {
#pragma unroll
    for (int o = 1; o < 64; o <<= 1) v += __shfl_xor(v, o);
    return v;
}
__device__ __forceinline__ u32x2 pk4(f32x4 v) { u32x2 w; w.x = pk2(v[0], v[1]); w.y = pk2(v[2], v[3]); return w; }

#define XB_TMO      128
#define XB_XCNT(j)  (256  + 64 * (j))
#define XB_XSUB(j)  (1280 + 64 * (j))
#define XB_XGEN(j)  (2304 + 64 * (j))
#define XB_TOP      3328
#define XB_TOPGEN   3392
#define XCD_BAR_WORDS 3456
#define XB_SPIN_CAP (1u << 22)
__device__ __forceinline__ unsigned xb_ld(unsigned* p)              { return __hip_atomic_load(p, __ATOMIC_RELAXED, __HIP_MEMORY_SCOPE_AGENT); }
__device__ __forceinline__ unsigned xb_add(unsigned* p, unsigned v) { return __hip_atomic_fetch_add(p, v, __ATOMIC_RELAXED, __HIP_MEMORY_SCOPE_AGENT); }
__device__ __forceinline__ unsigned xb_xcc_id() { return (unsigned)__builtin_amdgcn_s_getreg((3 << 11) | 20) & 0xFu; }
#define XB_SPIN(cond, bar) do { unsigned _sp = 0; while (cond) { __builtin_amdgcn_s_sleep(1); \
    if ((++_sp & 255u) == 0u) { if (xb_ld(&(bar)[XB_TMO])) break; if (_sp > XB_SPIN_CAP) { atomicAdd(&(bar)[XB_TMO], 1u); break; } } } } while (0)
struct XcdBarrier { unsigned* bar; unsigned x; volatile LAS unsigned* st; };
__device__ __forceinline__ XcdBarrier xcd_barrier_post(unsigned* bar, volatile LAS unsigned* st) {
    XcdBarrier b; b.bar = bar; b.x = xb_xcc_id(); b.st = st;
    if (threadIdx.x == 0) (void)xb_add(&bar[XB_XCNT(b.x)], 1u);
    return b;
}
__device__ __forceinline__ void xcd_barrier_complete(unsigned* bar, unsigned x, unsigned& nloc, unsigned& nx) {
    const unsigned G = gridDim.x * gridDim.y * gridDim.z;
    unsigned sum, cnt, mine, sp = 0u;
    for (;;) {
        sum = 0u; cnt = 0u; mine = 0u;
#pragma unroll
        for (unsigned j = 0; j < 16; ++j) { const unsigned c = xb_ld(&bar[XB_XCNT(j)]); sum += c; cnt += (c > 0u) ? 1u : 0u; mine = (j == x) ? c : mine; }
        if (sum == G) break;
        __builtin_amdgcn_s_sleep(1);
        if ((++sp & 255u) == 0u) { if (xb_ld(&bar[XB_TMO])) break; if (sp > XB_SPIN_CAP) { atomicAdd(&bar[XB_TMO], 1u); break; } }
    }
    nloc = mine > 0u ? mine : 1u; nx = cnt > 0u ? cnt : 1u;
}
__device__ __forceinline__ void xcd_barrier(const XcdBarrier& b) {
    asm volatile("s_waitcnt vmcnt(0)" ::: "memory");
    __syncthreads();
    if (threadIdx.x == 0) {
        unsigned* bar = b.bar;
        __builtin_amdgcn_s_waitcnt(0);
        unsigned nloc = b.st[0], nx = b.st[1];
        if (nloc == 0u) { xcd_barrier_complete(bar, b.x, nloc, nx); b.st[0] = nloc; b.st[1] = nx; }
        const unsigned old = xb_add(&bar[XB_XSUB(b.x)], 1u);
        const unsigned gen = old / nloc;
        if (old + 1u == (gen + 1u) * nloc) {
            __builtin_amdgcn_fence(__ATOMIC_RELEASE, "agent");
            asm volatile("s_waitcnt vmcnt(0)" ::: "memory");
            const unsigned og = xb_add(&bar[XB_TOP], 1u);
            const unsigned tg = og / nx;
            if (og + 1u == (tg + 1u) * nx) xb_add(&bar[XB_TOPGEN], 1u);
            else XB_SPIN(xb_ld(&bar[XB_TOPGEN]) == tg, bar);
            __builtin_amdgcn_fence(__ATOMIC_ACQUIRE, "agent");
            xb_add(&bar[XB_XGEN(b.x)], 1u);
            asm volatile("s_waitcnt vmcnt(0)" ::: "memory");
        } else {
            XB_SPIN(xb_ld(&bar[XB_XGEN(b.x)]) == gen, bar);
            __builtin_amdgcn_fence(__ATOMIC_ACQUIRE, "agent");
            asm volatile("s_waitcnt vmcnt(0)" ::: "memory");
        }
    }
    __syncthreads();
}

namespace pg8 {
constexpr int BM = 256, BK = 64, HALF = 128, HTB = HALF * BK * 2, STAGE_BYTES = 8 * HTB, NXCD = 8, WGM = 8;
__host__ __device__ __forceinline__ int lds_byte(int r, int c) { const int st = (r >> 4) * 2 + (c >> 5), rr = r & 15, cc = c & 31, ob = rr * 64 + cc * 2; return st * 1024 + (ob ^ (((ob >> 9) & 1) << 5)); }
__host__ __device__ __forceinline__ void stage_rc(int b, int& R, int& C) { const int st = b / 1024, sb = b % 1024, swz = sb ^ (((sb >> 9) & 1) << 5); R = (st >> 1) * 16 + swz / 64; C = (st & 1) * 32 + (swz % 64) / 2; }

struct Unit { const char* A; const char* B; const int* rows; int K, pm, pn, ex; };

__device__ __forceinline__ void map_tile(int L, int nM, int nN, int& pm, int& pn) {
    const int nwg = nM * nN; int wgid = L;
    { const int q = nwg / NXCD, r = nwg % NXCD, xcd = wgid % NXCD, off = wgid / NXCD; wgid = (xcd < r ? xcd * (q + 1) : r * (q + 1) + (xcd - r) * q) + off; }
    const int nig = WGM * nN, gid = wgid / nig, fm = gid * WGM, gsz = (nM - fm) < WGM ? (nM - fm) : WGM;
    pm = fm + ((wgid % nig) % gsz); pn = (wgid % nig) / gsz;
}
__device__ __forceinline__ void a_offs(const Unit& u, int lda, int tid, unsigned (&vA)[2][2]) {
#pragma unroll
    for (int h = 0; h < 2; ++h)
#pragma unroll
        for (int i = 0; i < 2; ++i) { int R, C; stage_rc(tid * 16 + i * 8192, R, C); const int r = h * HALF + R; const int ar = u.rows ? u.rows[r] : r; vA[h][i] = (unsigned)(ar * lda + C) * 2u; }
}

template <class Epi, class Sched>
__device__ __forceinline__ void gemm_phase(LAS unsigned char* lds, const int tid, const int lda, const int ldb, const Sched& S, const Epi& E) {
    const int wid = __builtin_amdgcn_readfirstlane(tid >> 6), lane = tid & 63, wr = wid >> 2, wc = wid & 3, fr = lane & 15, fq = lane >> 4;
    unsigned voffB[2];
#pragma unroll
    for (int i = 0; i < 2; ++i) { int R, C; stage_rc(tid * 16 + i * 8192, R, C); voffB[i] = (unsigned)(R * ldb + C) * 2u; }
    const size_t kstep = (size_t)(BK * 2);
    const size_t hsB = (size_t)HALF * ldb * 2;
    const unsigned ldsw = (unsigned)wid * 1024u;
    const int aoff = lds_byte(wr * 64 + fr, fq * 8), boff = lds_byte(wc * 32 + fr, fq * 8);
#define PG8_SA(b, h) (((b) * 2 + (h)) * HTB)
#define PG8_SB(b, h) ((4 + (b) * 2 + (h)) * HTB)
#define PG8_STAGE(bufoff, gbase, voff) do { _Pragma("unroll") for (int _i = 0; _i < 2; ++_i) \
        __builtin_amdgcn_global_load_lds((const unsigned*)((const char*)(gbase) + (voff)[_i]), (LAS unsigned*)(lds + (bufoff) + ldsw + _i * 8192), 16, 0, 0); } while (0)
#define PG8_LDA(dst, b, h) do { _Pragma("unroll") for (int m = 0; m < 4; ++m) _Pragma("unroll") for (int k = 0; k < 2; ++k) dst[m][k] = *(const LAS bf16x8*)(lds + PG8_SA(b, h) + aoff + m * 2048 + k * 1024); } while (0)
#define PG8_LDB(dst, b, h) do { _Pragma("unroll") for (int n = 0; n < 2; ++n) _Pragma("unroll") for (int k = 0; k < 2; ++k) dst[n][k] = *(const LAS bf16x8*)(lds + PG8_SB(b, h) + boff + n * 2048 + k * 1024); } while (0)
#define PG8_MMA(ai, bj, At, Bt) do { __builtin_amdgcn_s_setprio(1); _Pragma("unroll") for (int m = 0; m < 4; ++m) _Pragma("unroll") for (int n = 0; n < 2; ++n) _Pragma("unroll") for (int k = 0; k < 2; ++k) \
        acc[ai][bj][m][n] = __builtin_amdgcn_mfma_f32_16x16x32_bf16(Bt[n][k], At[m][k], acc[ai][bj][m][n], 0, 0, 0); __builtin_amdgcn_s_setprio(0); } while (0)
#define PG8_WAIT_V(n) asm volatile("s_waitcnt vmcnt(" #n ")" ::: "memory")
#define PG8_WAIT_L(n) asm volatile("s_waitcnt lgkmcnt(" #n ")" ::: "memory")
#define PG8_BAR __builtin_amdgcn_s_barrier()
#define PG8_SCHED __builtin_amdgcn_sched_barrier(0)
    Unit cur, nxt; int ui = 0;
    if (!S.next(0, cur)) return;
    f32x4 acc[2][2][4][2];
#pragma unroll
    for (int a = 0; a < 2; ++a)
#pragma unroll
        for (int b = 0; b < 2; ++b)
#pragma unroll
            for (int m = 0; m < 4; ++m)
#pragma unroll
                for (int n = 0; n < 2; ++n) acc[a][b][m][n] = (f32x4){0.f, 0.f, 0.f, 0.f};
    bf16x8 At[4][2], B0[2][2], B1[2][2];
    unsigned vA[2][2], wA[2][2];
    a_offs(cur, lda, tid, vA);
    const char* cA = cur.A; const char* cB = cur.B;
    PG8_STAGE(PG8_SB(0, 0), cB, voffB); PG8_STAGE(PG8_SB(0, 1), cB + hsB, voffB); PG8_STAGE(PG8_SA(0, 0), cA, vA[0]); PG8_STAGE(PG8_SA(0, 1), cA, vA[1]);
    if (wr == 1) PG8_BAR;
    PG8_WAIT_V(2); PG8_BAR;
    PG8_STAGE(PG8_SB(1, 0), cB + kstep, voffB); PG8_STAGE(PG8_SA(1, 0), cA + kstep, vA[0]); PG8_STAGE(PG8_SB(1, 1), cB + hsB + kstep, voffB);
    PG8_WAIT_V(6); PG8_BAR;
    for (;;) {
        const bool has_next = S.next(ui + 1, nxt);
        if (!has_next) nxt = cur;
        const char* nA = nxt.A; const char* nB = nxt.B;
        a_offs(nxt, lda, tid, wA);
        const int nt = cur.K / BK;
        asm volatile(".p2align 8" ::: "memory");
        for (int t = 0; t < nt; t += 2) {
            const bool last = (t == nt - 2);
            const char* a1 = cA + (size_t)(t + 1) * kstep;
            const char* a2 = last ? nA : cA + (size_t)(t + 2) * kstep; const char* b2 = last ? nB : cB + (size_t)(t + 2) * kstep;
            const char* a3 = a2 + kstep; const char* b3 = b2 + kstep;
            PG8_LDB(B0, 0, 0); PG8_LDB(B1, 0, 1); PG8_SCHED; PG8_LDA(At, 0, 0); PG8_STAGE(PG8_SA(1, 1), a1, vA[1]);
            if (last) {
#pragma unroll
                for (int h = 0; h < 2; ++h)
#pragma unroll
                    for (int i = 0; i < 2; ++i) vA[h][i] = wA[h][i];
            }
            PG8_WAIT_V(8); PG8_WAIT_L(0); PG8_BAR; PG8_MMA(0, 0, At, B0); PG8_MMA(0, 1, At, B1); PG8_BAR; PG8_SCHED;
            PG8_LDA(At, 0, 1); PG8_STAGE(PG8_SB(0, 0), b2, voffB); PG8_STAGE(PG8_SB(0, 1), b2 + hsB, voffB); PG8_STAGE(PG8_SA(0, 0), a2, vA[0]);
            PG8_WAIT_V(8); PG8_WAIT_L(0); PG8_BAR; PG8_MMA(1, 0, At, B0); PG8_MMA(1, 1, At, B1); PG8_BAR; PG8_SCHED;
            PG8_LDB(B0, 1, 0); PG8_LDB(B1, 1, 1); PG8_SCHED; PG8_LDA(At, 1, 0); PG8_STAGE(PG8_SA(0, 1), a2, vA[1]);
            PG8_WAIT_V(8); PG8_WAIT_L(0); PG8_BAR; PG8_MMA(0, 0, At, B0); PG8_MMA(0, 1, At, B1); PG8_BAR; PG8_SCHED;
            PG8_LDA(At, 1, 1); PG8_STAGE(PG8_SB(1, 0), b3, voffB); PG8_STAGE(PG8_SB(1, 1), b3 + hsB, voffB); PG8_STAGE(PG8_SA(1, 0), a3, vA[0]);
            PG8_WAIT_V(8); PG8_WAIT_L(0); PG8_BAR; PG8_MMA(1, 0, At, B0); PG8_MMA(1, 1, At, B1); PG8_BAR; PG8_SCHED;
        }
        if (wr == 0) PG8_BAR;
        { int fr_ = fr, fq_ = fq; asm volatile("" : "+v"(fr_), "+v"(fq_));
          E.run(acc, cur, wr, wc, fr_, fq_); }
        if (!has_next) break;
#pragma unroll
        for (int a = 0; a < 2; ++a)
#pragma unroll
            for (int b = 0; b < 2; ++b)
#pragma unroll
                for (int m = 0; m < 4; ++m)
#pragma unroll
                    for (int n = 0; n < 2; ++n) acc[a][b][m][n] = (f32x4){0.f, 0.f, 0.f, 0.f};
        cur = nxt; cA = nA; cB = nB; ++ui;
        if (wr == 1) PG8_BAR;
    }
    PG8_WAIT_V(0);
    PG8_BAR;
#undef PG8_SA
#undef PG8_SB
#undef PG8_STAGE
#undef PG8_LDA
#undef PG8_LDB
#undef PG8_MMA
#undef PG8_WAIT_V
#undef PG8_WAIT_L
#undef PG8_BAR
#undef PG8_SCHED
}
template <class Epi, class Sched>
__device__ __forceinline__ void gemm_phase_simt(LAS unsigned char* lds, const int tid, const int lda, const int ldb, const Sched& S, const Epi& E) {
    LAS float* As = (LAS float*)lds;
    LAS float* Bs = (LAS float*)(lds + 32 * 132 * 4);
    const int ty = tid >> 4, tx = tid & 15, c0 = (tx >> 2) * 32 + (tx & 3) * 4;
    const int lr = tid >> 2, lk = (tid & 3) * 8;
    Unit u;
    for (int ui = 0; S.next(ui, u); ++ui) {
        for (int sub = 0; sub < 4; ++sub) {
            const int sr = sub >> 1, sc = sub & 1;
            float acc[4][8];
#pragma unroll
            for (int i = 0; i < 4; ++i)
#pragma unroll
                for (int j = 0; j < 8; ++j) acc[i][j] = 0.f;
            const int arow = sr * 128 + lr, brow = sc * 128 + lr;
            const int ar = u.rows ? u.rows[arow] : arow;
            const bf16_t* ap = (const bf16_t*)u.A + (size_t)ar * lda + lk;
            const bf16_t* bp = (const bf16_t*)u.B + (size_t)brow * ldb + lk;
            for (int k0 = 0; k0 < u.K; k0 += 32) {
                const u32x4 av = *(const u32x4*)(ap + k0), bv = *(const u32x4*)(bp + k0);
                __syncthreads();
#pragma unroll
                for (int j = 0; j < 4; ++j) {
                    As[(lk + 2 * j) * 132 + lr] = bflo(av[j]); As[(lk + 2 * j + 1) * 132 + lr] = bfhi(av[j]);
                    Bs[(lk + 2 * j) * 132 + lr] = bflo(bv[j]); Bs[(lk + 2 * j + 1) * 132 + lr] = bfhi(bv[j]);
                }
                __syncthreads();
#pragma unroll 4
                for (int k = 0; k < 32; ++k) {
                    const f32x4 a4 = *(const LAS f32x4*)(As + k * 132 + ty * 4);
                    const f32x4 b0 = *(const LAS f32x4*)(Bs + k * 132 + c0), b1 = *(const LAS f32x4*)(Bs + k * 132 + c0 + 16);
#pragma unroll
                    for (int i = 0; i < 4; ++i)
#pragma unroll
                        for (int j = 0; j < 4; ++j) { acc[i][j] += a4[i] * b0[j]; acc[i][4 + j] += a4[i] * b1[j]; }
                }
            }
#pragma unroll
            for (int i = 0; i < 4; ++i)
                E.store1(u, sr * 128 + ty * 4 + i, sc * 128 + c0, (f32x4){acc[i][0], acc[i][1], acc[i][2], acc[i][3]}, (f32x4){acc[i][4], acc[i][5], acc[i][6], acc[i][7]});
        }
    }
    __syncthreads();
}
}

#if USE_MFMA_GEMM
#define GEMM_PHASE(lds, lda, ldb, S, E) pg8::gemm_phase(lds, F.tid, lda, ldb, S, E)
#else
#define GEMM_PHASE(lds, lda, ldb, S, E) pg8::gemm_phase_simt(lds, F.tid, lda, ldb, S, E)
#endif

struct Args { const float* in[21]; float* out; unsigned char* ws; int ph_lo, ph_hi; };
enum { I_X = 0, I_C, I_CTX, I_CCTX, I_WADA, I_BADA, I_GN1, I_WIN, I_BG, I_GH, I_CW, I_CB, I_CLG, I_CLB, I_WOUT, I_GN2, I_WR, I_WEG, I_WEU, I_WED, I_GF };
__device__ __forceinline__ const float* arg_in(const Args& a, int i) { asm volatile("" : "+s"(i)); return a.in[i]; }
struct Frame {
    LAS unsigned char* lds;
    int tid, lane, wave, G, bid;
    unsigned char* ws;
    const Args& A;
};
#define FIN(i) arg_in(F.A, (i))
#define WSP(T, off) ((T*)(F.ws + (off)))

template <class Src>
__device__ __forceinline__ void tr_item(const Src& src, bf16_t* dst, int ldd, int n0, int k0, LAS float* scr, int lane) {
    f32x4 v[8];
#pragma unroll
    for (int i = 0; i < 8; ++i) v[i] = src.ld4(k0 + i * 8 + (lane >> 3), n0 + (lane & 7) * 4);
#pragma unroll
    for (int i = 0; i < 8; ++i) { LAS float* p = scr + (i * 8 + (lane >> 3)) * 33 + (lane & 7) * 4; p[0] = v[i][0]; p[1] = v[i][1]; p[2] = v[i][2]; p[3] = v[i][3]; }
    LDS_WAIT(); asm volatile("" ::: "memory");
    const int c = lane & 7;
#pragma unroll
    for (int j = 0; j < 4; ++j) { const int n = (lane >> 3) + 8 * j; const LAS float* s = scr + (8 * c) * 33 + n;
        u32x4 o; o.x = pk2(s[0 * 33], s[1 * 33]); o.y = pk2(s[2 * 33], s[3 * 33]); o.z = pk2(s[4 * 33], s[5 * 33]); o.w = pk2(s[6 * 33], s[7 * 33]);
        *(u32x4*)(dst + (size_t)(n0 + n) * ldd + k0 + 8 * c) = o; }
    LDS_WAIT(); asm volatile("" ::: "memory");
}
struct SrcWin { const float* w; __device__ __forceinline__ f32x4 ld4(int k, int n) const { return *(const f32x4*)(w + (size_t)k * INC + (n < 1536 ? n : n + 16)); } };
struct SrcPlain { const float* w; int ld; __device__ __forceinline__ f32x4 ld4(int k, int n) const { return *(const f32x4*)(w + (size_t)k * ld + n); } };
struct SrcGU { const float* wg; const float* wu; __device__ __forceinline__ f32x4 ld4(int k, int n) const { const int grp = n >> 5, i = n & 31;
    const uintptr_t base = (uintptr_t)wg + ((i < 16) ? (uintptr_t)0 : ((uintptr_t)wu - (uintptr_t)wg));
    return *(const f32x4*)((const float*)base + (size_t)k * D + grp * 16 + (i & 15)); } };

__device__ __forceinline__ void tr_store(const f32x4 (&v)[8], bf16_t* dst, int ldd, int n0, int k0, LAS float* scr, int lane) {
#pragma unroll
    for (int i = 0; i < 8; ++i) { LAS float* p = scr + (i * 8 + (lane >> 3)) * 33 + (lane & 7) * 4; p[0] = v[i][0]; p[1] = v[i][1]; p[2] = v[i][2]; p[3] = v[i][3]; }
    LDS_WAIT(); asm volatile("" ::: "memory");
    const int c = lane & 7;
#pragma unroll
    for (int j = 0; j < 4; ++j) { const int n = (lane >> 3) + 8 * j; const LAS float* s = scr + (8 * c) * 33 + n;
        u32x4 o; o.x = pk2(s[0 * 33], s[1 * 33]); o.y = pk2(s[2 * 33], s[3 * 33]); o.z = pk2(s[4 * 33], s[5 * 33]); o.w = pk2(s[6 * 33], s[7 * 33]);
        *(u32x4*)(dst + (size_t)(n0 + n) * ldd + k0 + 8 * c) = o; }
    LDS_WAIT(); asm volatile("" ::: "memory");
}
struct MoeItem { bf16_t* dst; int n0, k0; };
__device__ __forceinline__ MoeItem moe_item_load(Frame& F, int l, int it, const float* wg, const float* wu, const float* wd, f32x4 (&v)[8]) {
    constexpr int I_GU = NE * 64 * 16;
    MoeItem m; const int lane = F.lane;
    if (it < I_GU) { const int e = it / 1024, r = it % 1024, sup = r >> 3, wv = r & 7, nb = (sup & 15) * 4 + (wv & 3), kb = (sup >> 4) * 2 + (wv >> 2);
        SrcGU s{wg + ((size_t)l * NE + e) * D * D, wu + ((size_t)l * NE + e) * D * D};
        m.dst = WSP(bf16_t, WS_WGU) + (size_t)e * 2048 * D; m.n0 = nb * 32; m.k0 = kb * 64;
#pragma unroll
        for (int i = 0; i < 8; ++i) v[i] = s.ld4(m.k0 + i * 8 + (lane >> 3), m.n0 + (lane & 7) * 4);
    } else { const int r0 = it - I_GU, e = r0 / 512, r = r0 % 512, sup = r >> 3, wv = r & 7, nb = (sup & 7) * 4 + (wv & 3), kb = (sup >> 3) * 2 + (wv >> 2);
        SrcPlain s{wd + ((size_t)l * NE + e) * D * D, D};
        m.dst = WSP(bf16_t, WS_WD) + (size_t)e * D * D; m.n0 = nb * 32; m.k0 = kb * 64;
#pragma unroll
        for (int i = 0; i < 8; ++i) v[i] = s.ld4(m.k0 + i * 8 + (lane >> 3), m.n0 + (lane & 7) * 4);
    }
    return m;
}
__device__ __forceinline__ void convert_moe_weights(Frame& F, int l, int gw, int ngw) {
    LAS float* scr = (LAS float*)(F.lds + F.wave * 8448);
    const float* w_e_gate = FIN(I_WEG); const float* w_e_up = FIN(I_WEU); const float* w_e_down = FIN(I_WED);
    constexpr int NIT = NE * 64 * 16 + NE * 32 * 16;
    if (gw >= NIT) return;
    f32x4 va[8], vb[8];
    MoeItem ma = moe_item_load(F, l, gw, w_e_gate, w_e_up, w_e_down, va), mb = ma;
    for (int it = gw; it < NIT; it += 2 * ngw) {
        const int i1 = it + ngw, i2 = it + 2 * ngw;
        if (i1 < NIT) mb = moe_item_load(F, l, i1, w_e_gate, w_e_up, w_e_down, vb);
        tr_store(va, ma.dst, D, ma.n0, ma.k0, scr, F.lane);
        if (i1 < NIT) {
            if (i2 < NIT) ma = moe_item_load(F, l, i2, w_e_gate, w_e_up, w_e_down, va);
            tr_store(vb, mb.dst, D, mb.n0, mb.k0, scr, F.lane);
        }
    }
}

__device__ __forceinline__ void phase_prep(Frame& F) {
    const int tid = F.tid;
    {
        LAS float* s = (LAS float*)F.lds;
        LAS float* red = (LAS float*)(F.lds + 9 * 1024 * 4);
        float* MOD = WSP(float, WS_MOD);
        const float* c_in = FIN(I_C); const float* c_ctx = FIN(I_CCTX); const float* w_ada = FIN(I_WADA); const float* b_ada = FIN(I_BADA);
        bool staged = false;
        for (int it = F.bid; it < 192; it += F.G) {
            if (!staged) { for (int i = tid; i < 9 * 1024; i += NTHR) { const int r = i >> 10, k = i & 1023; const float cv = (r < 8) ? c_in[r * 1024 + k] : c_ctx[k]; s[i] = siluf_(cv); } staged = true; }
            __syncthreads();
            const int l = it / 96, cgp = it % 96, col = cgp * 64 + (tid & 63), kq = tid >> 6;
            float acc[9];
#pragma unroll
            for (int r = 0; r < 9; ++r) acc[r] = 0.f;
            const float* w = w_ada + ((size_t)l * 1024 + kq * 128) * 6144 + col;
            for (int k0 = 0; k0 < 128; k0 += 32) {
                float wv[32];
#pragma unroll
                for (int k = 0; k < 32; ++k) wv[k] = w[(size_t)(k0 + k) * 6144];
#pragma unroll
                for (int k = 0; k < 32; ++k)
#pragma unroll
                    for (int r = 0; r < 9; ++r) acc[r] += s[r * 1024 + kq * 128 + k0 + k] * wv[k];
            }
#pragma unroll
            for (int r = 0; r < 9; ++r) red[(kq * 9 + r) * 64 + (tid & 63)] = acc[r];
            __syncthreads();
            for (int o = tid; o < 576; o += NTHR) { const int r = o >> 6, cc = o & 63; float sum = 0.f;
#pragma unroll
                for (int q = 0; q < 8; ++q) sum += red[(q * 9 + r) * 64 + cc];
                MOD[((size_t)l * 9 + r) * 6144 + cgp * 64 + cc] = sum + b_ada[l * 6144 + cgp * 64 + cc]; }
            __syncthreads();
        }
        __syncthreads();
    }
    {
        bf16_t* FL = WSP(bf16_t, WS_FL); bf16_t* FC = WSP(bf16_t, WS_FC);
        const size_t gth = (size_t)F.bid * NTHR + tid, nth = (size_t)F.G * NTHR;
        for (size_t it = gth; it < (size_t)4096 * 1024 / 8; it += nth) {
            const int r = (int)(it / 128), t0 = (int)(it % 128) * 8, part = r >> 11, k = r & 2047; unsigned w[4];
#pragma unroll
            for (int j = 0; j < 4; ++j) { float v[2];
#pragma unroll
                for (int q = 0; q < 2; ++q) { const int ph = (k * (t0 + 2 * j + q)) & 2047; const float ang = (float)ph * (6.283185307179586f / 2048.f); v[q] = (part ? sinf(ang) : cosf(ang)) * 0.022097086912079608f; }
                w[j] = pk2(v[0], v[1]); }
            *(u32x4*)(FL + (size_t)r * 1024 + t0) = (u32x4){w[0], w[1], w[2], w[3]};
        }
        for (size_t it = gth; it < (size_t)512 * 256 / 8; it += nth) {
            const int r = (int)(it / 32), t0 = (int)(it % 32) * 8, part = r >> 8, k = r & 255; unsigned w[4];
#pragma unroll
            for (int j = 0; j < 4; ++j) { float v[2];
#pragma unroll
                for (int q = 0; q < 2; ++q) { const int ph = (k * (t0 + 2 * j + q)) & 255; const float ang = (float)ph * (6.283185307179586f / 256.f); v[q] = (part ? sinf(ang) : cosf(ang)) * 0.0625f; }
                w[j] = pk2(v[0], v[1]); }
            *(u32x4*)(FC + (size_t)r * 1024 + t0) = (u32x4){w[0], w[1], w[2], w[3]};
        }
    }
    const int gw = F.bid * NWAVES + F.wave, ngw = F.G * NWAVES;
    {
        LAS float* scr = (LAS float*)(F.lds + F.wave * 8448);
        bf16_t* WIN = WSP(bf16_t, WS_WIN); bf16_t* WOUT = WSP(bf16_t, WS_WOUT);
        const float* w_in = FIN(I_WIN); const float* w_out = FIN(I_WOUT);
        constexpr int I_IN = 2 * 88 * 16, I_OP = 2 * 32 * 12, I_PQ = 2 * 32 * 8;
        for (int it = gw; it < I_IN + I_OP + I_PQ; it += ngw) {
            if (it < I_IN) { const int l = it / 1408, r = it % 1408, nb = r / 16, kb = r % 16;
                SrcWin s{w_in + (size_t)l * D * INC};
                tr_item(s, WIN + (size_t)l * NIN * D, D, nb * 32, kb * 64, scr, F.lane);
            } else if (it < I_IN + I_OP) { const int r0 = it - I_IN, l = r0 / 384, r = r0 % 384, nb = r / 12, kb = r % 12;
                SrcPlain s{w_out + (size_t)l * D * D, D};
                tr_item(s, WOUT + (size_t)l * D * KOUT, KOUT, nb * 32, kb * 64, scr, F.lane);
            } else { const int r0 = it - I_IN - I_OP, l = r0 / 256, r = r0 % 256, nb = r / 8, gp = r % 8, g = gp & 3, part = gp >> 2;
                const float* wsrc = w_out + (size_t)l * D * D + (size_t)(768 + g * 64) * D + nb * 32;
#pragma unroll 8
                for (int i = 0; i < 32; ++i) { const int kk = 2 * i + (F.lane >> 5), nn = F.lane & 31; scr[kk * 33 + nn] = wsrc[(size_t)kk * D + nn]; }
                LDS_WAIT(); asm volatile("" ::: "memory");
                const int c8 = F.lane & 7;
                float o[4][8];
#pragma unroll
                for (int j = 0; j < 4; ++j)
#pragma unroll
                    for (int q = 0; q < 8; ++q) o[j][q] = 0.f;
                for (int m = 0; m < 64; ++m) {
                    float twd[8];
#pragma unroll
                    for (int q = 0; q < 8; ++q) { const float ang = (float)((m * (c8 * 8 + q)) & 63) * (6.283185307179586f / 64.f); twd[q] = part ? -__sinf(ang) : __cosf(ang); }
#pragma unroll
                    for (int j = 0; j < 4; ++j) { const float bv = scr[m * 33 + (F.lane >> 3) + 8 * j];
#pragma unroll
                        for (int q = 0; q < 8; ++q) o[j][q] += twd[q] * bv; }
                }
#pragma unroll
                for (int j = 0; j < 4; ++j) { const int n = (F.lane >> 3) + 8 * j;
                    u32x4 ov; ov.x = pk2(o[j][0] * 0.125f, o[j][1] * 0.125f); ov.y = pk2(o[j][2] * 0.125f, o[j][3] * 0.125f); ov.z = pk2(o[j][4] * 0.125f, o[j][5] * 0.125f); ov.w = pk2(o[j][6] * 0.125f, o[j][7] * 0.125f);
                    *(u32x4*)(WOUT + (size_t)l * D * KOUT + (size_t)(nb * 32 + n) * KOUT + 768 + part * 256 + g * 64 + c8 * 8) = ov; }
                LDS_WAIT(); asm volatile("" ::: "memory");
            }
        }
    }
}

__device__ __forceinline__ void stage_small_w(Frame& F, LAS float* wT, const float* src, int ld, int coloff) {
    for (int i = F.tid; i < 16 * 1024; i += NTHR) { const int k = i >> 4, c = i & 15; wT[c * 1024 + k] = src[(size_t)k * ld + coloff + c]; }
    __syncthreads();
}
__device__ __forceinline__ float reduce16(float (&acc)[16], int lane) {
    float v8[8], v4[4], v2[2], v1;
#pragma unroll
    for (int i = 0; i < 8; ++i) { const float snd = (lane & 32) ? acc[i] : acc[i + 8], kp = (lane & 32) ? acc[i + 8] : acc[i]; v8[i] = kp + __shfl_xor(snd, 32); }
#pragma unroll
    for (int i = 0; i < 4; ++i) { const float snd = (lane & 16) ? v8[i] : v8[i + 4], kp = (lane & 16) ? v8[i + 4] : v8[i]; v4[i] = kp + __shfl_xor(snd, 16); }
#pragma unroll
    for (int i = 0; i < 2; ++i) { const float snd = (lane & 8) ? v4[i] : v4[i + 2], kp = (lane & 8) ? v4[i + 2] : v4[i]; v2[i] = kp + __shfl_xor(snd, 8); }
    { const float snd = (lane & 4) ? v2[0] : v2[1], kp = (lane & 4) ? v2[1] : v2[0]; v1 = kp + __shfl_xor(snd, 4); }
    v1 += __shfl_xor(v1, 2); v1 += __shfl_xor(v1, 1);
    return v1;
}
__device__ __forceinline__ float norm_row(const f32x4 (&v)[4], const float* gain, const float* shift, const float* scale, bf16_t* xn_row, const LAS float* wT, int lane) {
    float ss = 0.f;
#pragma unroll
    for (int j = 0; j < 4; ++j) ss += (v[j][0] * v[j][0] + v[j][1] * v[j][1]) + (v[j][2] * v[j][2] + v[j][3] * v[j][3]);
    ss = wave_sum(ss);
    const float r = 1.0f / sqrtf(ss * (1.0f / D) + EPS);
    float acc[16];
#pragma unroll
    for (int c = 0; c < 16; ++c) acc[c] = 0.f;
#pragma unroll
    for (int j = 0; j < 4; ++j) {
        const int o = 4 * lane + 256 * j;
        const f32x4 g = *(const f32x4*)(gain + o), sh = *(const f32x4*)(shift + o), sc = *(const f32x4*)(scale + o);
        f32x4 y;
#pragma unroll
        for (int q = 0; q < 4; ++q) y[q] = v[j][q] * r * g[q] * (1.0f + sc[q]) + sh[q];
        *(u32x2*)(xn_row + o) = pk4(y);
        f32x4 wv[16];
#pragma unroll
        for (int c = 0; c < 16; ++c) wv[c] = *(const LAS f32x4*)(wT + c * 1024 + o);
        __builtin_amdgcn_sched_barrier(0);
#pragma unroll
        for (int c = 0; c < 16; ++c) acc[c] += (y[0] * wv[c][0] + y[1] * wv[c][1]) + (y[2] * wv[c][2] + y[3] * wv[c][3]);
        __builtin_amdgcn_sched_barrier(0);
        asm volatile("" ::: "memory");
    }
    return reduce16(acc, lane);
}
__device__ __forceinline__ void row_tail_gates(float myv, const float* b_gates_l, float* gates_row, int lane) {
    if ((lane & 3) == 0) { const int c = lane >> 2; gates_row[c] = myv + b_gates_l[c]; }
}
__device__ __forceinline__ void row_tail_router(float myv, float* aff_row, int lane) {
    float mx = myv;
#pragma unroll
    for (int o = 4; o < 64; o <<= 1) mx = fmaxf(mx, __shfl_xor(mx, o));
    const float e = expf(myv - mx); float s = e;
#pragma unroll
    for (int o = 4; o < 64; o <<= 1) s += __shfl_xor(s, o);
    if ((lane & 3) == 0) aff_row[lane >> 2] = e / s;
}
__device__ __forceinline__ int mod_row(int tok) { return tok < NLAT ? (tok >> 11) : 8; }

__device__ __forceinline__ void phase_norm1_l0(Frame& F) {
    LAS float* wT = (LAS float*)F.lds;
    stage_small_w(F, wT, FIN(I_WIN), INC, 1536);
    const float* MOD = WSP(float, WS_MOD); bf16_t* XN = WSP(bf16_t, WS_XN); float* GATES = WSP(float, WS_GATES);
    const float* x_in = FIN(I_X); const float* ctx_in = FIN(I_CTX); const float* g_norm1 = FIN(I_GN1); const float* b_gates = FIN(I_BG);
    const int gw = F.bid * NWAVES + F.wave, ngw = F.G * NWAVES;
    f32x4 vn[4];
    { const float* src = gw < NLAT ? x_in + (size_t)gw * D : ctx_in + (size_t)(gw - NLAT) * D;
#pragma unroll
      for (int j = 0; j < 4; ++j) vn[j] = *(const f32x4*)(src + 4 * F.lane + 256 * j); }
    for (int tok = gw; tok < NTOK; tok += ngw) {
        f32x4 v[4];
#pragma unroll
        for (int j = 0; j < 4; ++j) v[j] = vn[j];
        const int tn = tok + ngw;
        if (tn < NTOK) { const float* src = tn < NLAT ? x_in + (size_t)tn * D : ctx_in + (size_t)(tn - NLAT) * D;
#pragma unroll
            for (int j = 0; j < 4; ++j) vn[j] = *(const f32x4*)(src + 4 * F.lane + 256 * j); }
        const float* md = MOD + (size_t)mod_row(tok) * 6144;
        const float myv = norm_row(v, g_norm1, md, md + 1024, XN + (size_t)tok * D, wT, F.lane);
        row_tail_gates(myv, b_gates, GATES + (size_t)tok * 16, F.lane);
    }
    __syncthreads();
}
__device__ __forceinline__ void phase_norm2(Frame& F, int l) {
    LAS float* wT = (LAS float*)F.lds;
    stage_small_w(F, wT, FIN(I_WR) + (size_t)l * D * 16, 16, 0);
    const float* g_norm2 = FIN(I_GN2);
    const float* MOD = WSP(float, WS_MOD); bf16_t* XN = WSP(bf16_t, WS_XN); float* AFF = WSP(float, WS_AFF); const float* X = WSP(float, WS_X);
    const int gw = F.bid * NWAVES + F.wave, ngw = F.G * NWAVES;
    const int ntok = (l == 0) ? NTOK : NLAT;
    f32x4 vn[4];
#pragma unroll
    for (int j = 0; j < 4; ++j) vn[j] = *(const f32x4*)(X + (size_t)gw * D + 4 * F.lane + 256 * j);
    for (int tok = gw; tok < ntok; tok += ngw) {
        f32x4 v[4];
#pragma unroll
        for (int j = 0; j < 4; ++j) v[j] = vn[j];
        const int tn = tok + ngw;
        if (tn < ntok) {
#pragma unroll
            for (int j = 0; j < 4; ++j) vn[j] = *(const f32x4*)(X + (size_t)tn * D + 4 * F.lane + 256 * j); }
        const float* md = MOD + ((size_t)l * 9 + mod_row(tok)) * 6144;
        const float myv = norm_row(v, g_norm2 + l * D, md + 3 * 1024, md + 4 * 1024, XN + (size_t)tok * D, wT, F.lane);
        row_tail_router(myv, AFF + (size_t)tok * 16, F.lane);
    }
    __syncthreads();
}
__device__ __forceinline__ void phase_combine(Frame& F, int l) {
    LAS float* wT = (LAS float*)F.lds;
    if (l == 0) stage_small_w(F, wT, FIN(I_WIN) + (size_t)1 * D * INC, INC, 1536);
    const float* g_norm1 = FIN(I_GN1); const float* b_gates = FIN(I_BG); const float* g_final = FIN(I_GF); float* outp = F.A.out;
    const float* MOD = WSP(float, WS_MOD); bf16_t* XN = WSP(bf16_t, WS_XN); float* GATES = WSP(float, WS_GATES); float* X = WSP(float, WS_X);
    const int* INV = WSP(int, WS_INV); const bf16_t* YS = WSP(bf16_t, WS_YS);
    const int gw = F.bid * NWAVES + F.wave, ngw = F.G * NWAVES;
    const int ntok = (l == 0) ? NTOK : NLAT;
    f32x4 vn[4]; int invn = INV[(size_t)gw * 16 + (F.lane & 15)];
#pragma unroll
    for (int j = 0; j < 4; ++j) vn[j] = *(const f32x4*)(X + (size_t)gw * D + 4 * F.lane + 256 * j);
    for (int tok = gw; tok < ntok; tok += ngw) {
        f32x4 v[4], a[4];
#pragma unroll
        for (int j = 0; j < 4; ++j) { v[j] = vn[j]; a[j] = (f32x4){0.f, 0.f, 0.f, 0.f}; }
        const int myinv = invn;
        { const int tn = tok + ngw;
          if (tn < ntok) { invn = INV[(size_t)tn * 16 + (F.lane & 15)];
#pragma unroll
              for (int j = 0; j < 4; ++j) vn[j] = *(const f32x4*)(X + (size_t)tn * D + 4 * F.lane + 256 * j); } }
        {
            unsigned long long mask = __ballot(myinv >= 0) & 0xffffull;
            while (mask) { const int e = __builtin_ctzll(mask); mask &= mask - 1;
                const int r = __builtin_amdgcn_readlane(myinv, e);
                const bf16_t* yr = YS + ((size_t)e * RPE + r) * D;
#pragma unroll
                for (int j = 0; j < 4; ++j) { const u32x2 w = *(const u32x2*)(yr + 4 * F.lane + 256 * j); a[j][0] += bflo(w.x); a[j][1] += bfhi(w.x); a[j][2] += bflo(w.y); a[j][3] += bfhi(w.y); } }
        }
        const float* md = MOD + ((size_t)l * 9 + mod_row(tok)) * 6144;
#pragma unroll
        for (int j = 0; j < 4; ++j) { const f32x4 gt = *(const f32x4*)(md + 5 * 1024 + 4 * F.lane + 256 * j); v[j] = v[j] + gt * a[j]; }
        if (l == 0) {
#pragma unroll
            for (int j = 0; j < 4; ++j) *(f32x4*)(X + (size_t)tok * D + 4 * F.lane + 256 * j) = v[j];
            const float* md1 = MOD + ((size_t)9 + mod_row(tok)) * 6144;
            const float myv = norm_row(v, g_norm1 + D, md1, md1 + 1024, XN + (size_t)tok * D, wT, F.lane);
            row_tail_gates(myv, b_gates + 16, GATES + (size_t)tok * 16, F.lane);
        } else {
            float ss = 0.f;
#pragma unroll
            for (int j = 0; j < 4; ++j) ss += (v[j][0] * v[j][0] + v[j][1] * v[j][1]) + (v[j][2] * v[j][2] + v[j][3] * v[j][3]);
            ss = wave_sum(ss);
            const float r = 1.0f / sqrtf(ss * (1.0f / D) + EPS);
#pragma unroll
            for (int j = 0; j < 4; ++j) { const f32x4 g = *(const f32x4*)(g_final + 4 * F.lane + 256 * j); *(f32x4*)(outp + (size_t)tok * D + 4 * F.lane + 256 * j) = v[j] * r * g; }
        }
    }
    __syncthreads();
}

__device__ __forceinline__ int block_count(LAS int* cbuf, int par, int wave, int lane, int c_wave  ) {
    if (lane == 0) cbuf[par * 8 + wave] = c_wave;
    __syncthreads();
    int t = 0;
#pragma unroll
    for (int q = 0; q < 8; ++q) t += cbuf[par * 8 + q];
    return t;
}
__device__ __forceinline__ void phase_topk(Frame& F, int l) {
    LAS int* cbuf = (LAS int*)F.lds;
    const float* AFF = WSP(float, WS_AFF); int* INV = WSP(int, WS_INV); int* ROWTOK = WSP(int, WS_ROWTOK); float* GATEV = WSP(float, WS_GATEV);
    const int nitems = (l == 0) ? 256 : 128;
    for (int it = F.bid; it < nitems; it += F.G) {
        const int s = it >> 4, e = it & 15;
        const bool lat = s < 8;
        const int n = lat ? SEQ : CTXL, cap = lat ? 256 : 32, tok0 = lat ? s * SEQ : NLAT + (s - 8) * CTXL, rowbase = lat ? s * 256 : 2048 + (s - 8) * 32;
        const bool active = 4 * F.tid < n;
        unsigned k[4];
#pragma unroll
        for (int q = 0; q < 4; ++q) k[q] = active ? __float_as_uint(AFF[(size_t)(tok0 + 4 * F.tid + q) * 16 + e]) : 0u;
        __syncthreads();
        unsigned T = 0u; int par = 0;
        for (int bit = 30; bit >= 0; --bit) {
            const unsigned cand = T | (1u << bit);
            int cw = 0;
#pragma unroll
            for (int q = 0; q < 4; ++q) cw += __popcll(__ballot(k[q] >= cand));
            const int tot = block_count(cbuf, par, F.wave, F.lane, cw); par ^= 1;
            if (tot >= cap) T = cand;
        }
        int cw = 0;
#pragma unroll
        for (int q = 0; q < 4; ++q) cw += __popcll(__ballot(k[q] > T));
        const int c_gt = block_count(cbuf, par, F.wave, F.lane, cw); par ^= 1;
        int mg = 0, me = 0;
#pragma unroll
        for (int q = 0; q < 4; ++q) { mg += (k[q] > T) ? 1 : 0; me += (k[q] == T && active) ? 1 : 0; }
        int pk_ = mg | (me << 16), inc = pk_;
#pragma unroll
        for (int o = 1; o < 64; o <<= 1) { const int y = __shfl_up(inc, o); if (F.lane >= o) inc += y; }
        if (F.lane == 63) cbuf[16 + F.wave] = inc;
        __syncthreads();
        int base = 0;
#pragma unroll
        for (int q = 0; q < 8; ++q) base += (q < F.wave) ? cbuf[16 + q] : 0;
        int pre = base + inc - pk_; int pg = pre & 0xffff, pe = pre >> 16;
        if (active) {
#pragma unroll
            for (int q = 0; q < 4; ++q) {
                const int tok = tok0 + 4 * F.tid + q; int slot = -1;
                if (k[q] > T) { slot = pg; ++pg; }
                else if (k[q] == T) { if (c_gt + pe < cap) slot = c_gt + pe; ++pe; }
                if (slot >= 0) { ROWTOK[e * RPE + rowbase + slot] = tok; GATEV[e * RPE + rowbase + slot] = __uint_as_float(k[q]); }
                INV[(size_t)tok * 16 + e] = slot >= 0 ? rowbase + slot : -1;
            }
        }
        __syncthreads();
    }
    __syncthreads();
}

__device__ __forceinline__ void conv_items(Frame& F, int l, int first, int stride) {
    LAS float* gl = (LAS float*)F.lds;
    LAS float* ob = gl + 62 * 256;
    const bf16_t* CA = WSP(bf16_t, WS_CA); const bf16_t* CG = WSP(bf16_t, WS_CG); bf16_t* Y = WSP(bf16_t, WS_Y);
    const int nitems = (l == 0) ? 512 + 64 : 512;
    const int ch = F.tid & 255, th = F.tid >> 8;
    const float* conv_w = FIN(I_CW); const float* conv_b = FIN(I_CB); const float* conv_ln_g = FIN(I_CLG); const float* conv_ln_b = FIN(I_CLB);
    float w[31];
#pragma unroll
    for (int j = 0; j < 31; ++j) w[j] = conv_w[((size_t)l * 31 + j) * 256 + ch];
    const float cb = conv_b[l * 256 + ch];
    for (int it = first; it < nitems; it += stride) {
        const bool lat = it < 512;
        const int seqlen = lat ? SEQ : CTXL;
        const int b = lat ? it >> 6 : (it - 512) >> 3, t0 = lat ? (it & 63) * 32 : ((it - 512) & 7) * 32;
        const int tokb = lat ? b * SEQ : NLAT + b * CTXL;
        __syncthreads();
        for (int i = F.tid; i < 62 * 64; i += NTHR) {
            const int rr = i >> 6, c4 = (i & 63) * 4, t = t0 - 15 + rr;
            f32x4 g = (f32x4){0.f, 0.f, 0.f, 0.f};
            if (t >= 0 && t < seqlen) { const size_t o = (size_t)(tokb + t) * 256 + c4; const u32x2 a = *(const u32x2*)(CA + o), gg = *(const u32x2*)(CG + o);
                g[0] = bflo(a.x) * sigmoidf_(bflo(gg.x)); g[1] = bfhi(a.x) * sigmoidf_(bfhi(gg.x)); g[2] = bflo(a.y) * sigmoidf_(bflo(gg.y)); g[3] = bfhi(a.y) * sigmoidf_(bfhi(gg.y)); }
            *(LAS f32x4*)(gl + rr * 256 + c4) = g;
        }
        __syncthreads();
        for (int tt = 0; tt < 16; ++tt) {
            const LAS float* gp = gl + (th * 16 + tt) * 256 + ch;
            float gv[31];
#pragma unroll
            for (int j = 0; j < 31; ++j) gv[j] = gp[j * 256];
            __builtin_amdgcn_sched_barrier(0);
            float o = cb;
#pragma unroll
            for (int j = 0; j < 31; ++j) o += w[j] * gv[j];
            __builtin_amdgcn_sched_barrier(0);
            ob[(th * 16 + tt) * 256 + ch] = o;
        }
        __syncthreads();
        for (int tt = F.wave; tt < 32; tt += NWAVES) {
            const f32x4 v = *(const LAS f32x4*)(ob + tt * 256 + 4 * F.lane);
            const float mean = wave_sum((v[0] + v[1]) + (v[2] + v[3])) * (1.0f / 256.f);
            const f32x4 d = v - mean;
            const float var = wave_sum((d[0] * d[0] + d[1] * d[1]) + (d[2] * d[2] + d[3] * d[3])) * (1.0f / 256.f);
            const float rs = 1.0f / sqrtf(var + EPS);
            const f32x4 lg = *(const f32x4*)(conv_ln_g + l * 256 + 4 * F.lane), lb = *(const f32x4*)(conv_ln_b + l * 256 + 4 * F.lane);
            f32x4 y;
#pragma unroll
            for (int q = 0; q < 4; ++q) y[q] = siluf_(d[q] * rs * lg[q] + lb[q]);
            *(u32x2*)(Y + (size_t)(tokb + t0 + tt) * KOUT + 512 + 4 * F.lane) = pk4(y);
        }
    }
    __syncthreads();
}
__device__ __forceinline__ void ztrans_items(Frame& F, int l, int first, int stride) {
    LAS unsigned short* te = (LAS unsigned short*)(F.lds + F.wave * (2 * 64 * 66 * 2));
    LAS unsigned short* to = te + 64 * 66;
    const bf16_t* FR = WSP(bf16_t, WS_FR); bf16_t* ZE = WSP(bf16_t, WS_ZT); bf16_t* ZO = WSP(bf16_t, WS_ZO); bf16_t* ZTC = WSP(bf16_t, WS_ZTC);
    const int nlat = 8 * 16 * 4, nctx = (l == 0) ? 8 * 4 * 4 : 0;
    for (int it = first; it < nlat + nctx; it += stride) {
        const bool lat = it < nlat; const int r = lat ? it : it - nlat;
        const int b = lat ? r >> 6 : r >> 4, tb = lat ? (r >> 2) & 15 : (r >> 2) & 3, cb = r & 3;
        const int tokb = lat ? b * SEQ : NLAT + b * CTXL;
#pragma unroll
        for (int i = 0; i < 8; ++i) { const int tt = (F.lane >> 3) + 8 * i, c8 = (F.lane & 7) * 8, t = tb * 64 + tt;
            const u32x4 v = *(const u32x4*)(FR + (size_t)(tokb + t) * 256 + cb * 64 + c8);
            u32x4 m = (u32x4){0u, 0u, 0u, 0u};
            if (lat && t > 0) m = *(const u32x4*)(FR + (size_t)(tokb + SEQ - t) * 256 + cb * 64 + c8);
#pragma unroll
            for (int q = 0; q < 4; ++q) {
                if (lat) { const float a0 = bflo(v[q]), a1 = bfhi(v[q]), m0 = bflo(m[q]), m1 = bfhi(m[q]); const unsigned e_ = pk2(a0 + m0, a1 + m1), o_ = (t > 0) ? pk2(a0 - m0, a1 - m1) : 0u;
                    te[(c8 + 2 * q) * 66 + tt] = (unsigned short)(e_ & 0xffffu); te[(c8 + 2 * q + 1) * 66 + tt] = (unsigned short)(e_ >> 16);
                    to[(c8 + 2 * q) * 66 + tt] = (unsigned short)(o_ & 0xffffu); to[(c8 + 2 * q + 1) * 66 + tt] = (unsigned short)(o_ >> 16); }
                else { te[(c8 + 2 * q) * 66 + tt] = (unsigned short)(v[q] & 0xffffu); te[(c8 + 2 * q + 1) * 66 + tt] = (unsigned short)(v[q] >> 16); } } }
        LDS_WAIT(); asm volatile("" ::: "memory");
        const size_t drow = (size_t)(b * 256 + cb * 64) * 1024 + tb * 64;
#pragma unroll
        for (int i = 0; i < 8; ++i) { const int cc = (F.lane >> 3) + 8 * i, t8 = (F.lane & 7) * 8; u32x4 o;
#pragma unroll
            for (int q = 0; q < 4; ++q) o[q] = (unsigned)te[cc * 66 + t8 + 2 * q] | ((unsigned)te[cc * 66 + t8 + 2 * q + 1] << 16);
            *(u32x4*)((lat ? ZE : ZTC) + drow + (size_t)cc * 1024 + t8) = o;
            if (lat) {
#pragma unroll
                for (int q = 0; q < 4; ++q) o[q] = (unsigned)to[cc * 66 + t8 + 2 * q] | ((unsigned)to[cc * 66 + t8 + 2 * q + 1] << 16);
                *(u32x4*)(ZO + drow + (size_t)cc * 1024 + t8) = o; } }
        LDS_WAIT(); asm volatile("" ::: "memory");
    }
}
__device__ __forceinline__ void finalize_h(Frame& F, int l) {
    const bf16_t* HF = WSP(bf16_t, WS_HF); const bf16_t* HB = WSP(bf16_t, WS_HB); const bf16_t* O = WSP(bf16_t, WS_O); bf16_t* Y = WSP(bf16_t, WS_Y);
    const int gw = F.bid * NWAVES + F.wave, ngw = F.G * NWAVES;
    const int ntok = (l == 0) ? NTOK : NLAT;
    float gh[8];
    const float* g_hnorm = FIN(I_GH);
#pragma unroll
    for (int q = 0; q < 8; ++q) gh[q] = g_hnorm[l * 512 + 8 * F.lane + q];
    for (int tok = gw; tok < ntok; tok += ngw) {
        const size_t o = (size_t)tok * 512 + 8 * F.lane;
        const u32x4 a = *(const u32x4*)(HF + o), b = *(const u32x4*)(HB + o), og = *(const u32x4*)(O + o);
        float h[8]; float ss = 0.f;
#pragma unroll
        for (int q = 0; q < 4; ++q) { h[2 * q] = bflo(a[q]) + bflo(b[q]); h[2 * q + 1] = bfhi(a[q]) + bfhi(b[q]); ss += h[2 * q] * h[2 * q] + h[2 * q + 1] * h[2 * q + 1]; }
#pragma unroll
        for (int s = 1; s < 16; s <<= 1) ss += __shfl_xor(ss, s);
        const float r = 1.0f / sqrtf(ss * (1.0f / 128.f) + EPS);
        u32x4 w;
#pragma unroll
        for (int q = 0; q < 4; ++q) w[q] = pk2(h[2 * q] * r * gh[2 * q] * bflo(og[q]), h[2 * q + 1] * r * gh[2 * q + 1] * bfhi(og[q]));
        *(u32x4*)(Y + (size_t)tok * KOUT + 8 * F.lane) = w;
    }
}

using pg8::Unit;
enum { GM_INPROJ = 0, GM_DFT, GM_OUT, GM_MOE1, GM_MOE2 };
struct GemmCtl {
    int mode, l, G, c; unsigned char* ws; const Args& A;
    __device__ __forceinline__ unsigned char* W() const { unsigned char* p = ws; asm volatile("" : "+s"(p)); return p; }
    __device__ __forceinline__ bool next(int i, Unit& u) const {
        const int L = i * G + c; int pm, pn;
        u.rows = nullptr; u.ex = 0;
        switch (mode) {
        case GM_INPROJ: {
            const int n0 = 64 * 11, npn = (l == 0) ? 11 : 6;
            if (L >= n0 + 8 * npn) return false;
            if (L < n0) pg8::map_tile(L, 64, 11, pm, pn); else { pg8::map_tile(L - n0, 8, npn, pm, pn); pm += 64; }
            u.A = (const char*)(W() + WS_XN) + (size_t)pm * 256 * D * 2; u.B = (const char*)(W() + WS_WIN) + ((size_t)l * NIN + pn * 256) * D * 2; u.K = D;
        } break;
        case GM_DFT: {
            const int nctx = (l == 0) ? 16 : 0;
            if (L >= 128 + nctx) return false;
            if (L < 128) { pg8::map_tile(L, 16, 8, pm, pn); u.A = (const char*)(W() + WS_FL) + (size_t)pm * 256 * 1024 * 2; u.B = (const char*)(W() + ((pm >> 3) ? WS_ZO : WS_ZT)) + (size_t)pn * 256 * 1024 * 2; u.K = 1024; }
            else { const int r = L - 128; pm = r & 1; pn = r >> 1; u.A = (const char*)(W() + WS_FC) + (size_t)pm * 256 * 1024 * 2; u.B = (const char*)(W() + WS_ZTC) + (size_t)pn * 256 * 1024 * 2; u.K = CTXL; u.ex = 1; }
        } break;
        case GM_OUT: {
            const int nM = (l == 0) ? 72 : 64;
            if (L >= nM * 4) return false;
            pg8::map_tile(L, nM, 4, pm, pn);
            u.A = (const char*)(W() + WS_Y) + (size_t)pm * 256 * KOUT * 2; u.B = (const char*)(W() + WS_WOUT) + ((size_t)l * D + pn * 256) * KOUT * 2; u.K = KOUT;
        } break;
        case GM_MOE1: {
            const int nMe = (l == 0) ? 9 : 8; int pmg;
            if (L >= NE * nMe * 8) return false;
            pg8::map_tile(L, NE * nMe, 8, pmg, pn);
            const int e = pmg / nMe; pm = pmg % nMe;
            u.A = (const char*)(W() + WS_XN); u.rows = (const int*)(W() + WS_ROWTOK) + e * RPE + pm * 256; u.B = (const char*)(W() + WS_WGU) + ((size_t)e * 2048 + pn * 256) * D * 2; u.K = D; u.ex = e;
        } break;
        default: {
            const int nMe = (l == 0) ? 9 : 8; int pmg;
            if (L >= NE * nMe * 4) return false;
            pg8::map_tile(L, NE * nMe, 4, pmg, pn);
            const int e = pmg / nMe; pm = pmg % nMe;
            u.A = (const char*)(W() + WS_HID) + ((size_t)e * RPE + pm * 256) * D * 2; u.B = (const char*)(W() + WS_WD) + ((size_t)e * D + pn * 256) * D * 2; u.K = D; u.ex = e;
        } break;
        }
        u.pm = pm; u.pn = pn;
        return true;
    }
    struct CxIn { bf16_t* dst; int ld; float sc; int act; };
    __device__ __forceinline__ CxIn prep_in(const Unit& u) const {
        CxIn c; const int pn = u.pn; c.sc = 1.f; c.act = 0; size_t off; int cb;
        if (pn < 2) { off = WS_Q; c.ld = 512; cb = pn * 256; }
        else if (pn < 4) { off = WS_K; c.ld = 512; cb = (pn - 2) * 256; c.sc = 0.08838834764831845f; }
        else if (pn < 6) { off = WS_V; c.ld = 512; cb = (pn - 4) * 256; }
        else if (pn < 8) { off = WS_O; c.ld = 512; cb = (pn - 6) * 256; c.act = 1; }
        else if (pn == 8) { off = WS_CA; c.ld = 256; cb = 0; }
        else if (pn == 9) { off = WS_CG; c.ld = 256; cb = 0; }
        else { off = WS_FR; c.ld = 256; cb = 0; }
        c.dst = (bf16_t*)(W() + off) + (size_t)u.pm * 256 * c.ld + cb;
        return c;
    }
    __device__ __forceinline__ void store_in(const CxIn& c, int r, int col, f32x4 v0, f32x4 v1) const {
        if (c.act) {
#pragma unroll
            for (int q = 0; q < 4; ++q) { v0[q] = sigmoidf_(v0[q]); v1[q] = sigmoidf_(v1[q]); }
        } else { v0 = v0 * c.sc; v1 = v1 * c.sc; }
        bf16_t* p = c.dst + (size_t)r * c.ld + col;
        *(u32x2*)p = pk4(v0); *(u32x2*)(p + 16) = pk4(v1);
    }
    struct CxDft { bf16_t* dst; const bf16_t* z1024; };
    __device__ __forceinline__ CxDft prep_dft(const Unit& u) const {
        CxDft c; int part, tokb; c.z1024 = nullptr;
        if (u.ex == 0) { part = u.pm >> 3; tokb = u.pn * SEQ + (u.pm & 7) * 256; if (part == 0) c.z1024 = (const bf16_t*)(W() + WS_FR) + (size_t)(u.pn * SEQ + 1024) * 256; }
        else { part = u.pm; tokb = NLAT + u.pn * CTXL; }
        c.dst = (bf16_t*)(W() + WS_Y) + (size_t)tokb * KOUT + 768 + part * 256; return c;
    }
    __device__ __forceinline__ void store_dft(const CxDft& c, int r, int col, f32x4 v0, f32x4 v1) const {
        if (c.z1024) { const float sg = (r & 1) ? -0.022097086912079608f : 0.022097086912079608f; const u32x2 z0 = *(const u32x2*)(c.z1024 + col), z1 = *(const u32x2*)(c.z1024 + col + 16);
            v0[0] += sg * bflo(z0.x); v0[1] += sg * bfhi(z0.x); v0[2] += sg * bflo(z0.y); v0[3] += sg * bfhi(z0.y);
            v1[0] += sg * bflo(z1.x); v1[1] += sg * bfhi(z1.x); v1[2] += sg * bflo(z1.y); v1[3] += sg * bfhi(z1.y); }
        bf16_t* p = c.dst + (size_t)r * KOUT + col;
        *(u32x2*)p = pk4(v0); *(u32x2*)(p + 16) = pk4(v1);
    }
    struct CxOut { const float* src; float* dst; const float* gt; };
    __device__ __forceinline__ CxOut prep_out(const Unit& u) const {
        CxOut c; const int tok0 = u.pm * 256, col0 = u.pn * 256;
        if (l == 0) c.src = (tok0 < NLAT ? arg_in(A, I_X) + (size_t)tok0 * D : arg_in(A, I_CTX) + (size_t)(tok0 - NLAT) * D) + col0;
        else c.src = (const float*)(W() + WS_X) + (size_t)tok0 * D + col0;
        c.dst = (float*)(W() + WS_X) + (size_t)tok0 * D + col0;
        c.gt = (const float*)(W() + WS_MOD) + ((size_t)l * 9 + mod_row(tok0)) * 6144 + 2 * 1024 + col0;
        return c;
    }
    __device__ __forceinline__ void store_out(const CxOut& c, int r, int col, f32x4 v0, f32x4 v1) const {
        const size_t o = (size_t)r * D + col;
        const f32x4 g0 = *(const f32x4*)(c.gt + col), g1 = *(const f32x4*)(c.gt + col + 16);
        const f32x4 s0 = *(const f32x4*)(c.src + o), s1 = *(const f32x4*)(c.src + o + 16);
        *(f32x4*)(c.dst + o) = s0 + g0 * v0; *(f32x4*)(c.dst + o + 16) = s1 + g1 * v1;
    }
    __device__ __forceinline__ bf16_t* prep_m1(const Unit& u) const { return (bf16_t*)(W() + WS_HID) + ((size_t)u.ex * RPE + u.pm * 256) * D + u.pn * 128; }
    __device__ __forceinline__ void store_m1(bf16_t* dst, int r, int col, f32x4 v0, f32x4 v1) const {
        f32x4 h;
#pragma unroll
        for (int q = 0; q < 4; ++q) h[q] = siluf_(v0[q]) * v1[q];
        *(u32x2*)(dst + (size_t)r * D + (col >> 5) * 16 + (col & 15)) = pk4(h);
    }
    struct CxM2 { bf16_t* dst; const float* g; };
    __device__ __forceinline__ CxM2 prep_m2(const Unit& u) const { CxM2 c; c.dst = (bf16_t*)(W() + WS_YS) + ((size_t)u.ex * RPE + u.pm * 256) * D + u.pn * 256; c.g = (const float*)(W() + WS_GATEV) + u.ex * RPE + u.pm * 256; return c; }
    __device__ __forceinline__ void store_m2(const CxM2& c, int r, int col, f32x4 v0, f32x4 v1) const {
        const float g = c.g[r];
        bf16_t* p = c.dst + (size_t)r * D + col;
        *(u32x2*)p = pk4(v0 * g); *(u32x2*)(p + 16) = pk4(v1 * g);
    }
#define EPI_WALK(PREP, STORE) do { const auto cx = PREP(u); _Pragma("unroll") for (int ai = 0; ai < 2; ++ai) _Pragma("unroll") for (int m = 0; m < 4; ++m) _Pragma("unroll") for (int bj = 0; bj < 2; ++bj) \
        STORE(cx, ai * 128 + wr * 64 + m * 16 + fr, bj * 128 + wc * 32 + 4 * fq, acc[ai][bj][m][0], acc[ai][bj][m][1]); } while (0)
    __device__ __forceinline__ void run(const f32x4 (&acc)[2][2][4][2], const Unit& u, int wr, int wc, int fr, int fq) const {
        switch (mode) {
        case GM_INPROJ: EPI_WALK(prep_in, store_in); break;
        case GM_DFT: EPI_WALK(prep_dft, store_dft); break;
        case GM_OUT: EPI_WALK(prep_out, store_out); break;
        case GM_MOE1: EPI_WALK(prep_m1, store_m1); break;
        default: EPI_WALK(prep_m2, store_m2); break;
        }
    }
    __device__ __forceinline__ void store1(const Unit& u, int r, int c, f32x4 v0, f32x4 v1) const {
        switch (mode) {
        case GM_INPROJ: store_in(prep_in(u), r, c, v0, v1); break;
        case GM_DFT: store_dft(prep_dft(u), r, c, v0, v1); break;
        case GM_OUT: store_out(prep_out(u), r, c, v0, v1); break;
        case GM_MOE1: store_m1(prep_m1(u), r, c, v0, v1); break;
        default: store_m2(prep_m2(u), r, c, v0, v1); break;
        }
    }
};

__device__ __forceinline__ void scan_simt(Frame& F, int l) {
    if (F.bid >= 64) return;
    const int b = F.bid >> 3, h = (F.bid >> 1) & 3, dir = F.bid & 1;
    LAS float* qs = (LAS float*)F.lds; LAS float* ks = qs + 64 * 132; LAS float* vs = ks + 64 * 132; LAS float* st = vs + 64 * 132;
    LAS float* sm = st + 64 * 65;
    LAS float* as_ = sm; LAS float* Ms = sm + 64; LAS float* wint = sm + 128; LAS float* enm = sm + 192; LAS float* wst = sm + 256; LAS float* denom = sm + 320;
    LAS float* nvec = sm + 384; LAS float* ig = sm + 512; LAS float* lf = sm + 576; LAS int* toks = (LAS int*)(sm + 640); LAS float* scal = sm + 704;
    const bf16_t* Q = WSP(bf16_t, WS_Q); const bf16_t* K = WSP(bf16_t, WS_K); const bf16_t* V = WSP(bf16_t, WS_V); const float* GATES = WSP(float, WS_GATES);
    bf16_t* H = dir ? WSP(bf16_t, WS_HB) : WSP(bf16_t, WS_HF);
    float Creg[32];
#pragma unroll
    for (int i = 0; i < 32; ++i) Creg[i] = 0.f;
    float m_st = 0.f;
    if (F.tid < 128) nvec[F.tid] = 0.f;
    __syncthreads();
    for (int cc = 0; cc < 36; ++cc) {
        int tid = F.tid; asm volatile("" : "+v"(tid));
        const int lane = tid & 63, e = tid >> 2, dq = tid & 3;
        const bool isctx = cc < 4;
        const int c = isctx ? (dir ? 3 - cc : cc) : (dir ? 35 - cc : cc - 4);
        const bool want_out = !(isctx && l == 1);
        if (tid < 64) { const int j = tid;
            const int tok = isctx ? NLAT + b * CTXL + c * 64 + j : (h < 2 ? b * SEQ + c * 64 + j : b * SEQ + (j & 31) * 64 + 2 * c + (j >> 5));
            toks[j] = tok; const float* g = GATES + (size_t)tok * 16 + h * 4 + 2 * dir; ig[j] = g[0]; lf[j] = logsigmoidf_(g[1]); }
        __syncthreads();
        for (int it = tid; it < 1024; it += NTHR) { const int j = it >> 4, c8 = (it & 15) * 8; const size_t o = (size_t)toks[j] * 512 + h * 128 + c8;
            const u32x4 qv = *(const u32x4*)(Q + o), kv = *(const u32x4*)(K + o), vv = *(const u32x4*)(V + o);
#pragma unroll
            for (int q = 0; q < 4; ++q) { qs[j * 132 + c8 + 2 * q] = bflo(qv[q]); qs[j * 132 + c8 + 2 * q + 1] = bfhi(qv[q]); ks[j * 132 + c8 + 2 * q] = bflo(kv[q]); ks[j * 132 + c8 + 2 * q + 1] = bfhi(kv[q]);
                vs[j * 132 + c8 + 2 * q] = bflo(vv[q]); vs[j * 132 + c8 + 2 * q + 1] = bfhi(vv[q]); } }
        if (F.wave == 0) {
            const int p = dir ? 63 - lane : lane;
            float x = lf[p];
#pragma unroll
            for (int o = 1; o < 64; o <<= 1) { const float y = __shfl_up(x, o); if (lane >= o) x += y; }
            const float a = ig[p] - x; float cm = a;
#pragma unroll
            for (int o = 1; o < 64; o <<= 1) { const float y = __shfl_up(cm, o); if (lane >= o) cm = fmaxf(cm, y); }
            const float M = fmaxf(m_st, cm), Mend = __shfl(M, 63), blast = __shfl(x, 63);
            as_[p] = a; Ms[p] = M; wint[p] = expf(m_st - M); enm[p] = expf(-(x + M)); wst[p] = expf(a - Mend);
            if (lane == 0) { scal[0] = Mend; scal[1] = blast; }
        }
        __syncthreads();
        const float Mend = scal[0], blast = scal[1], decay = expf(m_st - Mend);
        if (want_out) {
            { const int t = tid >> 3, sg = tid & 7; float sacc[8];
#pragma unroll
                for (int i = 0; i < 8; ++i) sacc[i] = 0.f;
                for (int d4 = 0; d4 < 32; ++d4) { const f32x4 q4 = *(const LAS f32x4*)(qs + t * 132 + d4 * 4);
#pragma unroll
                    for (int i = 0; i < 8; ++i) { const f32x4 k4 = *(const LAS f32x4*)(ks + (i * 8 + sg) * 132 + d4 * 4); sacc[i] += (q4[0] * k4[0] + q4[1] * k4[1]) + (q4[2] * k4[2] + q4[3] * k4[3]); } }
#pragma unroll
                for (int i = 0; i < 8; ++i) { const int s = i * 8 + sg; const bool valid = dir ? (s >= t) : (s <= t); st[t * 65 + s] = valid ? sacc[i] * expf(as_[s] - Ms[t]) : 0.f; } }
            __syncthreads();
            if (tid < 64) { const int t = tid; float qn = 0.f, ssum = 0.f;
                for (int d = 0; d < 128; ++d) qn += qs[t * 132 + d] * nvec[d];
                for (int s = 0; s < 64; ++s) ssum += st[t * 65 + s];
                const float den = wint[t] * qn + ssum; denom[t] = fmaxf(fabsf(den), enm[t]); }
            float mine[16];
#pragma unroll
            for (int tt = 0; tt < 16; ++tt) {
                mine[tt] = 0.f;
#pragma unroll
                for (int u = 0; u < 4; ++u) { const int t = 4 * tt + u; float p = 0.f;
#pragma unroll
                    for (int i4 = 0; i4 < 8; ++i4) { const f32x4 q4 = *(const LAS f32x4*)(qs + t * 132 + dq * 32 + i4 * 4); p += (Creg[4 * i4] * q4[0] + Creg[4 * i4 + 1] * q4[1]) + (Creg[4 * i4 + 2] * q4[2] + Creg[4 * i4 + 3] * q4[3]); }
                    p += __shfl_xor(p, 1); p += __shfl_xor(p, 2);
                    mine[tt] = (u == dq) ? p : mine[tt]; asm volatile("" ::: "memory"); }
            }
#pragma unroll
            for (int tt = 0; tt < 16; ++tt) { const int t = 4 * tt + dq; float intra = 0.f;
#pragma unroll 8
                for (int s = 0; s < 64; ++s) intra += st[t * 65 + s] * vs[s * 132 + e];
                mine[tt] = wint[t] * mine[tt] + intra; asm volatile("" ::: "memory"); }
            __syncthreads();
#pragma unroll
            for (int tt = 0; tt < 16; ++tt) { const int t = 4 * tt + dq; H[(size_t)toks[t] * 512 + h * 128 + e] = (bf16_t)f2bf(mine[tt] / denom[t]); }
        }
#pragma unroll
        for (int i = 0; i < 32; ++i) Creg[i] *= decay;
#pragma unroll 2
        for (int s = 0; s < 64; ++s) { const float wv = wst[s] * vs[s * 132 + e];
#pragma unroll
            for (int i4 = 0; i4 < 8; ++i4) { const f32x4 k4 = *(const LAS f32x4*)(ks + s * 132 + dq * 32 + i4 * 4); Creg[4 * i4] += wv * k4[0]; Creg[4 * i4 + 1] += wv * k4[1]; Creg[4 * i4 + 2] += wv * k4[2]; Creg[4 * i4 + 3] += wv * k4[3]; } }
        float nn = 0.f;
        if (tid < 128) { nn = decay * nvec[tid]; for (int s = 0; s < 64; ++s) nn += wst[s] * ks[s * 132 + tid]; }
        __syncthreads();
        if (tid < 128) nvec[tid] = nn;
        m_st = blast + Mend;
        __syncthreads();
    }
}

__device__ __forceinline__ int scan_tok(bool isctx, int b, int h, int c, int j) {
    return isctx ? NLAT + b * CTXL + c * 64 + j : (h < 2 ? b * SEQ + c * 64 + j : b * SEQ + (j & 31) * 64 + 2 * c + (j >> 5));
}
__device__ __forceinline__ int img256(int row, int chunk) { return row * 256 + ((chunk ^ (row & 15)) << 4); }
__device__ __forceinline__ int img128(int row, int chunk) { return row * 128 + ((chunk ^ ((row >> 1) & 7)) << 4); }
__device__ __forceinline__ int off_b(int row, int ch) { return 256 * row + 16 * (ch ^ (((row & 3) << 2) | ((row >> 2) & 3))); }
__device__ __forceinline__ int rowrd16(int lane, int rb, int ks) { return off_b((lane & 15) + 16 * rb, 4 * ks + (lane >> 4)); }
__device__ __forceinline__ int trrd16(int lane, int c, int ks, int t) { const int g = lane >> 4, q = (lane & 15) >> 2, p = lane & 3;
    return off_b(32 * ks + 8 * g + 4 * t + q, 2 * c + (p >> 1)) + 8 * (p & 1); }
typedef short s16x4 __attribute__((ext_vector_type(4)));
__device__ __forceinline__ bf16x8 tr_frag(LAS unsigned char* img, int lane, int c, int ks, unsigned zv) {
    const s16x4 lo = __builtin_amdgcn_ds_read_tr16_b64_v4i16((LAS s16x4*)(img + trrd16(lane, c, ks, 0)));
    const s16x4 hi = __builtin_amdgcn_ds_read_tr16_b64_v4i16((LAS s16x4*)(img + trrd16(lane, c, ks, 1)));
    u32x2 a = __builtin_bit_cast(u32x2, lo), b = __builtin_bit_cast(u32x2, hi);
    a.x ^= zv; a.y ^= zv; b.x ^= zv; b.y ^= zv;
    const u32x4 r = (u32x4){a.x, a.y, b.x, b.y};
    return __builtin_bit_cast(bf16x8, r);
}
__device__ __forceinline__ void scan_mfma(Frame& F, int l) {
    if (F.bid >= 64) return;
    const int b = F.bid >> 3, h = (F.bid >> 1) & 3, dir = F.bid & 1;
    LAS unsigned char* L = F.lds;
    constexpr int O_QI = 0, O_KI = 16384, O_VI = 32768, O_ST = 49152, O_CL = 57344, O_HO = 94208, O_SM = 110592;
    LAS float* GV = (LAS float*)(L + O_SM);
    LAS float* SC = GV + 36 * 192;
    LAS float* DEN = SC + 36 * 4;
    const bf16_t* Q = WSP(bf16_t, WS_Q); const bf16_t* K = WSP(bf16_t, WS_K); const bf16_t* V = WSP(bf16_t, WS_V); const float* GATES = WSP(float, WS_GATES);
    bf16_t* H = dir ? WSP(bf16_t, WS_HB) : WSP(bf16_t, WS_HF);
    const int w = F.wave;
    { unsigned z0 = 0u; asm volatile("" : "+v"(z0));
      for (int i = F.tid; i < 36864 / 16; i += NTHR) *(LAS u32x4*)(L + O_CL + i * 16) = (u32x4){z0, z0, z0, z0}; }
    for (int cc = w; cc < 36; cc += NWAVES) {
        const bool ic = cc < 4; const int c_ = ic ? (dir ? 3 - cc : cc) : (dir ? 35 - cc : cc - 4), p_ = dir ? 63 - F.lane : F.lane;
        const f32x2 g = *(const f32x2*)(GATES + (size_t)scan_tok(ic, b, h, c_, p_) * 16 + h * 4 + 2 * dir);
        float x = logsigmoidf_(g[1]);
#pragma unroll
        for (int o = 1; o < 64; o <<= 1) { const float y = __shfl_up(x, o); if (F.lane >= o) x += y; }
        const float a = g[0] - x; float cm = a;
#pragma unroll
        for (int o = 1; o < 64; o <<= 1) { const float y = __shfl_up(cm, o); if (F.lane >= o) cm = fmaxf(cm, y); }
        GV[cc * 192 + p_] = a; GV[cc * 192 + 64 + p_] = x; GV[cc * 192 + 128 + p_] = cm;
        if (F.lane == 63) { SC[cc * 4 + 3] = x; SC[cc * 4 + 1] = cm; }
    }
    __syncthreads();
    if (F.tid == 0) { float m = 0.f;
        for (int cc = 0; cc < 36; ++cc) { const float Mend = fmaxf(m, SC[cc * 4 + 1]); SC[cc * 4 + 0] = m; SC[cc * 4 + 1] = Mend; SC[cc * 4 + 2] = expf(m - Mend); m = SC[cc * 4 + 3] + Mend; } }
    f32x4 accC[9];
#pragma unroll
    for (int i = 0; i < 9; ++i) accC[i] = (f32x4){0.f, 0.f, 0.f, 0.f};
    u32x4 pq[2], pk[2], pv[2];
#define SC_LOAD(CC) do { const int cc_ = (CC); const bool ic_ = cc_ < 4; const int c_ = ic_ ? (dir ? 3 - cc_ : cc_) : (dir ? 35 - cc_ : cc_ - 4); \
        _Pragma("unroll") for (int i_ = 0; i_ < 2; ++i_) { const int it_ = tid + NTHR * i_, s_ = it_ >> 4, c8_ = it_ & 15; const size_t o_ = (size_t)scan_tok(ic_, b, h, c_, s_) * 512 + h * 128 + c8_ * 8; \
            pq[i_] = *(const u32x4*)(Q + o_); pk[i_] = *(const u32x4*)(K + o_); pv[i_] = *(const u32x4*)(V + o_); } } while (0)
#define SC_WRITE() do { _Pragma("unroll") for (int i_ = 0; i_ < 2; ++i_) { const int it_ = tid + NTHR * i_, s_ = it_ >> 4, c8_ = it_ & 15; \
            *(LAS u32x4*)(L + O_QI + img256(s_, c8_)) = pq[i_]; *(LAS u32x4*)(L + O_KI + off_b(s_, c8_)) = pk[i_]; *(LAS u32x4*)(L + O_VI + off_b(s_, c8_)) = pv[i_]; } } while (0)
#define SC_MFMA(A, B, C) __builtin_amdgcn_mfma_f32_16x16x32_bf16((A), (B), (C), 0, 0, 0)
#define SC_BAR() do { asm volatile("s_waitcnt lgkmcnt(0)" ::: "memory"); __builtin_amdgcn_s_barrier(); asm volatile("" ::: "memory"); } while (0)
    {
        const int tid = F.tid;
        SC_LOAD(0);
        __syncthreads();
        SC_WRITE();
        __syncthreads();
    }
    for (int cc = 0; cc < 36; ++cc) {
        int tid = F.tid; asm volatile("" : "+v"(tid));
        const int lane = tid & 63, fr = lane & 15, fq = lane >> 4;
        const bool isctx = cc < 4, want_out = !(isctx && l == 1), more = cc + 1 < 36;
        const int c = isctx ? (dir ? 3 - cc : cc) : (dir ? 35 - cc : cc - 4);
        const LAS float* vb = GV + cc * 192; const float m_in = SC[cc * 4 + 0];
        unsigned zv = 0u; asm volatile("" : "+v"(zv));
        const short one_ = (fr == 0) ? (short)0x3F80 : (short)0;
        const bf16x8 ONES = (bf16x8){one_, one_, one_, one_, one_, one_, one_, one_};
        if (more) SC_LOAD(cc + 1);
        if (want_out) {
            const int tb = w >> 1, sb = 2 * (w & 1);
            f32x4 s0 = (f32x4){0.f, 0.f, 0.f, 0.f}, s1 = s0;
#pragma unroll
            for (int ks = 0; ks < 4; ++ks) {
                const bf16x8 fy = *(const LAS bf16x8*)(L + O_QI + img256(tb * 16 + fr, ks * 4 + fq));
                const bf16x8 fx0 = *(const LAS bf16x8*)(L + O_KI + rowrd16(lane, sb, ks)), fx1 = *(const LAS bf16x8*)(L + O_KI + rowrd16(lane, sb + 1, ks));
                s0 = SC_MFMA(fx0, fy, s0); s1 = SC_MFMA(fx1, fy, s1); }
            const int t = tb * 16 + fr; const float Mt = fmaxf(m_in, vb[128 + t]);
#pragma unroll
            for (int i = 0; i < 2; ++i) { const int sr0 = (sb + i) * 16 + 4 * fq; const f32x4 a4 = *(const LAS f32x4*)(vb + sr0); const f32x4 sv = i ? s1 : s0; f32x4 o;
#pragma unroll
                for (int r = 0; r < 4; ++r) { const int sI = sr0 + r; const bool valid = dir ? (sI >= t) : (sI <= t); o[r] = valid ? sv[r] * __expf(a4[r] - Mt) : 0.f; }
                *(LAS u32x2*)(L + O_ST + img128(t, sr0 >> 3) + (sr0 & 7) * 2) = pk4(o); }
        }
        SC_BAR();
        {
            const float decay = SC[cc * 4 + 2], Mend = SC[cc * 4 + 1];
#pragma unroll
            for (int et = 0; et < 9; ++et) accC[et] = accC[et] * decay;
#pragma unroll
            for (int ks = 0; ks < 2; ++ks) {
                const bf16x8 kx = tr_frag(L + O_KI, lane, w, ks, zv);
                const f32x4 a0 = *(const LAS f32x4*)(vb + 32 * ks + 8 * fq), a1 = *(const LAS f32x4*)(vb + 32 * ks + 8 * fq + 4);
                u32x4 ax;
#pragma unroll
                for (int j = 0; j < 4; ++j) { const float w0 = __expf((j < 2 ? a0[2 * j] : a1[2 * j - 4]) - Mend), w1 = __expf((j < 2 ? a0[2 * j + 1] : a1[2 * j - 3]) - Mend);
                    ax[j] = pk2(bf2f((unsigned short)kx[2 * j]) * w0, bf2f((unsigned short)kx[2 * j + 1]) * w1); }
                const bf16x8 axf = __builtin_bit_cast(bf16x8, ax);
#pragma unroll
                for (int et = 0; et < 8; ++et) { const bf16x8 fv = tr_frag(L + O_VI, lane, et, ks, zv); accC[et] = SC_MFMA(axf, fv, accC[et]); }
                accC[8] = SC_MFMA(axf, ONES, accC[8]);
            }
        }
        f32x4 num[4];
        if (want_out) {
            bf16x8 ac[4], av[2];
#pragma unroll
            for (int ks = 0; ks < 4; ++ks) ac[ks] = *(const LAS bf16x8*)(L + O_CL + img256(w * 16 + fr, ks * 4 + fq));
#pragma unroll
            for (int ks = 0; ks < 2; ++ks) av[ks] = tr_frag(L + O_VI, lane, w, ks, zv);
#pragma unroll
            for (int tb = 0; tb < 4; ++tb) {
                f32x4 nI = (f32x4){0.f, 0.f, 0.f, 0.f}, nS = nI;
#pragma unroll
                for (int ks = 0; ks < 4; ++ks) { const bf16x8 fy = *(const LAS bf16x8*)(L + O_QI + img256(tb * 16 + fr, ks * 4 + fq)); nI = SC_MFMA(ac[ks], fy, nI); }
#pragma unroll
                for (int ks = 0; ks < 2; ++ks) { const bf16x8 fs = *(const LAS bf16x8*)(L + O_ST + img128(tb * 16 + fr, ks * 4 + fq)); nS = SC_MFMA(av[ks], fs, nS); }
                num[tb] = nI * __expf(m_in - fmaxf(m_in, vb[128 + tb * 16 + fr])) + nS;
            }
            if (w < 4) {
                f32x4 dI = (f32x4){0.f, 0.f, 0.f, 0.f}, dS = dI;
#pragma unroll
                for (int ks = 0; ks < 4; ++ks) { const bf16x8 a8 = *(const LAS bf16x8*)(L + O_CL + img256(128 + fr, ks * 4 + fq)); const bf16x8 fy = *(const LAS bf16x8*)(L + O_QI + img256(w * 16 + fr, ks * 4 + fq)); dI = SC_MFMA(a8, fy, dI); }
#pragma unroll
                for (int ks = 0; ks < 2; ++ks) { const bf16x8 fs = *(const LAS bf16x8*)(L + O_ST + img128(w * 16 + fr, ks * 4 + fq)); dS = SC_MFMA(ONES, fs, dS); }
                const int t = w * 16 + fr; const float Mt = fmaxf(m_in, vb[128 + t]); const float den = __expf(m_in - Mt) * dI[0] + dS[0];
                if (lane < 16) DEN[t] = fmaxf(fabsf(den), __expf(-(vb[64 + t] + Mt)));
            }
        }
        SC_BAR();
        if (want_out) {
#pragma unroll
            for (int tb = 0; tb < 4; ++tb) { const int t = tb * 16 + fr, e0 = w * 16 + 4 * fq; const float rd = 1.0f / DEN[t];
                *(LAS u32x2*)(L + O_HO + img256(t, e0 >> 3) + (e0 & 7) * 2) = pk4(num[tb] * rd); }
        }
#pragma unroll
        for (int et = 0; et < 9; ++et) { const int d0 = w * 16 + 4 * fq; *(LAS u32x2*)(L + O_CL + img256(et * 16 + fr, d0 >> 3) + (d0 & 7) * 2) = pk4(accC[et]); }
        if (more) SC_WRITE();
        SC_BAR();
        if (want_out) {
            const int t = tid >> 3; bf16_t* hp = H + (size_t)scan_tok(isctx, b, h, c, t) * 512 + h * 128;
#pragma unroll
            for (int i = 0; i < 2; ++i) { const int ch = (tid & 7) * 2 + i; *(u32x4*)(hp + ch * 8) = *(const LAS u32x4*)(L + O_HO + img256(t, ch)); }
        }
    }
#undef SC_LOAD
#undef SC_WRITE
#undef SC_MFMA
#undef SC_BAR
}

__device__ __forceinline__ void helper_barrier(Frame& F, unsigned* cnt, unsigned nhelpers) {
    asm volatile("s_waitcnt vmcnt(0)" ::: "memory");
    __syncthreads();
    if (F.tid == 0) {
        __builtin_amdgcn_fence(__ATOMIC_RELEASE, "agent");
        asm volatile("s_waitcnt vmcnt(0)" ::: "memory");
        __hip_atomic_fetch_add(cnt, 1u, __ATOMIC_RELAXED, __HIP_MEMORY_SCOPE_AGENT);
        unsigned sp = 0;
        while (__hip_atomic_load(cnt, __ATOMIC_RELAXED, __HIP_MEMORY_SCOPE_AGENT) < nhelpers) { __builtin_amdgcn_s_sleep(2); if (++sp > (1u << 22)) break; }
        __builtin_amdgcn_fence(__ATOMIC_ACQUIRE, "agent");
        asm volatile("s_waitcnt vmcnt(0)" ::: "memory");
    }
    __syncthreads();
}

constexpr int NPHASES = 20;
enum { K_PREP = 0, K_NORM1, K_INPROJ, K_MIX1, K_MIX2, K_OUTPROJ, K_NORM2, K_TOPK, K_MOE1, K_MOE2, K_COMBINE };

__global__ void __launch_bounds__(NTHR, 2) fwd_kernel(Args args) {
    extern __shared__ __attribute__((aligned(16))) unsigned char lds_raw[];
    Frame F{(LAS unsigned char*)lds_raw, (int)threadIdx.x, (int)(threadIdx.x & 63), __builtin_amdgcn_readfirstlane((int)(threadIdx.x >> 6)), (int)gridDim.x, (int)blockIdx.x, args.ws, args};
    volatile LAS unsigned* MISC = (volatile LAS unsigned*)(F.lds + LDSCTL_OFF);
    if (F.tid < 16) MISC[F.tid] = 0u;
    __syncthreads();
    XcdBarrier bar; bar.bar = (unsigned*)(F.ws + WS_CTL); bar.x = 0; bar.st = MISC;
    const int lo = args.ph_lo, hi = args.ph_hi;
    if (hi - lo > 1) bar = xcd_barrier_post((unsigned*)(F.ws + WS_CTL), MISC);
    for (int ph = lo; ph < hi; ++ph) {
        int l, kind;
        if (ph == 0) { l = 0; kind = K_PREP; } else if (ph == 1) { l = 0; kind = K_NORM1; } else if (ph < 11) { l = 0; kind = K_INPROJ + (ph - 2); } else { l = 1; kind = K_INPROJ + (ph - 11); }
#ifndef PHMASK
#define PHMASK 0xFFFF
#endif
#define PHON(k) ((PHMASK >> (k)) & 1)
#ifndef REPMASK
#define REPMASK 0
#endif
        int nrep_ = 1 + ((REPMASK >> kind) & 1); asm volatile("" : "+s"(nrep_));
        for (int rep_ = 0; rep_ < nrep_; ++rep_) {
        if (rep_) xcd_barrier(bar);
        { int t_ = threadIdx.x, b_ = blockIdx.x; unsigned char* w_ = args.ws; asm volatile("" : "+v"(t_)); asm volatile("" : "+s"(b_)); asm volatile("" : "+s"(w_));
          F.tid = t_; F.lane = t_ & 63; F.wave = __builtin_amdgcn_readfirstlane(t_ >> 6); F.bid = b_; F.ws = w_; }
        l = __builtin_amdgcn_readfirstlane(l); kind = __builtin_amdgcn_readfirstlane(kind); asm volatile("" : "+s"(l)); asm volatile("" : "+s"(kind));
        unsigned char* ws = F.ws;
        bool run_gemm = (kind == K_INPROJ || kind == K_OUTPROJ || kind == K_MOE1 || kind == K_MOE2);
        int gm = kind == K_INPROJ ? GM_INPROJ : kind == K_OUTPROJ ? GM_OUT : kind == K_MOE1 ? GM_MOE1 : GM_MOE2, gc = F.bid, gG = F.G;
        const bool helper = (kind == K_MIX1) && (F.bid >= 64);
        switch (kind) {
        case K_PREP: if (PHON(0)) phase_prep(F); break;
        case K_NORM1: if (PHON(1)) phase_norm1_l0(F); break;
        case K_MIX1: if (PHON(3)) {
            if (!helper) scan_mfma(F, l);
            else { const int hb = F.bid - 64, hg = F.G - 64;
                conv_items(F, l, hb, hg);
                ztrans_items(F, l, hb * NWAVES + F.wave, hg * NWAVES);
                helper_barrier(F, (unsigned*)(ws + WS_CTL) + 8192 + 64 * l + 64 * 2 * rep_, (unsigned)hg);
                run_gemm = true; gm = GM_DFT; gc = hb; gG = hg; }
        } break;
        case K_MIX2: if (PHON(4)) finalize_h(F, l); break;
        case K_NORM2: if (PHON(6)) phase_norm2(F, l); break;
        case K_TOPK: if (PHON(7)) phase_topk(F, l); break;
        case K_COMBINE: if (PHON(10)) phase_combine(F, l); break;
        default: break;
        }
        if (run_gemm && PHON(2)) {
            GemmCtl S{gm, l, gG, gc, ws, F.A};
            const int ld = gm == GM_OUT ? KOUT : D;
            GEMM_PHASE(F.lds, ld, ld, S, S);
        }
        if (helper && PHON(3)) convert_moe_weights(F, l, (F.bid - 64) * NWAVES + F.wave, (F.G - 64) * NWAVES);
        }
        if (ph + 1 < hi) xcd_barrier(bar);
    }
}

extern "C" void kernel_launch(void* const* d_in, const int* in_sizes, int n_in, void* d_out, int out_size, void* d_ws, size_t ws_size, hipStream_t stream) {
    static int grid = 0;
    if (grid == 0) {
        if (n_in != 21 || out_size != NLAT * D || ws_size < WS_END) { fprintf(stderr, "kernel_launch: unexpected shapes (n_in %d out %d ws %zu need %zu)\n", n_in, out_size, ws_size, (size_t)WS_END); grid = -1; return; }
        int dev = 0, cus = 0, per_cu = 0;
        hipGetDevice(&dev); hipDeviceGetAttribute(&cus, hipDeviceAttributeMultiprocessorCount, dev);
        if (hipFuncSetAttribute((const void*)fwd_kernel, hipFuncAttributeMaxDynamicSharedMemorySize, LDS_BYTES) != hipSuccess) { fprintf(stderr, "kernel_launch: hipFuncSetAttribute failed\n"); grid = -1; return; }
        hipOccupancyMaxActiveBlocksPerMultiprocessor(&per_cu, (const void*)fwd_kernel, NTHR, LDS_BYTES);
        (void)hipGetLastError();
        if (per_cu < 1) fprintf(stderr, "kernel_launch: occupancy query reports %d\n", per_cu);
        grid = cus;
    }
    if (grid < 0) return;
    hipMemsetAsync((char*)d_ws + WS_CTL, 0, 65536, stream);
    Args a{};
    for (int i = 0; i < 21; ++i) a.in[i] = (const float*)d_in[i];
    a.out = (float*)d_out; a.ws = (unsigned char*)d_ws;
#if N_LAUNCHES == 1
    a.ph_lo = 0; a.ph_hi = NPHASES;
    void* kargs[] = {&a};
    hipError_t e = hipLaunchCooperativeKernel((const void*)fwd_kernel, dim3(grid), dim3(NTHR), kargs, LDS_BYTES, stream);
    if (e != hipSuccess) fprintf(stderr, "kernel_launch: cooperative launch failed: %s (grid %d)\n", hipGetErrorString(e), grid);
#else
#ifndef MAXPH
#define MAXPH NPHASES
#endif
    for (int ph = 0; ph < MAXPH; ++ph) { a.ph_lo = ph; a.ph_hi = ph + 1; hipLaunchKernelGGL(fwd_kernel, dim3(grid), dim3(NTHR), LDS_BYTES, stream, a); }
#endif
}
```

```cpp
#include <hip/hip_runtime.h>
#include <cstdio>
#include <cstdint>

#ifndef N_LAUNCHES
#define N_LAUNCHES 1
#endif
#define OLD_REDUCE 1
#ifndef USE_MFMA_GEMM
#define USE_MFMA_GEMM 1
#endif

#define LAS __attribute__((address_space(3)))
#define GAS __attribute__((address_space(1)))
typedef unsigned short bf16_t;
typedef short bf16x8 __attribute__((ext_vector_type(8)));
typedef float f32x4 __attribute__((ext_vector_type(4)));
typedef float f32x2 __attribute__((ext_vector_type(2)));
typedef unsigned u32x4 __attribute__((ext_vector_type(4)));
typedef unsigned u32x2 __attribute__((ext_vector_type(2)));
typedef GAS unsigned gu32;
#define RLX_AGENT __ATOMIC_RELAXED, __HIP_MEMORY_SCOPE_AGENT
#define LDS_WAIT() asm volatile("s_waitcnt lgkmcnt(0)" ::: "memory")
#define VM_WAIT() asm volatile("s_waitcnt vmcnt(0)" ::: "memory")

constexpr int D = 1024, NB = 8, SEQ = 2048, CTXL = 256;
constexpr int NLAT = NB * SEQ, NCTX = NB * CTXL, NTOK = NLAT + NCTX;
constexpr int INC = 2832, NIN = 2816;
constexpr int KOUT = 1280;
constexpr int NE = 16, RPE = 2304;
constexpr float EPS = 1e-6f;
constexpr int NTHR = 512, NWAVES = 8;

constexpr size_t al256(size_t x) { return (x + 255) & ~(size_t)255; }
constexpr size_t WS_CTL = 0;
constexpr size_t WS_MOD = WS_CTL + 65536;
constexpr size_t WS_WIN = WS_MOD + al256((size_t)2 * 9 * 6144 * 4);
constexpr size_t WS_WOUT = WS_WIN + (size_t)2 * NIN * D * 2;
constexpr size_t WS_WGU = WS_WOUT + (size_t)2 * D * KOUT * 2;
constexpr size_t WS_WD = WS_WGU + (size_t)NE * 2048 * D * 2;
constexpr size_t WS_FL = WS_WD + (size_t)NE * D * D * 2;
constexpr size_t WS_FC = WS_FL + (size_t)4096 * 1024 * 2;
constexpr size_t WS_X = WS_FL + (size_t)4096 * 2048 * 2 + (size_t)512 * 2048 * 2;
constexpr size_t WS_XN = WS_X + (size_t)NTOK * D * 4;
constexpr size_t WS_GATES = WS_XN + (size_t)NTOK * D * 2;
constexpr size_t WS_AFF = WS_GATES + (size_t)NTOK * 16 * 4;
constexpr size_t WS_INV = WS_AFF + (size_t)NTOK * 16 * 4;
constexpr size_t WS_ROWTOK = WS_INV + (size_t)NTOK * 16 * 4;
constexpr size_t WS_GATEV = WS_ROWTOK + (size_t)NE * RPE * 4;
constexpr size_t WS_R1 = WS_GATEV + (size_t)NE * RPE * 4;
constexpr size_t SZ_QKV = (size_t)NTOK * 512 * 2;
constexpr size_t WS_Q = WS_R1, WS_K = WS_Q + SZ_QKV, WS_V = WS_K + SZ_QKV, WS_O = WS_V + SZ_QKV;
constexpr size_t WS_HID = WS_R1;
constexpr size_t WS_R2 = WS_R1 + 4 * SZ_QKV;
constexpr size_t SZ_C = (size_t)NTOK * 256 * 2;
constexpr size_t WS_CA = WS_R2, WS_CG = WS_CA + SZ_C, WS_FR = WS_CG + SZ_C, WS_ZT = WS_FR + SZ_C;
constexpr size_t WS_ZO = WS_ZT + (size_t)2048 * 1024 * 2;
constexpr size_t WS_ZTC = WS_ZT + (size_t)2048 * 2048 * 2;
constexpr size_t WS_HF = WS_ZT + 2 * (size_t)2048 * 2048 * 2, WS_HB = WS_HF + SZ_QKV, WS_Y = WS_HB + SZ_QKV;
constexpr size_t WS_YS = WS_R2;
constexpr size_t WS_END = WS_Y + (size_t)NTOK * KOUT * 2;
static_assert((size_t)NE * RPE * D * 2 <= 4 * SZ_QKV, "HID alias");
static_assert(WS_YS + (size_t)NE * RPE * D * 2 <= WS_END, "YS alias");

constexpr int RING_BYTES = 139264;
constexpr int LDSCTL_OFF = RING_BYTES;
constexpr int LDS_BYTES = RING_BYTES + 1024;

__device__ __forceinline__ unsigned f2bf(float f) { unsigned u = __float_as_uint(f); u += 0x7FFFu + ((u >> 16) & 1u); return u >> 16; }
typedef __bf16 bf16x2_t __attribute__((ext_vector_type(2)));
__device__ __forceinline__ unsigned pk2(float lo, float hi) { const bf16x2_t r = __builtin_convertvector((f32x2){lo, hi}, bf16x2_t); return __builtin_bit_cast(unsigned, r); }
__device__ __forceinline__ float bf2f(unsigned b) { return __uint_as_float(b << 16); }
__device__ __forceinline__ float bflo(unsigned w) { return __uint_as_float(w << 16); }
__device__ __forceinline__ float bfhi(unsigned w) { return __uint_as_float(w & 0xffff0000u); }
__device__ __forceinline__ float sigmoidf_(float x) { return __builtin_amdgcn_rcpf(1.0f + __expf(-x)); }
__device__ __forceinline__ float siluf_(float x) { return x * __builtin_amdgcn_rcpf(1.0f + __expf(-x)); }
__device__ __forceinline__ float logsigmoidf_(float x) { return x >= 0.f ? -log1pf(expf(-x)) : x - log1pf(expf(x)); }
__device__ __forceinline__ float wave_sum(float v) {
#pragma unroll
    for (int o = 1; o < 64; o <<= 1) v += __shfl_xor(v, o);
    return v;
}
__device__ __forceinline__ u32x2 pk4(f32x4 v) { u32x2 w; w.x = pk2(v[0], v[1]); w.y = pk2(v[2], v[3]); return w; }

#define XB_TMO      128
#define XB_XCNT(j)  (256  + 64 * (j))
#define XB_XSUB(j)  (1280 + 64 * (j))
#define XB_XGEN(j)  (2304 + 64 * (j))
#define XB_TOP      3328
#define XB_TOPGEN   3392
#define XCD_BAR_WORDS 3456
#define XB_SPIN_CAP (1u << 22)
__device__ __forceinline__ unsigned xb_ld(unsigned* p)              { return __hip_atomic_load(p, __ATOMIC_RELAXED, __HIP_MEMORY_SCOPE_AGENT); }
__device__ __forceinline__ unsigned xb_add(unsigned* p, unsigned v) { return __hip_atomic_fetch_add(p, v, __ATOMIC_RELAXED, __HIP_MEMORY_SCOPE_AGENT); }
__device__ __forceinline__ unsigned xb_xcc_id() { return (unsigned)__builtin_amdgcn_s_getreg((3 << 11) | 20) & 0xFu; }
#define XB_SPIN(cond, bar) do { unsigned _sp = 0; while (cond) { __builtin_amdgcn_s_sleep(1); \
    if ((++_sp & 255u) == 0u) { if (xb_ld(&(bar)[XB_TMO])) break; if (_sp > XB_SPIN_CAP) { atomicAdd(&(bar)[XB_TMO], 1u); break; } } } } while (0)
struct XcdBarrier { unsigned* bar; unsigned x; volatile LAS unsigned* st; };
__device__ __forceinline__ XcdBarrier xcd_barrier_post(unsigned* bar, volatile LAS unsigned* st) {
    XcdBarrier b; b.bar = bar; b.x = xb_xcc_id(); b.st = st;
    if (threadIdx.x == 0) (void)xb_add(&bar[XB_XCNT(b.x)], 1u);
    return b;
}
__device__ __forceinline__ void xcd_barrier_complete(unsigned* bar, unsigned x, unsigned& nloc, unsigned& nx) {
    const unsigned G = gridDim.x * gridDim.y * gridDim.z;
    unsigned sum, cnt, mine, sp = 0u;
    for (;;) {
        sum = 0u; cnt = 0u; mine = 0u;
#pragma unroll
        for (unsigned j = 0; j < 16; ++j) { const unsigned c = xb_ld(&bar[XB_XCNT(j)]); sum += c; cnt += (c > 0u) ? 1u : 0u; mine = (j == x) ? c : mine; }
        if (sum == G) break;
        __builtin_amdgcn_s_sleep(1);
        if ((++sp & 255u) == 0u) { if (xb_ld(&bar[XB_TMO])) break; if (sp > XB_SPIN_CAP) { atomicAdd(&bar[XB_TMO], 1u); break; } }
    }
    nloc = mine > 0u ? mine : 1u; nx = cnt > 0u ? cnt : 1u;
}
__device__ __forceinline__ void xcd_barrier(const XcdBarrier& b) {
    asm volatile("s_waitcnt vmcnt(0)" ::: "memory");
    __syncthreads();
    if (threadIdx.x == 0) {
        unsigned* bar = b.bar;
        __builtin_amdgcn_s_waitcnt(0);
        unsigned nloc = b.st[0], nx = b.st[1];
        if (nloc == 0u) { xcd_barrier_complete(bar, b.x, nloc, nx); b.st[0] = nloc; b.st[1] = nx; }
        const unsigned old = xb_add(&bar[XB_XSUB(b.x)], 1u);
        const unsigned gen = old / nloc;
        if (old + 1u == (gen + 1u) * nloc) {
            __builtin_amdgcn_fence(__ATOMIC_RELEASE, "agent");
            asm volatile("s_waitcnt vmcnt(0)" ::: "memory");
            const unsigned og = xb_add(&bar[XB_TOP], 1u);
            const unsigned tg = og / nx;
            if (og + 1u == (tg + 1u) * nx) xb_add(&bar[XB_TOPGEN], 1u);
            else XB_SPIN(xb_ld(&bar[XB_TOPGEN]) == tg, bar);
            __builtin_amdgcn_fence(__ATOMIC_ACQUIRE, "agent");
            xb_add(&bar[XB_XGEN(b.x)], 1u);
            asm volatile("s_waitcnt vmcnt(0)" ::: "memory");
        } else {
            XB_SPIN(xb_ld(&bar[XB_XGEN(b.x)]) == gen, bar);
            __builtin_amdgcn_fence(__ATOMIC_ACQUIRE, "agent");
            asm volatile("s_waitcnt vmcnt(0)" ::: "memory");
        }
    }
    __syncthreads();
}

namespace pg8 {
constexpr int BM = 256, BK = 64, HALF = 128, HTB = HALF * BK * 2, STAGE_BYTES = 8 * HTB, NXCD = 8, WGM = 8;
__host__ __device__ __forceinline__ int lds_byte(int r, int c) { const int st = (r >> 4) * 2 + (c >> 5), rr = r & 15, cc = c & 31, ob = rr * 64 + cc * 2; return st * 1024 + (ob ^ (((ob >> 9) & 1) << 5)); }
__host__ __device__ __forceinline__ void stage_rc(int b, int& R, int& C) { const int st = b / 1024, sb = b % 1024, swz = sb ^ (((sb >> 9) & 1) << 5); R = (st >> 1) * 16 + swz / 64; C = (st & 1) * 32 + (swz % 64) / 2; }

struct Unit { const char* A; const char* B; const int* rows; int K, pm, pn, ex; };

__device__ __forceinline__ void map_tile(int L, int nM, int nN, int& pm, int& pn) {
    const int nwg = nM * nN; int wgid = L;
    { const int q = nwg / NXCD, r = nwg % NXCD, xcd = wgid % NXCD, off = wgid / NXCD; wgid = (xcd < r ? xcd * (q + 1) : r * (q + 1) + (xcd - r) * q) + off; }
    const int nig = WGM * nN, gid = wgid / nig, fm = gid * WGM, gsz = (nM - fm) < WGM ? (nM - fm) : WGM;
    pm = fm + ((wgid % nig) % gsz); pn = (wgid % nig) / gsz;
}
__device__ __forceinline__ void a_offs(const Unit& u, int lda, int tid, unsigned (&vA)[2][2]) {
#pragma unroll
    for (int h = 0; h < 2; ++h)
#pragma unroll
        for (int i = 0; i < 2; ++i) { int R, C; stage_rc(tid * 16 + i * 8192, R, C); const int r = h * HALF + R; const int ar = u.rows ? u.rows[r] : r; vA[h][i] = (unsigned)(ar * lda + C) * 2u; }
}

template <class Epi, class Sched>
__device__ __forceinline__ void gemm_phase(LAS unsigned char* lds, const int tid, const int lda, const int ldb, const Sched& S, const Epi& E) {
    const int wid = __builtin_amdgcn_readfirstlane(tid >> 6), lane = tid & 63, wr = wid >> 2, wc = wid & 3, fr = lane & 15, fq = lane >> 4;
    unsigned voffB[2];
#pragma unroll
    for (int i = 0; i < 2; ++i) { int R, C; stage_rc(tid * 16 + i * 8192, R, C); voffB[i] = (unsigned)(R * ldb + C) * 2u; }
    const size_t kstep = (size_t)(BK * 2);
    const size_t hsB = (size_t)HALF * ldb * 2;
    const unsigned ldsw = (unsigned)wid * 1024u;
    const int aoff = lds_byte(wr * 64 + fr, fq * 8), boff = lds_byte(wc * 32 + fr, fq * 8);
#define PG8_SA(b, h) (((b) * 2 + (h)) * HTB)
#define PG8_SB(b, h) ((4 + (b) * 2 + (h)) * HTB)
#define PG8_STAGE(bufoff, gbase, voff) do { _Pragma("unroll") for (int _i = 0; _i < 2; ++_i) \
        __builtin_amdgcn_global_load_lds((const unsigned*)((const char*)(gbase) + (voff)[_i]), (LAS unsigned*)(lds + (bufoff) + ldsw + _i * 8192), 16, 0, 0); } while (0)
#define PG8_LDA(dst, b, h) do { _Pragma("unroll") for (int m = 0; m < 4; ++m) _Pragma("unroll") for (int k = 0; k < 2; ++k) dst[m][k] = *(const LAS bf16x8*)(lds + PG8_SA(b, h) + aoff + m * 2048 + k * 1024); } while (0)
#define PG8_LDB(dst, b, h) do { _Pragma("unroll") for (int n = 0; n < 2; ++n) _Pragma("unroll") for (int k = 0; k < 2; ++k) dst[n][k] = *(const LAS bf16x8*)(lds + PG8_SB(b, h) + boff + n * 2048 + k * 1024); } while (0)
#define PG8_MMA(ai, bj, At, Bt) do { __builtin_amdgcn_s_setprio(1); _Pragma("unroll") for (int m = 0; m < 4; ++m) _Pragma("unroll") for (int n = 0; n < 2; ++n) _Pragma("unroll") for (int k = 0; k < 2; ++k) \
        acc[ai][bj][m][n] = __builtin_amdgcn_mfma_f32_16x16x32_bf16(Bt[n][k], At[m][k], acc[ai][bj][m][n], 0, 0, 0); __builtin_amdgcn_s_setprio(0); } while (0)
#define PG8_WAIT_V(n) asm volatile("s_waitcnt vmcnt(" #n ")" ::: "memory")
#define PG8_WAIT_L(n) asm volatile("s_waitcnt lgkmcnt(" #n ")" ::: "memory")
#define PG8_BAR __builtin_amdgcn_s_barrier()
#define PG8_SCHED __builtin_amdgcn_sched_barrier(0)
    Unit cur, nxt; int ui = 0;
    if (!S.next(0, cur)) return;
    f32x4 acc[2][2][4][2];
#pragma unroll
    for (int a = 0; a < 2; ++a)
#pragma unroll
        for (int b = 0; b < 2; ++b)
#pragma unroll
            for (int m = 0; m < 4; ++m)
#pragma unroll
                for (int n = 0; n < 2; ++n) acc[a][b][m][n] = (f32x4){0.f, 0.f, 0.f, 0.f};
    bf16x8 At[4][2], B0[2][2], B1[2][2];
    unsigned vA[2][2], wA[2][2];
    a_offs(cur, lda, tid, vA);
    const char* cA = cur.A; const char* cB = cur.B;
    PG8_STAGE(PG8_SB(0, 0), cB, voffB); PG8_STAGE(PG8_SB(0, 1), cB + hsB, voffB); PG8_STAGE(PG8_SA(0, 0), cA, vA[0]); PG8_STAGE(PG8_SA(0, 1), cA, vA[1]);
    if (wr == 1) PG8_BAR;
    PG8_WAIT_V(2); PG8_BAR;
    PG8_STAGE(PG8_SB(1, 0), cB + kstep, voffB); PG8_STAGE(PG8_SA(1, 0), cA + kstep, vA[0]); PG8_STAGE(PG8_SB(1, 1), cB + hsB + kstep, voffB);
    PG8_WAIT_V(6); PG8_BAR;
    for (;;) {
        const bool has_next = S.next(ui + 1, nxt);
        if (!has_next) nxt = cur;
        const char* nA = nxt.A; const char* nB = nxt.B;
        a_offs(nxt, lda, tid, wA);
        const int nt = cur.K / BK;
        asm volatile(".p2align 8" ::: "memory");
        for (int t = 0; t < nt; t += 2) {
            const bool last = (t == nt - 2);
            const char* a1 = cA + (size_t)(t + 1) * kstep;
            const char* a2 = last ? nA : cA + (size_t)(t + 2) * kstep; const char* b2 = last ? nB : cB + (size_t)(t + 2) * kstep;
            const char* a3 = a2 + kstep; const char* b3 = b2 + kstep;
            PG8_LDB(B0, 0, 0); PG8_LDB(B1, 0, 1); PG8_SCHED; PG8_LDA(At, 0, 0); PG8_STAGE(PG8_SA(1, 1), a1, vA[1]);
            if (last) {
#pragma unroll
                for (int h = 0; h < 2; ++h)
#pragma unroll
                    for (int i = 0; i < 2; ++i) vA[h][i] = wA[h][i];
            }
            PG8_WAIT_V(8); PG8_WAIT_L(0); PG8_BAR; PG8_MMA(0, 0, At, B0); PG8_MMA(0, 1, At, B1); PG8_BAR; PG8_SCHED;
            PG8_LDA(At, 0, 1); PG8_STAGE(PG8_SB(0, 0), b2, voffB); PG8_STAGE(PG8_SB(0, 1), b2 + hsB, voffB); PG8_STAGE(PG8_SA(0, 0), a2, vA[0]);
            PG8_WAIT_V(8); PG8_WAIT_L(0); PG8_BAR; PG8_MMA(1, 0, At, B0); PG8_MMA(1, 1, At, B1); PG8_BAR; PG8_SCHED;
            PG8_LDB(B0, 1, 0); PG8_LDB(B1, 1, 1); PG8_SCHED; PG8_LDA(At, 1, 0); PG8_STAGE(PG8_SA(0, 1), a2, vA[1]);
            PG8_WAIT_V(8); PG8_WAIT_L(0); PG8_BAR; PG8_MMA(0, 0, At, B0); PG8_MMA(0, 1, At, B1); PG8_BAR; PG8_SCHED;
            PG8_LDA(At, 1, 1); PG8_STAGE(PG8_SB(1, 0), b3, voffB); PG8_STAGE(PG8_SB(1, 1), b3 + hsB, voffB); PG8_STAGE(PG8_SA(1, 0), a3, vA[0]);
            PG8_WAIT_V(8); PG8_WAIT_L(0); PG8_BAR; PG8_MMA(1, 0, At, B0); PG8_MMA(1, 1, At, B1); PG8_BAR; PG8_SCHED;
        }
        if (wr == 0) PG8_BAR;
        { int fr_ = fr, fq_ = fq; asm volatile("" : "+v"(fr_), "+v"(fq_));
          E.run(acc, cur, wr, wc, fr_, fq_); }
        if (!has_next) break;
#pragma unroll
        for (int a = 0; a < 2; ++a)
#pragma unroll
            for (int b = 0; b < 2; ++b)
#pragma unroll
                for (int m = 0; m < 4; ++m)
#pragma unroll
                    for (int n = 0; n < 2; ++n) acc[a][b][m][n] = (f32x4){0.f, 0.f, 0.f, 0.f};
        cur = nxt; cA = nA; cB = nB; ++ui;
        if (wr == 1) PG8_BAR;
    }
    PG8_WAIT_V(0);
    PG8_BAR;
#undef PG8_SA
#undef PG8_SB
#undef PG8_STAGE
#undef PG8_LDA
#undef PG8_LDB
#undef PG8_MMA
#undef PG8_WAIT_V
#undef PG8_WAIT_L
#undef PG8_BAR
#undef PG8_SCHED
}
template <class Epi, class Sched>
__device__ __forceinline__ void gemm_phase_simt(LAS unsigned char* lds, const int tid, const int lda, const int ldb, const Sched& S, const Epi& E) {
    LAS float* As = (LAS float*)lds;
    LAS float* Bs = (LAS float*)(lds + 32 * 132 * 4);
    const int ty = tid >> 4, tx = tid & 15, c0 = (tx >> 2) * 32 + (tx & 3) * 4;
    const int lr = tid >> 2, lk = (tid & 3) * 8;
    Unit u;
    for (int ui = 0; S.next(ui, u); ++ui) {
        for (int sub = 0; sub < 4; ++sub) {
            const int sr = sub >> 1, sc = sub & 1;
            float acc[4][8];
#pragma unroll
            for (int i = 0; i < 4; ++i)
#pragma unroll
                for (int j = 0; j < 8; ++j) acc[i][j] = 0.f;
            const int arow = sr * 128 + lr, brow = sc * 128 + lr;
            const int ar = u.rows ? u.rows[arow] : arow;
            const bf16_t* ap = (const bf16_t*)u.A + (size_t)ar * lda + lk;
            const bf16_t* bp = (const bf16_t*)u.B + (size_t)brow * ldb + lk;
            for (int k0 = 0; k0 < u.K; k0 += 32) {
                const u32x4 av = *(const u32x4*)(ap + k0), bv = *(const u32x4*)(bp + k0);
                __syncthreads();
#pragma unroll
                for (int j = 0; j < 4; ++j) {
                    As[(lk + 2 * j) * 132 + lr] = bflo(av[j]); As[(lk + 2 * j + 1) * 132 + lr] = bfhi(av[j]);
                    Bs[(lk + 2 * j) * 132 + lr] = bflo(bv[j]); Bs[(lk + 2 * j + 1) * 132 + lr] = bfhi(bv[j]);
                }
                __syncthreads();
#pragma unroll 4
                for (int k = 0; k < 32; ++k) {
                    const f32x4 a4 = *(const LAS f32x4*)(As + k * 132 + ty * 4);
                    const f32x4 b0 = *(const LAS f32x4*)(Bs + k * 132 + c0), b1 = *(const LAS f32x4*)(Bs + k * 132 + c0 + 16);
#pragma unroll
                    for (int i = 0; i < 4; ++i)
#pragma unroll
                        for (int j = 0; j < 4; ++j) { acc[i][j] += a4[i] * b0[j]; acc[i][4 + j] += a4[i] * b1[j]; }
                }
            }
#pragma unroll
            for (int i = 0; i < 4; ++i)
                E.store1(u, sr * 128 + ty * 4 + i, sc * 128 + c0, (f32x4){acc[i][0], acc[i][1], acc[i][2], acc[i][3]}, (f32x4){acc[i][4], acc[i][5], acc[i][6], acc[i][7]});
        }
    }
    __syncthreads();
}
}

#if USE_MFMA_GEMM
#define GEMM_PHASE(lds, lda, ldb, S, E) pg8::gemm_phase(lds, F.tid, lda, ldb, S, E)
#else
#define GEMM_PHASE(lds, lda, ldb, S, E) pg8::gemm_phase_simt(lds, F.tid, lda, ldb, S, E)
#endif

struct Args { const float* in[21]; float* out; unsigned char* ws; int ph_lo, ph_hi; };
enum { I_X = 0, I_C, I_CTX, I_CCTX, I_WADA, I_BADA, I_GN1, I_WIN, I_BG, I_GH, I_CW, I_CB, I_CLG, I_CLB, I_WOUT, I_GN2, I_WR, I_WEG, I_WEU, I_WED, I_GF };
__device__ __forceinline__ const float* arg_in(const Args& a, int i) { asm volatile("" : "+s"(i)); return a.in[i]; }
struct Frame {
    LAS unsigned char* lds;
    int tid, lane, wave, G, bid;
    unsigned char* ws;
    const Args& A;
};
#define FIN(i) arg_in(F.A, (i))
#define WSP(T, off) ((T*)(F.ws + (off)))

template <class Src>
__device__ __forceinline__ void tr_item(const Src& src, bf16_t* dst, int ldd, int n0, int k0, LAS float* scr, int lane) {
    f32x4 v[8];
#pragma unroll
    for (int i = 0; i < 8; ++i) v[i] = src.ld4(k0 + i * 8 + (lane >> 3), n0 + (lane & 7) * 4);
#pragma unroll
    for (int i = 0; i < 8; ++i) { LAS float* p = scr + (i * 8 + (lane >> 3)) * 33 + (lane & 7) * 4; p[0] = v[i][0]; p[1] = v[i][1]; p[2] = v[i][2]; p[3] = v[i][3]; }
    LDS_WAIT(); asm volatile("" ::: "memory");
    const int c = lane & 7;
#pragma unroll
    for (int j = 0; j < 4; ++j) { const int n = (lane >> 3) + 8 * j; const LAS float* s = scr + (8 * c) * 33 + n;
        u32x4 o; o.x = pk2(s[0 * 33], s[1 * 33]); o.y = pk2(s[2 * 33], s[3 * 33]); o.z = pk2(s[4 * 33], s[5 * 33]); o.w = pk2(s[6 * 33], s[7 * 33]);
        *(u32x4*)(dst + (size_t)(n0 + n) * ldd + k0 + 8 * c) = o; }
    LDS_WAIT(); asm volatile("" ::: "memory");
}
struct SrcWin { const float* w; __device__ __forceinline__ f32x4 ld4(int k, int n) const { return *(const f32x4*)(w + (size_t)k * INC + (n < 1536 ? n : n + 16)); } };
struct SrcPlain { const float* w; int ld; __device__ __forceinline__ f32x4 ld4(int k, int n) const { return *(const f32x4*)(w + (size_t)k * ld + n); } };
struct SrcGU { const float* wg; const float* wu; __device__ __forceinline__ f32x4 ld4(int k, int n) const { const int grp = n >> 5, i = n & 31;
    const uintptr_t base = (uintptr_t)wg + ((i < 16) ? (uintptr_t)0 : ((uintptr_t)wu - (uintptr_t)wg));
    return *(const f32x4*)((const float*)base + (size_t)k * D + grp * 16 + (i & 15)); } };

__device__ __forceinline__ void tr_store(const f32x4 (&v)[8], bf16_t* dst, int ldd, int n0, int k0, LAS float* scr, int lane) {
#pragma unroll
    for (int i = 0; i < 8; ++i) { LAS float* p = scr + (i * 8 + (lane >> 3)) * 33 + (lane & 7) * 4; p[0] = v[i][0]; p[1] = v[i][1]; p[2] = v[i][2]; p[3] = v[i][3]; }
    LDS_WAIT(); asm volatile("" ::: "memory");
    const int c = lane & 7;
#pragma unroll
    for (int j = 0; j < 4; ++j) { const int n = (lane >> 3) + 8 * j; const LAS float* s = scr + (8 * c) * 33 + n;
        u32x4 o; o.x = pk2(s[0 * 33], s[1 * 33]); o.y = pk2(s[2 * 33], s[3 * 33]); o.z = pk2(s[4 * 33], s[5 * 33]); o.w = pk2(s[6 * 33], s[7 * 33]);
        *(u32x4*)(dst + (size_t)(n0 + n) * ldd + k0 + 8 * c) = o; }
    LDS_WAIT(); asm volatile("" ::: "memory");
}
struct MoeItem { bf16_t* dst; int n0, k0; };
__device__ __forceinline__ MoeItem moe_item_load(Frame& F, int l, int it, const float* wg, const float* wu, const float* wd, f32x4 (&v)[8]) {
    constexpr int I_GU = NE * 64 * 16;
    MoeItem m; const int lane = F.lane;
    if (it < I_GU) { const int e = it / 1024, r = it % 1024, sup = r >> 3, wv = r & 7, nb = (sup & 15) * 4 + (wv & 3), kb = (sup >> 4) * 2 + (wv >> 2);
        SrcGU s{wg + ((size_t)l * NE + e) * D * D, wu + ((size_t)l * NE + e) * D * D};
        m.dst = WSP(bf16_t, WS_WGU) + (size_t)e * 2048 * D; m.n0 = nb * 32; m.k0 = kb * 64;
#pragma unroll
        for (int i = 0; i < 8; ++i) v[i] = s.ld4(m.k0 + i * 8 + (lane >> 3), m.n0 + (lane & 7) * 4);
    } else { const int r0 = it - I_GU, e = r0 / 512, r = r0 % 512, sup = r >> 3, wv = r & 7, nb = (sup & 7) * 4 + (wv & 3), kb = (sup >> 3) * 2 + (wv >> 2);
        SrcPlain s{wd + ((size_t)l * NE + e) * D * D, D};
        m.dst = WSP(bf16_t, WS_WD) + (size_t)e * D * D; m.n0 = nb * 32; m.k0 = kb * 64;
#pragma unroll
        for (int i = 0; i < 8; ++i) v[i] = s.ld4(m.k0 + i * 8 + (lane >> 3), m.n0 + (lane & 7) * 4);
    }
    return m;
}
__device__ __forceinline__ void convert_moe_weights(Frame& F, int l, int gw, int ngw) {
    LAS float* scr = (LAS float*)(F.lds + F.wave * 8448);
    const float* w_e_gate = FIN(I_WEG); const float* w_e_up = FIN(I_WEU); const float* w_e_down = FIN(I_WED);
    constexpr int NIT = NE * 64 * 16 + NE * 32 * 16;
    if (gw >= NIT) return;
    f32x4 va[8], vb[8];
    MoeItem ma = moe_item_load(F, l, gw, w_e_gate, w_e_up, w_e_down, va), mb = ma;
    for (int it = gw; it < NIT; it += 2 * ngw) {
        const int i1 = it + ngw, i2 = it + 2 * ngw;
        if (i1 < NIT) mb = moe_item_load(F, l, i1, w_e_gate, w_e_up, w_e_down, vb);
        tr_store(va, ma.dst, D, ma.n0, ma.k0, scr, F.lane);
        if (i1 < NIT) {
            if (i2 < NIT) ma = moe_item_load(F, l, i2, w_e_gate, w_e_up, w_e_down, va);
            tr_store(vb, mb.dst, D, mb.n0, mb.k0, scr, F.lane);
        }
    }
}

__device__ __forceinline__ void phase_prep(Frame& F) {
    const int tid = F.tid;
    {
        LAS float* s = (LAS float*)F.lds;
        LAS float* red = (LAS float*)(F.lds + 9 * 1024 * 4);
        float* MOD = WSP(float, WS_MOD);
        const float* c_in = FIN(I_C); const float* c_ctx = FIN(I_CCTX); const float* w_ada = FIN(I_WADA); const float* b_ada = FIN(I_BADA);
        bool staged = false;
        for (int it = F.bid; it < 192; it += F.G) {
            if (!staged) { for (int i = tid; i < 9 * 1024; i += NTHR) { const int r = i >> 10, k = i & 1023; const float cv = (r < 8) ? c_in[r * 1024 + k] : c_ctx[k]; s[i] = siluf_(cv); } staged = true; }
            __syncthreads();
            const int l = it / 96, cgp = it % 96, col = cgp * 64 + (tid & 63), kq = tid >> 6;
            float acc[9];
#pragma unroll
            for (int r = 0; r < 9; ++r) acc[r] = 0.f;
            const float* w = w_ada + ((size_t)l * 1024 + kq * 128) * 6144 + col;
            for (int k0 = 0; k0 < 128; k0 += 32) {
                float wv[32];
#pragma unroll
                for (int k = 0; k < 32; ++k) wv[k] = w[(size_t)(k0 + k) * 6144];
#pragma unroll
                for (int k = 0; k < 32; ++k)
#pragma unroll
                    for (int r = 0; r < 9; ++r) acc[r] += s[r * 1024 + kq * 128 + k0 + k] * wv[k];
            }
#pragma unroll
            for (int r = 0; r < 9; ++r) red[(kq * 9 + r) * 64 + (tid & 63)] = acc[r];
            __syncthreads();
            for (int o = tid; o < 576; o += NTHR) { const int r = o >> 6, cc = o & 63; float sum = 0.f;
#pragma unroll
                for (int q = 0; q < 8; ++q) sum += red[(q * 9 + r) * 64 + cc];
                MOD[((size_t)l * 9 + r) * 6144 + cgp * 64 + cc] = sum + b_ada[l * 6144 + cgp * 64 + cc]; }
            __syncthreads();
        }
        __syncthreads();
    }
    {
        bf16_t* FL = WSP(bf16_t, WS_FL); bf16_t* FC = WSP(bf16_t, WS_FC);
        const size_t gth = (size_t)F.bid * NTHR + tid, nth = (size_t)F.G * NTHR;
        for (size_t it = gth; it < (size_t)4096 * 1024 / 8; it += nth) {
            const int r = (int)(it / 128), t0 = (int)(it % 128) * 8, part = r >> 11, k = r & 2047; unsigned w[4];
#pragma unroll
            for (int j = 0; j < 4; ++j) { float v[2];
#pragma unroll
                for (int q = 0; q < 2; ++q) { const int ph = (k * (t0 + 2 * j + q)) & 2047; const float ang = (float)ph * (6.283185307179586f / 2048.f); v[q] = (part ? sinf(ang) : cosf(ang)) * 0.022097086912079608f; }
                w[j] = pk2(v[0], v[1]); }
            *(u32x4*)(FL + (size_t)r * 1024 + t0) = (u32x4){w[0], w[1], w[2], w[3]};
        }
        for (size_t it = gth; it < (size_t)512 * 256 / 8; it += nth) {
            const int r = (int)(it / 32), t0 = (int)(it % 32) * 8, part = r >> 8, k = r & 255; unsigned w[4];
#pragma unroll
            for (int j = 0; j < 4; ++j) { float v[2];
#pragma unroll
                for (int q = 0; q < 2; ++q) { const int ph = (k * (t0 + 2 * j + q)) & 255; const float ang = (float)ph * (6.283185307179586f / 256.f); v[q] = (part ? sinf(ang) : cosf(ang)) * 0.0625f; }
                w[j] = pk2(v[0], v[1]); }
            *(u32x4*)(FC + (size_t)r * 1024 + t0) = (u32x4){w[0], w[1], w[2], w[3]};
        }
    }
    const int gw = F.bid * NWAVES + F.wave, ngw = F.G * NWAVES;
    {
        LAS float* scr = (LAS float*)(F.lds + F.wave * 8448);
        bf16_t* WIN = WSP(bf16_t, WS_WIN); bf16_t* WOUT = WSP(bf16_t, WS_WOUT);
        const float* w_in = FIN(I_WIN); const float* w_out = FIN(I_WOUT);
        constexpr int I_IN = 2 * 88 * 16, I_OP = 2 * 32 * 12, I_PQ = 2 * 32 * 8;
        for (int it = gw; it < I_IN + I_OP + I_PQ; it += ngw) {
            if (it < I_IN) { const int l = it / 1408, r = it % 1408, nb = r / 16, kb = r % 16;
                SrcWin s{w_in + (size_t)l * D * INC};
                tr_item(s, WIN + (size_t)l * NIN * D, D, nb * 32, kb * 64, scr, F.lane);
            } else if (it < I_IN + I_OP) { const int r0 = it - I_IN, l = r0 / 384, r = r0 % 384, nb = r / 12, kb = r % 12;
                SrcPlain s{w_out + (size_t)l * D * D, D};
                tr_item(s, WOUT + (size_t)l * D * KOUT, KOUT, nb * 32, kb * 64, scr, F.lane);
            } else { const int r0 = it - I_IN - I_OP, l = r0 / 256, r = r0 % 256, nb = r / 8, gp = r % 8, g = gp & 3, part = gp >> 2;
                const float* wsrc = w_out + (size_t)l * D * D + (size_t)(768 + g * 64) * D + nb * 32;
#pragma unroll 8
                for (int i = 0; i < 32; ++i) { const int kk = 2 * i + (F.lane >> 5), nn = F.lane & 31; scr[kk * 33 + nn] = wsrc[(size_t)kk * D + nn]; }
                LDS_WAIT(); asm volatile("" ::: "memory");
                const int c8 = F.lane & 7;
                float o[4][8];
#pragma unroll
                for (int j = 0; j < 4; ++j)
#pragma unroll
                    for (int q = 0; q < 8; ++q) o[j][q] = 0.f;
                for (int m = 0; m < 64; ++m) {
                    float twd[8];
#pragma unroll
                    for (int q = 0; q < 8; ++q) { const float ang = (float)((m * (c8 * 8 + q)) & 63) * (6.283185307179586f / 64.f); twd[q] = part ? -__sinf(ang) : __cosf(ang); }
#pragma unroll
                    for (int j = 0; j < 4; ++j) { const float bv = scr[m * 33 + (F.lane >> 3) + 8 * j];
#pragma unroll
                        for (int q = 0; q < 8; ++q) o[j][q] += twd[q] * bv; }
                }
#pragma unroll
                for (int j = 0; j < 4; ++j) { const int n = (F.lane >> 3) + 8 * j;
                    u32x4 ov; ov.x = pk2(o[j][0] * 0.125f, o[j][1] * 0.125f); ov.y = pk2(o[j][2] * 0.125f, o[j][3] * 0.125f); ov.z = pk2(o[j][4] * 0.125f, o[j][5] * 0.125f); ov.w = pk2(o[j][6] * 0.125f, o[j][7] * 0.125f);
                    *(u32x4*)(WOUT + (size_t)l * D * KOUT + (size_t)(nb * 32 + n) * KOUT + 768 + part * 256 + g * 64 + c8 * 8) = ov; }
                LDS_WAIT(); asm volatile("" ::: "memory");
            }
        }
    }
}

constexpr int ROW_PRM = 65536;
template <int CTRL> __device__ __forceinline__ float dppf(float v) { return __builtin_bit_cast(float, __builtin_amdgcn_update_dpp(0, __builtin_bit_cast(int, v), CTRL, 0xF, 0xF, true)); }
__device__ __forceinline__ float rdlane(float v, int l) { return __builtin_bit_cast(float, __builtin_amdgcn_readlane(__builtin_bit_cast(int, v), l)); }
__device__ __forceinline__ float wave_sum_dpp(float v) {
    v += dppf<0xB1>(v); v += dppf<0x4E>(v); v += dppf<0x141>(v); v += dppf<0x140>(v);
    return (rdlane(v, 0) + rdlane(v, 16)) + (rdlane(v, 32) + rdlane(v, 48));
}
__device__ __forceinline__ void stage_small_w(Frame& F, LAS float* wT, const float* src, int ld, int coloff) {
    for (int i = F.tid; i < 16 * 1024; i += NTHR) { const int k = i >> 4, c = i & 15; wT[c * 1024 + k] = src[(size_t)k * ld + coloff + c]; }
}
__device__ __forceinline__ float swap_add32(float a, float b) { const u32x2 r = __builtin_amdgcn_permlane32_swap(__builtin_bit_cast(unsigned, a), __builtin_bit_cast(unsigned, b), false, false); return __builtin_bit_cast(float, r.x) + __builtin_bit_cast(float, r.y); }
__device__ __forceinline__ float swap_add16(float a, float b) { const u32x2 r = __builtin_amdgcn_permlane16_swap(__builtin_bit_cast(unsigned, a), __builtin_bit_cast(unsigned, b), false, false); return __builtin_bit_cast(float, r.x) + __builtin_bit_cast(float, r.y); }
#ifdef OLD_REDUCE
__device__ __forceinline__ float reduce16(const float (&acc)[16], int lane) {
    float v8[8], v4[4], v2[2], v1;
#pragma unroll
    for (int i = 0; i < 8; ++i) { const float snd = (lane & 32) ? acc[i] : acc[i + 8], kp = (lane & 32) ? acc[i + 8] : acc[i]; v8[i] = kp + __shfl_xor(snd, 32); }
#pragma unroll
    for (int i = 0; i < 4; ++i) { const float snd = (lane & 16) ? v8[i] : v8[i + 4], kp = (lane & 16) ? v8[i + 4] : v8[i]; v4[i] = kp + __shfl_xor(snd, 16); }
#pragma unroll
    for (int i = 0; i < 2; ++i) { const float snd = (lane & 8) ? v4[i] : v4[i + 2], kp = (lane & 8) ? v4[i + 2] : v4[i]; v2[i] = kp + __shfl_xor(snd, 8); }
    { const float snd = (lane & 4) ? v2[0] : v2[1], kp = (lane & 4) ? v2[1] : v2[0]; v1 = kp + __shfl_xor(snd, 4); }
    v1 += __shfl_xor(v1, 2); v1 += __shfl_xor(v1, 1);
    return v1;
}
#else
__device__ __forceinline__ float reduce16(const float (&acc)[16], int lane) {
    float v8[8], v4[4], v2[2], v1;
#pragma unroll
    for (int i = 0; i < 8; ++i) v8[i] = swap_add32(acc[i], acc[i + 8]);
#pragma unroll
    for (int i = 0; i < 4; ++i) v4[i] = swap_add16(v8[i], v8[i + 4]);
#pragma unroll
    for (int i = 0; i < 2; ++i) { const float snd = (lane & 8) ? v4[i] : v4[i + 2], kp = (lane & 8) ? v4[i + 2] : v4[i]; v2[i] = kp + dppf<0x140>(snd); }
    { const float snd = (lane & 4) ? v2[0] : v2[1], kp = (lane & 4) ? v2[1] : v2[0]; v1 = kp + dppf<0x141>(snd); }
    v1 += dppf<0x4E>(v1); v1 += dppf<0xB1>(v1);
    return v1;
}
#endif
__device__ __forceinline__ int mod_row(int tok) { return tok < NLAT ? (tok >> 11) : 8; }
__device__ __forceinline__ void pair_range(int ntok, int gw, int ngw, int& p0, int& p1) { const int np = ntok >> 1; p0 = (int)(((long long)np * gw) / ngw); p1 = (int)(((long long)np * (gw + 1)) / ngw); }
__device__ __forceinline__ void block_mod_rows(Frame& F, int ntok, int& mrA, int& mrB) {
    int q0, q1, r0, r1; pair_range(ntok, F.bid * NWAVES, F.G * NWAVES, q0, q1); pair_range(ntok, F.bid * NWAVES + NWAVES - 1, F.G * NWAVES, r0, r1);
    mrA = mod_row(min(2 * q0, ntok - 1)); mrB = mod_row(min(max(2 * r1 - 1, 0), ntok - 1));
}
__device__ __forceinline__ float sumsq4(const f32x4 (&v)[4]) { float ss = 0.f;
#pragma unroll
    for (int j = 0; j < 4; ++j) ss += (v[j][0] * v[j][0] + v[j][1] * v[j][1]) + (v[j][2] * v[j][2] + v[j][3] * v[j][3]);
    return ss; }
__device__ __forceinline__ void norm_pair(const f32x4 (&va)[4], const f32x4 (&vb)[4], const LAS float* cfp, const LAS float* shp, bf16_t* xn_a, f32x2 (&yy)[16], int lane) {
    const float ra = 1.0f / sqrtf(wave_sum_dpp(sumsq4(va)) * (1.0f / D) + EPS), rb = 1.0f / sqrtf(wave_sum_dpp(sumsq4(vb)) * (1.0f / D) + EPS);
#pragma unroll
    for (int j = 0; j < 4; ++j) { const int o = 4 * lane + 256 * j;
        const f32x4 cf = *(const LAS f32x4*)(cfp + o), sh = *(const LAS f32x4*)(shp + o);
        f32x4 ya, yb;
#pragma unroll
        for (int q = 0; q < 4; ++q) { ya[q] = va[j][q] * ra * cf[q] + sh[q]; yb[q] = vb[j][q] * rb * cf[q] + sh[q]; yy[4 * j + q] = (f32x2){ya[q], yb[q]}; }
        *(u32x2*)(xn_a + o) = pk4(ya); *(u32x2*)(xn_a + D + o) = pk4(yb); }
}
__device__ __forceinline__ void gate_products2(const f32x2 (&yy)[16], const LAS float* wT, int lane, float& ga, float& gb) {
    f32x2 acc[16];
#pragma unroll
    for (int c = 0; c < 16; ++c) acc[c] = (f32x2){0.f, 0.f};
#pragma unroll
    for (int j = 0; j < 4; ++j) {
#pragma unroll
        for (int h = 0; h < 2; ++h) {
            f32x4 wv[8];
#pragma unroll
            for (int c = 0; c < 8; ++c) wv[c] = *(const LAS f32x4*)(wT + (8 * h + c) * 1024 + 4 * lane + 256 * j);
            __builtin_amdgcn_sched_barrier(0);
#pragma unroll
            for (int c = 0; c < 8; ++c)
#pragma unroll
                for (int q = 0; q < 4; ++q) acc[8 * h + c] += yy[4 * j + q] * (f32x2){wv[c][q], wv[c][q]};
            __builtin_amdgcn_sched_barrier(0);
        }
    }
    float a1[16], b1[16];
#pragma unroll
    for (int c = 0; c < 16; ++c) { a1[c] = acc[c][0]; b1[c] = acc[c][1]; }
    ga = reduce16(a1, lane); gb = reduce16(b1, lane);
}
__device__ __forceinline__ void row_tail_gates(float myv, const float* b_gates_l, float* gates_row, int lane) {
    if ((lane & 3) == 0) { const int c = lane >> 2; gates_row[c] = myv + b_gates_l[c]; }
}
__device__ __forceinline__ void row_tail_router(float myv, float* aff_row, int lane) {
    float mx = myv;
#pragma unroll
    for (int o = 4; o < 64; o <<= 1) mx = fmaxf(mx, __shfl_xor(mx, o));
    const float e = expf(myv - mx); float s = e;
#pragma unroll
    for (int o = 4; o < 64; o <<= 1) s += __shfl_xor(s, o);
    if ((lane & 3) == 0) aff_row[lane >> 2] = e / s;
}
#define LOAD_PAIR(va, vb, src) { _Pragma("unroll") for (int j = 0; j < 4; ++j) { va[j] = *(const f32x4*)((src) + 4 * F.lane + 256 * j); vb[j] = *(const f32x4*)((src) + D + 4 * F.lane + 256 * j); } }

__device__ __forceinline__ void phase_norm1_l0(Frame& F) {
    LAS float* wT = (LAS float*)F.lds; LAS float* prm = (LAS float*)(F.lds + ROW_PRM);
    const float* MOD = WSP(float, WS_MOD); bf16_t* XN = WSP(bf16_t, WS_XN); float* GATES = WSP(float, WS_GATES);
    const float* x_in = FIN(I_X); const float* ctx_in = FIN(I_CTX); const float* g_norm1 = FIN(I_GN1); const float* b_gates = FIN(I_BG);
    const int gw = F.bid * NWAVES + F.wave, ngw = F.G * NWAVES;
    int p0, p1; pair_range(NTOK, gw, ngw, p0, p1);
#define N1_SRC(t) ((t) < NLAT ? x_in + (size_t)(t) * D : ctx_in + (size_t)((t) - NLAT) * D)
    f32x4 va[4], vb[4];
    if (p0 < p1) { const float* src = N1_SRC(2 * p0); LOAD_PAIR(va, vb, src) }
    int mrA, mrB; block_mod_rows(F, NTOK, mrA, mrB);
    stage_small_w(F, wT, FIN(I_WIN), INC, 1536);
    for (int i = F.tid; i < 2048; i += NTHR) { const int set = i >> 10, k = i & 1023; const float* md = MOD + (size_t)(set ? mrB : mrA) * 6144;
        prm[(set * 3 + 0) * 1024 + k] = g_norm1[k] * (1.0f + md[1024 + k]); prm[(set * 3 + 1) * 1024 + k] = md[k]; }
    __syncthreads();
    for (int p = p0; p < p1; ++p) {
        const int tok = 2 * p, set = (mod_row(tok) != mrA) ? 1 : 0;
        f32x2 yy[16];
        norm_pair(va, vb, prm + (set * 3 + 0) * 1024, prm + (set * 3 + 1) * 1024, XN + (size_t)tok * D, yy, F.lane);
        if (p + 1 < p1) { const float* src = N1_SRC(tok + 2); LOAD_PAIR(va, vb, src) }
        float ga, gb; gate_products2(yy, wT, F.lane, ga, gb);
        row_tail_gates(ga, b_gates, GATES + (size_t)tok * 16, F.lane); row_tail_gates(gb, b_gates, GATES + (size_t)(tok + 1) * 16, F.lane);
    }
#undef N1_SRC
    __syncthreads();
}
__device__ __forceinline__ void phase_norm2(Frame& F, int l) {
    LAS float* wT = (LAS float*)F.lds; LAS float* prm = (LAS float*)(F.lds + ROW_PRM);
    const float* g_norm2 = FIN(I_GN2) + l * D;
    const float* MOD = WSP(float, WS_MOD); bf16_t* XN = WSP(bf16_t, WS_XN); float* AFF = WSP(float, WS_AFF); const float* X = WSP(float, WS_X);
    const int gw = F.bid * NWAVES + F.wave, ngw = F.G * NWAVES;
    const int ntok = (l == 0) ? NTOK : NLAT;
    int p0, p1; pair_range(ntok, gw, ngw, p0, p1);
    f32x4 va[4], vb[4];
    if (p0 < p1) { const float* src = X + (size_t)(2 * p0) * D; LOAD_PAIR(va, vb, src) }
    int mrA, mrB; block_mod_rows(F, ntok, mrA, mrB);
    stage_small_w(F, wT, FIN(I_WR) + (size_t)l * D * 16, 16, 0);
    for (int i = F.tid; i < 2048; i += NTHR) { const int set = i >> 10, k = i & 1023; const float* md = MOD + ((size_t)l * 9 + (set ? mrB : mrA)) * 6144;
        prm[(set * 3 + 0) * 1024 + k] = g_norm2[k] * (1.0f + md[4 * 1024 + k]); prm[(set * 3 + 1) * 1024 + k] = md[3 * 1024 + k]; }
    __syncthreads();
    for (int p = p0; p < p1; ++p) {
        const int tok = 2 * p, set = (mod_row(tok) != mrA) ? 1 : 0;
        f32x2 yy[16];
        norm_pair(va, vb, prm + (set * 3 + 0) * 1024, prm + (set * 3 + 1) * 1024, XN + (size_t)tok * D, yy, F.lane);
        if (p + 1 < p1) { const float* src = X + (size_t)(tok + 2) * D; LOAD_PAIR(va, vb, src) }
        float ga, gb; gate_products2(yy, wT, F.lane, ga, gb);
        row_tail_router(ga, AFF + (size_t)tok * 16, F.lane); row_tail_router(gb, AFF + (size_t)(tok + 1) * 16, F.lane);
    }
    __syncthreads();
}
constexpr int CMB_K = 2;
struct CmbSlots { u32x2 y[2][CMB_K][4]; };
__device__ __forceinline__ unsigned row_inv_mask(int invw, int sub) { return (unsigned)((__ballot(invw >= 0) >> (16 * sub)) & 0xffffull); }
__device__ __forceinline__ void cmb_issue(CmbSlots& S, const bf16_t* YS, int invw_a, int sub_a, int invw_b, int sub_b, int lane) {
#pragma unroll
    for (int rr = 0; rr < 2; ++rr) { const int invw = rr ? invw_b : invw_a, sub = rr ? sub_b : sub_a; unsigned mask = row_inv_mask(invw, sub);
#pragma unroll
        for (int s = 0; s < CMB_K; ++s) {
            int e = 0, r = 0;
            if (mask) { e = __builtin_ctz(mask); mask &= mask - 1; r = __builtin_amdgcn_readlane(invw, 16 * sub + e); }
            const bf16_t* yr = YS + ((size_t)e * RPE + r) * D;
#pragma unroll
            for (int j = 0; j < 4; ++j) S.y[rr][s][j] = *(const u32x2*)(yr + 4 * lane + 256 * j); } }
}
__device__ __forceinline__ void cmb_accum(f32x4 (&a)[4], const u32x2 (&w)[4]) {
#pragma unroll
    for (int j = 0; j < 4; ++j) { a[j][0] += bflo(w[j].x); a[j][1] += bfhi(w[j].x); a[j][2] += bflo(w[j].y); a[j][3] += bfhi(w[j].y); }
}
__device__ __forceinline__ void phase_combine(Frame& F, int l) {
    LAS float* wT = (LAS float*)F.lds; LAS float* prm = (LAS float*)(F.lds + ROW_PRM);
    const float* g_norm1 = FIN(I_GN1) + D; const float* b_gates = FIN(I_BG) + 16; const float* g_final = FIN(I_GF); float* outp = F.A.out;
    const float* MOD = WSP(float, WS_MOD); bf16_t* XN = WSP(bf16_t, WS_XN); float* GATES = WSP(float, WS_GATES); float* X = WSP(float, WS_X);
    const int* INV = WSP(int, WS_INV); const bf16_t* YS = WSP(bf16_t, WS_YS);
    const int gw = F.bid * NWAVES + F.wave, ngw = F.G * NWAVES;
    const int ntok = (l == 0) ? NTOK : NLAT;
    int p0, p1; pair_range(ntok, gw, ngw, p0, p1);
    const int t0 = 2 * p0;
    int invw[3];
#pragma unroll
    for (int i = 0; i < 3; ++i) { const int idx = t0 * 16 + 64 * i + F.lane; invw[i] = (idx < ntok * 16) ? INV[idx] : -1; }
#define INVW(ri) (((ri) >> 2) == 0 ? invw[0] : ((ri) >> 2) == 1 ? invw[1] : invw[2])
    f32x4 va[4], vb[4]; CmbSlots S;
    if (p0 < p1) { const float* src = X + (size_t)t0 * D; LOAD_PAIR(va, vb, src) cmb_issue(S, YS, INVW(0), 0, INVW(1), 1, F.lane); }
    int mrA, mrB; block_mod_rows(F, ntok, mrA, mrB);
    if (l == 0) stage_small_w(F, wT, FIN(I_WIN) + (size_t)1 * D * INC, INC, 1536);
    for (int i = F.tid; i < 2048; i += NTHR) { const int set = i >> 10, k = i & 1023, mr = set ? mrB : mrA; const float* md = MOD + ((size_t)l * 9 + mr) * 6144; const float* md1 = MOD + ((size_t)9 + mr) * 6144;
        prm[(set * 3 + 2) * 1024 + k] = md[5 * 1024 + k];
        if (l == 0) { prm[(set * 3 + 0) * 1024 + k] = g_norm1[k] * (1.0f + md1[1024 + k]); prm[(set * 3 + 1) * 1024 + k] = md1[k]; }
        else prm[(set * 3 + 0) * 1024 + k] = g_final[k]; }
    __syncthreads();
    for (int p = p0; p < p1; ++p) {
        const int tok = 2 * p, ri = tok - t0, set = (mod_row(tok) != mrA) ? 1 : 0;
        const LAS float* pp = prm + set * 3 * 1024;
#pragma unroll
        for (int rr = 0; rr < 2; ++rr) {
            f32x4 a[4];
#pragma unroll
            for (int j = 0; j < 4; ++j) a[j] = (f32x4){0.f, 0.f, 0.f, 0.f};
            const int iw = INVW(ri + rr), sub = (ri + rr) & 3;
            unsigned mask = row_inv_mask(iw, sub);
#pragma unroll
            for (int s = 0; s < CMB_K; ++s) if (mask) { mask &= mask - 1; cmb_accum(a, S.y[rr][s]); }
            while (mask) { const int e = __builtin_ctz(mask); mask &= mask - 1;
                const int r = __builtin_amdgcn_readlane(iw, 16 * sub + e);
                const bf16_t* yr = YS + ((size_t)e * RPE + r) * D;
                u32x2 w[4];
#pragma unroll
                for (int j = 0; j < 4; ++j) w[j] = *(const u32x2*)(yr + 4 * F.lane + 256 * j);
                cmb_accum(a, w); }
#pragma unroll
            for (int j = 0; j < 4; ++j) { const f32x4 gt = *(const LAS f32x4*)(pp + 2 * 1024 + 4 * F.lane + 256 * j); if (rr == 0) va[j] = va[j] + gt * a[j]; else vb[j] = vb[j] + gt * a[j]; }
        }
        if (l == 0) {
#pragma unroll
            for (int j = 0; j < 4; ++j) { *(f32x4*)(X + (size_t)tok * D + 4 * F.lane + 256 * j) = va[j]; *(f32x4*)(X + (size_t)(tok + 1) * D + 4 * F.lane + 256 * j) = vb[j]; }
            f32x2 yy[16];
            norm_pair(va, vb, pp, pp + 1024, XN + (size_t)tok * D, yy, F.lane);
            if (p + 1 < p1) { const float* src = X + (size_t)(tok + 2) * D; LOAD_PAIR(va, vb, src) cmb_issue(S, YS, INVW(ri + 2), (ri + 2) & 3, INVW(ri + 3), (ri + 3) & 3, F.lane); }
            float ga, gb; gate_products2(yy, wT, F.lane, ga, gb);
            row_tail_gates(ga, b_gates, GATES + (size_t)tok * 16, F.lane); row_tail_gates(gb, b_gates, GATES + (size_t)(tok + 1) * 16, F.lane);
        } else {
            const float ra = 1.0f / sqrtf(wave_sum_dpp(sumsq4(va)) * (1.0f / D) + EPS), rb = 1.0f / sqrtf(wave_sum_dpp(sumsq4(vb)) * (1.0f / D) + EPS);
#pragma unroll
            for (int j = 0; j < 4; ++j) { const f32x4 g = *(const LAS f32x4*)(pp + 4 * F.lane + 256 * j);
                *(f32x4*)(outp + (size_t)tok * D + 4 * F.lane + 256 * j) = va[j] * ra * g; *(f32x4*)(outp + (size_t)(tok + 1) * D + 4 * F.lane + 256 * j) = vb[j] * rb * g; }
            if (p + 1 < p1) { const float* src = X + (size_t)(tok + 2) * D; LOAD_PAIR(va, vb, src) cmb_issue(S, YS, INVW(ri + 2), (ri + 2) & 3, INVW(ri + 3), (ri + 3) & 3, F.lane); }
        }
    }
#undef INVW
    __syncthreads();
}

__device__ __forceinline__ int block_count(LAS int* cbuf, int par, int wave, int lane, int c_wave  ) {
    if (lane == 0) cbuf[par * 8 + wave] = c_wave;
    __syncthreads();
    int t = 0;
#pragma unroll
    for (int q = 0; q < 8; ++q) t += cbuf[par * 8 + q];
    return t;
}
__device__ __forceinline__ void phase_topk(Frame& F, int l) {
    LAS int* cbuf = (LAS int*)F.lds;
    const float* AFF = WSP(float, WS_AFF); int* INV = WSP(int, WS_INV); int* ROWTOK = WSP(int, WS_ROWTOK); float* GATEV = WSP(float, WS_GATEV);
    const int nitems = (l == 0) ? 256 : 128;
    for (int it = F.bid; it < nitems; it += F.G) {
        const int s = it >> 4, e = it & 15;
        const bool lat = s < 8;
        const int n = lat ? SEQ : CTXL, cap = lat ? 256 : 32, tok0 = lat ? s * SEQ : NLAT + (s - 8) * CTXL, rowbase = lat ? s * 256 : 2048 + (s - 8) * 32;
        const bool active = 4 * F.tid < n;
        unsigned k[4];
#pragma unroll
        for (int q = 0; q < 4; ++q) k[q] = active ? __float_as_uint(AFF[(size_t)(tok0 + 4 * F.tid + q) * 16 + e]) : 0u;
        __syncthreads();
        unsigned T = 0u; int par = 0;
        for (int bit = 30; bit >= 0; --bit) {
            const unsigned cand = T | (1u << bit);
            int cw = 0;
#pragma unroll
            for (int q = 0; q < 4; ++q) cw += __popcll(__ballot(k[q] >= cand));
            const int tot = block_count(cbuf, par, F.wave, F.lane, cw); par ^= 1;
            if (tot >= cap) T = cand;
        }
        int cw = 0;
#pragma unroll
        for (int q = 0; q < 4; ++q) cw += __popcll(__ballot(k[q] > T));
        const int c_gt = block_count(cbuf, par, F.wave, F.lane, cw); par ^= 1;
        int mg = 0, me = 0;
#pragma unroll
        for (int q = 0; q < 4; ++q) { mg += (k[q] > T) ? 1 : 0; me += (k[q] == T && active) ? 1 : 0; }
        int pk_ = mg | (me << 16), inc = pk_;
#pragma unroll
        for (int o = 1; o < 64; o <<= 1) { const int y = __shfl_up(inc, o); if (F.lane >= o) inc += y; }
        if (F.lane == 63) cbuf[16 + F.wave] = inc;
        __syncthreads();
        int base = 0;
#pragma unroll
        for (int q = 0; q < 8; ++q) base += (q < F.wave) ? cbuf[16 + q] : 0;
        int pre = base + inc - pk_; int pg = pre & 0xffff, pe = pre >> 16;
        if (active) {
#pragma unroll
            for (int q = 0; q < 4; ++q) {
                const int tok = tok0 + 4 * F.tid + q; int slot = -1;
                if (k[q] > T) { slot = pg; ++pg; }
                else if (k[q] == T) { if (c_gt + pe < cap) slot = c_gt + pe; ++pe; }
                if (slot >= 0) { ROWTOK[e * RPE + rowbase + slot] = tok; GATEV[e * RPE + rowbase + slot] = __uint_as_float(k[q]); }
                INV[(size_t)tok * 16 + e] = slot >= 0 ? rowbase + slot : -1;
            }
        }
        __syncthreads();
    }
    __syncthreads();
}

__device__ __forceinline__ void conv_items(Frame& F, int l, int first, int stride) {
    LAS float* gl = (LAS float*)F.lds;
    LAS float* ob = gl + 62 * 256;
    const bf16_t* CA = WSP(bf16_t, WS_CA); const bf16_t* CG = WSP(bf16_t, WS_CG); bf16_t* Y = WSP(bf16_t, WS_Y);
    const int nitems = (l == 0) ? 512 + 64 : 512;
    const int ch = F.tid & 255, th = F.tid >> 8;
    const float* conv_w = FIN(I_CW); const float* conv_b = FIN(I_CB); const float* conv_ln_g = FIN(I_CLG); const float* conv_ln_b = FIN(I_CLB);
    float w[31];
#pragma unroll
    for (int j = 0; j < 31; ++j) w[j] = conv_w[((size_t)l * 31 + j) * 256 + ch];
    const float cb = conv_b[l * 256 + ch];
    for (int it = first; it < nitems; it += stride) {
        const bool lat = it < 512;
        const int seqlen = lat ? SEQ : CTXL;
        const int b = lat ? it >> 6 : (it - 512) >> 3, t0 = lat ? (it & 63) * 32 : ((it - 512) & 7) * 32;
        const int tokb = lat ? b * SEQ : NLAT + b * CTXL;
        __syncthreads();
        for (int i = F.tid; i < 62 * 64; i += NTHR) {
            const int rr = i >> 6, c4 = (i & 63) * 4, t = t0 - 15 + rr;
            f32x4 g = (f32x4){0.f, 0.f, 0.f, 0.f};
            if (t >= 0 && t < seqlen) { const size_t o = (size_t)(tokb + t) * 256 + c4; const u32x2 a = *(const u32x2*)(CA + o), gg = *(const u32x2*)(CG + o);
                g[0] = bflo(a.x) * sigmoidf_(bflo(gg.x)); g[1] = bfhi(a.x) * sigmoidf_(bfhi(gg.x)); g[2] = bflo(a.y) * sigmoidf_(bflo(gg.y)); g[3] = bfhi(a.y) * sigmoidf_(bfhi(gg.y)); }
            *(LAS f32x4*)(gl + rr * 256 + c4) = g;
        }
        __syncthreads();
        for (int tt = 0; tt < 16; ++tt) {
            const LAS float* gp = gl + (th * 16 + tt) * 256 + ch;
            float gv[31];
#pragma unroll
            for (int j = 0; j < 31; ++j) gv[j] = gp[j * 256];
            __builtin_amdgcn_sched_barrier(0);
            float o = cb;
#pragma unroll
            for (int j = 0; j < 31; ++j) o += w[j] * gv[j];
            __builtin_amdgcn_sched_barrier(0);
            ob[(th * 16 + tt) * 256 + ch] = o;
        }
        __syncthreads();
        for (int tt = F.wave; tt < 32; tt += NWAVES) {
            const f32x4 v = *(const LAS f32x4*)(ob + tt * 256 + 4 * F.lane);
            const float mean = wave_sum((v[0] + v[1]) + (v[2] + v[3])) * (1.0f / 256.f);
            const f32x4 d = v - mean;
            const float var = wave_sum((d[0] * d[0] + d[1] * d[1]) + (d[2] * d[2] + d[3] * d[3])) * (1.0f / 256.f);
            const float rs = 1.0f / sqrtf(var + EPS);
            const f32x4 lg = *(const f32x4*)(conv_ln_g + l * 256 + 4 * F.lane), lb = *(const f32x4*)(conv_ln_b + l * 256 + 4 * F.lane);
            f32x4 y;
#pragma unroll
            for (int q = 0; q < 4; ++q) y[q] = siluf_(d[q] * rs * lg[q] + lb[q]);
            *(u32x2*)(Y + (size_t)(tokb + t0 + tt) * KOUT + 512 + 4 * F.lane) = pk4(y);
        }
    }
    __syncthreads();
}
__device__ __forceinline__ void ztrans_items(Frame& F, int l, int first, int stride) {
    LAS unsigned short* te = (LAS unsigned short*)(F.lds + F.wave * (2 * 64 * 66 * 2));
    LAS unsigned short* to = te + 64 * 66;
    const bf16_t* FR = WSP(bf16_t, WS_FR); bf16_t* ZE = WSP(bf16_t, WS_ZT); bf16_t* ZO = WSP(bf16_t, WS_ZO); bf16_t* ZTC = WSP(bf16_t, WS_ZTC);
    const int nlat = 8 * 16 * 4, nctx = (l == 0) ? 8 * 4 * 4 : 0;
    for (int it = first; it < nlat + nctx; it += stride) {
        const bool lat = it < nlat; const int r = lat ? it : it - nlat;
        const int b = lat ? r >> 6 : r >> 4, tb = lat ? (r >> 2) & 15 : (r >> 2) & 3, cb = r & 3;
        const int tokb = lat ? b * SEQ : NLAT + b * CTXL;
#pragma unroll
        for (int i = 0; i < 8; ++i) { const int tt = (F.lane >> 3) + 8 * i, c8 = (F.lane & 7) * 8, t = tb * 64 + tt;
            const u32x4 v = *(const u32x4*)(FR + (size_t)(tokb + t) * 256 + cb * 64 + c8);
            u32x4 m = (u32x4){0u, 0u, 0u, 0u};
            if (lat && t > 0) m = *(const u32x4*)(FR + (size_t)(tokb + SEQ - t) * 256 + cb * 64 + c8);
#pragma unroll
            for (int q = 0; q < 4; ++q) {
                if (lat) { const float a0 = bflo(v[q]), a1 = bfhi(v[q]), m0 = bflo(m[q]), m1 = bfhi(m[q]); const unsigned e_ = pk2(a0 + m0, a1 + m1), o_ = (t > 0) ? pk2(a0 - m0, a1 - m1) : 0u;
                    te[(c8 + 2 * q) * 66 + tt] = (unsigned short)(e_ & 0xffffu); te[(c8 + 2 * q + 1) * 66 + tt] = (unsigned short)(e_ >> 16);
                    to[(c8 + 2 * q) * 66 + tt] = (unsigned short)(o_ & 0xffffu); to[(c8 + 2 * q + 1) * 66 + tt] = (unsigned short)(o_ >> 16); }
                else { te[(c8 + 2 * q) * 66 + tt] = (unsigned short)(v[q] & 0xffffu); te[(c8 + 2 * q + 1) * 66 + tt] = (unsigned short)(v[q] >> 16); } } }
        LDS_WAIT(); asm volatile("" ::: "memory");
        const size_t drow = (size_t)(b * 256 + cb * 64) * 1024 + tb * 64;
#pragma unroll
        for (int i = 0; i < 8; ++i) { const int cc = (F.lane >> 3) + 8 * i, t8 = (F.lane & 7) * 8; u32x4 o;
#pragma unroll
            for (int q = 0; q < 4; ++q) o[q] = (unsigned)te[cc * 66 + t8 + 2 * q] | ((unsigned)te[cc * 66 + t8 + 2 * q + 1] << 16);
            *(u32x4*)((lat ? ZE : ZTC) + drow + (size_t)cc * 1024 + t8) = o;
            if (lat) {
#pragma unroll
                for (int q = 0; q < 4; ++q) o[q] = (unsigned)to[cc * 66 + t8 + 2 * q] | ((unsigned)to[cc * 66 + t8 + 2 * q + 1] << 16);
                *(u32x4*)(ZO + drow + (size_t)cc * 1024 + t8) = o; } }
        LDS_WAIT(); asm volatile("" ::: "memory");
    }
}
__device__ __forceinline__ void finalize_h(Frame& F, int l) {
    const bf16_t* HF = WSP(bf16_t, WS_HF); const bf16_t* HB = WSP(bf16_t, WS_HB); const bf16_t* O = WSP(bf16_t, WS_O); bf16_t* Y = WSP(bf16_t, WS_Y);
    const int gw = F.bid * NWAVES + F.wave, ngw = F.G * NWAVES;
    const int ntok = (l == 0) ? NTOK : NLAT;
    float gh[8];
    const float* g_hnorm = FIN(I_GH);
#pragma unroll
    for (int q = 0; q < 8; ++q) gh[q] = g_hnorm[l * 512 + 8 * F.lane + q];
    for (int tok = gw; tok < ntok; tok += ngw) {
        const size_t o = (size_t)tok * 512 + 8 * F.lane;
        const u32x4 a = *(const u32x4*)(HF + o), b = *(const u32x4*)(HB + o), og = *(const u32x4*)(O + o);
        float h[8]; float ss = 0.f;
#pragma unroll
        for (int q = 0; q < 4; ++q) { h[2 * q] = bflo(a[q]) + bflo(b[q]); h[2 * q + 1] = bfhi(a[q]) + bfhi(b[q]); ss += h[2 * q] * h[2 * q] + h[2 * q + 1] * h[2 * q + 1]; }
#pragma unroll
        for (int s = 1; s < 16; s <<= 1) ss += __shfl_xor(ss, s);
        const float r = 1.0f / sqrtf(ss * (1.0f / 128.f) + EPS);
        u32x4 w;
#pragma unroll
        for (int q = 0; q < 4; ++q) w[q] = pk2(h[2 * q] * r * gh[2 * q] * bflo(og[q]), h[2 * q + 1] * r * gh[2 * q + 1] * bfhi(og[q]));
        *(u32x4*)(Y + (size_t)tok * KOUT + 8 * F.lane) = w;
    }
}

using pg8::Unit;
enum { GM_INPROJ = 0, GM_DFT, GM_OUT, GM_MOE1, GM_MOE2 };
struct GemmCtl {
    int mode, l, G, c; unsigned char* ws; const Args& A;
    __device__ __forceinline__ unsigned char* W() const { unsigned char* p = ws; asm volatile("" : "+s"(p)); return p; }
    __device__ __forceinline__ bool next(int i, Unit& u) const {
        const int L = i * G + c; int pm, pn;
        u.rows = nullptr; u.ex = 0;
        switch (mode) {
        case GM_INPROJ: {
            const int n0 = 64 * 11, npn = (l == 0) ? 11 : 6;
            if (L >= n0 + 8 * npn) return false;
            if (L < n0) pg8::map_tile(L, 64, 11, pm, pn); else { pg8::map_tile(L - n0, 8, npn, pm, pn); pm += 64; }
            u.A = (const char*)(W() + WS_XN) + (size_t)pm * 256 * D * 2; u.B = (const char*)(W() + WS_WIN) + ((size_t)l * NIN + pn * 256) * D * 2; u.K = D;
        } break;
        case GM_DFT: {
            const int nctx = (l == 0) ? 16 : 0;
            if (L >= 128 + nctx) return false;
            if (L < 128) { pg8::map_tile(L, 16, 8, pm, pn); u.A = (const char*)(W() + WS_FL) + (size_t)pm * 256 * 1024 * 2; u.B = (const char*)(W() + ((pm >> 3) ? WS_ZO : WS_ZT)) + (size_t)pn * 256 * 1024 * 2; u.K = 1024; }
            else { const int r = L - 128; pm = r & 1; pn = r >> 1; u.A = (const char*)(W() + WS_FC) + (size_t)pm * 256 * 1024 * 2; u.B = (const char*)(W() + WS_ZTC) + (size_t)pn * 256 * 1024 * 2; u.K = CTXL; u.ex = 1; }
        } break;
        case GM_OUT: {
            const int nM = (l == 0) ? 72 : 64;
            if (L >= nM * 4) return false;
            pg8::map_tile(L, nM, 4, pm, pn);
            u.A = (const char*)(W() + WS_Y) + (size_t)pm * 256 * KOUT * 2; u.B = (const char*)(W() + WS_WOUT) + ((size_t)l * D + pn * 256) * KOUT * 2; u.K = KOUT;
        } break;
        case GM_MOE1: {
            const int nMe = (l == 0) ? 9 : 8; int pmg;
            if (L >= NE * nMe * 8) return false;
            pg8::map_tile(L, NE * nMe, 8, pmg, pn);
            const int e = pmg / nMe; pm = pmg % nMe;
            u.A = (const char*)(W() + WS_XN); u.rows = (const int*)(W() + WS_ROWTOK) + e * RPE + pm * 256; u.B = (const char*)(W() + WS_WGU) + ((size_t)e * 2048 + pn * 256) * D * 2; u.K = D; u.ex = e;
        } break;
        default: {
            const int nMe = (l == 0) ? 9 : 8; int pmg;
            if (L >= NE * nMe * 4) return false;
            pg8::map_tile(L, NE * nMe, 4, pmg, pn);
            const int e = pmg / nMe; pm = pmg % nMe;
            u.A = (const char*)(W() + WS_HID) + ((size_t)e * RPE + pm * 256) * D * 2; u.B = (const char*)(W() + WS_WD) + ((size_t)e * D + pn * 256) * D * 2; u.K = D; u.ex = e;
        } break;
        }
        u.pm = pm; u.pn = pn;
        return true;
    }
    struct CxIn { bf16_t* dst; int ld; float sc; int act; };
    __device__ __forceinline__ CxIn prep_in(const Unit& u) const {
        CxIn c; const int pn = u.pn; c.sc = 1.f; c.act = 0; size_t off; int cb;
        if (pn < 2) { off = WS_Q; c.ld = 512; cb = pn * 256; }
        else if (pn < 4) { off = WS_K; c.ld = 512; cb = (pn - 2) * 256; c.sc = 0.08838834764831845f; }
        else if (pn < 6) { off = WS_V; c.ld = 512; cb = (pn - 4) * 256; }
        else if (pn < 8) { off = WS_O; c.ld = 512; cb = (pn - 6) * 256; c.act = 1; }
        else if (pn == 8) { off = WS_CA; c.ld = 256; cb = 0; }
        else if (pn == 9) { off = WS_CG; c.ld = 256; cb = 0; }
        else { off = WS_FR; c.ld = 256; cb = 0; }
        c.dst = (bf16_t*)(W() + off) + (size_t)u.pm * 256 * c.ld + cb;
        return c;
    }
    __device__ __forceinline__ void store_in(const CxIn& c, int r, int col, f32x4 v0, f32x4 v1) const {
        if (c.act) {
#pragma unroll
            for (int q = 0; q < 4; ++q) { v0[q] = sigmoidf_(v0[q]); v1[q] = sigmoidf_(v1[q]); }
        } else { v0 = v0 * c.sc; v1 = v1 * c.sc; }
        bf16_t* p = c.dst + (size_t)r * c.ld + col;
        *(u32x2*)p = pk4(v0); *(u32x2*)(p + 16) = pk4(v1);
    }
    struct CxDft { bf16_t* dst; const bf16_t* z1024; };
    __device__ __forceinline__ CxDft prep_dft(const Unit& u) const {
        CxDft c; int part, tokb; c.z1024 = nullptr;
        if (u.ex == 0) { part = u.pm >> 3; tokb = u.pn * SEQ + (u.pm & 7) * 256; if (part == 0) c.z1024 = (const bf16_t*)(W() + WS_FR) + (size_t)(u.pn * SEQ + 1024) * 256; }
        else { part = u.pm; tokb = NLAT + u.pn * CTXL; }
        c.dst = (bf16_t*)(W() + WS_Y) + (size_t)tokb * KOUT + 768 + part * 256; return c;
    }
    __device__ __forceinline__ void store_dft(const CxDft& c, int r, int col, f32x4 v0, f32x4 v1) const {
        if (c.z1024) { const float sg = (r & 1) ? -0.022097086912079608f : 0.022097086912079608f; const u32x2 z0 = *(const u32x2*)(c.z1024 + col), z1 = *(const u32x2*)(c.z1024 + col + 16);
            v0[0] += sg * bflo(z0.x); v0[1] += sg * bfhi(z0.x); v0[2] += sg * bflo(z0.y); v0[3] += sg * bfhi(z0.y);
            v1[0] += sg * bflo(z1.x); v1[1] += sg * bfhi(z1.x); v1[2] += sg * bflo(z1.y); v1[3] += sg * bfhi(z1.y); }
        bf16_t* p = c.dst + (size_t)r * KOUT + col;
        *(u32x2*)p = pk4(v0); *(u32x2*)(p + 16) = pk4(v1);
    }
    struct CxOut { const float* src; float* dst; const float* gt; };
    __device__ __forceinline__ CxOut prep_out(const Unit& u) const {
        CxOut c; const int tok0 = u.pm * 256, col0 = u.pn * 256;
        if (l == 0) c.src = (tok0 < NLAT ? arg_in(A, I_X) + (size_t)tok0 * D : arg_in(A, I_CTX) + (size_t)(tok0 - NLAT) * D) + col0;
        else c.src = (const float*)(W() + WS_X) + (size_t)tok0 * D + col0;
        c.dst = (float*)(W() + WS_X) + (size_t)tok0 * D + col0;
        c.gt = (const float*)(W() + WS_MOD) + ((size_t)l * 9 + mod_row(tok0)) * 6144 + 2 * 1024 + col0;
        return c;
    }
    __device__ __forceinline__ void store_out(const CxOut& c, int r, int col, f32x4 v0, f32x4 v1) const {
        const size_t o = (size_t)r * D + col;
        const f32x4 g0 = *(const f32x4*)(c.gt + col), g1 = *(const f32x4*)(c.gt + col + 16);
        const f32x4 s0 = *(const f32x4*)(c.src + o), s1 = *(const f32x4*)(c.src + o + 16);
        *(f32x4*)(c.dst + o) = s0 + g0 * v0; *(f32x4*)(c.dst + o + 16) = s1 + g1 * v1;
    }
    __device__ __forceinline__ bf16_t* prep_m1(const Unit& u) const { return (bf16_t*)(W() + WS_HID) + ((size_t)u.ex * RPE + u.pm * 256) * D + u.pn * 128; }
    __device__ __forceinline__ void store_m1(bf16_t* dst, int r, int col, f32x4 v0, f32x4 v1) const {
        f32x4 h;
#pragma unroll
        for (int q = 0; q < 4; ++q) h[q] = siluf_(v0[q]) * v1[q];
        *(u32x2*)(dst + (size_t)r * D + (col >> 5) * 16 + (col & 15)) = pk4(h);
    }
    struct CxM2 { bf16_t* dst; const float* g; };
    __device__ __forceinline__ CxM2 prep_m2(const Unit& u) const { CxM2 c; c.dst = (bf16_t*)(W() + WS_YS) + ((size_t)u.ex * RPE + u.pm * 256) * D + u.pn * 256; c.g = (const float*)(W() + WS_GATEV) + u.ex * RPE + u.pm * 256; return c; }
    __device__ __forceinline__ void store_m2(const CxM2& c, int r, int col, f32x4 v0, f32x4 v1) const {
        const float g = c.g[r];
        bf16_t* p = c.dst + (size_t)r * D + col;
        *(u32x2*)p = pk4(v0 * g); *(u32x2*)(p + 16) = pk4(v1 * g);
    }
#define EPI_WALK(PREP, STORE) do { const auto cx = PREP(u); _Pragma("unroll") for (int ai = 0; ai < 2; ++ai) _Pragma("unroll") for (int m = 0; m < 4; ++m) _Pragma("unroll") for (int bj = 0; bj < 2; ++bj) \
        STORE(cx, ai * 128 + wr * 64 + m * 16 + fr, bj * 128 + wc * 32 + 4 * fq, acc[ai][bj][m][0], acc[ai][bj][m][1]); } while (0)
    __device__ __forceinline__ void run(const f32x4 (&acc)[2][2][4][2], const Unit& u, int wr, int wc, int fr, int fq) const {
        switch (mode) {
        case GM_INPROJ: EPI_WALK(prep_in, store_in); break;
        case GM_DFT: EPI_WALK(prep_dft, store_dft); break;
        case GM_OUT: EPI_WALK(prep_out, store_out); break;
        case GM_MOE1: EPI_WALK(prep_m1, store_m1); break;
        default: EPI_WALK(prep_m2, store_m2); break;
        }
    }
    __device__ __forceinline__ void store1(const Unit& u, int r, int c, f32x4 v0, f32x4 v1) const {
        switch (mode) {
        case GM_INPROJ: store_in(prep_in(u), r, c, v0, v1); break;
        case GM_DFT: store_dft(prep_dft(u), r, c, v0, v1); break;
        case GM_OUT: store_out(prep_out(u), r, c, v0, v1); break;
        case GM_MOE1: store_m1(prep_m1(u), r, c, v0, v1); break;
        default: store_m2(prep_m2(u), r, c, v0, v1); break;
        }
    }
};

__device__ __forceinline__ void scan_simt(Frame& F, int l) {
    if (F.bid >= 64) return;
    const int b = F.bid >> 3, h = (F.bid >> 1) & 3, dir = F.bid & 1;
    LAS float* qs = (LAS float*)F.lds; LAS float* ks = qs + 64 * 132; LAS float* vs = ks + 64 * 132; LAS float* st = vs + 64 * 132;
    LAS float* sm = st + 64 * 65;
    LAS float* as_ = sm; LAS float* Ms = sm + 64; LAS float* wint = sm + 128; LAS float* enm = sm + 192; LAS float* wst = sm + 256; LAS float* denom = sm + 320;
    LAS float* nvec = sm + 384; LAS float* ig = sm + 512; LAS float* lf = sm + 576; LAS int* toks = (LAS int*)(sm + 640); LAS float* scal = sm + 704;
    const bf16_t* Q = WSP(bf16_t, WS_Q); const bf16_t* K = WSP(bf16_t, WS_K); const bf16_t* V = WSP(bf16_t, WS_V); const float* GATES = WSP(float, WS_GATES);
    bf16_t* H = dir ? WSP(bf16_t, WS_HB) : WSP(bf16_t, WS_HF);
    float Creg[32];
#pragma unroll
    for (int i = 0; i < 32; ++i) Creg[i] = 0.f;
    float m_st = 0.f;
    if (F.tid < 128) nvec[F.tid] = 0.f;
    __syncthreads();
    for (int cc = 0; cc < 36; ++cc) {
        int tid = F.tid; asm volatile("" : "+v"(tid));
        const int lane = tid & 63, e = tid >> 2, dq = tid & 3;
        const bool isctx = cc < 4;
        const int c = isctx ? (dir ? 3 - cc : cc) : (dir ? 35 - cc : cc - 4);
        const bool want_out = !(isctx && l == 1);
        if (tid < 64) { const int j = tid;
            const int tok = isctx ? NLAT + b * CTXL + c * 64 + j : (h < 2 ? b * SEQ + c * 64 + j : b * SEQ + (j & 31) * 64 + 2 * c + (j >> 5));
            toks[j] = tok; const float* g = GATES + (size_t)tok * 16 + h * 4 + 2 * dir; ig[j] = g[0]; lf[j] = logsigmoidf_(g[1]); }
        __syncthreads();
        for (int it = tid; it < 1024; it += NTHR) { const int j = it >> 4, c8 = (it & 15) * 8; const size_t o = (size_t)toks[j] * 512 + h * 128 + c8;
            const u32x4 qv = *(const u32x4*)(Q + o), kv = *(const u32x4*)(K + o), vv = *(const u32x4*)(V + o);
#pragma unroll
            for (int q = 0; q < 4; ++q) { qs[j * 132 + c8 + 2 * q] = bflo(qv[q]); qs[j * 132 + c8 + 2 * q + 1] = bfhi(qv[q]); ks[j * 132 + c8 + 2 * q] = bflo(kv[q]); ks[j * 132 + c8 + 2 * q + 1] = bfhi(kv[q]);
                vs[j * 132 + c8 + 2 * q] = bflo(vv[q]); vs[j * 132 + c8 + 2 * q + 1] = bfhi(vv[q]); } }
        if (F.wave == 0) {
            const int p = dir ? 63 - lane : lane;
            float x = lf[p];
#pragma unroll
            for (int o = 1; o < 64; o <<= 1) { const float y = __shfl_up(x, o); if (lane >= o) x += y; }
            const float a = ig[p] - x; float cm = a;
#pragma unroll
            for (int o = 1; o < 64; o <<= 1) { const float y = __shfl_up(cm, o); if (lane >= o) cm = fmaxf(cm, y); }
            const float M = fmaxf(m_st, cm), Mend = __shfl(M, 63), blast = __shfl(x, 63);
            as_[p] = a; Ms[p] = M; wint[p] = expf(m_st - M); enm[p] = expf(-(x + M)); wst[p] = expf(a - Mend);
            if (lane == 0) { scal[0] = Mend; scal[1] = blast; }
        }
        __syncthreads();
        const float Mend = scal[0], blast = scal[1], decay = expf(m_st - Mend);
        if (want_out) {
            { const int t = tid >> 3, sg = tid & 7; float sacc[8];
#pragma unroll
                for (int i = 0; i < 8; ++i) sacc[i] = 0.f;
                for (int d4 = 0; d4 < 32; ++d4) { const f32x4 q4 = *(const LAS f32x4*)(qs + t * 132 + d4 * 4);
#pragma unroll
                    for (int i = 0; i < 8; ++i) { const f32x4 k4 = *(const LAS f32x4*)(ks + (i * 8 + sg) * 132 + d4 * 4); sacc[i] += (q4[0] * k4[0] + q4[1] * k4[1]) + (q4[2] * k4[2] + q4[3] * k4[3]); } }
#pragma unroll
                for (int i = 0; i < 8; ++i) { const int s = i * 8 + sg; const bool valid = dir ? (s >= t) : (s <= t); st[t * 65 + s] = valid ? sacc[i] * expf(as_[s] - Ms[t]) : 0.f; } }
            __syncthreads();
            if (tid < 64) { const int t = tid; float qn = 0.f, ssum = 0.f;
                for (int d = 0; d < 128; ++d) qn += qs[t * 132 + d] * nvec[d];
                for (int s = 0; s < 64; ++s) ssum += st[t * 65 + s];
                const float den = wint[t] * qn + ssum; denom[t] = fmaxf(fabsf(den), enm[t]); }
            float mine[16];
#pragma unroll
            for (int tt = 0; tt < 16; ++tt) {
                mine[tt] = 0.f;
#pragma unroll
                for (int u = 0; u < 4; ++u) { const int t = 4 * tt + u; float p = 0.f;
#pragma unroll
                    for (int i4 = 0; i4 < 8; ++i4) { const f32x4 q4 = *(const LAS f32x4*)(qs + t * 132 + dq * 32 + i4 * 4); p += (Creg[4 * i4] * q4[0] + Creg[4 * i4 + 1] * q4[1]) + (Creg[4 * i4 + 2] * q4[2] + Creg[4 * i4 + 3] * q4[3]); }
                    p += __shfl_xor(p, 1); p += __shfl_xor(p, 2);
                    mine[tt] = (u == dq) ? p : mine[tt]; asm volatile("" ::: "memory"); }
            }
#pragma unroll
            for (int tt = 0; tt < 16; ++tt) { const int t = 4 * tt + dq; float intra = 0.f;
#pragma unroll 8
                for (int s = 0; s < 64; ++s) intra += st[t * 65 + s] * vs[s * 132 + e];
                mine[tt] = wint[t] * mine[tt] + intra; asm volatile("" ::: "memory"); }
            __syncthreads();
#pragma unroll
            for (int tt = 0; tt < 16; ++tt) { const int t = 4 * tt + dq; H[(size_t)toks[t] * 512 + h * 128 + e] = (bf16_t)f2bf(mine[tt] / denom[t]); }
        }
#pragma unroll
        for (int i = 0; i < 32; ++i) Creg[i] *= decay;
#pragma unroll 2
        for (int s = 0; s < 64; ++s) { const float wv = wst[s] * vs[s * 132 + e];
#pragma unroll
            for (int i4 = 0; i4 < 8; ++i4) { const f32x4 k4 = *(const LAS f32x4*)(ks + s * 132 + dq * 32 + i4 * 4); Creg[4 * i4] += wv * k4[0]; Creg[4 * i4 + 1] += wv * k4[1]; Creg[4 * i4 + 2] += wv * k4[2]; Creg[4 * i4 + 3] += wv * k4[3]; } }
        float nn = 0.f;
        if (tid < 128) { nn = decay * nvec[tid]; for (int s = 0; s < 64; ++s) nn += wst[s] * ks[s * 132 + tid]; }
        __syncthreads();
        if (tid < 128) nvec[tid] = nn;
        m_st = blast + Mend;
        __syncthreads();
    }
}

__device__ __forceinline__ int scan_tok(bool isctx, int b, int h, int c, int j) {
    return isctx ? NLAT + b * CTXL + c * 64 + j : (h < 2 ? b * SEQ + c * 64 + j : b * SEQ + (j & 31) * 64 + 2 * c + (j >> 5));
}
__device__ __forceinline__ int img256(int row, int chunk) { return row * 256 + ((chunk ^ (row & 15)) << 4); }
__device__ __forceinline__ int img128(int row, int chunk) { return row * 128 + ((chunk ^ ((row >> 1) & 7)) << 4); }
__device__ __forceinline__ int off_b(int row, int ch) { return 256 * row + 16 * (ch ^ (((row & 3) << 2) | ((row >> 2) & 3))); }
__device__ __forceinline__ int rowrd16(int lane, int rb, int ks) { return off_b((lane & 15) + 16 * rb, 4 * ks + (lane >> 4)); }
__device__ __forceinline__ int trrd16(int lane, int c, int ks, int t) { const int g = lane >> 4, q = (lane & 15) >> 2, p = lane & 3;
    return off_b(32 * ks + 8 * g + 4 * t + q, 2 * c + (p >> 1)) + 8 * (p & 1); }
typedef short s16x4 __attribute__((ext_vector_type(4)));
__device__ __forceinline__ bf16x8 tr_frag(LAS unsigned char* img, int lane, int c, int ks, unsigned zv) {
    const s16x4 lo = __builtin_amdgcn_ds_read_tr16_b64_v4i16((LAS s16x4*)(img + trrd16(lane, c, ks, 0)));
    const s16x4 hi = __builtin_amdgcn_ds_read_tr16_b64_v4i16((LAS s16x4*)(img + trrd16(lane, c, ks, 1)));
    u32x2 a = __builtin_bit_cast(u32x2, lo), b = __builtin_bit_cast(u32x2, hi);
    a.x ^= zv; a.y ^= zv; b.x ^= zv; b.y ^= zv;
    const u32x4 r = (u32x4){a.x, a.y, b.x, b.y};
    return __builtin_bit_cast(bf16x8, r);
}
__device__ __forceinline__ void scan_mfma(Frame& F, int l) {
    if (F.bid >= 64) return;
    const int b = F.bid >> 3, h = (F.bid >> 1) & 3, dir = F.bid & 1;
    LAS unsigned char* L = F.lds;
    constexpr int O_QI = 0, O_KI = 16384, O_VI = 32768, O_ST = 49152, O_CL = 57344, O_HO = 94208, O_SM = 110592;
    LAS float* GV = (LAS float*)(L + O_SM);
    LAS float* SC = GV + 36 * 192;
    LAS float* DEN = SC + 36 * 4;
    const bf16_t* Q = WSP(bf16_t, WS_Q); const bf16_t* K = WSP(bf16_t, WS_K); const bf16_t* V = WSP(bf16_t, WS_V); const float* GATES = WSP(float, WS_GATES);
    bf16_t* H = dir ? WSP(bf16_t, WS_HB) : WSP(bf16_t, WS_HF);
    const int w = F.wave;
    { unsigned z0 = 0u; asm volatile("" : "+v"(z0));
      for (int i = F.tid; i < 36864 / 16; i += NTHR) *(LAS u32x4*)(L + O_CL + i * 16) = (u32x4){z0, z0, z0, z0}; }
    for (int cc = w; cc < 36; cc += NWAVES) {
        const bool ic = cc < 4; const int c_ = ic ? (dir ? 3 - cc : cc) : (dir ? 35 - cc : cc - 4), p_ = dir ? 63 - F.lane : F.lane;
        const f32x2 g = *(const f32x2*)(GATES + (size_t)scan_tok(ic, b, h, c_, p_) * 16 + h * 4 + 2 * dir);
        float x = logsigmoidf_(g[1]);
#pragma unroll
        for (int o = 1; o < 64; o <<= 1) { const float y = __shfl_up(x, o); if (F.lane >= o) x += y; }
        const float a = g[0] - x; float cm = a;
#pragma unroll
        for (int o = 1; o < 64; o <<= 1) { const float y = __shfl_up(cm, o); if (F.lane >= o) cm = fmaxf(cm, y); }
        GV[cc * 192 + p_] = a; GV[cc * 192 + 64 + p_] = x; GV[cc * 192 + 128 + p_] = cm;
        if (F.lane == 63) { SC[cc * 4 + 3] = x; SC[cc * 4 + 1] = cm; }
    }
    __syncthreads();
    if (F.tid == 0) { float m = 0.f;
        for (int cc = 0; cc < 36; ++cc) { const float Mend = fmaxf(m, SC[cc * 4 + 1]); SC[cc * 4 + 0] = m; SC[cc * 4 + 1] = Mend; SC[cc * 4 + 2] = expf(m - Mend); m = SC[cc * 4 + 3] + Mend; } }
    f32x4 accC[9];
#pragma unroll
    for (int i = 0; i < 9; ++i) accC[i] = (f32x4){0.f, 0.f, 0.f, 0.f};
    u32x4 pq[2], pk[2], pv[2];
#define SC_LOAD(CC) do { const int cc_ = (CC); const bool ic_ = cc_ < 4; const int c_ = ic_ ? (dir ? 3 - cc_ : cc_) : (dir ? 35 - cc_ : cc_ - 4); \
        _Pragma("unroll") for (int i_ = 0; i_ < 2; ++i_) { const int it_ = tid + NTHR * i_, s_ = it_ >> 4, c8_ = it_ & 15; const size_t o_ = (size_t)scan_tok(ic_, b, h, c_, s_) * 512 + h * 128 + c8_ * 8; \
            pq[i_] = *(const u32x4*)(Q + o_); pk[i_] = *(const u32x4*)(K + o_); pv[i_] = *(const u32x4*)(V + o_); } } while (0)
#define SC_WRITE() do { _Pragma("unroll") for (int i_ = 0; i_ < 2; ++i_) { const int it_ = tid + NTHR * i_, s_ = it_ >> 4, c8_ = it_ & 15; \
            *(LAS u32x4*)(L + O_QI + img256(s_, c8_)) = pq[i_]; *(LAS u32x4*)(L + O_KI + off_b(s_, c8_)) = pk[i_]; *(LAS u32x4*)(L + O_VI + off_b(s_, c8_)) = pv[i_]; } } while (0)
#define SC_MFMA(A, B, C) __builtin_amdgcn_mfma_f32_16x16x32_bf16((A), (B), (C), 0, 0, 0)
#define SC_BAR() do { asm volatile("s_waitcnt lgkmcnt(0)" ::: "memory"); __builtin_amdgcn_s_barrier(); asm volatile("" ::: "memory"); } while (0)
    {
        const int tid = F.tid;
        SC_LOAD(0);
        __syncthreads();
        SC_WRITE();
        __syncthreads();
    }
    for (int cc = 0; cc < 36; ++cc) {
        int tid = F.tid; asm volatile("" : "+v"(tid));
        const int lane = tid & 63, fr = lane & 15, fq = lane >> 4;
        const bool isctx = cc < 4, want_out = !(isctx && l == 1), more = cc + 1 < 36;
        const int c = isctx ? (dir ? 3 - cc : cc) : (dir ? 35 - cc : cc - 4);
        const LAS float* vb = GV + cc * 192; const float m_in = SC[cc * 4 + 0];
        unsigned zv = 0u; asm volatile("" : "+v"(zv));
        const short one_ = (fr == 0) ? (short)0x3F80 : (short)0;
        const bf16x8 ONES = (bf16x8){one_, one_, one_, one_, one_, one_, one_, one_};
        if (more) SC_LOAD(cc + 1);
        if (want_out) {
            const int tb = w >> 1, sb = 2 * (w & 1);
            f32x4 s0 = (f32x4){0.f, 0.f, 0.f, 0.f}, s1 = s0;
#pragma unroll
            for (int ks = 0; ks < 4; ++ks) {
                const bf16x8 fy = *(const LAS bf16x8*)(L + O_QI + img256(tb * 16 + fr, ks * 4 + fq));
                const bf16x8 fx0 = *(const LAS bf16x8*)(L + O_KI + rowrd16(lane, sb, ks)), fx1 = *(const LAS bf16x8*)(L + O_KI + rowrd16(lane, sb + 1, ks));
                s0 = SC_MFMA(fx0, fy, s0); s1 = SC_MFMA(fx1, fy, s1); }
            const int t = tb * 16 + fr; const float Mt = fmaxf(m_in, vb[128 + t]);
#pragma unroll
            for (int i = 0; i < 2; ++i) { const int sr0 = (sb + i) * 16 + 4 * fq; const f32x4 a4 = *(const LAS f32x4*)(vb + sr0); const f32x4 sv = i ? s1 : s0; f32x4 o;
#pragma unroll
                for (int r = 0; r < 4; ++r) { const int sI = sr0 + r; const bool valid = dir ? (sI >= t) : (sI <= t); o[r] = valid ? sv[r] * __expf(a4[r] - Mt) : 0.f; }
                *(LAS u32x2*)(L + O_ST + img128(t, sr0 >> 3) + (sr0 & 7) * 2) = pk4(o); }
        }
        SC_BAR();
        {
            const float decay = SC[cc * 4 + 2], Mend = SC[cc * 4 + 1];
#pragma unroll
            for (int et = 0; et < 9; ++et) accC[et] = accC[et] * decay;
#pragma unroll
            for (int ks = 0; ks < 2; ++ks) {
                const bf16x8 kx = tr_frag(L + O_KI, lane, w, ks, zv);
                const f32x4 a0 = *(const LAS f32x4*)(vb + 32 * ks + 8 * fq), a1 = *(const LAS f32x4*)(vb + 32 * ks + 8 * fq + 4);
                u32x4 ax;
#pragma unroll
                for (int j = 0; j < 4; ++j) { const float w0 = __expf((j < 2 ? a0[2 * j] : a1[2 * j - 4]) - Mend), w1 = __expf((j < 2 ? a0[2 * j + 1] : a1[2 * j - 3]) - Mend);
                    ax[j] = pk2(bf2f((unsigned short)kx[2 * j]) * w0, bf2f((unsigned short)kx[2 * j + 1]) * w1); }
                const bf16x8 axf = __builtin_bit_cast(bf16x8, ax);
#pragma unroll
                for (int et = 0; et < 8; ++et) { const bf16x8 fv = tr_frag(L + O_VI, lane, et, ks, zv); accC[et] = SC_MFMA(axf, fv, accC[et]); }
                accC[8] = SC_MFMA(axf, ONES, accC[8]);
            }
        }
        f32x4 num[4];
        if (want_out) {
            bf16x8 ac[4], av[2];
#pragma unroll
            for (int ks = 0; ks < 4; ++ks) ac[ks] = *(const LAS bf16x8*)(L + O_CL + img256(w * 16 + fr, ks * 4 + fq));
#pragma unroll
            for (int ks = 0; ks < 2; ++ks) av[ks] = tr_frag(L + O_VI, lane, w, ks, zv);
#pragma unroll
            for (int tb = 0; tb < 4; ++tb) {
                f32x4 nI = (f32x4){0.f, 0.f, 0.f, 0.f}, nS = nI;
#pragma unroll
                for (int ks = 0; ks < 4; ++ks) { const bf16x8 fy = *(const LAS bf16x8*)(L + O_QI + img256(tb * 16 + fr, ks * 4 + fq)); nI = SC_MFMA(ac[ks], fy, nI); }
#pragma unroll
                for (int ks = 0; ks < 2; ++ks) { const bf16x8 fs = *(const LAS bf16x8*)(L + O_ST + img128(tb * 16 + fr, ks * 4 + fq)); nS = SC_MFMA(av[ks], fs, nS); }
                num[tb] = nI * __expf(m_in - fmaxf(m_in, vb[128 + tb * 16 + fr])) + nS;
            }
            if (w < 4) {
                f32x4 dI = (f32x4){0.f, 0.f, 0.f, 0.f}, dS = dI;
#pragma unroll
                for (int ks = 0; ks < 4; ++ks) { const bf16x8 a8 = *(const LAS bf16x8*)(L + O_CL + img256(128 + fr, ks * 4 + fq)); const bf16x8 fy = *(const LAS bf16x8*)(L + O_QI + img256(w * 16 + fr, ks * 4 + fq)); dI = SC_MFMA(a8, fy, dI); }
#pragma unroll
                for (int ks = 0; ks < 2; ++ks) { const bf16x8 fs = *(const LAS bf16x8*)(L + O_ST + img128(w * 16 + fr, ks * 4 + fq)); dS = SC_MFMA(ONES, fs, dS); }
                const int t = w * 16 + fr; const float Mt = fmaxf(m_in, vb[128 + t]); const float den = __expf(m_in - Mt) * dI[0] + dS[0];
                if (lane < 16) DEN[t] = fmaxf(fabsf(den), __expf(-(vb[64 + t] + Mt)));
            }
        }
        SC_BAR();
        if (want_out) {
#pragma unroll
            for (int tb = 0; tb < 4; ++tb) { const int t = tb * 16 + fr, e0 = w * 16 + 4 * fq; const float rd = 1.0f / DEN[t];
                *(LAS u32x2*)(L + O_HO + img256(t, e0 >> 3) + (e0 & 7) * 2) = pk4(num[tb] * rd); }
        }
#pragma unroll
        for (int et = 0; et < 9; ++et) { const int d0 = w * 16 + 4 * fq; *(LAS u32x2*)(L + O_CL + img256(et * 16 + fr, d0 >> 3) + (d0 & 7) * 2) = pk4(accC[et]); }
        if (more) SC_WRITE();
        SC_BAR();
        if (want_out) {
            const int t = tid >> 3; bf16_t* hp = H + (size_t)scan_tok(isctx, b, h, c, t) * 512 + h * 128;
#pragma unroll
            for (int i = 0; i < 2; ++i) { const int ch = (tid & 7) * 2 + i; *(u32x4*)(hp + ch * 8) = *(const LAS u32x4*)(L + O_HO + img256(t, ch)); }
        }
    }
#undef SC_LOAD
#undef SC_WRITE
#undef SC_MFMA
#undef SC_BAR
}

__device__ __forceinline__ void helper_barrier(Frame& F, unsigned* cnt, unsigned nhelpers) {
    asm volatile("s_waitcnt vmcnt(0)" ::: "memory");
    __syncthreads();
    if (F.tid == 0) {
        __builtin_amdgcn_fence(__ATOMIC_RELEASE, "agent");
        asm volatile("s_waitcnt vmcnt(0)" ::: "memory");
        __hip_atomic_fetch_add(cnt, 1u, __ATOMIC_RELAXED, __HIP_MEMORY_SCOPE_AGENT);
        unsigned sp = 0;
        while (__hip_atomic_load(cnt, __ATOMIC_RELAXED, __HIP_MEMORY_SCOPE_AGENT) < nhelpers) { __builtin_amdgcn_s_sleep(2); if (++sp > (1u << 22)) break; }
        __builtin_amdgcn_fence(__ATOMIC_ACQUIRE, "agent");
        asm volatile("s_waitcnt vmcnt(0)" ::: "memory");
    }
    __syncthreads();
}

constexpr int NPHASES = 20;
enum { K_PREP = 0, K_NORM1, K_INPROJ, K_MIX1, K_MIX2, K_OUTPROJ, K_NORM2, K_TOPK, K_MOE1, K_MOE2, K_COMBINE };

__global__ void __launch_bounds__(NTHR, 2) fwd_kernel(Args args) {
    extern __shared__ __attribute__((aligned(16))) unsigned char lds_raw[];
    Frame F{(LAS unsigned char*)lds_raw, (int)threadIdx.x, (int)(threadIdx.x & 63), __builtin_amdgcn_readfirstlane((int)(threadIdx.x >> 6)), (int)gridDim.x, (int)blockIdx.x, args.ws, args};
    volatile LAS unsigned* MISC = (volatile LAS unsigned*)(F.lds + LDSCTL_OFF);
    if (F.tid < 16) MISC[F.tid] = 0u;
    __syncthreads();
    XcdBarrier bar; bar.bar = (unsigned*)(F.ws + WS_CTL); bar.x = 0; bar.st = MISC;
    const int lo = args.ph_lo, hi = args.ph_hi;
    if (hi - lo > 1) bar = xcd_barrier_post((unsigned*)(F.ws + WS_CTL), MISC);
    for (int ph = lo; ph < hi; ++ph) {
        int l, kind;
        if (ph == 0) { l = 0; kind = K_PREP; } else if (ph == 1) { l = 0; kind = K_NORM1; } else if (ph < 11) { l = 0; kind = K_INPROJ + (ph - 2); } else { l = 1; kind = K_INPROJ + (ph - 11); }
#ifndef PHMASK
#define PHMASK 0xFFFF
#endif
#define PHON(k) ((PHMASK >> (k)) & 1)
#ifndef REPMASK
#define REPMASK 0
#endif
        int nrep_ = 1 + ((REPMASK >> kind) & 1); asm volatile("" : "+s"(nrep_));
        for (int rep_ = 0; rep_ < nrep_; ++rep_) {
        if (rep_) xcd_barrier(bar);
        { int t_ = threadIdx.x, b_ = blockIdx.x; unsigned char* w_ = args.ws; asm volatile("" : "+v"(t_)); asm volatile("" : "+s"(b_)); asm volatile("" : "+s"(w_));
          F.tid = t_; F.lane = t_ & 63; F.wave = __builtin_amdgcn_readfirstlane(t_ >> 6); F.bid = b_; F.ws = w_; }
        l = __builtin_amdgcn_readfirstlane(l); kind = __builtin_amdgcn_readfirstlane(kind); asm volatile("" : "+s"(l)); asm volatile("" : "+s"(kind));
        unsigned char* ws = F.ws;
        bool run_gemm = (kind == K_INPROJ || kind == K_OUTPROJ || kind == K_MOE1 || kind == K_MOE2);
        int gm = kind == K_INPROJ ? GM_INPROJ : kind == K_OUTPROJ ? GM_OUT : kind == K_MOE1 ? GM_MOE1 : GM_MOE2, gc = F.bid, gG = F.G;
        const bool helper = (kind == K_MIX1) && (F.bid >= 64);
        switch (kind) {
        case K_PREP: if (PHON(0)) phase_prep(F); break;
        case K_NORM1: if (PHON(1)) phase_norm1_l0(F); break;
        case K_MIX1: if (PHON(3)) {
            if (!helper) scan_mfma(F, l);
            else { const int hb = F.bid - 64, hg = F.G - 64;
                conv_items(F, l, hb, hg);
                ztrans_items(F, l, hb * NWAVES + F.wave, hg * NWAVES);
                helper_barrier(F, (unsigned*)(ws + WS_CTL) + 8192 + 64 * l + 64 * 2 * rep_, (unsigned)hg);
                run_gemm = true; gm = GM_DFT; gc = hb; gG = hg; }
        } break;
        case K_MIX2: if (PHON(4)) finalize_h(F, l); break;
        case K_NORM2: if (PHON(6)) phase_norm2(F, l); break;
        case K_TOPK: if (PHON(7)) phase_topk(F, l); break;
        case K_COMBINE: if (PHON(10)) phase_combine(F, l); break;
        default: break;
        }
        if (run_gemm && PHON(2)) {
            GemmCtl S{gm, l, gG, gc, ws, F.A};
            const int ld = gm == GM_OUT ? KOUT : D;
            GEMM_PHASE(F.lds, ld, ld, S, S);
        }
        if (helper && PHON(3)) convert_moe_weights(F, l, (F.bid - 64) * NWAVES + F.wave, (F.G - 64) * NWAVES);
        }
        if (ph + 1 < hi) xcd_barrier(bar);
    }
}

extern "C" void kernel_launch(void* const* d_in, const int* in_sizes, int n_in, void* d_out, int out_size, void* d_ws, size_t ws_size, hipStream_t stream) {
    static int grid = 0;
    if (grid == 0) {
        if (n_in != 21 || out_size != NLAT * D || ws_size < WS_END) { fprintf(stderr, "kernel_launch: unexpected shapes (n_in %d out %d ws %zu need %zu)\n", n_in, out_size, ws_size, (size_t)WS_END); grid = -1; return; }
        int dev = 0, cus = 0, per_cu = 0;
        hipGetDevice(&dev); hipDeviceGetAttribute(&cus, hipDeviceAttributeMultiprocessorCount, dev);
        if (hipFuncSetAttribute((const void*)fwd_kernel, hipFuncAttributeMaxDynamicSharedMemorySize, LDS_BYTES) != hipSuccess) { fprintf(stderr, "kernel_launch: hipFuncSetAttribute failed\n"); grid = -1; return; }
        hipOccupancyMaxActiveBlocksPerMultiprocessor(&per_cu, (const void*)fwd_kernel, NTHR, LDS_BYTES);
        (void)hipGetLastError();
        if (per_cu < 1) fprintf(stderr, "kernel_launch: occupancy query reports %d\n", per_cu);
        grid = cus;
    }
    if (grid < 0) return;
    hipMemsetAsync((char*)d_ws + WS_CTL, 0, 65536, stream);
    Args a{};
    for (int i = 0; i < 21; ++i) a.in[i] = (const float*)d_in[i];
    a.out = (float*)d_out; a.ws = (unsigned char*)d_ws;
#if N_LAUNCHES == 1
    a.ph_lo = 0; a.ph_hi = NPHASES;
    void* kargs[] = {&a};
    hipError_t e = hipLaunchCooperativeKernel((const void*)fwd_kernel, dim3(grid), dim3(NTHR), kargs, LDS_BYTES, stream);
    if (e != hipSuccess) fprintf(stderr, "kernel_launch: cooperative launch failed: %s (grid %d)\n", hipGetErrorString(e), grid);
#else
#ifndef MAXPH
#define MAXPH NPHASES
#endif
    for (int ph = 0; ph < MAXPH; ++ph) { a.ph_lo = ph; a.ph_hi = ph + 1; hipLaunchKernelGGL(fwd_kernel, dim3(grid), dim3(NTHR), LDS_BYTES, stream, a); }
#endif
}
```

```cpp
#include <hip/hip_runtime.h>
#include <cstdio>
#include <cstdint>

#ifndef N_LAUNCHES
#define N_LAUNCHES 1
#endif
#ifndef USE_MFMA_GEMM
#define USE_MFMA_GEMM 1
#endif

#define LAS __attribute__((address_space(3)))
#define GAS __attribute__((address_space(1)))
typedef unsigned short bf16_t;
typedef short bf16x8 __attribute__((ext_vector_type(8)));
typedef float f32x4 __attribute__((ext_vector_type(4)));
typedef float f32x2 __attribute__((ext_vector_type(2)));
typedef unsigned u32x4 __attribute__((ext_vector_type(4)));
typedef unsigned u32x2 __attribute__((ext_vector_type(2)));
typedef GAS unsigned gu32;
#define RLX_AGENT __ATOMIC_RELAXED, __HIP_MEMORY_SCOPE_AGENT
#define LDS_WAIT() asm volatile("s_waitcnt lgkmcnt(0)" ::: "memory")
#define VM_WAIT() asm volatile("s_waitcnt vmcnt(0)" ::: "memory")

constexpr int D = 1024, NB = 8, SEQ = 2048, CTXL = 256;
constexpr int NLAT = NB * SEQ, NCTX = NB * CTXL, NTOK = NLAT + NCTX;
constexpr int INC = 2832, NIN = 2816;
constexpr int KOUT = 1280;
constexpr int NE = 16, RPE = 2304;
constexpr float EPS = 1e-6f;
constexpr int NTHR = 512, NWAVES = 8;

constexpr size_t al256(size_t x) { return (x + 255) & ~(size_t)255; }
constexpr size_t WS_CTL = 0;
constexpr size_t WS_MOD = WS_CTL + 65536;
constexpr size_t WS_WIN = WS_MOD + al256((size_t)2 * 9 * 6144 * 4);
constexpr size_t WS_WOUT = WS_WIN + (size_t)2 * NIN * D * 2;
constexpr size_t WS_WGU = WS_WOUT + (size_t)2 * D * KOUT * 2;
constexpr size_t WS_WD = WS_WGU + (size_t)NE * 2048 * D * 2;
constexpr size_t WS_FL = WS_WD + (size_t)NE * D * D * 2;
constexpr size_t WS_FC = WS_FL + (size_t)4096 * 1024 * 2;
constexpr size_t WS_X = WS_FL + (size_t)4096 * 2048 * 2 + (size_t)512 * 2048 * 2;
constexpr size_t WS_XN = WS_X + (size_t)NTOK * D * 4;
constexpr size_t WS_GATES = WS_XN + (size_t)NTOK * D * 2;
constexpr size_t WS_AFF = WS_GATES + (size_t)NTOK * 16 * 4;
constexpr size_t WS_INV = WS_AFF + (size_t)NTOK * 16 * 4;
constexpr size_t WS_ROWTOK = WS_INV + (size_t)NTOK * 16 * 4;
constexpr size_t WS_GATEV = WS_ROWTOK + (size_t)NE * RPE * 4;
constexpr size_t WS_R1 = WS_GATEV + (size_t)NE * RPE * 4;
constexpr size_t SZ_QKV = (size_t)NTOK * 512 * 2;
constexpr size_t WS_Q = WS_R1, WS_K = WS_Q + SZ_QKV, WS_V = WS_K + SZ_QKV, WS_O = WS_V + SZ_QKV;
constexpr size_t WS_HID = WS_R1;
constexpr size_t WS_R2 = WS_R1 + 4 * SZ_QKV;
constexpr size_t SZ_C = (size_t)NTOK * 256 * 2;
constexpr size_t WS_CA = WS_R2, WS_CG = WS_CA + SZ_C, WS_FR = WS_CG + SZ_C, WS_ZT = WS_FR + SZ_C;
constexpr size_t WS_ZO = WS_ZT + (size_t)2048 * 1024 * 2;
constexpr size_t WS_ZTC = WS_ZT + (size_t)2048 * 2048 * 2;
constexpr size_t WS_HF = WS_ZT + 2 * (size_t)2048 * 2048 * 2, WS_HB = WS_HF + SZ_QKV, WS_Y = WS_HB + SZ_QKV;
constexpr size_t WS_YS = WS_R2;
constexpr size_t WS_END = WS_Y + (size_t)NTOK * KOUT * 2;
static_assert((size_t)NE * RPE * D * 2 <= 4 * SZ_QKV, "HID alias");
static_assert(WS_YS + (size_t)NE * RPE * D * 2 <= WS_END, "YS alias");

constexpr int RING_BYTES = 139264;
constexpr int LDSCTL_OFF = RING_BYTES;
constexpr int LDS_BYTES = RING_BYTES + 1024;

__device__ __forceinline__ unsigned f2bf(float f) { unsigned u = __float_as_uint(f); u += 0x7FFFu + ((u >> 16) & 1u); return u >> 16; }
typedef __bf16 bf16x2_t __attribute__((ext_vector_type(2)));
__device__ __forceinline__ unsigned pk2(float lo, float hi) { const bf16x2_t r = __builtin_convertvector((f32x2){lo, hi}, bf16x2_t); return __builtin_bit_cast(unsigned, r); }
__device__ __forceinline__ float bf2f(unsigned b) { return __uint_as_float(b << 16); }
__device__ __forceinline__ float bflo(unsigned w) { return __uint_as_float(w << 16); }
__device__ __forceinline__ float bfhi(unsigned w) { return __uint_as_float(w & 0xffff0000u); }
__device__ __forceinline__ float sigmoidf_(float x) { return __builtin_amdgcn_rcpf(1.0f + __expf(-x)); }
__device__ __forceinline__ float siluf_(float x) { return x * __builtin_amdgcn_rcpf(1.0f + __expf(-x)); }
__device__ __forceinline__ float logsigmoidf_(float x) { return x >= 0.f ? -log1pf(expf(-x)) : x - log1pf(expf(x)); }
__device__ __forceinline__ float wave_sum(float v) {
#pragma unroll
    for (int o = 1; o < 64; o <<= 1) v += __shfl_xor(v, o);
    return v;
}
__device__ __forceinline__ u32x2 pk4(f32x4 v) { u32x2 w; w.x = pk2(v[0], v[1]); w.y = pk2(v[2], v[3]); return w; }

#define XB_TMO      128
#define XB_XCNT(j)  (256  + 64 * (j))
#define XB_XSUB(j)  (1280 + 64 * (j))
#define XB_XGEN(j)  (2304 + 64 * (j))
#define XB_TOP      3328
#define XB_TOPGEN   3392
#define XCD_BAR_WORDS 3456
#define XB_SPIN_CAP (1u << 22)
__device__ __forceinline__ unsigned xb_ld(unsigned* p)              { return __hip_atomic_load(p, __ATOMIC_RELAXED, __HIP_MEMORY_SCOPE_AGENT); }
__device__ __forceinline__ unsigned xb_add(unsigned* p, unsigned v) { return __hip_atomic_fetch_add(p, v, __ATOMIC_RELAXED, __HIP_MEMORY_SCOPE_AGENT); }
__device__ __forceinline__ unsigned xb_xcc_id() { return (unsigned)__builtin_amdgcn_s_getreg((3 << 11) | 20) & 0xFu; }
#define XB_SPIN(cond, bar) do { unsigned _sp = 0; while (cond) { __builtin_amdgcn_s_sleep(1); \
    if ((++_sp & 255u) == 0u) { if (xb_ld(&(bar)[XB_TMO])) break; if (_sp > XB_SPIN_CAP) { atomicAdd(&(bar)[XB_TMO], 1u); break; } } } } while (0)
struct XcdBarrier { unsigned* bar; unsigned x; volatile LAS unsigned* st; };
__device__ __forceinline__ XcdBarrier xcd_barrier_post(unsigned* bar, volatile LAS unsigned* st) {
    XcdBarrier b; b.bar = bar; b.x = xb_xcc_id(); b.st = st;
    if (threadIdx.x == 0) (void)xb_add(&bar[XB_XCNT(b.x)], 1u);
    return b;
}
__device__ __forceinline__ void xcd_barrier_complete(unsigned* bar, unsigned x, unsigned& nloc, unsigned& nx) {
    const unsigned G = gridDim.x * gridDim.y * gridDim.z;
    unsigned sum, cnt, mine, sp = 0u;
    for (;;) {
        sum = 0u; cnt = 0u; mine = 0u;
#pragma unroll
        for (unsigned j = 0; j < 16; ++j) { const unsigned c = xb_ld(&bar[XB_XCNT(j)]); sum += c; cnt += (c > 0u) ? 1u : 0u; mine = (j == x) ? c : mine; }
        if (sum == G) break;
        __builtin_amdgcn_s_sleep(1);
        if ((++sp & 255u) == 0u) { if (xb_ld(&bar[XB_TMO])) break; if (sp > XB_SPIN_CAP) { atomicAdd(&bar[XB_TMO], 1u); break; } }
    }
    nloc = mine > 0u ? mine : 1u; nx = cnt > 0u ? cnt : 1u;
}
__device__ __forceinline__ void xcd_barrier(const XcdBarrier& b) {
    asm volatile("s_waitcnt vmcnt(0)" ::: "memory");
    __syncthreads();
    if (threadIdx.x == 0) {
        unsigned* bar = b.bar;
        __builtin_amdgcn_s_waitcnt(0);
        unsigned nloc = b.st[0], nx = b.st[1];
        if (nloc == 0u) { xcd_barrier_complete(bar, b.x, nloc, nx); b.st[0] = nloc; b.st[1] = nx; }
        const unsigned old = xb_add(&bar[XB_XSUB(b.x)], 1u);
        const unsigned gen = old / nloc;
        if (old + 1u == (gen + 1u) * nloc) {
            __builtin_amdgcn_fence(__ATOMIC_RELEASE, "agent");
            asm volatile("s_waitcnt vmcnt(0)" ::: "memory");
            const unsigned og = xb_add(&bar[XB_TOP], 1u);
            const unsigned tg = og / nx;
            if (og + 1u == (tg + 1u) * nx) xb_add(&bar[XB_TOPGEN], 1u);
            else XB_SPIN(xb_ld(&bar[XB_TOPGEN]) == tg, bar);
            __builtin_amdgcn_fence(__ATOMIC_ACQUIRE, "agent");
            xb_add(&bar[XB_XGEN(b.x)], 1u);
            asm volatile("s_waitcnt vmcnt(0)" ::: "memory");
        } else {
            XB_SPIN(xb_ld(&bar[XB_XGEN(b.x)]) == gen, bar);
            __builtin_amdgcn_fence(__ATOMIC_ACQUIRE, "agent");
            asm volatile("s_waitcnt vmcnt(0)" ::: "memory");
        }
    }
    __syncthreads();
}

namespace pg8 {
constexpr int BM = 256, BK = 64, HALF = 128, HTB = HALF * BK * 2, STAGE_BYTES = 8 * HTB, NXCD = 8, WGM = 8;
__host__ __device__ __forceinline__ int lds_byte(int r, int c) { const int st = (r >> 4) * 2 + (c >> 5), rr = r & 15, cc = c & 31, ob = rr * 64 + cc * 2; return st * 1024 + (ob ^ (((ob >> 9) & 1) << 5)); }
__host__ __device__ __forceinline__ void stage_rc(int b, int& R, int& C) { const int st = b / 1024, sb = b % 1024, swz = sb ^ (((sb >> 9) & 1) << 5); R = (st >> 1) * 16 + swz / 64; C = (st & 1) * 32 + (swz % 64) / 2; }

struct Unit { const char* A; const char* B; const int* rows; int K, pm, pn, ex; };

__device__ __forceinline__ void map_tile(int L, int nM, int nN, int& pm, int& pn) {
    const int nwg = nM * nN; int wgid = L;
    { const int q = nwg / NXCD, r = nwg % NXCD, xcd = wgid % NXCD, off = wgid / NXCD; wgid = (xcd < r ? xcd * (q + 1) : r * (q + 1) + (xcd - r) * q) + off; }
    const int nig = WGM * nN, gid = wgid / nig, fm = gid * WGM, gsz = (nM - fm) < WGM ? (nM - fm) : WGM;
    pm = fm + ((wgid % nig) % gsz); pn = (wgid % nig) / gsz;
}
__device__ __forceinline__ void a_offs(const Unit& u, int lda, int tid, unsigned (&vA)[2][2]) {
#pragma unroll
    for (int h = 0; h < 2; ++h)
#pragma unroll
        for (int i = 0; i < 2; ++i) { int R, C; stage_rc(tid * 16 + i * 8192, R, C); const int r = h * HALF + R; const int ar = u.rows ? u.rows[r] : r; vA[h][i] = (unsigned)(ar * lda + C) * 2u; }
}

template <class Epi, class Sched>
__device__ __forceinline__ void gemm_phase(LAS unsigned char* lds, const int tid, const int lda, const int ldb, const Sched& S, const Epi& E) {
    const int wid = __builtin_amdgcn_readfirstlane(tid >> 6), lane = tid & 63, wr = wid >> 2, wc = wid & 3, fr = lane & 15, fq = lane >> 4;
    unsigned voffB[2];
#pragma unroll
    for (int i = 0; i < 2; ++i) { int R, C; stage_rc(tid * 16 + i * 8192, R, C); voffB[i] = (unsigned)(R * ldb + C) * 2u; }
    const size_t kstep = (size_t)(BK * 2);
    const size_t hsB = (size_t)HALF * ldb * 2;
    const unsigned ldsw = (unsigned)wid * 1024u;
    const int aoff = lds_byte(wr * 64 + fr, fq * 8), boff = lds_byte(wc * 32 + fr, fq * 8);
#define PG8_SA(b, h) (((b) * 2 + (h)) * HTB)
#define PG8_SB(b, h) ((4 + (b) * 2 + (h)) * HTB)
#define PG8_STAGE(bufoff, gbase, voff) do { _Pragma("unroll") for (int _i = 0; _i < 2; ++_i) \
        __builtin_amdgcn_global_load_lds((const unsigned*)((const char*)(gbase) + (voff)[_i]), (LAS unsigned*)(lds + (bufoff) + ldsw + _i * 8192), 16, 0, 0); } while (0)
#define PG8_LDA(dst, b, h) do { _Pragma("unroll") for (int m = 0; m < 4; ++m) _Pragma("unroll") for (int k = 0; k < 2; ++k) dst[m][k] = *(const LAS bf16x8*)(lds + PG8_SA(b, h) + aoff + m * 2048 + k * 1024); } while (0)
#define PG8_LDB(dst, b, h) do { _Pragma("unroll") for (int n = 0; n < 2; ++n) _Pragma("unroll") for (int k = 0; k < 2; ++k) dst[n][k] = *(const LAS bf16x8*)(lds + PG8_SB(b, h) + boff + n * 2048 + k * 1024); } while (0)
#define PG8_MMA(ai, bj, At, Bt) do { __builtin_amdgcn_s_setprio(1); _Pragma("unroll") for (int m = 0; m < 4; ++m) _Pragma("unroll") for (int n = 0; n < 2; ++n) _Pragma("unroll") for (int k = 0; k < 2; ++k) \
        acc[ai][bj][m][n] = __builtin_amdgcn_mfma_f32_16x16x32_bf16(Bt[n][k], At[m][k], acc[ai][bj][m][n], 0, 0, 0); __builtin_amdgcn_s_setprio(0); } while (0)
#define PG8_WAIT_V(n) asm volatile("s_waitcnt vmcnt(" #n ")" ::: "memory")
#define PG8_WAIT_L(n) asm volatile("s_waitcnt lgkmcnt(" #n ")" ::: "memory")
#define PG8_BAR __builtin_amdgcn_s_barrier()
#define PG8_SCHED __builtin_amdgcn_sched_barrier(0)
    Unit cur, nxt; int ui = 0;
    if (!S.next(0, cur)) return;
    f32x4 acc[2][2][4][2];
#pragma unroll
    for (int a = 0; a < 2; ++a)
#pragma unroll
        for (int b = 0; b < 2; ++b)
#pragma unroll
            for (int m = 0; m < 4; ++m)
#pragma unroll
                for (int n = 0; n < 2; ++n) acc[a][b][m][n] = (f32x4){0.f, 0.f, 0.f, 0.f};
    bf16x8 At[4][2], B0[2][2], B1[2][2];
    unsigned vA[2][2], wA[2][2];
    a_offs(cur, lda, tid, vA);
    const char* cA = cur.A; const char* cB = cur.B;
    PG8_STAGE(PG8_SB(0, 0), cB, voffB); PG8_STAGE(PG8_SB(0, 1), cB + hsB, voffB); PG8_STAGE(PG8_SA(0, 0), cA, vA[0]); PG8_STAGE(PG8_SA(0, 1), cA, vA[1]);
    if (wr == 1) PG8_BAR;
    PG8_WAIT_V(2); PG8_BAR;
    PG8_STAGE(PG8_SB(1, 0), cB + kstep, voffB); PG8_STAGE(PG8_SA(1, 0), cA + kstep, vA[0]); PG8_STAGE(PG8_SB(1, 1), cB + hsB + kstep, voffB);
    PG8_WAIT_V(6); PG8_BAR;
    for (;;) {
        const bool has_next = S.next(ui + 1, nxt);
        if (!has_next) nxt = cur;
        const char* nA = nxt.A; const char* nB = nxt.B;
        a_offs(nxt, lda, tid, wA);
        const int nt = cur.K / BK;
        asm volatile(".p2align 8" ::: "memory");
        for (int t = 0; t < nt; t += 2) {
            const bool last = (t == nt - 2);
            const char* a1 = cA + (size_t)(t + 1) * kstep;
            const char* a2 = last ? nA : cA + (size_t)(t + 2) * kstep; const char* b2 = last ? nB : cB + (size_t)(t + 2) * kstep;
            const char* a3 = a2 + kstep; const char* b3 = b2 + kstep;
            PG8_LDB(B0, 0, 0); PG8_LDB(B1, 0, 1); PG8_SCHED; PG8_LDA(At, 0, 0); PG8_STAGE(PG8_SA(1, 1), a1, vA[1]);
            if (last) {
#pragma unroll
                for (int h = 0; h < 2; ++h)
#pragma unroll
                    for (int i = 0; i < 2; ++i) vA[h][i] = wA[h][i];
            }
            PG8_WAIT_V(8); PG8_WAIT_L(0); PG8_BAR; PG8_MMA(0, 0, At, B0); PG8_MMA(0, 1, At, B1); PG8_BAR; PG8_SCHED;
            PG8_LDA(At, 0, 1); PG8_STAGE(PG8_SB(0, 0), b2, voffB); PG8_STAGE(PG8_SB(0, 1), b2 + hsB, voffB); PG8_STAGE(PG8_SA(0, 0), a2, vA[0]);
            PG8_WAIT_V(8); PG8_WAIT_L(0); PG8_BAR; PG8_MMA(1, 0, At, B0); PG8_MMA(1, 1, At, B1); PG8_BAR; PG8_SCHED;
            PG8_LDB(B0, 1, 0); PG8_LDB(B1, 1, 1); PG8_SCHED; PG8_LDA(At, 1, 0); PG8_STAGE(PG8_SA(0, 1), a2, vA[1]);
            PG8_WAIT_V(8); PG8_WAIT_L(0); PG8_BAR; PG8_MMA(0, 0, At, B0); PG8_MMA(0, 1, At, B1); PG8_BAR; PG8_SCHED;
            PG8_LDA(At, 1, 1); PG8_STAGE(PG8_SB(1, 0), b3, voffB); PG8_STAGE(PG8_SB(1, 1), b3 + hsB, voffB); PG8_STAGE(PG8_SA(1, 0), a3, vA[0]);
            PG8_WAIT_V(8); PG8_WAIT_L(0); PG8_BAR; PG8_MMA(1, 0, At, B0); PG8_MMA(1, 1, At, B1); PG8_BAR; PG8_SCHED;
        }
        if (wr == 0) PG8_BAR;
        { int fr_ = fr, fq_ = fq; asm volatile("" : "+v"(fr_), "+v"(fq_));
          E.run(acc, cur, wr, wc, fr_, fq_); }
        if (!has_next) break;
#pragma unroll
        for (int a = 0; a < 2; ++a)
#pragma unroll
            for (int b = 0; b < 2; ++b)
#pragma unroll
                for (int m = 0; m < 4; ++m)
#pragma unroll
                    for (int n = 0; n < 2; ++n) acc[a][b][m][n] = (f32x4){0.f, 0.f, 0.f, 0.f};
        cur = nxt; cA = nA; cB = nB; ++ui;
        if (wr == 1) PG8_BAR;
    }
    PG8_WAIT_V(0);
    PG8_BAR;
#undef PG8_SA
#undef PG8_SB
#undef PG8_STAGE
#undef PG8_LDA
#undef PG8_LDB
#undef PG8_MMA
#undef PG8_WAIT_V
#undef PG8_WAIT_L
#undef PG8_BAR
#undef PG8_SCHED
}
template <class Epi, class Sched>
__device__ __forceinline__ void gemm_phase_simt(LAS unsigned char* lds, const int tid, const int lda, const int ldb, const Sched& S, const Epi& E) {
    LAS float* As = (LAS float*)lds;
    LAS float* Bs = (LAS float*)(lds + 32 * 132 * 4);
    const int ty = tid >> 4, tx = tid & 15, c0 = (tx >> 2) * 32 + (tx & 3) * 4;
    const int lr = tid >> 2, lk = (tid & 3) * 8;
    Unit u;
    for (int ui = 0; S.next(ui, u); ++ui) {
        for (int sub = 0; sub < 4; ++sub) {
            const int sr = sub >> 1, sc = sub & 1;
            float acc[4][8];
#pragma unroll
            for (int i = 0; i < 4; ++i)
#pragma unroll
                for (int j = 0; j < 8; ++j) acc[i][j] = 0.f;
            const int arow = sr * 128 + lr, brow = sc * 128 + lr;
            const int ar = u.rows ? u.rows[arow] : arow;
            const bf16_t* ap = (const bf16_t*)u.A + (size_t)ar * lda + lk;
            const bf16_t* bp = (const bf16_t*)u.B + (size_t)brow * ldb + lk;
            for (int k0 = 0; k0 < u.K; k0 += 32) {
                const u32x4 av = *(const u32x4*)(ap + k0), bv = *(const u32x4*)(bp + k0);
                __syncthreads();
#pragma unroll
                for (int j = 0; j < 4; ++j) {
                    As[(lk + 2 * j) * 132 + lr] = bflo(av[j]); As[(lk + 2 * j + 1) * 132 + lr] = bfhi(av[j]);
                    Bs[(lk + 2 * j) * 132 + lr] = bflo(bv[j]); Bs[(lk + 2 * j + 1) * 132 + lr] = bfhi(bv[j]);
                }
                __syncthreads();
#pragma unroll 4
                for (int k = 0; k < 32; ++k) {
                    const f32x4 a4 = *(const LAS f32x4*)(As + k * 132 + ty * 4);
                    const f32x4 b0 = *(const LAS f32x4*)(Bs + k * 132 + c0), b1 = *(const LAS f32x4*)(Bs + k * 132 + c0 + 16);
#pragma unroll
                    for (int i = 0; i < 4; ++i)
#pragma unroll
                        for (int j = 0; j < 4; ++j) { acc[i][j] += a4[i] * b0[j]; acc[i][4 + j] += a4[i] * b1[j]; }
                }
            }
#pragma unroll
            for (int i = 0; i < 4; ++i)
                E.store1(u, sr * 128 + ty * 4 + i, sc * 128 + c0, (f32x4){acc[i][0], acc[i][1], acc[i][2], acc[i][3]}, (f32x4){acc[i][4], acc[i][5], acc[i][6], acc[i][7]});
        }
    }
    __syncthreads();
}
}

#if USE_MFMA_GEMM
#define GEMM_PHASE(lds, lda, ldb, S, E) pg8::gemm_phase(lds, F.tid, lda, ldb, S, E)
#else
#define GEMM_PHASE(lds, lda, ldb, S, E) pg8::gemm_phase_simt(lds, F.tid, lda, ldb, S, E)
#endif

struct Args { const float* in[21]; float* out; unsigned char* ws; int ph_lo, ph_hi; };
enum { I_X = 0, I_C, I_CTX, I_CCTX, I_WADA, I_BADA, I_GN1, I_WIN, I_BG, I_GH, I_CW, I_CB, I_CLG, I_CLB, I_WOUT, I_GN2, I_WR, I_WEG, I_WEU, I_WED, I_GF };
__device__ __forceinline__ const float* arg_in(const Args& a, int i) { asm volatile("" : "+s"(i)); return a.in[i]; }
struct Frame {
    LAS unsigned char* lds;
    int tid, lane, wave, G, bid;
    unsigned char* ws;
    const Args& A;
};
#define FIN(i) arg_in(F.A, (i))
#define WSP(T, off) ((T*)(F.ws + (off)))

template <class Src>
__device__ __forceinline__ void tr_item(const Src& src, bf16_t* dst, int ldd, int n0, int k0, LAS float* scr, int lane) {
    f32x4 v[8];
#pragma unroll
    for (int i = 0; i < 8; ++i) v[i] = src.ld4(k0 + i * 8 + (lane >> 3), n0 + (lane & 7) * 4);
#pragma unroll
    for (int i = 0; i < 8; ++i) { LAS float* p = scr + (i * 8 + (lane >> 3)) * 33 + (lane & 7) * 4; p[0] = v[i][0]; p[1] = v[i][1]; p[2] = v[i][2]; p[3] = v[i][3]; }
    LDS_WAIT(); asm volatile("" ::: "memory");
    const int c = lane & 7;
#pragma unroll
    for (int j = 0; j < 4; ++j) { const int n = (lane >> 3) + 8 * j; const LAS float* s = scr + (8 * c) * 33 + n;
        u32x4 o; o.x = pk2(s[0 * 33], s[1 * 33]); o.y = pk2(s[2 * 33], s[3 * 33]); o.z = pk2(s[4 * 33], s[5 * 33]); o.w = pk2(s[6 * 33], s[7 * 33]);
        *(u32x4*)(dst + (size_t)(n0 + n) * ldd + k0 + 8 * c) = o; }
    LDS_WAIT(); asm volatile("" ::: "memory");
}
struct SrcWin { const float* w; __device__ __forceinline__ f32x4 ld4(int k, int n) const { return *(const f32x4*)(w + (size_t)k * INC + (n < 1536 ? n : n + 16)); } };
struct SrcPlain { const float* w; int ld; __device__ __forceinline__ f32x4 ld4(int k, int n) const { return *(const f32x4*)(w + (size_t)k * ld + n); } };
struct SrcGU { const float* wg; const float* wu; __device__ __forceinline__ f32x4 ld4(int k, int n) const { const int grp = n >> 5, i = n & 31;
    const uintptr_t base = (uintptr_t)wg + ((i < 16) ? (uintptr_t)0 : ((uintptr_t)wu - (uintptr_t)wg));
    return *(const f32x4*)((const float*)base + (size_t)k * D + grp * 16 + (i & 15)); } };

__device__ __forceinline__ void tr_store(const f32x4 (&v)[8], bf16_t* dst, int ldd, int n0, int k0, LAS float* scr, int lane) {
#pragma unroll
    for (int i = 0; i < 8; ++i) { LAS float* p = scr + (i * 8 + (lane >> 3)) * 33 + (lane & 7) * 4; p[0] = v[i][0]; p[1] = v[i][1]; p[2] = v[i][2]; p[3] = v[i][3]; }
    LDS_WAIT(); asm volatile("" ::: "memory");
    const int c = lane & 7;
#pragma unroll
    for (int j = 0; j < 4; ++j) { const int n = (lane >> 3) + 8 * j; const LAS float* s = scr + (8 * c) * 33 + n;
        u32x4 o; o.x = pk2(s[0 * 33], s[1 * 33]); o.y = pk2(s[2 * 33], s[3 * 33]); o.z = pk2(s[4 * 33], s[5 * 33]); o.w = pk2(s[6 * 33], s[7 * 33]);
        *(u32x4*)(dst + (size_t)(n0 + n) * ldd + k0 + 8 * c) = o; }
    LDS_WAIT(); asm volatile("" ::: "memory");
}
struct MoeItem { bf16_t* dst; int n0, k0; };
__device__ __forceinline__ MoeItem moe_item_load(Frame& F, int l, int it, const float* wg, const float* wu, const float* wd, f32x4 (&v)[8]) {
    constexpr int I_GU = NE * 64 * 16;
    MoeItem m; const int lane = F.lane;
    if (it < I_GU) { const int e = it / 1024, r = it % 1024, sup = r >> 3, wv = r & 7, nb = (sup & 15) * 4 + (wv & 3), kb = (sup >> 4) * 2 + (wv >> 2);
        SrcGU s{wg + ((size_t)l * NE + e) * D * D, wu + ((size_t)l * NE + e) * D * D};
        m.dst = WSP(bf16_t, WS_WGU) + (size_t)e * 2048 * D; m.n0 = nb * 32; m.k0 = kb * 64;
#pragma unroll
        for (int i = 0; i < 8; ++i) v[i] = s.ld4(m.k0 + i * 8 + (lane >> 3), m.n0 + (lane & 7) * 4);
    } else { const int r0 = it - I_GU, e = r0 / 512, r = r0 % 512, sup = r >> 3, wv = r & 7, nb = (sup & 7) * 4 + (wv & 3), kb = (sup >> 3) * 2 + (wv >> 2);
        SrcPlain s{wd + ((size_t)l * NE + e) * D * D, D};
        m.dst = WSP(bf16_t, WS_WD) + (size_t)e * D * D; m.n0 = nb * 32; m.k0 = kb * 64;
#pragma unroll
        for (int i = 0; i < 8; ++i) v[i] = s.ld4(m.k0 + i * 8 + (lane >> 3), m.n0 + (lane & 7) * 4);
    }
    return m;
}
__device__ __forceinline__ void convert_moe_weights(Frame& F, int l, int gw, int ngw) {
    LAS float* scr = (LAS float*)(F.lds + F.wave * 8448);
    const float* w_e_gate = FIN(I_WEG); const float* w_e_up = FIN(I_WEU); const float* w_e_down = FIN(I_WED);
    constexpr int NIT = NE * 64 * 16 + NE * 32 * 16;
    if (gw >= NIT) return;
    f32x4 va[8], vb[8];
    MoeItem ma = moe_item_load(F, l, gw, w_e_gate, w_e_up, w_e_down, va), mb = ma;
    for (int it = gw; it < NIT; it += 2 * ngw) {
        const int i1 = it + ngw, i2 = it + 2 * ngw;
        if (i1 < NIT) mb = moe_item_load(F, l, i1, w_e_gate, w_e_up, w_e_down, vb);
        tr_store(va, ma.dst, D, ma.n0, ma.k0, scr, F.lane);
        if (i1 < NIT) {
            if (i2 < NIT) ma = moe_item_load(F, l, i2, w_e_gate, w_e_up, w_e_down, va);
            tr_store(vb, mb.dst, D, mb.n0, mb.k0, scr, F.lane);
        }
    }
}

__device__ __forceinline__ void phase_prep(Frame& F) {
    const int tid = F.tid;
    {
        LAS float* s = (LAS float*)F.lds;
        LAS float* red = (LAS float*)(F.lds + 9 * 1024 * 4);
        float* MOD = WSP(float, WS_MOD);
        const float* c_in = FIN(I_C); const float* c_ctx = FIN(I_CCTX); const float* w_ada = FIN(I_WADA); const float* b_ada = FIN(I_BADA);
        bool staged = false;
        for (int it = F.bid; it < 192; it += F.G) {
            if (!staged) { for (int i = tid; i < 9 * 1024; i += NTHR) { const int r = i >> 10, k = i & 1023; const float cv = (r < 8) ? c_in[r * 1024 + k] : c_ctx[k]; s[i] = siluf_(cv); } staged = true; }
            __syncthreads();
            const int l = it / 96, cgp = it % 96, col = cgp * 64 + (tid & 63), kq = tid >> 6;
            float acc[9];
#pragma unroll
            for (int r = 0; r < 9; ++r) acc[r] = 0.f;
            const float* w = w_ada + ((size_t)l * 1024 + kq * 128) * 6144 + col;
            for (int k0 = 0; k0 < 128; k0 += 32) {
                float wv[32];
#pragma unroll
                for (int k = 0; k < 32; ++k) wv[k] = w[(size_t)(k0 + k) * 6144];
#pragma unroll
                for (int k = 0; k < 32; ++k)
#pragma unroll
                    for (int r = 0; r < 9; ++r) acc[r] += s[r * 1024 + kq * 128 + k0 + k] * wv[k];
            }
#pragma unroll
            for (int r = 0; r < 9; ++r) red[(kq * 9 + r) * 64 + (tid & 63)] = acc[r];
            __syncthreads();
            for (int o = tid; o < 576; o += NTHR) { const int r = o >> 6, cc = o & 63; float sum = 0.f;
#pragma unroll
                for (int q = 0; q < 8; ++q) sum += red[(q * 9 + r) * 64 + cc];
                MOD[((size_t)l * 9 + r) * 6144 + cgp * 64 + cc] = sum + b_ada[l * 6144 + cgp * 64 + cc]; }
            __syncthreads();
        }
        __syncthreads();
    }
    {
        bf16_t* FL = WSP(bf16_t, WS_FL); bf16_t* FC = WSP(bf16_t, WS_FC);
        const size_t gth = (size_t)F.bid * NTHR + tid, nth = (size_t)F.G * NTHR;
        for (size_t it = gth; it < (size_t)4096 * 1024 / 8; it += nth) {
            const int r = (int)(it / 128), t0 = (int)(it % 128) * 8, part = r >> 11, k = r & 2047; unsigned w[4];
#pragma unroll
            for (int j = 0; j < 4; ++j) { float v[2];
#pragma unroll
                for (int q = 0; q < 2; ++q) { const int ph = (k * (t0 + 2 * j + q)) & 2047; const float ang = (float)ph * (6.283185307179586f / 2048.f); v[q] = (part ? sinf(ang) : cosf(ang)) * 0.022097086912079608f; }
                w[j] = pk2(v[0], v[1]); }
            *(u32x4*)(FL + (size_t)r * 1024 + t0) = (u32x4){w[0], w[1], w[2], w[3]};
        }
        for (size_t it = gth; it < (size_t)512 * 256 / 8; it += nth) {
            const int r = (int)(it / 32), t0 = (int)(it % 32) * 8, part = r >> 8, k = r & 255; unsigned w[4];
#pragma unroll
            for (int j = 0; j < 4; ++j) { float v[2];
#pragma unroll
                for (int q = 0; q < 2; ++q) { const int ph = (k * (t0 + 2 * j + q)) & 255; const float ang = (float)ph * (6.283185307179586f / 256.f); v[q] = (part ? sinf(ang) : cosf(ang)) * 0.0625f; }
                w[j] = pk2(v[0], v[1]); }
            *(u32x4*)(FC + (size_t)r * 1024 + t0) = (u32x4){w[0], w[1], w[2], w[3]};
        }
    }
    const int gw = F.bid * NWAVES + F.wave, ngw = F.G * NWAVES;
    {
        LAS float* scr = (LAS float*)(F.lds + F.wave * 8448);
        bf16_t* WIN = WSP(bf16_t, WS_WIN); bf16_t* WOUT = WSP(bf16_t, WS_WOUT);
        const float* w_in = FIN(I_WIN); const float* w_out = FIN(I_WOUT);
        constexpr int I_IN = 2 * 88 * 16, I_OP = 2 * 32 * 12, I_PQ = 2 * 32 * 8;
        for (int it = gw; it < I_IN + I_OP + I_PQ; it += ngw) {
            if (it < I_IN) { const int l = it / 1408, r = it % 1408, nb = r / 16, kb = r % 16;
                SrcWin s{w_in + (size_t)l * D * INC};
                tr_item(s, WIN + (size_t)l * NIN * D, D, nb * 32, kb * 64, scr, F.lane);
            } else if (it < I_IN + I_OP) { const int r0 = it - I_IN, l = r0 / 384, r = r0 % 384, nb = r / 12, kb = r % 12;
                SrcPlain s{w_out + (size_t)l * D * D, D};
                tr_item(s, WOUT + (size_t)l * D * KOUT, KOUT, nb * 32, kb * 64, scr, F.lane);
            } else { const int r0 = it - I_IN - I_OP, l = r0 / 256, r = r0 % 256, nb = r / 8, gp = r % 8, g = gp & 3, part = gp >> 2;
                const float* wsrc = w_out + (size_t)l * D * D + (size_t)(768 + g * 64) * D + nb * 32;
#pragma unroll 8
                for (int i = 0; i < 32; ++i) { const int kk = 2 * i + (F.lane >> 5), nn = F.lane & 31; scr[kk * 33 + nn] = wsrc[(size_t)kk * D + nn]; }
                LDS_WAIT(); asm volatile("" ::: "memory");
                const int c8 = F.lane & 7;
                float o[4][8];
#pragma unroll
                for (int j = 0; j < 4; ++j)
#pragma unroll
                    for (int q = 0; q < 8; ++q) o[j][q] = 0.f;
                for (int m = 0; m < 64; ++m) {
                    float twd[8];
#pragma unroll
                    for (int q = 0; q < 8; ++q) { const float ang = (float)((m * (c8 * 8 + q)) & 63) * (6.283185307179586f / 64.f); twd[q] = part ? -__sinf(ang) : __cosf(ang); }
#pragma unroll
                    for (int j = 0; j < 4; ++j) { const float bv = scr[m * 33 + (F.lane >> 3) + 8 * j];
#pragma unroll
                        for (int q = 0; q < 8; ++q) o[j][q] += twd[q] * bv; }
                }
#pragma unroll
                for (int j = 0; j < 4; ++j) { const int n = (F.lane >> 3) + 8 * j;
                    u32x4 ov; ov.x = pk2(o[j][0] * 0.125f, o[j][1] * 0.125f); ov.y = pk2(o[j][2] * 0.125f, o[j][3] * 0.125f); ov.z = pk2(o[j][4] * 0.125f, o[j][5] * 0.125f); ov.w = pk2(o[j][6] * 0.125f, o[j][7] * 0.125f);
                    *(u32x4*)(WOUT + (size_t)l * D * KOUT + (size_t)(nb * 32 + n) * KOUT + 768 + part * 256 + g * 64 + c8 * 8) = ov; }
                LDS_WAIT(); asm volatile("" ::: "memory");
            }
        }
    }
}

constexpr int ROW_PRM = 65536;
template <int CTRL> __device__ __forceinline__ float dppf(float v) { return __builtin_bit_cast(float, __builtin_amdgcn_update_dpp(0, __builtin_bit_cast(int, v), CTRL, 0xF, 0xF, true)); }
__device__ __forceinline__ float rdlane(float v, int l) { return __builtin_bit_cast(float, __builtin_amdgcn_readlane(__builtin_bit_cast(int, v), l)); }
__device__ __forceinline__ float wave_sum_dpp(float v) {
    v += dppf<0xB1>(v); v += dppf<0x4E>(v); v += dppf<0x141>(v); v += dppf<0x140>(v);
    return (rdlane(v, 0) + rdlane(v, 16)) + (rdlane(v, 32) + rdlane(v, 48));
}
__device__ __forceinline__ void stage_small_w(Frame& F, LAS float* wT, const float* src, int ld, int coloff) {
    for (int i = F.tid; i < 16 * 1024; i += NTHR) { const int k = i >> 4, c = i & 15; wT[c * 1024 + k] = src[(size_t)k * ld + coloff + c]; }
}
#define SWAP4(INS, a0, b0, a1, b1, a2, b2, a3, b3) asm volatile("s_nop 1\n\t" INS " %0, %1\n\t" INS " %2, %3\n\t" INS " %4, %5\n\t" INS " %6, %7\n\ts_nop 1" : "+v"(a0), "+v"(b0), "+v"(a1), "+v"(b1), "+v"(a2), "+v"(b2), "+v"(a3), "+v"(b3))
#ifdef OLD_REDUCE
__device__ __forceinline__ float reduce16(const float (&acc)[16], int lane) {
    float v8[8], v4[4], v2[2], v1;
#pragma unroll
    for (int i = 0; i < 8; ++i) { const float snd = (lane & 32) ? acc[i] : acc[i + 8], kp = (lane & 32) ? acc[i + 8] : acc[i]; v8[i] = kp + __shfl_xor(snd, 32); }
#pragma unroll
    for (int i = 0; i < 4; ++i) { const float snd = (lane & 16) ? v8[i] : v8[i + 4], kp = (lane & 16) ? v8[i + 4] : v8[i]; v4[i] = kp + __shfl_xor(snd, 16); }
#pragma unroll
    for (int i = 0; i < 2; ++i) { const float snd = (lane & 8) ? v4[i] : v4[i + 2], kp = (lane & 8) ? v4[i + 2] : v4[i]; v2[i] = kp + __shfl_xor(snd, 8); }
    { const float snd = (lane & 4) ? v2[0] : v2[1], kp = (lane & 4) ? v2[1] : v2[0]; v1 = kp + __shfl_xor(snd, 4); }
    v1 += __shfl_xor(v1, 2); v1 += __shfl_xor(v1, 1);
    return v1;
}
#else
__device__ __forceinline__ float reduce16(const float (&acc)[16], int lane) {
    float v8[8], v4[4], v2[2], v1, t[16];
#pragma unroll
    for (int i = 0; i < 16; ++i) t[i] = acc[i];
    SWAP4("v_permlane32_swap_b32", t[0], t[8], t[1], t[9], t[2], t[10], t[3], t[11]); SWAP4("v_permlane32_swap_b32", t[4], t[12], t[5], t[13], t[6], t[14], t[7], t[15]);
#pragma unroll
    for (int i = 0; i < 8; ++i) v8[i] = t[i] + t[i + 8];
    SWAP4("v_permlane16_swap_b32", v8[0], v8[4], v8[1], v8[5], v8[2], v8[6], v8[3], v8[7]);
#pragma unroll
    for (int i = 0; i < 4; ++i) v4[i] = v8[i] + v8[i + 4];
#pragma unroll
    for (int i = 0; i < 2; ++i) { const float snd = (lane & 8) ? v4[i] : v4[i + 2], kp = (lane & 8) ? v4[i + 2] : v4[i]; v2[i] = kp + dppf<0x140>(snd); }
    { const float snd = (lane & 4) ? v2[0] : v2[1], kp = (lane & 4) ? v2[1] : v2[0]; v1 = kp + dppf<0x141>(snd); }
    v1 += dppf<0x4E>(v1); v1 += dppf<0xB1>(v1);
    return v1;
}
#endif
__device__ __forceinline__ int mod_row(int tok) { return tok < NLAT ? (tok >> 11) : 8; }
__device__ __forceinline__ void pair_range(int ntok, int gw, int ngw, int& p0, int& p1) { const int np = ntok >> 1; p0 = (int)(((long long)np * gw) / ngw); p1 = (int)(((long long)np * (gw + 1)) / ngw); }
__device__ __forceinline__ void block_mod_rows(Frame& F, int ntok, int& mrA, int& mrB) {
    int q0, q1, r0, r1; pair_range(ntok, F.bid * NWAVES, F.G * NWAVES, q0, q1); pair_range(ntok, F.bid * NWAVES + NWAVES - 1, F.G * NWAVES, r0, r1);
    mrA = mod_row(min(2 * q0, ntok - 1)); mrB = mod_row(min(max(2 * r1 - 1, 0), ntok - 1));
}
__device__ __forceinline__ float sumsq4(const f32x4 (&v)[4]) { float ss = 0.f;
#pragma unroll
    for (int j = 0; j < 4; ++j) ss += (v[j][0] * v[j][0] + v[j][1] * v[j][1]) + (v[j][2] * v[j][2] + v[j][3] * v[j][3]);
    return ss; }
__device__ __forceinline__ void norm_pair(const f32x4 (&va)[4], const f32x4 (&vb)[4], const LAS float* cfp, const LAS float* shp, bf16_t* xn_a, f32x2 (&yy)[16], int lane) {
    const float ra = 1.0f / sqrtf(wave_sum_dpp(sumsq4(va)) * (1.0f / D) + EPS), rb = 1.0f / sqrtf(wave_sum_dpp(sumsq4(vb)) * (1.0f / D) + EPS);
#pragma unroll
    for (int j = 0; j < 4; ++j) { const int o = 4 * lane + 256 * j;
        const f32x4 cf = *(const LAS f32x4*)(cfp + o), sh = *(const LAS f32x4*)(shp + o);
        f32x4 ya, yb;
#pragma unroll
        for (int q = 0; q < 4; ++q) { ya[q] = va[j][q] * ra * cf[q] + sh[q]; yb[q] = vb[j][q] * rb * cf[q] + sh[q]; yy[4 * j + q] = (f32x2){ya[q], yb[q]}; }
        *(u32x2*)(xn_a + o) = pk4(ya); *(u32x2*)(xn_a + D + o) = pk4(yb); }
}
__device__ __forceinline__ void gate_products2(const f32x2 (&yy)[16], const LAS float* wT, int lane, float& ga, float& gb) {
    f32x2 acc[16];
#pragma unroll
    for (int c = 0; c < 16; ++c) acc[c] = (f32x2){0.f, 0.f};
#pragma unroll
    for (int j = 0; j < 4; ++j) {
#pragma unroll
        for (int h = 0; h < 2; ++h) {
            f32x4 wv[8];
#pragma unroll
            for (int c = 0; c < 8; ++c) wv[c] = *(const LAS f32x4*)(wT + (8 * h + c) * 1024 + 4 * lane + 256 * j);
            __builtin_amdgcn_sched_barrier(0);
#pragma unroll
            for (int c = 0; c < 8; ++c)
#pragma unroll
                for (int q = 0; q < 4; ++q) acc[8 * h + c] += yy[4 * j + q] * (f32x2){wv[c][q], wv[c][q]};
            __builtin_amdgcn_sched_barrier(0);
        }
    }
    float a1[16], b1[16];
#pragma unroll
    for (int c = 0; c < 16; ++c) { a1[c] = acc[c][0]; b1[c] = acc[c][1]; }
    ga = reduce16(a1, lane); gb = reduce16(b1, lane);
}
__device__ __forceinline__ void row_tail_gates(float myv, const float* b_gates_l, float* gates_row, int lane) {
    if ((lane & 3) == 0) { const int c = lane >> 2; gates_row[c] = myv + b_gates_l[c]; }
}
__device__ __forceinline__ void row_tail_router(float myv, float* aff_row, int lane) {
    float mx = myv;
#pragma unroll
    for (int o = 4; o < 64; o <<= 1) mx = fmaxf(mx, __shfl_xor(mx, o));
    const float e = expf(myv - mx); float s = e;
#pragma unroll
    for (int o = 4; o < 64; o <<= 1) s += __shfl_xor(s, o);
    if ((lane & 3) == 0) aff_row[lane >> 2] = e / s;
}
#define LOAD_PAIR(va, vb, src) { _Pragma("unroll") for (int j = 0; j < 4; ++j) { va[j] = *(const f32x4*)((src) + 4 * F.lane + 256 * j); vb[j] = *(const f32x4*)((src) + D + 4 * F.lane + 256 * j); } }

__device__ __forceinline__ void phase_norm1_l0(Frame& F) {
    LAS float* wT = (LAS float*)F.lds; LAS float* prm = (LAS float*)(F.lds + ROW_PRM);
    const float* MOD = WSP(float, WS_MOD); bf16_t* XN = WSP(bf16_t, WS_XN); float* GATES = WSP(float, WS_GATES);
    const float* x_in = FIN(I_X); const float* ctx_in = FIN(I_CTX); const float* g_norm1 = FIN(I_GN1); const float* b_gates = FIN(I_BG);
    const int gw = F.bid * NWAVES + F.wave, ngw = F.G * NWAVES;
    int p0, p1; pair_range(NTOK, gw, ngw, p0, p1);
#define N1_SRC(t) ((t) < NLAT ? x_in + (size_t)(t) * D : ctx_in + (size_t)((t) - NLAT) * D)
    f32x4 va[4], vb[4];
    if (p0 < p1) { const float* src = N1_SRC(2 * p0); LOAD_PAIR(va, vb, src) }
    int mrA, mrB; block_mod_rows(F, NTOK, mrA, mrB);
    stage_small_w(F, wT, FIN(I_WIN), INC, 1536);
    for (int i = F.tid; i < 2048; i += NTHR) { const int set = i >> 10, k = i & 1023; const float* md = MOD + (size_t)(set ? mrB : mrA) * 6144;
        prm[(set * 3 + 0) * 1024 + k] = g_norm1[k] * (1.0f + md[1024 + k]); prm[(set * 3 + 1) * 1024 + k] = md[k]; }
    __syncthreads();
    for (int p = p0; p < p1; ++p) {
        const int tok = 2 * p, set = (mod_row(tok) != mrA) ? 1 : 0;
        f32x2 yy[16];
        norm_pair(va, vb, prm + (set * 3 + 0) * 1024, prm + (set * 3 + 1) * 1024, XN + (size_t)tok * D, yy, F.lane);
        if (p + 1 < p1) { const float* src = N1_SRC(tok + 2); LOAD_PAIR(va, vb, src) }
        float ga, gb; gate_products2(yy, wT, F.lane, ga, gb);
        row_tail_gates(ga, b_gates, GATES + (size_t)tok * 16, F.lane); row_tail_gates(gb, b_gates, GATES + (size_t)(tok + 1) * 16, F.lane);
    }
#undef N1_SRC
    __syncthreads();
}
__device__ __forceinline__ void phase_norm2(Frame& F, int l) {
    LAS float* wT = (LAS float*)F.lds; LAS float* prm = (LAS float*)(F.lds + ROW_PRM);
    const float* g_norm2 = FIN(I_GN2) + l * D;
    const float* MOD = WSP(float, WS_MOD); bf16_t* XN = WSP(bf16_t, WS_XN); float* AFF = WSP(float, WS_AFF); const float* X = WSP(float, WS_X);
    const int gw = F.bid * NWAVES + F.wave, ngw = F.G * NWAVES;
    const int ntok = (l == 0) ? NTOK : NLAT;
    int p0, p1; pair_range(ntok, gw, ngw, p0, p1);
    f32x4 va[4], vb[4];
    if (p0 < p1) { const float* src = X + (size_t)(2 * p0) * D; LOAD_PAIR(va, vb, src) }
    int mrA, mrB; block_mod_rows(F, ntok, mrA, mrB);
    stage_small_w(F, wT, FIN(I_WR) + (size_t)l * D * 16, 16, 0);
    for (int i = F.tid; i < 2048; i += NTHR) { const int set = i >> 10, k = i & 1023; const float* md = MOD + ((size_t)l * 9 + (set ? mrB : mrA)) * 6144;
        prm[(set * 3 + 0) * 1024 + k] = g_norm2[k] * (1.0f + md[4 * 1024 + k]); prm[(set * 3 + 1) * 1024 + k] = md[3 * 1024 + k]; }
    __syncthreads();
    for (int p = p0; p < p1; ++p) {
        const int tok = 2 * p, set = (mod_row(tok) != mrA) ? 1 : 0;
        f32x2 yy[16];
        norm_pair(va, vb, prm + (set * 3 + 0) * 1024, prm + (set * 3 + 1) * 1024, XN + (size_t)tok * D, yy, F.lane);
        if (p + 1 < p1) { const float* src = X + (size_t)(tok + 2) * D; LOAD_PAIR(va, vb, src) }
        float ga, gb; gate_products2(yy, wT, F.lane, ga, gb);
        row_tail_router(ga, AFF + (size_t)tok * 16, F.lane); row_tail_router(gb, AFF + (size_t)(tok + 1) * 16, F.lane);
    }
    __syncthreads();
}
constexpr int CMB_K = 2;
struct CmbSlots { u32x2 y[2][CMB_K][4]; };
__device__ __forceinline__ unsigned row_inv_mask(int invw, int sub) { return (unsigned)((__ballot(invw >= 0) >> (16 * sub)) & 0xffffull); }
__device__ __forceinline__ void cmb_issue(CmbSlots& S, const bf16_t* YS, int invw_a, int sub_a, int invw_b, int sub_b, int lane) {
#pragma unroll
    for (int rr = 0; rr < 2; ++rr) { const int invw = rr ? invw_b : invw_a, sub = rr ? sub_b : sub_a; unsigned mask = row_inv_mask(invw, sub);
#pragma unroll
        for (int s = 0; s < CMB_K; ++s) {
            int e = 0, r = 0;
            if (mask) { e = __builtin_ctz(mask); mask &= mask - 1; r = __builtin_amdgcn_readlane(invw, 16 * sub + e); }
            const bf16_t* yr = YS + ((size_t)e * RPE + r) * D;
#pragma unroll
            for (int j = 0; j < 4; ++j) S.y[rr][s][j] = *(const u32x2*)(yr + 4 * lane + 256 * j); } }
}
__device__ __forceinline__ void cmb_accum(f32x4 (&a)[4], const u32x2 (&w)[4]) {
#pragma unroll
    for (int j = 0; j < 4; ++j) { a[j][0] += bflo(w[j].x); a[j][1] += bfhi(w[j].x); a[j][2] += bflo(w[j].y); a[j][3] += bfhi(w[j].y); }
}
__device__ __forceinline__ void phase_combine(Frame& F, int l) {
    LAS float* wT = (LAS float*)F.lds; LAS float* prm = (LAS float*)(F.lds + ROW_PRM);
    const float* g_norm1 = FIN(I_GN1) + D; const float* b_gates = FIN(I_BG) + 16; const float* g_final = FIN(I_GF); float* outp = F.A.out;
    const float* MOD = WSP(float, WS_MOD); bf16_t* XN = WSP(bf16_t, WS_XN); float* GATES = WSP(float, WS_GATES); float* X = WSP(float, WS_X);
    const int* INV = WSP(int, WS_INV); const bf16_t* YS = WSP(bf16_t, WS_YS);
    const int gw = F.bid * NWAVES + F.wave, ngw = F.G * NWAVES;
    const int ntok = (l == 0) ? NTOK : NLAT;
    int p0, p1; pair_range(ntok, gw, ngw, p0, p1);
    const int t0 = 2 * p0;
    int invw[3];
#pragma unroll
    for (int i = 0; i < 3; ++i) { const int idx = t0 * 16 + 64 * i + F.lane; invw[i] = (idx < ntok * 16) ? INV[idx] : -1; }
#define INVW(ri) (((ri) >> 2) == 0 ? invw[0] : ((ri) >> 2) == 1 ? invw[1] : invw[2])
    f32x4 va[4], vb[4]; CmbSlots S;
    if (p0 < p1) { const float* src = X + (size_t)t0 * D; LOAD_PAIR(va, vb, src) cmb_issue(S, YS, INVW(0), 0, INVW(1), 1, F.lane); }
    int mrA, mrB; block_mod_rows(F, ntok, mrA, mrB);
    if (l == 0) stage_small_w(F, wT, FIN(I_WIN) + (size_t)1 * D * INC, INC, 1536);
    for (int i = F.tid; i < 2048; i += NTHR) { const int set = i >> 10, k = i & 1023, mr = set ? mrB : mrA; const float* md = MOD + ((size_t)l * 9 + mr) * 6144; const float* md1 = MOD + ((size_t)9 + mr) * 6144;
        prm[(set * 3 + 2) * 1024 + k] = md[5 * 1024 + k];
        if (l == 0) { prm[(set * 3 + 0) * 1024 + k] = g_norm1[k] * (1.0f + md1[1024 + k]); prm[(set * 3 + 1) * 1024 + k] = md1[k]; }
        else prm[(set * 3 + 0) * 1024 + k] = g_final[k]; }
    __syncthreads();
    for (int p = p0; p < p1; ++p) {
        const int tok = 2 * p, ri = tok - t0, set = (mod_row(tok) != mrA) ? 1 : 0;
        const LAS float* pp = prm + set * 3 * 1024;
#pragma unroll
        for (int rr = 0; rr < 2; ++rr) {
            f32x4 a[4];
#pragma unroll
            for (int j = 0; j < 4; ++j) a[j] = (f32x4){0.f, 0.f, 0.f, 0.f};
            const int iw = INVW(ri + rr), sub = (ri + rr) & 3;
            unsigned mask = row_inv_mask(iw, sub);
#pragma unroll
            for (int s = 0; s < CMB_K; ++s) if (mask) { mask &= mask - 1; cmb_accum(a, S.y[rr][s]); }
            while (mask) { const int e = __builtin_ctz(mask); mask &= mask - 1;
                const int r = __builtin_amdgcn_readlane(iw, 16 * sub + e);
                const bf16_t* yr = YS + ((size_t)e * RPE + r) * D;
                u32x2 w[4];
#pragma unroll
                for (int j = 0; j < 4; ++j) w[j] = *(const u32x2*)(yr + 4 * F.lane + 256 * j);
                cmb_accum(a, w); }
#pragma unroll
            for (int j = 0; j < 4; ++j) { const f32x4 gt = *(const LAS f32x4*)(pp + 2 * 1024 + 4 * F.lane + 256 * j); if (rr == 0) va[j] = va[j] + gt * a[j]; else vb[j] = vb[j] + gt * a[j]; }
        }
        if (l == 0) {
#pragma unroll
            for (int j = 0; j < 4; ++j) { *(f32x4*)(X + (size_t)tok * D + 4 * F.lane + 256 * j) = va[j]; *(f32x4*)(X + (size_t)(tok + 1) * D + 4 * F.lane + 256 * j) = vb[j]; }
            f32x2 yy[16];
            norm_pair(va, vb, pp, pp + 1024, XN + (size_t)tok * D, yy, F.lane);
            if (p + 1 < p1) { const float* src = X + (size_t)(tok + 2) * D; LOAD_PAIR(va, vb, src) cmb_issue(S, YS, INVW(ri + 2), (ri + 2) & 3, INVW(ri + 3), (ri + 3) & 3, F.lane); }
            float ga, gb; gate_products2(yy, wT, F.lane, ga, gb);
            row_tail_gates(ga, b_gates, GATES + (size_t)tok * 16, F.lane); row_tail_gates(gb, b_gates, GATES + (size_t)(tok + 1) * 16, F.lane);
        } else {
            const float ra = 1.0f / sqrtf(wave_sum_dpp(sumsq4(va)) * (1.0f / D) + EPS), rb = 1.0f / sqrtf(wave_sum_dpp(sumsq4(vb)) * (1.0f / D) + EPS);
#pragma unroll
            for (int j = 0; j < 4; ++j) { const f32x4 g = *(const LAS f32x4*)(pp + 4 * F.lane + 256 * j);
                *(f32x4*)(outp + (size_t)tok * D + 4 * F.lane + 256 * j) = va[j] * ra * g; *(f32x4*)(outp + (size_t)(tok + 1) * D + 4 * F.lane + 256 * j) = vb[j] * rb * g; }
            if (p + 1 < p1) { const float* src = X + (size_t)(tok + 2) * D; LOAD_PAIR(va, vb, src) cmb_issue(S, YS, INVW(ri + 2), (ri + 2) & 3, INVW(ri + 3), (ri + 3) & 3, F.lane); }
        }
    }
#undef INVW
    __syncthreads();
}

__device__ __forceinline__ int block_count(LAS int* cbuf, int par, int wave, int lane, int c_wave  ) {
    if (lane == 0) cbuf[par * 8 + wave] = c_wave;
    __syncthreads();
    int t = 0;
#pragma unroll
    for (int q = 0; q < 8; ++q) t += cbuf[par * 8 + q];
    return t;
}
__device__ __forceinline__ void phase_topk(Frame& F, int l) {
    LAS int* cbuf = (LAS int*)F.lds;
    const float* AFF = WSP(float, WS_AFF); int* INV = WSP(int, WS_INV); int* ROWTOK = WSP(int, WS_ROWTOK); float* GATEV = WSP(float, WS_GATEV);
    const int nitems = (l == 0) ? 256 : 128;
    for (int it = F.bid; it < nitems; it += F.G) {
        const int s = it >> 4, e = it & 15;
        const bool lat = s < 8;
        const int n = lat ? SEQ : CTXL, cap = lat ? 256 : 32, tok0 = lat ? s * SEQ : NLAT + (s - 8) * CTXL, rowbase = lat ? s * 256 : 2048 + (s - 8) * 32;
        const bool active = 4 * F.tid < n;
        unsigned k[4];
#pragma unroll
        for (int q = 0; q < 4; ++q) k[q] = active ? __float_as_uint(AFF[(size_t)(tok0 + 4 * F.tid + q) * 16 + e]) : 0u;
        __syncthreads();
        unsigned T = 0u; int par = 0;
        for (int bit = 30; bit >= 0; --bit) {
            const unsigned cand = T | (1u << bit);
            int cw = 0;
#pragma unroll
            for (int q = 0; q < 4; ++q) cw += __popcll(__ballot(k[q] >= cand));
            const int tot = block_count(cbuf, par, F.wave, F.lane, cw); par ^= 1;
            if (tot >= cap) T = cand;
        }
        int cw = 0;
#pragma unroll
        for (int q = 0; q < 4; ++q) cw += __popcll(__ballot(k[q] > T));
        const int c_gt = block_count(cbuf, par, F.wave, F.lane, cw); par ^= 1;
        int mg = 0, me = 0;
#pragma unroll
        for (int q = 0; q < 4; ++q) { mg += (k[q] > T) ? 1 : 0; me += (k[q] == T && active) ? 1 : 0; }
        int pk_ = mg | (me << 16), inc = pk_;
#pragma unroll
        for (int o = 1; o < 64; o <<= 1) { const int y = __shfl_up(inc, o); if (F.lane >= o) inc += y; }
        if (F.lane == 63) cbuf[16 + F.wave] = inc;
        __syncthreads();
        int base = 0;
#pragma unroll
        for (int q = 0; q < 8; ++q) base += (q < F.wave) ? cbuf[16 + q] : 0;
        int pre = base + inc - pk_; int pg = pre & 0xffff, pe = pre >> 16;
        if (active) {
#pragma unroll
            for (int q = 0; q < 4; ++q) {
                const int tok = tok0 + 4 * F.tid + q; int slot = -1;
                if (k[q] > T) { slot = pg; ++pg; }
                else if (k[q] == T) { if (c_gt + pe < cap) slot = c_gt + pe; ++pe; }
                if (slot >= 0) { ROWTOK[e * RPE + rowbase + slot] = tok; GATEV[e * RPE + rowbase + slot] = __uint_as_float(k[q]); }
                INV[(size_t)tok * 16 + e] = slot >= 0 ? rowbase + slot : -1;
            }
        }
        __syncthreads();
    }
    __syncthreads();
}

__device__ __forceinline__ void conv_items(Frame& F, int l, int first, int stride) {
    LAS float* gl = (LAS float*)F.lds;
    LAS float* ob = gl + 62 * 256;
    const bf16_t* CA = WSP(bf16_t, WS_CA); const bf16_t* CG = WSP(bf16_t, WS_CG); bf16_t* Y = WSP(bf16_t, WS_Y);
    const int nitems = (l == 0) ? 512 + 64 : 512;
    const int ch = F.tid & 255, th = F.tid >> 8;
    const float* conv_w = FIN(I_CW); const float* conv_b = FIN(I_CB); const float* conv_ln_g = FIN(I_CLG); const float* conv_ln_b = FIN(I_CLB);
    float w[31];
#pragma unroll
    for (int j = 0; j < 31; ++j) w[j] = conv_w[((size_t)l * 31 + j) * 256 + ch];
    const float cb = conv_b[l * 256 + ch];
    for (int it = first; it < nitems; it += stride) {
        const bool lat = it < 512;
        const int seqlen = lat ? SEQ : CTXL;
        const int b = lat ? it >> 6 : (it - 512) >> 3, t0 = lat ? (it & 63) * 32 : ((it - 512) & 7) * 32;
        const int tokb = lat ? b * SEQ : NLAT + b * CTXL;
        __syncthreads();
        for (int i = F.tid; i < 62 * 64; i += NTHR) {
            const int rr = i >> 6, c4 = (i & 63) * 4, t = t0 - 15 + rr;
            f32x4 g = (f32x4){0.f, 0.f, 0.f, 0.f};
            if (t >= 0 && t < seqlen) { const size_t o = (size_t)(tokb + t) * 256 + c4; const u32x2 a = *(const u32x2*)(CA + o), gg = *(const u32x2*)(CG + o);
                g[0] = bflo(a.x) * sigmoidf_(bflo(gg.x)); g[1] = bfhi(a.x) * sigmoidf_(bfhi(gg.x)); g[2] = bflo(a.y) * sigmoidf_(bflo(gg.y)); g[3] = bfhi(a.y) * sigmoidf_(bfhi(gg.y)); }
            *(LAS f32x4*)(gl + rr * 256 + c4) = g;
        }
        __syncthreads();
        for (int tt = 0; tt < 16; ++tt) {
            const LAS float* gp = gl + (th * 16 + tt) * 256 + ch;
            float gv[31];
#pragma unroll
            for (int j = 0; j < 31; ++j) gv[j] = gp[j * 256];
            __builtin_amdgcn_sched_barrier(0);
            float o = cb;
#pragma unroll
            for (int j = 0; j < 31; ++j) o += w[j] * gv[j];
            __builtin_amdgcn_sched_barrier(0);
            ob[(th * 16 + tt) * 256 + ch] = o;
        }
        __syncthreads();
        for (int tt = F.wave; tt < 32; tt += NWAVES) {
            const f32x4 v = *(const LAS f32x4*)(ob + tt * 256 + 4 * F.lane);
            const float mean = wave_sum((v[0] + v[1]) + (v[2] + v[3])) * (1.0f / 256.f);
            const f32x4 d = v - mean;
            const float var = wave_sum((d[0] * d[0] + d[1] * d[1]) + (d[2] * d[2] + d[3] * d[3])) * (1.0f / 256.f);
            const float rs = 1.0f / sqrtf(var + EPS);
            const f32x4 lg = *(const f32x4*)(conv_ln_g + l * 256 + 4 * F.lane), lb = *(const f32x4*)(conv_ln_b + l * 256 + 4 * F.lane);
            f32x4 y;
#pragma unroll
            for (int q = 0; q < 4; ++q) y[q] = siluf_(d[q] * rs * lg[q] + lb[q]);
            *(u32x2*)(Y + (size_t)(tokb + t0 + tt) * KOUT + 512 + 4 * F.lane) = pk4(y);
        }
    }
    __syncthreads();
}
__device__ __forceinline__ void ztrans_items(Frame& F, int l, int first, int stride) {
    LAS unsigned short* te = (LAS unsigned short*)(F.lds + F.wave * (2 * 64 * 66 * 2));
    LAS unsigned short* to = te + 64 * 66;
    const bf16_t* FR = WSP(bf16_t, WS_FR); bf16_t* ZE = WSP(bf16_t, WS_ZT); bf16_t* ZO = WSP(bf16_t, WS_ZO); bf16_t* ZTC = WSP(bf16_t, WS_ZTC);
    const int nlat = 8 * 16 * 4, nctx = (l == 0) ? 8 * 4 * 4 : 0;
    for (int it = first; it < nlat + nctx; it += stride) {
        const bool lat = it < nlat; const int r = lat ? it : it - nlat;
        const int b = lat ? r >> 6 : r >> 4, tb = lat ? (r >> 2) & 15 : (r >> 2) & 3, cb = r & 3;
        const int tokb = lat ? b * SEQ : NLAT + b * CTXL;
#pragma unroll
        for (int i = 0; i < 8; ++i) { const int tt = (F.lane >> 3) + 8 * i, c8 = (F.lane & 7) * 8, t = tb * 64 + tt;
            const u32x4 v = *(const u32x4*)(FR + (size_t)(tokb + t) * 256 + cb * 64 + c8);
            u32x4 m = (u32x4){0u, 0u, 0u, 0u};
            if (lat && t > 0) m = *(const u32x4*)(FR + (size_t)(tokb + SEQ - t) * 256 + cb * 64 + c8);
#pragma unroll
            for (int q = 0; q < 4; ++q) {
                if (lat) { const float a0 = bflo(v[q]), a1 = bfhi(v[q]), m0 = bflo(m[q]), m1 = bfhi(m[q]); const unsigned e_ = pk2(a0 + m0, a1 + m1), o_ = (t > 0) ? pk2(a0 - m0, a1 - m1) : 0u;
                    te[(c8 + 2 * q) * 66 + tt] = (unsigned short)(e_ & 0xffffu); te[(c8 + 2 * q + 1) * 66 + tt] = (unsigned short)(e_ >> 16);
                    to[(c8 + 2 * q) * 66 + tt] = (unsigned short)(o_ & 0xffffu); to[(c8 + 2 * q + 1) * 66 + tt] = (unsigned short)(o_ >> 16); }
                else { te[(c8 + 2 * q) * 66 + tt] = (unsigned short)(v[q] & 0xffffu); te[(c8 + 2 * q + 1) * 66 + tt] = (unsigned short)(v[q] >> 16); } } }
        LDS_WAIT(); asm volatile("" ::: "memory");
        const size_t drow = (size_t)(b * 256 + cb * 64) * 1024 + tb * 64;
#pragma unroll
        for (int i = 0; i < 8; ++i) { const int cc = (F.lane >> 3) + 8 * i, t8 = (F.lane & 7) * 8; u32x4 o;
#pragma unroll
            for (int q = 0; q < 4; ++q) o[q] = (unsigned)te[cc * 66 + t8 + 2 * q] | ((unsigned)te[cc * 66 + t8 + 2 * q + 1] << 16);
            *(u32x4*)((lat ? ZE : ZTC) + drow + (size_t)cc * 1024 + t8) = o;
            if (lat) {
#pragma unroll
                for (int q = 0; q < 4; ++q) o[q] = (unsigned)to[cc * 66 + t8 + 2 * q] | ((unsigned)to[cc * 66 + t8 + 2 * q + 1] << 16);
                *(u32x4*)(ZO + drow + (size_t)cc * 1024 + t8) = o; } }
        LDS_WAIT(); asm volatile("" ::: "memory");
    }
}
__device__ __forceinline__ void finalize_h(Frame& F, int l) {
    const bf16_t* HF = WSP(bf16_t, WS_HF); const bf16_t* HB = WSP(bf16_t, WS_HB); const bf16_t* O = WSP(bf16_t, WS_O); bf16_t* Y = WSP(bf16_t, WS_Y);
    const int gw = F.bid * NWAVES + F.wave, ngw = F.G * NWAVES;
    const int ntok = (l == 0) ? NTOK : NLAT;
    float gh[8];
    const float* g_hnorm = FIN(I_GH);
#pragma unroll
    for (int q = 0; q < 8; ++q) gh[q] = g_hnorm[l * 512 + 8 * F.lane + q];
    for (int tok = gw; tok < ntok; tok += ngw) {
        const size_t o = (size_t)tok * 512 + 8 * F.lane;
        const u32x4 a = *(const u32x4*)(HF + o), b = *(const u32x4*)(HB + o), og = *(const u32x4*)(O + o);
        float h[8]; float ss = 0.f;
#pragma unroll
        for (int q = 0; q < 4; ++q) { h[2 * q] = bflo(a[q]) + bflo(b[q]); h[2 * q + 1] = bfhi(a[q]) + bfhi(b[q]); ss += h[2 * q] * h[2 * q] + h[2 * q + 1] * h[2 * q + 1]; }
#pragma unroll
        for (int s = 1; s < 16; s <<= 1) ss += __shfl_xor(ss, s);
        const float r = 1.0f / sqrtf(ss * (1.0f / 128.f) + EPS);
        u32x4 w;
#pragma unroll
        for (int q = 0; q < 4; ++q) w[q] = pk2(h[2 * q] * r * gh[2 * q] * bflo(og[q]), h[2 * q + 1] * r * gh[2 * q + 1] * bfhi(og[q]));
        *(u32x4*)(Y + (size_t)tok * KOUT + 8 * F.lane) = w;
    }
}

using pg8::Unit;
enum { GM_INPROJ = 0, GM_DFT, GM_OUT, GM_MOE1, GM_MOE2 };
struct GemmCtl {
    int mode, l, G, c; unsigned char* ws; const Args& A;
    __device__ __forceinline__ unsigned char* W() const { unsigned char* p = ws; asm volatile("" : "+s"(p)); return p; }
    __device__ __forceinline__ bool next(int i, Unit& u) const {
        const int L = i * G + c; int pm, pn;
        u.rows = nullptr; u.ex = 0;
        switch (mode) {
        case GM_INPROJ: {
            const int n0 = 64 * 11, npn = (l == 0) ? 11 : 6;
            if (L >= n0 + 8 * npn) return false;
            if (L < n0) pg8::map_tile(L, 64, 11, pm, pn); else { pg8::map_tile(L - n0, 8, npn, pm, pn); pm += 64; }
            u.A = (const char*)(W() + WS_XN) + (size_t)pm * 256 * D * 2; u.B = (const char*)(W() + WS_WIN) + ((size_t)l * NIN + pn * 256) * D * 2; u.K = D;
        } break;
        case GM_DFT: {
            const int nctx = (l == 0) ? 16 : 0;
            if (L >= 128 + nctx) return false;
            if (L < 128) { pg8::map_tile(L, 16, 8, pm, pn); u.A = (const char*)(W() + WS_FL) + (size_t)pm * 256 * 1024 * 2; u.B = (const char*)(W() + ((pm >> 3) ? WS_ZO : WS_ZT)) + (size_t)pn * 256 * 1024 * 2; u.K = 1024; }
            else { const int r = L - 128; pm = r & 1; pn = r >> 1; u.A = (const char*)(W() + WS_FC) + (size_t)pm * 256 * 1024 * 2; u.B = (const char*)(W() + WS_ZTC) + (size_t)pn * 256 * 1024 * 2; u.K = CTXL; u.ex = 1; }
        } break;
        case GM_OUT: {
            const int nM = (l == 0) ? 72 : 64;
            if (L >= nM * 4) return false;
            pg8::map_tile(L, nM, 4, pm, pn);
            u.A = (const char*)(W() + WS_Y) + (size_t)pm * 256 * KOUT * 2; u.B = (const char*)(W() + WS_WOUT) + ((size_t)l * D + pn * 256) * KOUT * 2; u.K = KOUT;
        } break;
        case GM_MOE1: {
            const int nMe = (l == 0) ? 9 : 8; int pmg;
            if (L >= NE * nMe * 8) return false;
            pg8::map_tile(L, NE * nMe, 8, pmg, pn);
            const int e = pmg / nMe; pm = pmg % nMe;
            u.A = (const char*)(W() + WS_XN); u.rows = (const int*)(W() + WS_ROWTOK) + e * RPE + pm * 256; u.B = (const char*)(W() + WS_WGU) + ((size_t)e * 2048 + pn * 256) * D * 2; u.K = D; u.ex = e;
        } break;
        default: {
            const int nMe = (l == 0) ? 9 : 8; int pmg;
            if (L >= NE * nMe * 4) return false;
            pg8::map_tile(L, NE * nMe, 4, pmg, pn);
            const int e = pmg / nMe; pm = pmg % nMe;
            u.A = (const char*)(W() + WS_HID) + ((size_t)e * RPE + pm * 256) * D * 2; u.B = (const char*)(W() + WS_WD) + ((size_t)e * D + pn * 256) * D * 2; u.K = D; u.ex = e;
        } break;
        }
        u.pm = pm; u.pn = pn;
        return true;
    }
    struct CxIn { bf16_t* dst; int ld; float sc; int act; };
    __device__ __forceinline__ CxIn prep_in(const Unit& u) const {
        CxIn c; const int pn = u.pn; c.sc = 1.f; c.act = 0; size_t off; int cb;
        if (pn < 2) { off = WS_Q; c.ld = 512; cb = pn * 256; }
        else if (pn < 4) { off = WS_K; c.ld = 512; cb = (pn - 2) * 256; c.sc = 0.08838834764831845f; }
        else if (pn < 6) { off = WS_V; c.ld = 512; cb = (pn - 4) * 256; }
        else if (pn < 8) { off = WS_O; c.ld = 512; cb = (pn - 6) * 256; c.act = 1; }
        else if (pn == 8) { off = WS_CA; c.ld = 256; cb = 0; }
        else if (pn == 9) { off = WS_CG; c.ld = 256; cb = 0; }
        else { off = WS_FR; c.ld = 256; cb = 0; }
        c.dst = (bf16_t*)(W() + off) + (size_t)u.pm * 256 * c.ld + cb;
        return c;
    }
    __device__ __forceinline__ void store_in(const CxIn& c, int r, int col, f32x4 v0, f32x4 v1) const {
        if (c.act) {
#pragma unroll
            for (int q = 0; q < 4; ++q) { v0[q] = sigmoidf_(v0[q]); v1[q] = sigmoidf_(v1[q]); }
        } else { v0 = v0 * c.sc; v1 = v1 * c.sc; }
        bf16_t* p = c.dst + (size_t)r * c.ld + col;
        *(u32x2*)p = pk4(v0); *(u32x2*)(p + 16) = pk4(v1);
    }
    struct CxDft { bf16_t* dst; const bf16_t* z1024; };
    __device__ __forceinline__ CxDft prep_dft(const Unit& u) const {
        CxDft c; int part, tokb; c.z1024 = nullptr;
        if (u.ex == 0) { part = u.pm >> 3; tokb = u.pn * SEQ + (u.pm & 7) * 256; if (part == 0) c.z1024 = (const bf16_t*)(W() + WS_FR) + (size_t)(u.pn * SEQ + 1024) * 256; }
        else { part = u.pm; tokb = NLAT + u.pn * CTXL; }
        c.dst = (bf16_t*)(W() + WS_Y) + (size_t)tokb * KOUT + 768 + part * 256; return c;
    }
    __device__ __forceinline__ void store_dft(const CxDft& c, int r, int col, f32x4 v0, f32x4 v1) const {
        if (c.z1024) { const float sg = (r & 1) ? -0.022097086912079608f : 0.022097086912079608f; const u32x2 z0 = *(const u32x2*)(c.z1024 + col), z1 = *(const u32x2*)(c.z1024 + col + 16);
            v0[0] += sg * bflo(z0.x); v0[1] += sg * bfhi(z0.x); v0[2] += sg * bflo(z0.y); v0[3] += sg * bfhi(z0.y);
            v1[0] += sg * bflo(z1.x); v1[1] += sg * bfhi(z1.x); v1[2] += sg * bflo(z1.y); v1[3] += sg * bfhi(z1.y); }
        bf16_t* p = c.dst + (size_t)r * KOUT + col;
        *(u32x2*)p = pk4(v0); *(u32x2*)(p + 16) = pk4(v1);
    }
    struct CxOut { const float* src; float* dst; const float* gt; };
    __device__ __forceinline__ CxOut prep_out(const Unit& u) const {
        CxOut c; const int tok0 = u.pm * 256, col0 = u.pn * 256;
        if (l == 0) c.src = (tok0 < NLAT ? arg_in(A, I_X) + (size_t)tok0 * D : arg_in(A, I_CTX) + (size_t)(tok0 - NLAT) * D) + col0;
        else c.src = (const float*)(W() + WS_X) + (size_t)tok0 * D + col0;
        c.dst = (float*)(W() + WS_X) + (size_t)tok0 * D + col0;
        c.gt = (const float*)(W() + WS_MOD) + ((size_t)l * 9 + mod_row(tok0)) * 6144 + 2 * 1024 + col0;
        return c;
    }
    __device__ __forceinline__ void store_out(const CxOut& c, int r, int col, f32x4 v0, f32x4 v1) const {
        const size_t o = (size_t)r * D + col;
        const f32x4 g0 = *(const f32x4*)(c.gt + col), g1 = *(const f32x4*)(c.gt + col + 16);
        const f32x4 s0 = *(const f32x4*)(c.src + o), s1 = *(const f32x4*)(c.src + o + 16);
        *(f32x4*)(c.dst + o) = s0 + g0 * v0; *(f32x4*)(c.dst + o + 16) = s1 + g1 * v1;
    }
    __device__ __forceinline__ bf16_t* prep_m1(const Unit& u) const { return (bf16_t*)(W() + WS_HID) + ((size_t)u.ex * RPE + u.pm * 256) * D + u.pn * 128; }
    __device__ __forceinline__ void store_m1(bf16_t* dst, int r, int col, f32x4 v0, f32x4 v1) const {
        f32x4 h;
#pragma unroll
        for (int q = 0; q < 4; ++q) h[q] = siluf_(v0[q]) * v1[q];
        *(u32x2*)(dst + (size_t)r * D + (col >> 5) * 16 + (col & 15)) = pk4(h);
    }
    struct CxM2 { bf16_t* dst; const float* g; };
    __device__ __forceinline__ CxM2 prep_m2(const Unit& u) const { CxM2 c; c.dst = (bf16_t*)(W() + WS_YS) + ((size_t)u.ex * RPE + u.pm * 256) * D + u.pn * 256; c.g = (const float*)(W() + WS_GATEV) + u.ex * RPE + u.pm * 256; return c; }
    __device__ __forceinline__ void store_m2(const CxM2& c, int r, int col, f32x4 v0, f32x4 v1) const {
        const float g = c.g[r];
        bf16_t* p = c.dst + (size_t)r * D + col;
        *(u32x2*)p = pk4(v0 * g); *(u32x2*)(p + 16) = pk4(v1 * g);
    }
#define EPI_WALK(PREP, STORE) do { const auto cx = PREP(u); _Pragma("unroll") for (int ai = 0; ai < 2; ++ai) _Pragma("unroll") for (int m = 0; m < 4; ++m) _Pragma("unroll") for (int bj = 0; bj < 2; ++bj) \
        STORE(cx, ai * 128 + wr * 64 + m * 16 + fr, bj * 128 + wc * 32 + 4 * fq, acc[ai][bj][m][0], acc[ai][bj][m][1]); } while (0)
    __device__ __forceinline__ void run(const f32x4 (&acc)[2][2][4][2], const Unit& u, int wr, int wc, int fr, int fq) const {
        switch (mode) {
        case GM_INPROJ: EPI_WALK(prep_in, store_in); break;
        case GM_DFT: EPI_WALK(prep_dft, store_dft); break;
        case GM_OUT: EPI_WALK(prep_out, store_out); break;
        case GM_MOE1: EPI_WALK(prep_m1, store_m1); break;
        default: EPI_WALK(prep_m2, store_m2); break;
        }
    }
    __device__ __forceinline__ void store1(const Unit& u, int r, int c, f32x4 v0, f32x4 v1) const {
        switch (mode) {
        case GM_INPROJ: store_in(prep_in(u), r, c, v0, v1); break;
        case GM_DFT: store_dft(prep_dft(u), r, c, v0, v1); break;
        case GM_OUT: store_out(prep_out(u), r, c, v0, v1); break;
        case GM_MOE1: store_m1(prep_m1(u), r, c, v0, v1); break;
        default: store_m2(prep_m2(u), r, c, v0, v1); break;
        }
    }
};

__device__ __forceinline__ void scan_simt(Frame& F, int l) {
    if (F.bid >= 64) return;
    const int b = F.bid >> 3, h = (F.bid >> 1) & 3, dir = F.bid & 1;
    LAS float* qs = (LAS float*)F.lds; LAS float* ks = qs + 64 * 132; LAS float* vs = ks + 64 * 132; LAS float* st = vs + 64 * 132;
    LAS float* sm = st + 64 * 65;
    LAS float* as_ = sm; LAS float* Ms = sm + 64; LAS float* wint = sm + 128; LAS float* enm = sm + 192; LAS float* wst = sm + 256; LAS float* denom = sm + 320;
    LAS float* nvec = sm + 384; LAS float* ig = sm + 512; LAS float* lf = sm + 576; LAS int* toks = (LAS int*)(sm + 640); LAS float* scal = sm + 704;
    const bf16_t* Q = WSP(bf16_t, WS_Q); const bf16_t* K = WSP(bf16_t, WS_K); const bf16_t* V = WSP(bf16_t, WS_V); const float* GATES = WSP(float, WS_GATES);
    bf16_t* H = dir ? WSP(bf16_t, WS_HB) : WSP(bf16_t, WS_HF);
    float Creg[32];
#pragma unroll
    for (int i = 0; i < 32; ++i) Creg[i] = 0.f;
    float m_st = 0.f;
    if (F.tid < 128) nvec[F.tid] = 0.f;
    __syncthreads();
    for (int cc = 0; cc < 36; ++cc) {
        int tid = F.tid; asm volatile("" : "+v"(tid));
        const int lane = tid & 63, e = tid >> 2, dq = tid & 3;
        const bool isctx = cc < 4;
        const int c = isctx ? (dir ? 3 - cc : cc) : (dir ? 35 - cc : cc - 4);
        const bool want_out = !(isctx && l == 1);
        if (tid < 64) { const int j = tid;
            const int tok = isctx ? NLAT + b * CTXL + c * 64 + j : (h < 2 ? b * SEQ + c * 64 + j : b * SEQ + (j & 31) * 64 + 2 * c + (j >> 5));
            toks[j] = tok; const float* g = GATES + (size_t)tok * 16 + h * 4 + 2 * dir; ig[j] = g[0]; lf[j] = logsigmoidf_(g[1]); }
        __syncthreads();
        for (int it = tid; it < 1024; it += NTHR) { const int j = it >> 4, c8 = (it & 15) * 8; const size_t o = (size_t)toks[j] * 512 + h * 128 + c8;
            const u32x4 qv = *(const u32x4*)(Q + o), kv = *(const u32x4*)(K + o), vv = *(const u32x4*)(V + o);
#pragma unroll
            for (int q = 0; q < 4; ++q) { qs[j * 132 + c8 + 2 * q] = bflo(qv[q]); qs[j * 132 + c8 + 2 * q + 1] = bfhi(qv[q]); ks[j * 132 + c8 + 2 * q] = bflo(kv[q]); ks[j * 132 + c8 + 2 * q + 1] = bfhi(kv[q]);
                vs[j * 132 + c8 + 2 * q] = bflo(vv[q]); vs[j * 132 + c8 + 2 * q + 1] = bfhi(vv[q]); } }
        if (F.wave == 0) {
            const int p = dir ? 63 - lane : lane;
            float x = lf[p];
#pragma unroll
            for (int o = 1; o < 64; o <<= 1) { const float y = __shfl_up(x, o); if (lane >= o) x += y; }
            const float a = ig[p] - x; float cm = a;
#pragma unroll
            for (int o = 1; o < 64; o <<= 1) { const float y = __shfl_up(cm, o); if (lane >= o) cm = fmaxf(cm, y); }
            const float M = fmaxf(m_st, cm), Mend = __shfl(M, 63), blast = __shfl(x, 63);
            as_[p] = a; Ms[p] = M; wint[p] = expf(m_st - M); enm[p] = expf(-(x + M)); wst[p] = expf(a - Mend);
            if (lane == 0) { scal[0] = Mend; scal[1] = blast; }
        }
        __syncthreads();
        const float Mend = scal[0], blast = scal[1], decay = expf(m_st - Mend);
        if (want_out) {
            { const int t = tid >> 3, sg = tid & 7; float sacc[8];
#pragma unroll
                for (int i = 0; i < 8; ++i) sacc[i] = 0.f;
                for (int d4 = 0; d4 < 32; ++d4) { const f32x4 q4 = *(const LAS f32x4*)(qs + t * 132 + d4 * 4);
#pragma unroll
                    for (int i = 0; i < 8; ++i) { const f32x4 k4 = *(const LAS f32x4*)(ks + (i * 8 + sg) * 132 + d4 * 4); sacc[i] += (q4[0] * k4[0] + q4[1] * k4[1]) + (q4[2] * k4[2] + q4[3] * k4[3]); } }
#pragma unroll
                for (int i = 0; i < 8; ++i) { const int s = i * 8 + sg; const bool valid = dir ? (s >= t) : (s <= t); st[t * 65 + s] = valid ? sacc[i] * expf(as_[s] - Ms[t]) : 0.f; } }
            __syncthreads();
            if (tid < 64) { const int t = tid; float qn = 0.f, ssum = 0.f;
                for (int d = 0; d < 128; ++d) qn += qs[t * 132 + d] * nvec[d];
                for (int s = 0; s < 64; ++s) ssum += st[t * 65 + s];
                const float den = wint[t] * qn + ssum; denom[t] = fmaxf(fabsf(den), enm[t]); }
            float mine[16];
#pragma unroll
            for (int tt = 0; tt < 16; ++tt) {
                mine[tt] = 0.f;
#pragma unroll
                for (int u = 0; u < 4; ++u) { const int t = 4 * tt + u; float p = 0.f;
#pragma unroll
                    for (int i4 = 0; i4 < 8; ++i4) { const f32x4 q4 = *(const LAS f32x4*)(qs + t * 132 + dq * 32 + i4 * 4); p += (Creg[4 * i4] * q4[0] + Creg[4 * i4 + 1] * q4[1]) + (Creg[4 * i4 + 2] * q4[2] + Creg[4 * i4 + 3] * q4[3]); }
                    p += __shfl_xor(p, 1); p += __shfl_xor(p, 2);
                    mine[tt] = (u == dq) ? p : mine[tt]; asm volatile("" ::: "memory"); }
            }
#pragma unroll
            for (int tt = 0; tt < 16; ++tt) { const int t = 4 * tt + dq; float intra = 0.f;
#pragma unroll 8
                for (int s = 0; s < 64; ++s) intra += st[t * 65 + s] * vs[s * 132 + e];
                mine[tt] = wint[t] * mine[tt] + intra; asm volatile("" ::: "memory"); }
            __syncthreads();
#pragma unroll
            for (int tt = 0; tt < 16; ++tt) { const int t = 4 * tt + dq; H[(size_t)toks[t] * 512 + h * 128 + e] = (bf16_t)f2bf(mine[tt] / denom[t]); }
        }
#pragma unroll
        for (int i = 0; i < 32; ++i) Creg[i] *= decay;
#pragma unroll 2
        for (int s = 0; s < 64; ++s) { const float wv = wst[s] * vs[s * 132 + e];
#pragma unroll
            for (int i4 = 0; i4 < 8; ++i4) { const f32x4 k4 = *(const LAS f32x4*)(ks + s * 132 + dq * 32 + i4 * 4); Creg[4 * i4] += wv * k4[0]; Creg[4 * i4 + 1] += wv * k4[1]; Creg[4 * i4 + 2] += wv * k4[2]; Creg[4 * i4 + 3] += wv * k4[3]; } }
        float nn = 0.f;
        if (tid < 128) { nn = decay * nvec[tid]; for (int s = 0; s < 64; ++s) nn += wst[s] * ks[s * 132 + tid]; }
        __syncthreads();
        if (tid < 128) nvec[tid] = nn;
        m_st = blast + Mend;
        __syncthreads();
    }
}

__device__ __forceinline__ int scan_tok(bool isctx, int b, int h, int c, int j) {
    return isctx ? NLAT + b * CTXL + c * 64 + j : (h < 2 ? b * SEQ + c * 64 + j : b * SEQ + (j & 31) * 64 + 2 * c + (j >> 5));
}
__device__ __forceinline__ int img256(int row, int chunk) { return row * 256 + ((chunk ^ (row & 15)) << 4); }
__device__ __forceinline__ int img128(int row, int chunk) { return row * 128 + ((chunk ^ ((row >> 1) & 7)) << 4); }
__device__ __forceinline__ int off_b(int row, int ch) { return 256 * row + 16 * (ch ^ (((row & 3) << 2) | ((row >> 2) & 3))); }
__device__ __forceinline__ int rowrd16(int lane, int rb, int ks) { return off_b((lane & 15) + 16 * rb, 4 * ks + (lane >> 4)); }
__device__ __forceinline__ int trrd16(int lane, int c, int ks, int t) { const int g = lane >> 4, q = (lane & 15) >> 2, p = lane & 3;
    return off_b(32 * ks + 8 * g + 4 * t + q, 2 * c + (p >> 1)) + 8 * (p & 1); }
typedef short s16x4 __attribute__((ext_vector_type(4)));
__device__ __forceinline__ bf16x8 tr_frag(LAS unsigned char* img, int lane, int c, int ks, unsigned zv) {
    const s16x4 lo = __builtin_amdgcn_ds_read_tr16_b64_v4i16((LAS s16x4*)(img + trrd16(lane, c, ks, 0)));
    const s16x4 hi = __builtin_amdgcn_ds_read_tr16_b64_v4i16((LAS s16x4*)(img + trrd16(lane, c, ks, 1)));
    u32x2 a = __builtin_bit_cast(u32x2, lo), b = __builtin_bit_cast(u32x2, hi);
    a.x ^= zv; a.y ^= zv; b.x ^= zv; b.y ^= zv;
    const u32x4 r = (u32x4){a.x, a.y, b.x, b.y};
    return __builtin_bit_cast(bf16x8, r);
}
__device__ __forceinline__ void scan_mfma(Frame& F, int l) {
    if (F.bid >= 64) return;
    const int b = F.bid >> 3, h = (F.bid >> 1) & 3, dir = F.bid & 1;
    LAS unsigned char* L = F.lds;
    constexpr int O_QI = 0, O_KI = 16384, O_VI = 32768, O_ST = 49152, O_CL = 57344, O_HO = 94208, O_SM = 110592;
    LAS float* GV = (LAS float*)(L + O_SM);
    LAS float* SC = GV + 36 * 192;
    LAS float* DEN = SC + 36 * 4;
    const bf16_t* Q = WSP(bf16_t, WS_Q); const bf16_t* K = WSP(bf16_t, WS_K); const bf16_t* V = WSP(bf16_t, WS_V); const float* GATES = WSP(float, WS_GATES);
    bf16_t* H = dir ? WSP(bf16_t, WS_HB) : WSP(bf16_t, WS_HF);
    const int w = F.wave;
    { unsigned z0 = 0u; asm volatile("" : "+v"(z0));
      for (int i = F.tid; i < 36864 / 16; i += NTHR) *(LAS u32x4*)(L + O_CL + i * 16) = (u32x4){z0, z0, z0, z0}; }
    for (int cc = w; cc < 36; cc += NWAVES) {
        const bool ic = cc < 4; const int c_ = ic ? (dir ? 3 - cc : cc) : (dir ? 35 - cc : cc - 4), p_ = dir ? 63 - F.lane : F.lane;
        const f32x2 g = *(const f32x2*)(GATES + (size_t)scan_tok(ic, b, h, c_, p_) * 16 + h * 4 + 2 * dir);
        float x = logsigmoidf_(g[1]);
#pragma unroll
        for (int o = 1; o < 64; o <<= 1) { const float y = __shfl_up(x, o); if (F.lane >= o) x += y; }
        const float a = g[0] - x; float cm = a;
#pragma unroll
        for (int o = 1; o < 64; o <<= 1) { const float y = __shfl_up(cm, o); if (F.lane >= o) cm = fmaxf(cm, y); }
        GV[cc * 192 + p_] = a; GV[cc * 192 + 64 + p_] = x; GV[cc * 192 + 128 + p_] = cm;
        if (F.lane == 63) { SC[cc * 4 + 3] = x; SC[cc * 4 + 1] = cm; }
    }
    __syncthreads();
    if (F.tid == 0) { float m = 0.f;
        for (int cc = 0; cc < 36; ++cc) { const float Mend = fmaxf(m, SC[cc * 4 + 1]); SC[cc * 4 + 0] = m; SC[cc * 4 + 1] = Mend; SC[cc * 4 + 2] = expf(m - Mend); m = SC[cc * 4 + 3] + Mend; } }
    f32x4 accC[9];
#pragma unroll
    for (int i = 0; i < 9; ++i) accC[i] = (f32x4){0.f, 0.f, 0.f, 0.f};
    u32x4 pq[2], pk[2], pv[2];
#define SC_LOAD(CC) do { const int cc_ = (CC); const bool ic_ = cc_ < 4; const int c_ = ic_ ? (dir ? 3 - cc_ : cc_) : (dir ? 35 - cc_ : cc_ - 4); \
        _Pragma("unroll") for (int i_ = 0; i_ < 2; ++i_) { const int it_ = tid + NTHR * i_, s_ = it_ >> 4, c8_ = it_ & 15; const size_t o_ = (size_t)scan_tok(ic_, b, h, c_, s_) * 512 + h * 128 + c8_ * 8; \
            pq[i_] = *(const u32x4*)(Q + o_); pk[i_] = *(const u32x4*)(K + o_); pv[i_] = *(const u32x4*)(V + o_); } } while (0)
#define SC_WRITE() do { _Pragma("unroll") for (int i_ = 0; i_ < 2; ++i_) { const int it_ = tid + NTHR * i_, s_ = it_ >> 4, c8_ = it_ & 15; \
            *(LAS u32x4*)(L + O_QI + img256(s_, c8_)) = pq[i_]; *(LAS u32x4*)(L + O_KI + off_b(s_, c8_)) = pk[i_]; *(LAS u32x4*)(L + O_VI + off_b(s_, c8_)) = pv[i_]; } } while (0)
#define SC_MFMA(A, B, C) __builtin_amdgcn_mfma_f32_16x16x32_bf16((A), (B), (C), 0, 0, 0)
#define SC_BAR() do { asm volatile("s_waitcnt lgkmcnt(0)" ::: "memory"); __builtin_amdgcn_s_barrier(); asm volatile("" ::: "memory"); } while (0)
    {
        const int tid = F.tid;
        SC_LOAD(0);
        __syncthreads();
        SC_WRITE();
        __syncthreads();
    }
    for (int cc = 0; cc < 36; ++cc) {
        int tid = F.tid; asm volatile("" : "+v"(tid));
        const int lane = tid & 63, fr = lane & 15, fq = lane >> 4;
        const bool isctx = cc < 4, want_out = !(isctx && l == 1), more = cc + 1 < 36;
        const int c = isctx ? (dir ? 3 - cc : cc) : (dir ? 35 - cc : cc - 4);
        const LAS float* vb = GV + cc * 192; const float m_in = SC[cc * 4 + 0];
        unsigned zv = 0u; asm volatile("" : "+v"(zv));
        const short one_ = (fr == 0) ? (short)0x3F80 : (short)0;
        const bf16x8 ONES = (bf16x8){one_, one_, one_, one_, one_, one_, one_, one_};
        if (more) SC_LOAD(cc + 1);
        if (want_out) {
            const int tb = w >> 1, sb = 2 * (w & 1);
            f32x4 s0 = (f32x4){0.f, 0.f, 0.f, 0.f}, s1 = s0;
#pragma unroll
            for (int ks = 0; ks < 4; ++ks) {
                const bf16x8 fy = *(const LAS bf16x8*)(L + O_QI + img256(tb * 16 + fr, ks * 4 + fq));
                const bf16x8 fx0 = *(const LAS bf16x8*)(L + O_KI + rowrd16(lane, sb, ks)), fx1 = *(const LAS bf16x8*)(L + O_KI + rowrd16(lane, sb + 1, ks));
                s0 = SC_MFMA(fx0, fy, s0); s1 = SC_MFMA(fx1, fy, s1); }
            const int t = tb * 16 + fr; const float Mt = fmaxf(m_in, vb[128 + t]);
#pragma unroll
            for (int i = 0; i < 2; ++i) { const int sr0 = (sb + i) * 16 + 4 * fq; const f32x4 a4 = *(const LAS f32x4*)(vb + sr0); const f32x4 sv = i ? s1 : s0; f32x4 o;
#pragma unroll
                for (int r = 0; r < 4; ++r) { const int sI = sr0 + r; const bool valid = dir ? (sI >= t) : (sI <= t); o[r] = valid ? sv[r] * __expf(a4[r] - Mt) : 0.f; }
                *(LAS u32x2*)(L + O_ST + img128(t, sr0 >> 3) + (sr0 & 7) * 2) = pk4(o); }
        }
        SC_BAR();
        {
            const float decay = SC[cc * 4 + 2], Mend = SC[cc * 4 + 1];
#pragma unroll
            for (int et = 0; et < 9; ++et) accC[et] = accC[et] * decay;
#pragma unroll
            for (int ks = 0; ks < 2; ++ks) {
                const bf16x8 kx = tr_frag(L + O_KI, lane, w, ks, zv);
                const f32x4 a0 = *(const LAS f32x4*)(vb + 32 * ks + 8 * fq), a1 = *(const LAS f32x4*)(vb + 32 * ks + 8 * fq + 4);
                u32x4 ax;
#pragma unroll
                for (int j = 0; j < 4; ++j) { const float w0 = __expf((j < 2 ? a0[2 * j] : a1[2 * j - 4]) - Mend), w1 = __expf((j < 2 ? a0[2 * j + 1] : a1[2 * j - 3]) - Mend);
                    ax[j] = pk2(bf2f((unsigned short)kx[2 * j]) * w0, bf2f((unsigned short)kx[2 * j + 1]) * w1); }
                const bf16x8 axf = __builtin_bit_cast(bf16x8, ax);
#pragma unroll
                for (int et = 0; et < 8; ++et) { const bf16x8 fv = tr_frag(L + O_VI, lane, et, ks, zv); accC[et] = SC_MFMA(axf, fv, accC[et]); }
                accC[8] = SC_MFMA(axf, ONES, accC[8]);
            }
        }
        f32x4 num[4];
        if (want_out) {
            bf16x8 ac[4], av[2];
#pragma unroll
            for (int ks = 0; ks < 4; ++ks) ac[ks] = *(const LAS bf16x8*)(L + O_CL + img256(w * 16 + fr, ks * 4 + fq));
#pragma unroll
            for (int ks = 0; ks < 2; ++ks) av[ks] = tr_frag(L + O_VI, lane, w, ks, zv);
#pragma unroll
            for (int tb = 0; tb < 4; ++tb) {
                f32x4 nI = (f32x4){0.f, 0.f, 0.f, 0.f}, nS = nI;
#pragma unroll
                for (int ks = 0; ks < 4; ++ks) { const bf16x8 fy = *(const LAS bf16x8*)(L + O_QI + img256(tb * 16 + fr, ks * 4 + fq)); nI = SC_MFMA(ac[ks], fy, nI); }
#pragma unroll
                for (int ks = 0; ks < 2; ++ks) { const bf16x8 fs = *(const LAS bf16x8*)(L + O_ST + img128(tb * 16 + fr, ks * 4 + fq)); nS = SC_MFMA(av[ks], fs, nS); }
                num[tb] = nI * __expf(m_in - fmaxf(m_in, vb[128 + tb * 16 + fr])) + nS;
            }
            if (w < 4) {
                f32x4 dI = (f32x4){0.f, 0.f, 0.f, 0.f}, dS = dI;
#pragma unroll
                for (int ks = 0; ks < 4; ++ks) { const bf16x8 a8 = *(const LAS bf16x8*)(L + O_CL + img256(128 + fr, ks * 4 + fq)); const bf16x8 fy = *(const LAS bf16x8*)(L + O_QI + img256(w * 16 + fr, ks * 4 + fq)); dI = SC_MFMA(a8, fy, dI); }
#pragma unroll
                for (int ks = 0; ks < 2; ++ks) { const bf16x8 fs = *(const LAS bf16x8*)(L + O_ST + img128(w * 16 + fr, ks * 4 + fq)); dS = SC_MFMA(ONES, fs, dS); }
                const int t = w * 16 + fr; const float Mt = fmaxf(m_in, vb[128 + t]); const float den = __expf(m_in - Mt) * dI[0] + dS[0];
                if (lane < 16) DEN[t] = fmaxf(fabsf(den), __expf(-(vb[64 + t] + Mt)));
            }
        }
        SC_BAR();
        if (want_out) {
#pragma unroll
            for (int tb = 0; tb < 4; ++tb) { const int t = tb * 16 + fr, e0 = w * 16 + 4 * fq; const float rd = 1.0f / DEN[t];
                *(LAS u32x2*)(L + O_HO + img256(t, e0 >> 3) + (e0 & 7) * 2) = pk4(num[tb] * rd); }
        }
#pragma unroll
        for (int et = 0; et < 9; ++et) { const int d0 = w * 16 + 4 * fq; *(LAS u32x2*)(L + O_CL + img256(et * 16 + fr, d0 >> 3) + (d0 & 7) * 2) = pk4(accC[et]); }
        if (more) SC_WRITE();
        SC_BAR();
        if (want_out) {
            const int t = tid >> 3; bf16_t* hp = H + (size_t)scan_tok(isctx, b, h, c, t) * 512 + h * 128;
#pragma unroll
            for (int i = 0; i < 2; ++i) { const int ch = (tid & 7) * 2 + i; *(u32x4*)(hp + ch * 8) = *(const LAS u32x4*)(L + O_HO + img256(t, ch)); }
        }
    }
#undef SC_LOAD
#undef SC_WRITE
#undef SC_MFMA
#undef SC_BAR
}

__device__ __forceinline__ void helper_barrier(Frame& F, unsigned* cnt, unsigned nhelpers) {
    asm volatile("s_waitcnt vmcnt(0)" ::: "memory");
    __syncthreads();
    if (F.tid == 0) {
        __builtin_amdgcn_fence(__ATOMIC_RELEASE, "agent");
        asm volatile("s_waitcnt vmcnt(0)" ::: "memory");
        __hip_atomic_fetch_add(cnt, 1u, __ATOMIC_RELAXED, __HIP_MEMORY_SCOPE_AGENT);
        unsigned sp = 0;
        while (__hip_atomic_load(cnt, __ATOMIC_RELAXED, __HIP_MEMORY_SCOPE_AGENT) < nhelpers) { __builtin_amdgcn_s_sleep(2); if (++sp > (1u << 22)) break; }
        __builtin_amdgcn_fence(__ATOMIC_ACQUIRE, "agent");
        asm volatile("s_waitcnt vmcnt(0)" ::: "memory");
    }
    __syncthreads();
}

constexpr int NPHASES = 20;
enum { K_PREP = 0, K_NORM1, K_INPROJ, K_MIX1, K_MIX2, K_OUTPROJ, K_NORM2, K_TOPK, K_MOE1, K_MOE2, K_COMBINE };

__global__ void __launch_bounds__(NTHR, 2) fwd_kernel(Args args) {
    extern __shared__ __attribute__((aligned(16))) unsigned char lds_raw[];
    Frame F{(LAS unsigned char*)lds_raw, (int)threadIdx.x, (int)(threadIdx.x & 63), __builtin_amdgcn_readfirstlane((int)(threadIdx.x >> 6)), (int)gridDim.x, (int)blockIdx.x, args.ws, args};
    volatile LAS unsigned* MISC = (volatile LAS unsigned*)(F.lds + LDSCTL_OFF);
    if (F.tid < 16) MISC[F.tid] = 0u;
    __syncthreads();
    XcdBarrier bar; bar.bar = (unsigned*)(F.ws + WS_CTL); bar.x = 0; bar.st = MISC;
    const int lo = args.ph_lo, hi = args.ph_hi;
    if (hi - lo > 1) bar = xcd_barrier_post((unsigned*)(F.ws + WS_CTL), MISC);
    for (int ph = lo; ph < hi; ++ph) {
        int l, kind;
        if (ph == 0) { l = 0; kind = K_PREP; } else if (ph == 1) { l = 0; kind = K_NORM1; } else if (ph < 11) { l = 0; kind = K_INPROJ + (ph - 2); } else { l = 1; kind = K_INPROJ + (ph - 11); }
#ifndef PHMASK
#define PHMASK 0xFFFF
#endif
#define PHON(k) ((PHMASK >> (k)) & 1)
#ifndef REPMASK
#define REPMASK 0
#endif
        int nrep_ = 1 + ((REPMASK >> kind) & 1); asm volatile("" : "+s"(nrep_));
        for (int rep_ = 0; rep_ < nrep_; ++rep_) {
        if (rep_) xcd_barrier(bar);
        { int t_ = threadIdx.x, b_ = blockIdx.x; unsigned char* w_ = args.ws; asm volatile("" : "+v"(t_)); asm volatile("" : "+s"(b_)); asm volatile("" : "+s"(w_));
          F.tid = t_; F.lane = t_ & 63; F.wave = __builtin_amdgcn_readfirstlane(t_ >> 6); F.bid = b_; F.ws = w_; }
        l = __builtin_amdgcn_readfirstlane(l); kind = __builtin_amdgcn_readfirstlane(kind); asm volatile("" : "+s"(l)); asm volatile("" : "+s"(kind));
        unsigned char* ws = F.ws;
        bool run_gemm = (kind == K_INPROJ || kind == K_OUTPROJ || kind == K_MOE1 || kind == K_MOE2);
        int gm = kind == K_INPROJ ? GM_INPROJ : kind == K_OUTPROJ ? GM_OUT : kind == K_MOE1 ? GM_MOE1 : GM_MOE2, gc = F.bid, gG = F.G;
        const bool helper = (kind == K_MIX1) && (F.bid >= 64);
        switch (kind) {
        case K_PREP: if (PHON(0)) phase_prep(F); break;
        case K_NORM1: if (PHON(1)) phase_norm1_l0(F); break;
        case K_MIX1: if (PHON(3)) {
            if (!helper) scan_mfma(F, l);
            else { const int hb = F.bid - 64, hg = F.G - 64;
                conv_items(F, l, hb, hg);
                ztrans_items(F, l, hb * NWAVES + F.wave, hg * NWAVES);
                helper_barrier(F, (unsigned*)(ws + WS_CTL) + 8192 + 64 * l + 64 * 2 * rep_, (unsigned)hg);
                run_gemm = true; gm = GM_DFT; gc = hb; gG = hg; }
        } break;
        case K_MIX2: if (PHON(4)) finalize_h(F, l); break;
        case K_NORM2: if (PHON(6)) phase_norm2(F, l); break;
        case K_TOPK: if (PHON(7)) phase_topk(F, l); break;
        case K_COMBINE: if (PHON(10)) phase_combine(F, l); break;
        default: break;
        }
        if (run_gemm && PHON(2)) {
            GemmCtl S{gm, l, gG, gc, ws, F.A};
            const int ld = gm == GM_OUT ? KOUT : D;
            GEMM_PHASE(F.lds, ld, ld, S, S);
        }
        if (helper && PHON(3)) convert_moe_weights(F, l, (F.bid - 64) * NWAVES + F.wave, (F.G - 64) * NWAVES);
        }
        if (ph + 1 < hi) xcd_barrier(bar);
    }
}

extern "C" void kernel_launch(void* const* d_in, const int* in_sizes, int n_in, void* d_out, int out_size, void* d_ws, size_t ws_size, hipStream_t stream) {
    static int grid = 0;
    if (grid == 0) {
        if (n_in != 21 || out_size != NLAT * D || ws_size < WS_END) { fprintf(stderr, "kernel_launch: unexpected shapes (n_in %d out %d ws %zu need %zu)\n", n_in, out_size, ws_size, (size_t)WS_END); grid = -1; return; }
        int dev = 0, cus = 0, per_cu = 0;
        hipGetDevice(&dev); hipDeviceGetAttribute(&cus, hipDeviceAttributeMultiprocessorCount, dev);
        if (hipFuncSetAttribute((const void*)fwd_kernel, hipFuncAttributeMaxDynamicSharedMemorySize, LDS_BYTES) != hipSuccess) { fprintf(stderr, "kernel_launch: hipFuncSetAttribute failed\n"); grid = -1; return; }
        hipOccupancyMaxActiveBlocksPerMultiprocessor(&per_cu, (const void*)fwd_kernel, NTHR, LDS_BYTES);
        (void)hipGetLastError();
        if (per_cu < 1) fprintf(stderr, "kernel_launch: occupancy query reports %d\n", per_cu);
        grid = cus;
    }
    if (grid < 0) return;
    hipMemsetAsync((char*)d_ws + WS_CTL, 0, 65536, stream);
    Args a{};
    for (int i = 0; i < 21; ++i) a.in[i] = (const float*)d_in[i];
    a.out = (float*)d_out; a.ws = (unsigned char*)d_ws;
#if N_LAUNCHES == 1
    a.ph_lo = 0; a.ph_hi = NPHASES;
    void* kargs[] = {&a};
    hipError_t e = hipLaunchCooperativeKernel((const void*)fwd_kernel, dim3(grid), dim3(NTHR), kargs, LDS_BYTES, stream);
    if (e != hipSuccess) fprintf(stderr, "kernel_launch: cooperative launch failed: %s (grid %d)\n", hipGetErrorString(e), grid);
#else
#ifndef MAXPH
#define MAXPH NPHASES
#endif
    for (int ph = 0; ph < MAXPH; ++ph) { a.ph_lo = ph; a.ph_hi = ph + 1; hipLaunchKernelGGL(fwd_kernel, dim3(grid), dim3(NTHR), LDS_BYTES, stream, a); }
#endif
}
```

```cpp
#include <hip/hip_runtime.h>
#include <cstdio>
#include <cstdint>

#ifndef N_LAUNCHES
#define N_LAUNCHES 1
#endif
#ifndef USE_MFMA_GEMM
#define USE_MFMA_GEMM 1
#endif

#define LAS __attribute__((address_space(3)))
#define GAS __attribute__((address_space(1)))
typedef unsigned short bf16_t;
typedef short bf16x8 __attribute__((ext_vector_type(8)));
typedef float f32x4 __attribute__((ext_vector_type(4)));
typedef float f32x2 __attribute__((ext_vector_type(2)));
typedef unsigned u32x4 __attribute__((ext_vector_type(4)));
typedef unsigned u32x2 __attribute__((ext_vector_type(2)));
typedef GAS unsigned gu32;
#define RLX_AGENT __ATOMIC_RELAXED, __HIP_MEMORY_SCOPE_AGENT
#define LDS_WAIT() asm volatile("s_waitcnt lgkmcnt(0)" ::: "memory")
#define VM_WAIT() asm volatile("s_waitcnt vmcnt(0)" ::: "memory")

constexpr int D = 1024, NB = 8, SEQ = 2048, CTXL = 256;
constexpr int NLAT = NB * SEQ, NCTX = NB * CTXL, NTOK = NLAT + NCTX;
constexpr int INC = 2832, NIN = 2816;
constexpr int KOUT = 1280;
constexpr int NE = 16, RPE = 2304;
constexpr float EPS = 1e-6f;
constexpr int NTHR = 512, NWAVES = 8;

constexpr size_t al256(size_t x) { return (x + 255) & ~(size_t)255; }
constexpr size_t WS_CTL = 0;
constexpr size_t WS_MOD = WS_CTL + 65536;
constexpr size_t WS_WIN = WS_MOD + al256((size_t)2 * 9 * 6144 * 4);
constexpr size_t WS_WOUT = WS_WIN + (size_t)2 * NIN * D * 2;
constexpr size_t WS_WGU = WS_WOUT + (size_t)2 * D * KOUT * 2;
constexpr size_t WS_WD = WS_WGU + (size_t)NE * 2048 * D * 2;
constexpr size_t WS_FL = WS_WD + (size_t)NE * D * D * 2;
constexpr size_t WS_FC = WS_FL + (size_t)4096 * 1024 * 2;
constexpr size_t WS_X = WS_FL + (size_t)4096 * 2048 * 2 + (size_t)512 * 2048 * 2;
constexpr size_t WS_XN = WS_X + (size_t)NTOK * D * 4;
constexpr size_t WS_GATES = WS_XN + (size_t)NTOK * D * 2;
constexpr size_t WS_AFF = WS_GATES + (size_t)NTOK * 16 * 4;
constexpr size_t WS_INV = WS_AFF + (size_t)NTOK * 16 * 4;
constexpr size_t WS_ROWTOK = WS_INV + (size_t)NTOK * 16 * 4;
constexpr size_t WS_GATEV = WS_ROWTOK + (size_t)NE * RPE * 4;
constexpr size_t WS_R1 = WS_GATEV + (size_t)NE * RPE * 4;
constexpr size_t SZ_QKV = (size_t)NTOK * 512 * 2;
constexpr size_t WS_Q = WS_R1, WS_K = WS_Q + SZ_QKV, WS_V = WS_K + SZ_QKV, WS_O = WS_V + SZ_QKV;
constexpr size_t WS_HID = WS_R1;
constexpr size_t WS_R2 = WS_R1 + 4 * SZ_QKV;
constexpr size_t SZ_C = (size_t)NTOK * 256 * 2;
constexpr size_t WS_CA = WS_R2, WS_CG = WS_CA + SZ_C, WS_FR = WS_CG + SZ_C, WS_ZT = WS_FR + SZ_C;
constexpr size_t WS_ZO = WS_ZT + (size_t)2048 * 1024 * 2;
constexpr size_t WS_ZTC = WS_ZT + (size_t)2048 * 2048 * 2;
constexpr size_t WS_HF = WS_ZT + 2 * (size_t)2048 * 2048 * 2, WS_HB = WS_HF + SZ_QKV, WS_Y = WS_HB + SZ_QKV;
constexpr size_t WS_YS = WS_R2;
constexpr size_t WS_END = WS_Y + (size_t)NTOK * KOUT * 2;
static_assert((size_t)NE * RPE * D * 2 <= 4 * SZ_QKV, "HID alias");
static_assert(WS_YS + (size_t)NE * RPE * D * 2 <= WS_END, "YS alias");

constexpr int RING_BYTES = 139264;
constexpr int LDSCTL_OFF = RING_BYTES;
constexpr int LDS_BYTES = RING_BYTES + 1024;

#define GAS __attribute__((address_space(1)))
template <class T> __device__ __forceinline__ T* as_global(T* p) { return (T*)(GAS T*)(uintptr_t)p; }
__device__ __forceinline__ unsigned f2bf(float f) { unsigned u = __float_as_uint(f); u += 0x7FFFu + ((u >> 16) & 1u); return u >> 16; }
typedef __bf16 bf16x2_t __attribute__((ext_vector_type(2)));
__device__ __forceinline__ unsigned pk2(float lo, float hi) { const bf16x2_t r = __builtin_convertvector((f32x2){lo, hi}, bf16x2_t); return __builtin_bit_cast(unsigned, r); }
__device__ __forceinline__ float bf2f(unsigned b) { return __uint_as_float(b << 16); }
__device__ __forceinline__ float bflo(unsigned w) { return __uint_as_float(w << 16); }
__device__ __forceinline__ float bfhi(unsigned w) { return __uint_as_float(w & 0xffff0000u); }
__device__ __forceinline__ float sigmoidf_(float x) { return __builtin_amdgcn_rcpf(1.0f + __expf(-x)); }
__device__ __forceinline__ float siluf_(float x) { return x * __builtin_amdgcn_rcpf(1.0f + __expf(-x)); }
__device__ __forceinline__ float logsigmoidf_(float x) { return x >= 0.f ? -log1pf(expf(-x)) : x - log1pf(expf(x)); }
__device__ __forceinline__ float wave_sum(float v) {
#pragma unroll
    for (int o = 1; o < 64; o <<= 1) v += __shfl_xor(v, o);
    return v;
}
__device__ __forceinline__ u32x2 pk4(f32x4 v) { u32x2 w; w.x = pk2(v[0], v[1]); w.y = pk2(v[2], v[3]); return w; }

#define XB_TMO      128
#define XB_XCNT(j)  (256  + 64 * (j))
#define XB_XSUB(j)  (1280 + 64 * (j))
#define XB_XGEN(j)  (2304 + 64 * (j))
#define XB_TOP      3328
#define XB_TOPGEN   3392
#define XCD_BAR_WORDS 3456
#define XB_SPIN_CAP (1u << 22)
__device__ __forceinline__ unsigned xb_ld(unsigned* p)              { return __hip_atomic_load(p, __ATOMIC_RELAXED, __HIP_MEMORY_SCOPE_AGENT); }
__device__ __forceinline__ unsigned xb_add(unsigned* p, unsigned v) { return __hip_atomic_fetch_add(p, v, __ATOMIC_RELAXED, __HIP_MEMORY_SCOPE_AGENT); }
__device__ __forceinline__ unsigned xb_xcc_id() { return (unsigned)__builtin_amdgcn_s_getreg((3 << 11) | 20) & 0xFu; }
#define XB_SPIN(cond, bar) do { unsigned _sp = 0; while (cond) { __builtin_amdgcn_s_sleep(1); \
    if ((++_sp & 255u) == 0u) { if (xb_ld(&(bar)[XB_TMO])) break; if (_sp > XB_SPIN_CAP) { atomicAdd(&(bar)[XB_TMO], 1u); break; } } } } while (0)
struct XcdBarrier { unsigned* bar; unsigned x; volatile LAS unsigned* st; };
__device__ __forceinline__ XcdBarrier xcd_barrier_post(unsigned* bar, volatile LAS unsigned* st) {
    XcdBarrier b; b.bar = bar; b.x = xb_xcc_id(); b.st = st;
    if (threadIdx.x == 0) (void)xb_add(&bar[XB_XCNT(b.x)], 1u);
    return b;
}
__device__ __forceinline__ void xcd_barrier_complete(unsigned* bar, unsigned x, unsigned& nloc, unsigned& nx) {
    const unsigned G = gridDim.x * gridDim.y * gridDim.z;
    unsigned sum, cnt, mine, sp = 0u;
    for (;;) {
        sum = 0u; cnt = 0u; mine = 0u;
#pragma unroll
        for (unsigned j = 0; j < 16; ++j) { const unsigned c = xb_ld(&bar[XB_XCNT(j)]); sum += c; cnt += (c > 0u) ? 1u : 0u; mine = (j == x) ? c : mine; }
        if (sum == G) break;
        __builtin_amdgcn_s_sleep(1);
        if ((++sp & 255u) == 0u) { if (xb_ld(&bar[XB_TMO])) break; if (sp > XB_SPIN_CAP) { atomicAdd(&bar[XB_TMO], 1u); break; } }
    }
    nloc = mine > 0u ? mine : 1u; nx = cnt > 0u ? cnt : 1u;
}
__device__ __forceinline__ void xcd_barrier(const XcdBarrier& b) {
    asm volatile("s_waitcnt vmcnt(0)" ::: "memory");
    __syncthreads();
    if (threadIdx.x == 0) {
        unsigned* bar = b.bar;
        __builtin_amdgcn_s_waitcnt(0);
        unsigned nloc = b.st[0], nx = b.st[1];
        if (nloc == 0u) { xcd_barrier_complete(bar, b.x, nloc, nx); b.st[0] = nloc; b.st[1] = nx; }
        const unsigned old = xb_add(&bar[XB_XSUB(b.x)], 1u);
        const unsigned gen = old / nloc;
        if (old + 1u == (gen + 1u) * nloc) {
            __builtin_amdgcn_fence(__ATOMIC_RELEASE, "agent");
            asm volatile("s_waitcnt vmcnt(0)" ::: "memory");
            const unsigned og = xb_add(&bar[XB_TOP], 1u);
            const unsigned tg = og / nx;
            if (og + 1u == (tg + 1u) * nx) xb_add(&bar[XB_TOPGEN], 1u);
            else XB_SPIN(xb_ld(&bar[XB_TOPGEN]) == tg, bar);
            __builtin_amdgcn_fence(__ATOMIC_ACQUIRE, "agent");
            xb_add(&bar[XB_XGEN(b.x)], 1u);
            asm volatile("s_waitcnt vmcnt(0)" ::: "memory");
        } else {
            XB_SPIN(xb_ld(&bar[XB_XGEN(b.x)]) == gen, bar);
            __builtin_amdgcn_fence(__ATOMIC_ACQUIRE, "agent");
            asm volatile("s_waitcnt vmcnt(0)" ::: "memory");
        }
    }
    __syncthreads();
}

namespace pg8 {
constexpr int BM = 256, BK = 64, HALF = 128, HTB = HALF * BK * 2, STAGE_BYTES = 8 * HTB, NXCD = 8, WGM = 8;
__host__ __device__ __forceinline__ int lds_byte(int r, int c) { const int st = (r >> 4) * 2 + (c >> 5), rr = r & 15, cc = c & 31, ob = rr * 64 + cc * 2; return st * 1024 + (ob ^ (((ob >> 9) & 1) << 5)); }
__host__ __device__ __forceinline__ void stage_rc(int b, int& R, int& C) { const int st = b / 1024, sb = b % 1024, swz = sb ^ (((sb >> 9) & 1) << 5); R = (st >> 1) * 16 + swz / 64; C = (st & 1) * 32 + (swz % 64) / 2; }

struct Unit { const char* A; const char* B; const int* rows; int K, pm, pn, ex; };

__device__ __forceinline__ void map_tile(int L, int nM, int nN, int& pm, int& pn) {
    const int nwg = nM * nN; int wgid = L;
    { const int q = nwg / NXCD, r = nwg % NXCD, xcd = wgid % NXCD, off = wgid / NXCD; wgid = (xcd < r ? xcd * (q + 1) : r * (q + 1) + (xcd - r) * q) + off; }
    const int nig = WGM * nN, gid = wgid / nig, fm = gid * WGM, gsz = (nM - fm) < WGM ? (nM - fm) : WGM;
    pm = fm + ((wgid % nig) % gsz); pn = (wgid % nig) / gsz;
}
__device__ __forceinline__ void a_offs(const Unit& u, int lda, int tid, unsigned (&vA)[2][2]) {
#pragma unroll
    for (int h = 0; h < 2; ++h)
#pragma unroll
        for (int i = 0; i < 2; ++i) { int R, C; stage_rc(tid * 16 + i * 8192, R, C); const int r = h * HALF + R; const int ar = u.rows ? u.rows[r] : r; vA[h][i] = (unsigned)(ar * lda + C) * 2u; }
}

template <class Epi, class Sched>
__device__ __forceinline__ void gemm_phase(LAS unsigned char* lds, const int tid, const int lda, const int ldb, const Sched& S, const Epi& E) {
    const int wid = __builtin_amdgcn_readfirstlane(tid >> 6), lane = tid & 63, wr = wid >> 2, wc = wid & 3, fr = lane & 15, fq = lane >> 4;
    unsigned voffB[2];
#pragma unroll
    for (int i = 0; i < 2; ++i) { int R, C; stage_rc(tid * 16 + i * 8192, R, C); voffB[i] = (unsigned)(R * ldb + C) * 2u; }
    const size_t kstep = (size_t)(BK * 2);
    const size_t hsB = (size_t)HALF * ldb * 2;
    const unsigned ldsw = (unsigned)wid * 1024u;
    const int aoff = lds_byte(wr * 64 + fr, fq * 8), boff = lds_byte(wc * 32 + fr, fq * 8);
#define PG8_SA(b, h) (((b) * 2 + (h)) * HTB)
#define PG8_SB(b, h) ((4 + (b) * 2 + (h)) * HTB)
#define PG8_STAGE(bufoff, gbase, voff) do { _Pragma("unroll") for (int _i = 0; _i < 2; ++_i) \
        __builtin_amdgcn_global_load_lds((const unsigned*)((const char*)(gbase) + (voff)[_i]), (LAS unsigned*)(lds + (bufoff) + ldsw + _i * 8192), 16, 0, 0); } while (0)
#define PG8_LDA(dst, b, h) do { _Pragma("unroll") for (int m = 0; m < 4; ++m) _Pragma("unroll") for (int k = 0; k < 2; ++k) dst[m][k] = *(const LAS bf16x8*)(lds + PG8_SA(b, h) + aoff + m * 2048 + k * 1024); } while (0)
#define PG8_LDB(dst, b, h) do { _Pragma("unroll") for (int n = 0; n < 2; ++n) _Pragma("unroll") for (int k = 0; k < 2; ++k) dst[n][k] = *(const LAS bf16x8*)(lds + PG8_SB(b, h) + boff + n * 2048 + k * 1024); } while (0)
#define PG8_MMA(ai, bj, At, Bt) do { __builtin_amdgcn_s_setprio(1); _Pragma("unroll") for (int m = 0; m < 4; ++m) _Pragma("unroll") for (int n = 0; n < 2; ++n) _Pragma("unroll") for (int k = 0; k < 2; ++k) \
        acc[ai][bj][m][n] = __builtin_amdgcn_mfma_f32_16x16x32_bf16(Bt[n][k], At[m][k], acc[ai][bj][m][n], 0, 0, 0); __builtin_amdgcn_s_setprio(0); } while (0)
#define PG8_WAIT_V(n) asm volatile("s_waitcnt vmcnt(" #n ")" ::: "memory")
#define PG8_WAIT_L(n) asm volatile("s_waitcnt lgkmcnt(" #n ")" ::: "memory")
#define PG8_BAR __builtin_amdgcn_s_barrier()
#define PG8_SCHED __builtin_amdgcn_sched_barrier(0)
    Unit cur, nxt; int ui = 0;
    if (!S.next(0, cur)) return;
    f32x4 acc[2][2][4][2];
#pragma unroll
    for (int a = 0; a < 2; ++a)
#pragma unroll
        for (int b = 0; b < 2; ++b)
#pragma unroll
            for (int m = 0; m < 4; ++m)
#pragma unroll
                for (int n = 0; n < 2; ++n) acc[a][b][m][n] = (f32x4){0.f, 0.f, 0.f, 0.f};
    bf16x8 At[4][2], B0[2][2], B1[2][2];
    unsigned vA[2][2], wA[2][2];
    a_offs(cur, lda, tid, vA);
    const char* cA = cur.A; const char* cB = cur.B;
    PG8_STAGE(PG8_SB(0, 0), cB, voffB); PG8_STAGE(PG8_SB(0, 1), cB + hsB, voffB); PG8_STAGE(PG8_SA(0, 0), cA, vA[0]); PG8_STAGE(PG8_SA(0, 1), cA, vA[1]);
    if (wr == 1) PG8_BAR;
    PG8_WAIT_V(2); PG8_BAR;
    PG8_STAGE(PG8_SB(1, 0), cB + kstep, voffB); PG8_STAGE(PG8_SA(1, 0), cA + kstep, vA[0]); PG8_STAGE(PG8_SB(1, 1), cB + hsB + kstep, voffB);
    PG8_WAIT_V(6); PG8_BAR;
    for (;;) {
        const bool has_next = S.next(ui + 1, nxt);
        if (!has_next) nxt = cur;
        const char* nA = nxt.A; const char* nB = nxt.B;
        a_offs(nxt, lda, tid, wA);
        const int nt = cur.K / BK;
        asm volatile(".p2align 8" ::: "memory");
        for (int t = 0; t < nt; t += 2) {
            const bool last = (t == nt - 2);
            const char* a1 = cA + (size_t)(t + 1) * kstep;
            const char* a2 = last ? nA : cA + (size_t)(t + 2) * kstep; const char* b2 = last ? nB : cB + (size_t)(t + 2) * kstep;
            const char* a3 = a2 + kstep; const char* b3 = b2 + kstep;
            PG8_LDB(B0, 0, 0); PG8_LDB(B1, 0, 1); PG8_SCHED; PG8_LDA(At, 0, 0); PG8_STAGE(PG8_SA(1, 1), a1, vA[1]);
            if (last) {
#pragma unroll
                for (int h = 0; h < 2; ++h)
#pragma unroll
                    for (int i = 0; i < 2; ++i) vA[h][i] = wA[h][i];
            }
            PG8_WAIT_V(8); PG8_WAIT_L(0); PG8_BAR; PG8_MMA(0, 0, At, B0); PG8_MMA(0, 1, At, B1); PG8_BAR; PG8_SCHED;
            PG8_LDA(At, 0, 1); PG8_STAGE(PG8_SB(0, 0), b2, voffB); PG8_STAGE(PG8_SB(0, 1), b2 + hsB, voffB); PG8_STAGE(PG8_SA(0, 0), a2, vA[0]);
            PG8_WAIT_V(8); PG8_WAIT_L(0); PG8_BAR; PG8_MMA(1, 0, At, B0); PG8_MMA(1, 1, At, B1); PG8_BAR; PG8_SCHED;
            PG8_LDB(B0, 1, 0); PG8_LDB(B1, 1, 1); PG8_SCHED; PG8_LDA(At, 1, 0); PG8_STAGE(PG8_SA(0, 1), a2, vA[1]);
            PG8_WAIT_V(8); PG8_WAIT_L(0); PG8_BAR; PG8_MMA(0, 0, At, B0); PG8_MMA(0, 1, At, B1); PG8_BAR; PG8_SCHED;
            PG8_LDA(At, 1, 1); PG8_STAGE(PG8_SB(1, 0), b3, voffB); PG8_STAGE(PG8_SB(1, 1), b3 + hsB, voffB); PG8_STAGE(PG8_SA(1, 0), a3, vA[0]);
            PG8_WAIT_V(8); PG8_WAIT_L(0); PG8_BAR; PG8_MMA(1, 0, At, B0); PG8_MMA(1, 1, At, B1); PG8_BAR; PG8_SCHED;
        }
        if (wr == 0) PG8_BAR;
        { int fr_ = fr, fq_ = fq; asm volatile("" : "+v"(fr_), "+v"(fq_));
          E.run(acc, cur, wr, wc, fr_, fq_); }
        if (!has_next) break;
#pragma unroll
        for (int a = 0; a < 2; ++a)
#pragma unroll
            for (int b = 0; b < 2; ++b)
#pragma unroll
                for (int m = 0; m < 4; ++m)
#pragma unroll
                    for (int n = 0; n < 2; ++n) acc[a][b][m][n] = (f32x4){0.f, 0.f, 0.f, 0.f};
        cur = nxt; cA = nA; cB = nB; ++ui;
        if (wr == 1) PG8_BAR;
    }
    PG8_WAIT_V(0);
    PG8_BAR;
#undef PG8_SA
#undef PG8_SB
#undef PG8_STAGE
#undef PG8_LDA
#undef PG8_LDB
#undef PG8_MMA
#undef PG8_WAIT_V
#undef PG8_WAIT_L
#undef PG8_BAR
#undef PG8_SCHED
}
template <class Epi, class Sched>
__device__ __forceinline__ void gemm_phase_simt(LAS unsigned char* lds, const int tid, const int lda, const int ldb, const Sched& S, const Epi& E) {
    LAS float* As = (LAS float*)lds;
    LAS float* Bs = (LAS float*)(lds + 32 * 132 * 4);
    const int ty = tid >> 4, tx = tid & 15, c0 = (tx >> 2) * 32 + (tx & 3) * 4;
    const int lr = tid >> 2, lk = (tid & 3) * 8;
    Unit u;
    for (int ui = 0; S.next(ui, u); ++ui) {
        for (int sub = 0; sub < 4; ++sub) {
            const int sr = sub >> 1, sc = sub & 1;
            float acc[4][8];
#pragma unroll
            for (int i = 0; i < 4; ++i)
#pragma unroll
                for (int j = 0; j < 8; ++j) acc[i][j] = 0.f;
            const int arow = sr * 128 + lr, brow = sc * 128 + lr;
            const int ar = u.rows ? u.rows[arow] : arow;
            const bf16_t* ap = (const bf16_t*)u.A + (size_t)ar * lda + lk;
            const bf16_t* bp = (const bf16_t*)u.B + (size_t)brow * ldb + lk;
            for (int k0 = 0; k0 < u.K; k0 += 32) {
                const u32x4 av = *(const u32x4*)(ap + k0), bv = *(const u32x4*)(bp + k0);
                __syncthreads();
#pragma unroll
                for (int j = 0; j < 4; ++j) {
                    As[(lk + 2 * j) * 132 + lr] = bflo(av[j]); As[(lk + 2 * j + 1) * 132 + lr] = bfhi(av[j]);
                    Bs[(lk + 2 * j) * 132 + lr] = bflo(bv[j]); Bs[(lk + 2 * j + 1) * 132 + lr] = bfhi(bv[j]);
                }
                __syncthreads();
#pragma unroll 4
                for (int k = 0; k < 32; ++k) {
                    const f32x4 a4 = *(const LAS f32x4*)(As + k * 132 + ty * 4);
                    const f32x4 b0 = *(const LAS f32x4*)(Bs + k * 132 + c0), b1 = *(const LAS f32x4*)(Bs + k * 132 + c0 + 16);
#pragma unroll
                    for (int i = 0; i < 4; ++i)
#pragma unroll
                        for (int j = 0; j < 4; ++j) { acc[i][j] += a4[i] * b0[j]; acc[i][4 + j] += a4[i] * b1[j]; }
                }
            }
#pragma unroll
            for (int i = 0; i < 4; ++i)
                E.store1(u, sr * 128 + ty * 4 + i, sc * 128 + c0, (f32x4){acc[i][0], acc[i][1], acc[i][2], acc[i][3]}, (f32x4){acc[i][4], acc[i][5], acc[i][6], acc[i][7]});
        }
    }
    __syncthreads();
}
}

#if USE_MFMA_GEMM
#define GEMM_PHASE(lds, lda, ldb, S, E) pg8::gemm_phase(lds, F.tid, lda, ldb, S, E)
#else
#define GEMM_PHASE(lds, lda, ldb, S, E) pg8::gemm_phase_simt(lds, F.tid, lda, ldb, S, E)
#endif

struct Args { const float* in[21]; float* out; unsigned char* ws; int ph_lo, ph_hi; };
enum { I_X = 0, I_C, I_CTX, I_CCTX, I_WADA, I_BADA, I_GN1, I_WIN, I_BG, I_GH, I_CW, I_CB, I_CLG, I_CLB, I_WOUT, I_GN2, I_WR, I_WEG, I_WEU, I_WED, I_GF };
__device__ __forceinline__ const float* arg_in(const Args& a, int i) { asm volatile("" : "+s"(i)); return a.in[i]; }
struct Frame {
    LAS unsigned char* lds;
    int tid, lane, wave, G, bid;
    GAS unsigned char* ws;
    const Args& A;
};
#define FIN(i) arg_in(F.A, (i))
#define WSP(T, off) ((T*)(F.ws + (off)))

template <class Src>
__device__ __forceinline__ void tr_item(const Src& src, bf16_t* dst, int ldd, int n0, int k0, LAS float* scr, int lane) {
    f32x4 v[8];
#pragma unroll
    for (int i = 0; i < 8; ++i) v[i] = src.ld4(k0 + i * 8 + (lane >> 3), n0 + (lane & 7) * 4);
#pragma unroll
    for (int i = 0; i < 8; ++i) { LAS float* p = scr + (i * 8 + (lane >> 3)) * 33 + (lane & 7) * 4; p[0] = v[i][0]; p[1] = v[i][1]; p[2] = v[i][2]; p[3] = v[i][3]; }
    LDS_WAIT(); asm volatile("" ::: "memory");
    const int c = lane & 7;
#pragma unroll
    for (int j = 0; j < 4; ++j) { const int n = (lane >> 3) + 8 * j; const LAS float* s = scr + (8 * c) * 33 + n;
        u32x4 o; o.x = pk2(s[0 * 33], s[1 * 33]); o.y = pk2(s[2 * 33], s[3 * 33]); o.z = pk2(s[4 * 33], s[5 * 33]); o.w = pk2(s[6 * 33], s[7 * 33]);
        *(u32x4*)(dst + (size_t)(n0 + n) * ldd + k0 + 8 * c) = o; }
    LDS_WAIT(); asm volatile("" ::: "memory");
}
struct SrcWin { const float* w; __device__ __forceinline__ f32x4 ld4(int k, int n) const { return *(const f32x4*)(w + (size_t)k * INC + (n < 1536 ? n : n + 16)); } };
struct SrcPlain { const float* w; int ld; __device__ __forceinline__ f32x4 ld4(int k, int n) const { return *(const f32x4*)(w + (size_t)k * ld + n); } };
struct SrcGU { const float* wg; const float* wu; __device__ __forceinline__ f32x4 ld4(int k, int n) const { const int grp = n >> 5, i = n & 31;
    const uintptr_t base = (uintptr_t)wg + ((i < 16) ? (uintptr_t)0 : ((uintptr_t)wu - (uintptr_t)wg));
    return *(const f32x4*)(as_global((const float*)base) + (size_t)k * D + grp * 16 + (i & 15)); } };

__device__ __forceinline__ void tr_store(const f32x4 (&v)[8], bf16_t* dst, int ldd, int n0, int k0, LAS float* scr, int lane) {
#pragma unroll
    for (int i = 0; i < 8; ++i) { LAS float* p = scr + (i * 8 + (lane >> 3)) * 33 + (lane & 7) * 4; p[0] = v[i][0]; p[1] = v[i][1]; p[2] = v[i][2]; p[3] = v[i][3]; }
    LDS_WAIT(); asm volatile("" ::: "memory");
    const int c = lane & 7;
#pragma unroll
    for (int j = 0; j < 4; ++j) { const int n = (lane >> 3) + 8 * j; const LAS float* s = scr + (8 * c) * 33 + n;
        u32x4 o; o.x = pk2(s[0 * 33], s[1 * 33]); o.y = pk2(s[2 * 33], s[3 * 33]); o.z = pk2(s[4 * 33], s[5 * 33]); o.w = pk2(s[6 * 33], s[7 * 33]);
        *(u32x4*)(dst + (size_t)(n0 + n) * ldd + k0 + 8 * c) = o; }
    LDS_WAIT(); asm volatile("" ::: "memory");
}
struct MoeItem { bf16_t* dst; int n0, k0; };
__device__ __forceinline__ MoeItem moe_item_load(Frame& F, int l, int it, const float* wg, const float* wu, const float* wd, f32x4 (&v)[8]) {
    constexpr int I_GU = NE * 64 * 16;
    MoeItem m; const int lane = F.lane;
    asm volatile("" : "+v"(it));
    const bool gu = it < I_GU; const int r0 = gu ? it : it - I_GU;
    const int e = gu ? (r0 >> 10) : (r0 >> 9), r = gu ? (r0 & 1023) : (r0 & 511), sup = r >> 3, wv = r & 7;
    const int nb = gu ? (sup & 15) * 4 + (wv & 3) : (sup & 7) * 4 + (wv & 3), kb = gu ? (sup >> 4) * 2 + (wv >> 2) : (sup >> 3) * 2 + (wv >> 2);
    m.n0 = nb * 32; m.k0 = kb * 64;
    m.dst = gu ? WSP(bf16_t, WS_WGU) + (size_t)e * 2048 * D : WSP(bf16_t, WS_WD) + (size_t)e * D * D;
    const int n = m.n0 + (lane & 7) * 4, grp = n >> 5, i = n & 31;
    const size_t eoff = ((size_t)l * NE + e) * D * D;
    const uintptr_t base = gu ? ((i < 16) ? (uintptr_t)wg : (uintptr_t)wu) : (uintptr_t)wd;
    const float* p0 = as_global((const float*)base) + eoff + (size_t)(m.k0 + (lane >> 3)) * D + (gu ? grp * 16 + (i & 15) : n);
#pragma unroll
    for (int q = 0; q < 8; ++q) v[q] = *(const f32x4*)(p0 + (size_t)q * 8 * D);
    return m;
}
__device__ __forceinline__ void convert_moe_weights(Frame& F, int l, int gw, int ngw) {
    LAS float* scr = (LAS float*)(F.lds + F.wave * 8448);
    const float* w_e_gate = FIN(I_WEG); const float* w_e_up = FIN(I_WEU); const float* w_e_down = FIN(I_WED);
    constexpr int NIT = NE * 64 * 16 + NE * 32 * 16;
    if (gw >= NIT) return;
    f32x4 va[8], vb[8];
    MoeItem ma = moe_item_load(F, l, gw, w_e_gate, w_e_up, w_e_down, va), mb = ma;
    for (int it = gw; it < NIT; it += 2 * ngw) {
        const int i1 = it + ngw, i2 = it + 2 * ngw;
        mb = moe_item_load(F, l, min(i1, NIT - 1), w_e_gate, w_e_up, w_e_down, vb);
        __builtin_amdgcn_sched_barrier(0);
        tr_store(va, ma.dst, D, ma.n0, ma.k0, scr, F.lane);
        ma = moe_item_load(F, l, min(i2, NIT - 1), w_e_gate, w_e_up, w_e_down, va);
        __builtin_amdgcn_sched_barrier(0);
        tr_store(vb, mb.dst, D, mb.n0, mb.k0, scr, F.lane);
    }
}

__device__ __forceinline__ void phase_prep(Frame& F) {
    const int tid = F.tid;
    {
        LAS float* s = (LAS float*)F.lds;
        LAS float* red = (LAS float*)(F.lds + 9 * 1024 * 4);
        float* MOD = WSP(float, WS_MOD);
        const float* c_in = FIN(I_C); const float* c_ctx = FIN(I_CCTX); const float* w_ada = FIN(I_WADA); const float* b_ada = FIN(I_BADA);
        bool staged = false;
        for (int it = F.bid; it < 192; it += F.G) {
            if (!staged) { for (int i = tid; i < 9 * 1024; i += NTHR) { const int r = i >> 10, k = i & 1023; const float cv = (r < 8) ? c_in[r * 1024 + k] : c_ctx[k]; s[i] = siluf_(cv); } staged = true; }
            __syncthreads();
            const int l = it / 96, cgp = it % 96, col = cgp * 64 + (tid & 63), kq = tid >> 6;
            float acc[9];
#pragma unroll
            for (int r = 0; r < 9; ++r) acc[r] = 0.f;
            const float* w = w_ada + ((size_t)l * 1024 + kq * 128) * 6144 + col;
            for (int k0 = 0; k0 < 128; k0 += 32) {
                float wv[32];
#pragma unroll
                for (int k = 0; k < 32; ++k) wv[k] = w[(size_t)(k0 + k) * 6144];
#pragma unroll
                for (int k = 0; k < 32; ++k)
#pragma unroll
                    for (int r = 0; r < 9; ++r) acc[r] += s[r * 1024 + kq * 128 + k0 + k] * wv[k];
            }
#pragma unroll
            for (int r = 0; r < 9; ++r) red[(kq * 9 + r) * 64 + (tid & 63)] = acc[r];
            __syncthreads();
            for (int o = tid; o < 576; o += NTHR) { const int r = o >> 6, cc = o & 63; float sum = 0.f;
#pragma unroll
                for (int q = 0; q < 8; ++q) sum += red[(q * 9 + r) * 64 + cc];
                MOD[((size_t)l * 9 + r) * 6144 + cgp * 64 + cc] = sum + b_ada[l * 6144 + cgp * 64 + cc]; }
            __syncthreads();
        }
        __syncthreads();
    }
    {
        bf16_t* FL = WSP(bf16_t, WS_FL); bf16_t* FC = WSP(bf16_t, WS_FC);
        const size_t gth = (size_t)F.bid * NTHR + tid, nth = (size_t)F.G * NTHR;
        for (size_t it = gth; it < (size_t)4096 * 1024 / 8; it += nth) {
            const int r = (int)(it / 128), t0 = (int)(it % 128) * 8, part = r >> 11, k = r & 2047; unsigned w[4];
#pragma unroll
            for (int j = 0; j < 4; ++j) { float v[2];
#pragma unroll
                for (int q = 0; q < 2; ++q) { const int ph = (k * (t0 + 2 * j + q)) & 2047; const float ang = (float)ph * (6.283185307179586f / 2048.f); v[q] = (part ? sinf(ang) : cosf(ang)) * 0.022097086912079608f; }
                w[j] = pk2(v[0], v[1]); }
            *(u32x4*)(FL + (size_t)r * 1024 + t0) = (u32x4){w[0], w[1], w[2], w[3]};
        }
        for (size_t it = gth; it < (size_t)512 * 256 / 8; it += nth) {
            const int r = (int)(it / 32), t0 = (int)(it % 32) * 8, part = r >> 8, k = r & 255; unsigned w[4];
#pragma unroll
            for (int j = 0; j < 4; ++j) { float v[2];
#pragma unroll
                for (int q = 0; q < 2; ++q) { const int ph = (k * (t0 + 2 * j + q)) & 255; const float ang = (float)ph * (6.283185307179586f / 256.f); v[q] = (part ? sinf(ang) : cosf(ang)) * 0.0625f; }
                w[j] = pk2(v[0], v[1]); }
            *(u32x4*)(FC + (size_t)r * 1024 + t0) = (u32x4){w[0], w[1], w[2], w[3]};
        }
    }
    const int gw = F.bid * NWAVES + F.wave, ngw = F.G * NWAVES;
    {
        LAS float* scr = (LAS float*)(F.lds + F.wave * 8448);
        bf16_t* WIN = WSP(bf16_t, WS_WIN); bf16_t* WOUT = WSP(bf16_t, WS_WOUT);
        const float* w_in = FIN(I_WIN); const float* w_out = FIN(I_WOUT);
        constexpr int I_IN = 2 * 88 * 16, I_OP = 2 * 32 * 12, I_PQ = 2 * 32 * 8;
        for (int it = gw; it < I_IN + I_OP + I_PQ; it += ngw) {
            if (it < I_IN) { const int l = it / 1408, r = it % 1408, nb = r / 16, kb = r % 16;
                SrcWin s{w_in + (size_t)l * D * INC};
                tr_item(s, WIN + (size_t)l * NIN * D, D, nb * 32, kb * 64, scr, F.lane);
            } else if (it < I_IN + I_OP) { const int r0 = it - I_IN, l = r0 / 384, r = r0 % 384, nb = r / 12, kb = r % 12;
                SrcPlain s{w_out + (size_t)l * D * D, D};
                tr_item(s, WOUT + (size_t)l * D * KOUT, KOUT, nb * 32, kb * 64, scr, F.lane);
            } else { const int r0 = it - I_IN - I_OP, l = r0 / 256, r = r0 % 256, nb = r / 8, gp = r % 8, g = gp & 3, part = gp >> 2;
                const float* wsrc = w_out + (size_t)l * D * D + (size_t)(768 + g * 64) * D + nb * 32;
#pragma unroll 8
                for (int i = 0; i < 32; ++i) { const int kk = 2 * i + (F.lane >> 5), nn = F.lane & 31; scr[kk * 33 + nn] = wsrc[(size_t)kk * D + nn]; }
                LDS_WAIT(); asm volatile("" ::: "memory");
                const int c8 = F.lane & 7;
                float o[4][8];
#pragma unroll
                for (int j = 0; j < 4; ++j)
#pragma unroll
                    for (int q = 0; q < 8; ++q) o[j][q] = 0.f;
                for (int m = 0; m < 64; ++m) {
                    float twd[8];
#pragma unroll
                    for (int q = 0; q < 8; ++q) { const float ang = (float)((m * (c8 * 8 + q)) & 63) * (6.283185307179586f / 64.f); twd[q] = part ? -__sinf(ang) : __cosf(ang); }
#pragma unroll
                    for (int j = 0; j < 4; ++j) { const float bv = scr[m * 33 + (F.lane >> 3) + 8 * j];
#pragma unroll
                        for (int q = 0; q < 8; ++q) o[j][q] += twd[q] * bv; }
                }
#pragma unroll
                for (int j = 0; j < 4; ++j) { const int n = (F.lane >> 3) + 8 * j;
                    u32x4 ov; ov.x = pk2(o[j][0] * 0.125f, o[j][1] * 0.125f); ov.y = pk2(o[j][2] * 0.125f, o[j][3] * 0.125f); ov.z = pk2(o[j][4] * 0.125f, o[j][5] * 0.125f); ov.w = pk2(o[j][6] * 0.125f, o[j][7] * 0.125f);
                    *(u32x4*)(WOUT + (size_t)l * D * KOUT + (size_t)(nb * 32 + n) * KOUT + 768 + part * 256 + g * 64 + c8 * 8) = ov; }
                LDS_WAIT(); asm volatile("" ::: "memory");
            }
        }
    }
}

constexpr int ROW_PRM = 65536;
template <int CTRL> __device__ __forceinline__ float dppf(float v) { return __builtin_bit_cast(float, __builtin_amdgcn_update_dpp(0, __builtin_bit_cast(int, v), CTRL, 0xF, 0xF, true)); }
__device__ __forceinline__ float rdlane(float v, int l) { return __builtin_bit_cast(float, __builtin_amdgcn_readlane(__builtin_bit_cast(int, v), l)); }
__device__ __forceinline__ float wave_sum_dpp(float v) {
    v += dppf<0xB1>(v); v += dppf<0x4E>(v); v += dppf<0x141>(v); v += dppf<0x140>(v);
    return (rdlane(v, 0) + rdlane(v, 16)) + (rdlane(v, 32) + rdlane(v, 48));
}
__device__ __forceinline__ void stage_small_w(Frame& F, LAS float* wT, const float* src, int ld, int coloff) {
    for (int i = F.tid; i < 16 * 1024; i += NTHR) { const int k = i >> 4, c = i & 15; wT[c * 1024 + k] = src[(size_t)k * ld + coloff + c]; }
}
#define SWAP4(INS, a0, b0, a1, b1, a2, b2, a3, b3) asm volatile("s_nop 1\n\t" INS " %0, %1\n\t" INS " %2, %3\n\t" INS " %4, %5\n\t" INS " %6, %7\n\ts_nop 1" : "+v"(a0), "+v"(b0), "+v"(a1), "+v"(b1), "+v"(a2), "+v"(b2), "+v"(a3), "+v"(b3))
#ifdef OLD_REDUCE
__device__ __forceinline__ float reduce16(const float (&acc)[16], int lane) {
    float v8[8], v4[4], v2[2], v1;
#pragma unroll
    for (int i = 0; i < 8; ++i) { const float snd = (lane & 32) ? acc[i] : acc[i + 8], kp = (lane & 32) ? acc[i + 8] : acc[i]; v8[i] = kp + __shfl_xor(snd, 32); }
#pragma unroll
    for (int i = 0; i < 4; ++i) { const float snd = (lane & 16) ? v8[i] : v8[i + 4], kp = (lane & 16) ? v8[i + 4] : v8[i]; v4[i] = kp + __shfl_xor(snd, 16); }
#pragma unroll
    for (int i = 0; i < 2; ++i) { const float snd = (lane & 8) ? v4[i] : v4[i + 2], kp = (lane & 8) ? v4[i + 2] : v4[i]; v2[i] = kp + __shfl_xor(snd, 8); }
    { const float snd = (lane & 4) ? v2[0] : v2[1], kp = (lane & 4) ? v2[1] : v2[0]; v1 = kp + __shfl_xor(snd, 4); }
    v1 += __shfl_xor(v1, 2); v1 += __shfl_xor(v1, 1);
    return v1;
}
#else
__device__ __forceinline__ float reduce16(const float (&acc)[16], int lane) {
    float v8[8], v4[4], v2[2], v1, t[16];
#pragma unroll
    for (int i = 0; i < 16; ++i) t[i] = acc[i];
    SWAP4("v_permlane32_swap_b32", t[0], t[8], t[1], t[9], t[2], t[10], t[3], t[11]); SWAP4("v_permlane32_swap_b32", t[4], t[12], t[5], t[13], t[6], t[14], t[7], t[15]);
#pragma unroll
    for (int i = 0; i < 8; ++i) v8[i] = t[i] + t[i + 8];
    SWAP4("v_permlane16_swap_b32", v8[0], v8[4], v8[1], v8[5], v8[2], v8[6], v8[3], v8[7]);
#pragma unroll
    for (int i = 0; i < 4; ++i) v4[i] = v8[i] + v8[i + 4];
#pragma unroll
    for (int i = 0; i < 2; ++i) { const float snd = (lane & 8) ? v4[i] : v4[i + 2], kp = (lane & 8) ? v4[i + 2] : v4[i]; v2[i] = kp + dppf<0x140>(snd); }
    { const float snd = (lane & 4) ? v2[0] : v2[1], kp = (lane & 4) ? v2[1] : v2[0]; v1 = kp + dppf<0x141>(snd); }
    v1 += dppf<0x4E>(v1); v1 += dppf<0xB1>(v1);
    return v1;
}
#endif
__device__ __forceinline__ int mod_row(int tok) { return tok < NLAT ? (tok >> 11) : 8; }
__device__ __forceinline__ void pair_range(int ntok, int gw, int ngw, int& p0, int& p1) { const int np = ntok >> 1; p0 = (int)(((long long)np * gw) / ngw); p1 = (int)(((long long)np * (gw + 1)) / ngw); }
__device__ __forceinline__ void block_mod_rows(Frame& F, int ntok, int& mrA, int& mrB) {
    int q0, q1, r0, r1; pair_range(ntok, F.bid * NWAVES, F.G * NWAVES, q0, q1); pair_range(ntok, F.bid * NWAVES + NWAVES - 1, F.G * NWAVES, r0, r1);
    mrA = mod_row(min(2 * q0, ntok - 1)); mrB = mod_row(min(max(2 * r1 - 1, 0), ntok - 1));
}
__device__ __forceinline__ float sumsq4(const f32x4 (&v)[4]) { float ss = 0.f;
#pragma unroll
    for (int j = 0; j < 4; ++j) ss += (v[j][0] * v[j][0] + v[j][1] * v[j][1]) + (v[j][2] * v[j][2] + v[j][3] * v[j][3]);
    return ss; }
__device__ __forceinline__ void norm_pair(const f32x4 (&va)[4], const f32x4 (&vb)[4], const LAS float* cfp, const LAS float* shp, bf16_t* xn_a, f32x2 (&yy)[16], int lane) {
    const float ra = 1.0f / sqrtf(wave_sum_dpp(sumsq4(va)) * (1.0f / D) + EPS), rb = 1.0f / sqrtf(wave_sum_dpp(sumsq4(vb)) * (1.0f / D) + EPS);
#pragma unroll
    for (int j = 0; j < 4; ++j) { const int o = 4 * lane + 256 * j;
        const f32x4 cf = *(const LAS f32x4*)(cfp + o), sh = *(const LAS f32x4*)(shp + o);
        f32x4 ya, yb;
#pragma unroll
        for (int q = 0; q < 4; ++q) { ya[q] = va[j][q] * ra * cf[q] + sh[q]; yb[q] = vb[j][q] * rb * cf[q] + sh[q]; yy[4 * j + q] = (f32x2){ya[q], yb[q]}; }
        *(u32x2*)(xn_a + o) = pk4(ya); *(u32x2*)(xn_a + D + o) = pk4(yb); }
}
__device__ __forceinline__ void gate_products2(const f32x2 (&yy)[16], const LAS float* wT, int lane, float& ga, float& gb) {
    f32x2 acc[16];
#pragma unroll
    for (int c = 0; c < 16; ++c) acc[c] = (f32x2){0.f, 0.f};
#pragma unroll
    for (int j = 0; j < 4; ++j) {
#pragma unroll
        for (int h = 0; h < 2; ++h) {
            f32x4 wv[8];
#pragma unroll
            for (int c = 0; c < 8; ++c) wv[c] = *(const LAS f32x4*)(wT + (8 * h + c) * 1024 + 4 * lane + 256 * j);
            __builtin_amdgcn_sched_barrier(0);
#pragma unroll
            for (int c = 0; c < 8; ++c)
#pragma unroll
                for (int q = 0; q < 4; ++q) acc[8 * h + c] += yy[4 * j + q] * (f32x2){wv[c][q], wv[c][q]};
            __builtin_amdgcn_sched_barrier(0);
        }
    }
    float a1[16], b1[16];
#pragma unroll
    for (int c = 0; c < 16; ++c) { a1[c] = acc[c][0]; b1[c] = acc[c][1]; }
    ga = reduce16(a1, lane); gb = reduce16(b1, lane);
}
__device__ __forceinline__ void row_tail_gates(float myv, const float* b_gates_l, float* gates_row, int lane) {
    if ((lane & 3) == 0) { const int c = lane >> 2; gates_row[c] = myv + b_gates_l[c]; }
}
__device__ __forceinline__ void row_tail_router(float myv, float* aff_row, int lane) {
    float mx = myv;
#pragma unroll
    for (int o = 4; o < 64; o <<= 1) mx = fmaxf(mx, __shfl_xor(mx, o));
    const float e = expf(myv - mx); float s = e;
#pragma unroll
    for (int o = 4; o < 64; o <<= 1) s += __shfl_xor(s, o);
    if ((lane & 3) == 0) aff_row[lane >> 2] = e / s;
}
#define LOAD_PAIR(va, vb, src) { _Pragma("unroll") for (int j = 0; j < 4; ++j) { va[j] = *(const f32x4*)((src) + 4 * F.lane + 256 * j); vb[j] = *(const f32x4*)((src) + D + 4 * F.lane + 256 * j); } }

__device__ __forceinline__ void phase_norm1_l0(Frame& F) {
    LAS float* wT = (LAS float*)F.lds; LAS float* prm = (LAS float*)(F.lds + ROW_PRM);
    const float* MOD = WSP(float, WS_MOD); bf16_t* XN = WSP(bf16_t, WS_XN); float* GATES = WSP(float, WS_GATES);
    const float* x_in = FIN(I_X); const float* ctx_in = FIN(I_CTX); const float* g_norm1 = FIN(I_GN1); const float* b_gates = FIN(I_BG);
    const int gw = F.bid * NWAVES + F.wave, ngw = F.G * NWAVES;
    int p0, p1; pair_range(NTOK, gw, ngw, p0, p1);
#define N1_SRC(t) ((t) < NLAT ? x_in + (size_t)(t) * D : ctx_in + (size_t)((t) - NLAT) * D)
    f32x4 va[4], vb[4];
    if (p0 < p1) { const float* src = N1_SRC(2 * p0); LOAD_PAIR(va, vb, src) }
    int mrA, mrB; block_mod_rows(F, NTOK, mrA, mrB);
    stage_small_w(F, wT, FIN(I_WIN), INC, 1536);
    for (int i = F.tid; i < 2048; i += NTHR) { const int set = i >> 10, k = i & 1023; const float* md = MOD + (size_t)(set ? mrB : mrA) * 6144;
        prm[(set * 3 + 0) * 1024 + k] = g_norm1[k] * (1.0f + md[1024 + k]); prm[(set * 3 + 1) * 1024 + k] = md[k]; }
    __syncthreads();
    for (int p = p0; p < p1; ++p) {
        const int tok = 2 * p, set = (mod_row(tok) != mrA) ? 1 : 0;
        f32x2 yy[16];
        norm_pair(va, vb, prm + (set * 3 + 0) * 1024, prm + (set * 3 + 1) * 1024, XN + (size_t)tok * D, yy, F.lane);
        if (p + 1 < p1) { const float* src = N1_SRC(tok + 2); LOAD_PAIR(va, vb, src) }
        float ga, gb; gate_products2(yy, wT, F.lane, ga, gb);
        row_tail_gates(ga, b_gates, GATES + (size_t)tok * 16, F.lane); row_tail_gates(gb, b_gates, GATES + (size_t)(tok + 1) * 16, F.lane);
    }
#undef N1_SRC
    __syncthreads();
}
__device__ __forceinline__ void phase_norm2(Frame& F, int l) {
    LAS float* wT = (LAS float*)F.lds; LAS float* prm = (LAS float*)(F.lds + ROW_PRM);
    const float* g_norm2 = FIN(I_GN2) + l * D;
    const float* MOD = WSP(float, WS_MOD); bf16_t* XN = WSP(bf16_t, WS_XN); float* AFF = WSP(float, WS_AFF); const float* X = WSP(float, WS_X);
    const int gw = F.bid * NWAVES + F.wave, ngw = F.G * NWAVES;
    const int ntok = (l == 0) ? NTOK : NLAT;
    int p0, p1; pair_range(ntok, gw, ngw, p0, p1);
    f32x4 va[4], vb[4];
    if (p0 < p1) { const float* src = X + (size_t)(2 * p0) * D; LOAD_PAIR(va, vb, src) }
    int mrA, mrB; block_mod_rows(F, ntok, mrA, mrB);
    stage_small_w(F, wT, FIN(I_WR) + (size_t)l * D * 16, 16, 0);
    for (int i = F.tid; i < 2048; i += NTHR) { const int set = i >> 10, k = i & 1023; const float* md = MOD + ((size_t)l * 9 + (set ? mrB : mrA)) * 6144;
        prm[(set * 3 + 0) * 1024 + k] = g_norm2[k] * (1.0f + md[4 * 1024 + k]); prm[(set * 3 + 1) * 1024 + k] = md[3 * 1024 + k]; }
    __syncthreads();
    for (int p = p0; p < p1; ++p) {
        const int tok = 2 * p, set = (mod_row(tok) != mrA) ? 1 : 0;
        f32x2 yy[16];
        norm_pair(va, vb, prm + (set * 3 + 0) * 1024, prm + (set * 3 + 1) * 1024, XN + (size_t)tok * D, yy, F.lane);
        if (p + 1 < p1) { const float* src = X + (size_t)(tok + 2) * D; LOAD_PAIR(va, vb, src) }
        float ga, gb; gate_products2(yy, wT, F.lane, ga, gb);
        row_tail_router(ga, AFF + (size_t)tok * 16, F.lane); row_tail_router(gb, AFF + (size_t)(tok + 1) * 16, F.lane);
    }
    __syncthreads();
}
constexpr int CMB_K = 2;
struct CmbSlots { u32x2 y[2][CMB_K][4]; };
__device__ __forceinline__ unsigned row_inv_mask(int invw, int sub) { return (unsigned)((__ballot(invw >= 0) >> (16 * sub)) & 0xffffull); }
__device__ __forceinline__ void cmb_issue(CmbSlots& S, const bf16_t* YS, int invw_a, int sub_a, int invw_b, int sub_b, int lane) {
#pragma unroll
    for (int rr = 0; rr < 2; ++rr) { const int invw = rr ? invw_b : invw_a, sub = rr ? sub_b : sub_a; unsigned mask = row_inv_mask(invw, sub);
#pragma unroll
        for (int s = 0; s < CMB_K; ++s) {
            int e = 0, r = 0;
            if (mask) { e = __builtin_ctz(mask); mask &= mask - 1; r = __builtin_amdgcn_readlane(invw, 16 * sub + e); }
            const bf16_t* yr = YS + ((size_t)e * RPE + r) * D;
#pragma unroll
            for (int j = 0; j < 4; ++j) S.y[rr][s][j] = *(const u32x2*)(yr + 4 * lane + 256 * j); } }
}
__device__ __forceinline__ void cmb_accum(f32x4 (&a)[4], const u32x2 (&w)[4]) {
#pragma unroll
    for (int j = 0; j < 4; ++j) { a[j][0] += bflo(w[j].x); a[j][1] += bfhi(w[j].x); a[j][2] += bflo(w[j].y); a[j][3] += bfhi(w[j].y); }
}
__device__ __forceinline__ void phase_combine(Frame& F, int l) {
    LAS float* wT = (LAS float*)F.lds; LAS float* prm = (LAS float*)(F.lds + ROW_PRM);
    const float* g_norm1 = FIN(I_GN1) + D; const float* b_gates = FIN(I_BG) + 16; const float* g_final = FIN(I_GF); float* outp = as_global(F.A.out);
    const float* MOD = WSP(float, WS_MOD); bf16_t* XN = WSP(bf16_t, WS_XN); float* GATES = WSP(float, WS_GATES); float* X = WSP(float, WS_X);
    const int* INV = WSP(int, WS_INV); const bf16_t* YS = WSP(bf16_t, WS_YS);
    const int gw = F.bid * NWAVES + F.wave, ngw = F.G * NWAVES;
    const int ntok = (l == 0) ? NTOK : NLAT;
    int p0, p1; pair_range(ntok, gw, ngw, p0, p1);
    const int t0 = 2 * p0;
    int invw[3];
#pragma unroll
    for (int i = 0; i < 3; ++i) { const int idx = t0 * 16 + 64 * i + F.lane; invw[i] = (idx < ntok * 16) ? INV[idx] : -1; }
#define INVW(ri) (((ri) >> 2) == 0 ? invw[0] : ((ri) >> 2) == 1 ? invw[1] : invw[2])
    f32x4 va[4], vb[4]; CmbSlots S;
    if (p0 < p1) { const float* src = X + (size_t)t0 * D; LOAD_PAIR(va, vb, src) cmb_issue(S, YS, INVW(0), 0, INVW(1), 1, F.lane); }
    int mrA, mrB; block_mod_rows(F, ntok, mrA, mrB);
    if (l == 0) stage_small_w(F, wT, FIN(I_WIN) + (size_t)1 * D * INC, INC, 1536);
    for (int i = F.tid; i < 2048; i += NTHR) { const int set = i >> 10, k = i & 1023, mr = set ? mrB : mrA; const float* md = MOD + ((size_t)l * 9 + mr) * 6144; const float* md1 = MOD + ((size_t)9 + mr) * 6144;
        prm[(set * 3 + 2) * 1024 + k] = md[5 * 1024 + k];
        if (l == 0) { prm[(set * 3 + 0) * 1024 + k] = g_norm1[k] * (1.0f + md1[1024 + k]); prm[(set * 3 + 1) * 1024 + k] = md1[k]; }
        else prm[(set * 3 + 0) * 1024 + k] = g_final[k]; }
    __syncthreads();
    for (int p = p0; p < p1; ++p) {
        const int tok = 2 * p, ri = tok - t0, set = (mod_row(tok) != mrA) ? 1 : 0;
        const LAS float* pp = prm + set * 3 * 1024;
#pragma unroll
        for (int rr = 0; rr < 2; ++rr) {
            f32x4 a[4];
#pragma unroll
            for (int j = 0; j < 4; ++j) a[j] = (f32x4){0.f, 0.f, 0.f, 0.f};
            const int iw = INVW(ri + rr), sub = (ri + rr) & 3;
            unsigned mask = row_inv_mask(iw, sub);
#pragma unroll
            for (int s = 0; s < CMB_K; ++s) if (mask) { mask &= mask - 1; cmb_accum(a, S.y[rr][s]); }
            while (mask) { const int e = __builtin_ctz(mask); mask &= mask - 1;
                const int r = __builtin_amdgcn_readlane(iw, 16 * sub + e);
                const bf16_t* yr = YS + ((size_t)e * RPE + r) * D;
                u32x2 w[4];
#pragma unroll
                for (int j = 0; j < 4; ++j) w[j] = *(const u32x2*)(yr + 4 * F.lane + 256 * j);
                cmb_accum(a, w); }
#pragma unroll
            for (int j = 0; j < 4; ++j) { const f32x4 gt = *(const LAS f32x4*)(pp + 2 * 1024 + 4 * F.lane + 256 * j); if (rr == 0) va[j] = va[j] + gt * a[j]; else vb[j] = vb[j] + gt * a[j]; }
        }
        if (l == 0) {
#pragma unroll
            for (int j = 0; j < 4; ++j) { *(f32x4*)(X + (size_t)tok * D + 4 * F.lane + 256 * j) = va[j]; *(f32x4*)(X + (size_t)(tok + 1) * D + 4 * F.lane + 256 * j) = vb[j]; }
            f32x2 yy[16];
            norm_pair(va, vb, pp, pp + 1024, XN + (size_t)tok * D, yy, F.lane);
            if (p + 1 < p1) { const float* src = X + (size_t)(tok + 2) * D; LOAD_PAIR(va, vb, src) cmb_issue(S, YS, INVW(ri + 2), (ri + 2) & 3, INVW(ri + 3), (ri + 3) & 3, F.lane); }
            float ga, gb; gate_products2(yy, wT, F.lane, ga, gb);
            row_tail_gates(ga, b_gates, GATES + (size_t)tok * 16, F.lane); row_tail_gates(gb, b_gates, GATES + (size_t)(tok + 1) * 16, F.lane);
        } else {
            const float ra = 1.0f / sqrtf(wave_sum_dpp(sumsq4(va)) * (1.0f / D) + EPS), rb = 1.0f / sqrtf(wave_sum_dpp(sumsq4(vb)) * (1.0f / D) + EPS);
#pragma unroll
            for (int j = 0; j < 4; ++j) { const f32x4 g = *(const LAS f32x4*)(pp + 4 * F.lane + 256 * j);
                *(f32x4*)(outp + (size_t)tok * D + 4 * F.lane + 256 * j) = va[j] * ra * g; *(f32x4*)(outp + (size_t)(tok + 1) * D + 4 * F.lane + 256 * j) = vb[j] * rb * g; }
            if (p + 1 < p1) { const float* src = X + (size_t)(tok + 2) * D; LOAD_PAIR(va, vb, src) cmb_issue(S, YS, INVW(ri + 2), (ri + 2) & 3, INVW(ri + 3), (ri + 3) & 3, F.lane); }
        }
    }
#undef INVW
    __syncthreads();
}

__device__ __forceinline__ int block_count(LAS int* cbuf, int par, int wave, int lane, int c_wave  ) {
    if (lane == 0) cbuf[par * 8 + wave] = c_wave;
    __syncthreads();
    int t = 0;
#pragma unroll
    for (int q = 0; q < 8; ++q) t += cbuf[par * 8 + q];
    return t;
}
__device__ __forceinline__ void phase_topk(Frame& F, int l) {
    LAS int* cbuf = (LAS int*)F.lds;
    const float* AFF = WSP(float, WS_AFF); int* INV = WSP(int, WS_INV); int* ROWTOK = WSP(int, WS_ROWTOK); float* GATEV = WSP(float, WS_GATEV);
    const int nitems = (l == 0) ? 256 : 128;
    for (int it = F.bid; it < nitems; it += F.G) {
        const int s = it >> 4, e = it & 15;
        const bool lat = s < 8;
        const int n = lat ? SEQ : CTXL, cap = lat ? 256 : 32, tok0 = lat ? s * SEQ : NLAT + (s - 8) * CTXL, rowbase = lat ? s * 256 : 2048 + (s - 8) * 32;
        const bool active = 4 * F.tid < n;
        unsigned k[4];
#pragma unroll
        for (int q = 0; q < 4; ++q) k[q] = active ? __float_as_uint(AFF[(size_t)(tok0 + 4 * F.tid + q) * 16 + e]) : 0u;
        __syncthreads();
        unsigned T = 0u; int par = 0;
        for (int bit = 30; bit >= 0; --bit) {
            const unsigned cand = T | (1u << bit);
            int cw = 0;
#pragma unroll
            for (int q = 0; q < 4; ++q) cw += __popcll(__ballot(k[q] >= cand));
            const int tot = block_count(cbuf, par, F.wave, F.lane, cw); par ^= 1;
            if (tot >= cap) T = cand;
        }
        int cw = 0;
#pragma unroll
        for (int q = 0; q < 4; ++q) cw += __popcll(__ballot(k[q] > T));
        const int c_gt = block_count(cbuf, par, F.wave, F.lane, cw); par ^= 1;
        int mg = 0, me = 0;
#pragma unroll
        for (int q = 0; q < 4; ++q) { mg += (k[q] > T) ? 1 : 0; me += (k[q] == T && active) ? 1 : 0; }
        int pk_ = mg | (me << 16), inc = pk_;
#pragma unroll
        for (int o = 1; o < 64; o <<= 1) { const int y = __shfl_up(inc, o); if (F.lane >= o) inc += y; }
        if (F.lane == 63) cbuf[16 + F.wave] = inc;
        __syncthreads();
        int base = 0;
#pragma unroll
        for (int q = 0; q < 8; ++q) base += (q < F.wave) ? cbuf[16 + q] : 0;
        int pre = base + inc - pk_; int pg = pre & 0xffff, pe = pre >> 16;
        if (active) {
#pragma unroll
            for (int q = 0; q < 4; ++q) {
                const int tok = tok0 + 4 * F.tid + q; int slot = -1;
                if (k[q] > T) { slot = pg; ++pg; }
                else if (k[q] == T) { if (c_gt + pe < cap) slot = c_gt + pe; ++pe; }
                if (slot >= 0) { ROWTOK[e * RPE + rowbase + slot] = tok; GATEV[e * RPE + rowbase + slot] = __uint_as_float(k[q]); }
                INV[(size_t)tok * 16 + e] = slot >= 0 ? rowbase + slot : -1;
            }
        }
        __syncthreads();
    }
    __syncthreads();
}

__device__ __forceinline__ void conv_items(Frame& F, int l, int first, int stride) {
    LAS float* gl = (LAS float*)F.lds;
    LAS float* ob = gl + 62 * 256;
    const bf16_t* CA = WSP(bf16_t, WS_CA); const bf16_t* CG = WSP(bf16_t, WS_CG); bf16_t* Y = WSP(bf16_t, WS_Y);
    const int nitems = (l == 0) ? 512 + 64 : 512;
    const int ch = F.tid & 255, th = F.tid >> 8;
    const float* conv_w = FIN(I_CW); const float* conv_b = FIN(I_CB); const float* conv_ln_g = FIN(I_CLG); const float* conv_ln_b = FIN(I_CLB);
    float w[31];
#pragma unroll
    for (int j = 0; j < 31; ++j) w[j] = conv_w[((size_t)l * 31 + j) * 256 + ch];
    const float cb = conv_b[l * 256 + ch];
    for (int it = first; it < nitems; it += stride) {
        const bool lat = it < 512;
        const int seqlen = lat ? SEQ : CTXL;
        const int b = lat ? it >> 6 : (it - 512) >> 3, t0 = lat ? (it & 63) * 32 : ((it - 512) & 7) * 32;
        const int tokb = lat ? b * SEQ : NLAT + b * CTXL;
        __syncthreads();
        for (int i = F.tid; i < 62 * 64; i += NTHR) {
            const int rr = i >> 6, c4 = (i & 63) * 4, t = t0 - 15 + rr;
            f32x4 g = (f32x4){0.f, 0.f, 0.f, 0.f};
            if (t >= 0 && t < seqlen) { const size_t o = (size_t)(tokb + t) * 256 + c4; const u32x2 a = *(const u32x2*)(CA + o), gg = *(const u32x2*)(CG + o);
                g[0] = bflo(a.x) * sigmoidf_(bflo(gg.x)); g[1] = bfhi(a.x) * sigmoidf_(bfhi(gg.x)); g[2] = bflo(a.y) * sigmoidf_(bflo(gg.y)); g[3] = bfhi(a.y) * sigmoidf_(bfhi(gg.y)); }
            *(LAS f32x4*)(gl + rr * 256 + c4) = g;
        }
        __syncthreads();
        for (int tt = 0; tt < 16; ++tt) {
            const LAS float* gp = gl + (th * 16 + tt) * 256 + ch;
            float gv[31];
#pragma unroll
            for (int j = 0; j < 31; ++j) gv[j] = gp[j * 256];
            __builtin_amdgcn_sched_barrier(0);
            float o = cb;
#pragma unroll
            for (int j = 0; j < 31; ++j) o += w[j] * gv[j];
            __builtin_amdgcn_sched_barrier(0);
            ob[(th * 16 + tt) * 256 + ch] = o;
        }
        __syncthreads();
        for (int tt = F.wave; tt < 32; tt += NWAVES) {
            const f32x4 v = *(const LAS f32x4*)(ob + tt * 256 + 4 * F.lane);
            const float mean = wave_sum((v[0] + v[1]) + (v[2] + v[3])) * (1.0f / 256.f);
            const f32x4 d = v - mean;
            const float var = wave_sum((d[0] * d[0] + d[1] * d[1]) + (d[2] * d[2] + d[3] * d[3])) * (1.0f / 256.f);
            const float rs = 1.0f / sqrtf(var + EPS);
            const f32x4 lg = *(const f32x4*)(conv_ln_g + l * 256 + 4 * F.lane), lb = *(const f32x4*)(conv_ln_b + l * 256 + 4 * F.lane);
            f32x4 y;
#pragma unroll
            for (int q = 0; q < 4; ++q) y[q] = siluf_(d[q] * rs * lg[q] + lb[q]);
            *(u32x2*)(Y + (size_t)(tokb + t0 + tt) * KOUT + 512 + 4 * F.lane) = pk4(y);
        }
    }
    __syncthreads();
}
__device__ __forceinline__ void ztrans_items(Frame& F, int l, int first, int stride) {
    LAS unsigned short* te = (LAS unsigned short*)(F.lds + F.wave * (2 * 64 * 66 * 2));
    LAS unsigned short* to = te + 64 * 66;
    const bf16_t* FR = WSP(bf16_t, WS_FR); bf16_t* ZE = WSP(bf16_t, WS_ZT); bf16_t* ZO = WSP(bf16_t, WS_ZO); bf16_t* ZTC = WSP(bf16_t, WS_ZTC);
    const int nlat = 8 * 16 * 4, nctx = (l == 0) ? 8 * 4 * 4 : 0;
    for (int it = first; it < nlat + nctx; it += stride) {
        const bool lat = it < nlat; const int r = lat ? it : it - nlat;
        const int b = lat ? r >> 6 : r >> 4, tb = lat ? (r >> 2) & 15 : (r >> 2) & 3, cb = r & 3;
        const int tokb = lat ? b * SEQ : NLAT + b * CTXL;
#pragma unroll
        for (int i = 0; i < 8; ++i) { const int tt = (F.lane >> 3) + 8 * i, c8 = (F.lane & 7) * 8, t = tb * 64 + tt;
            const u32x4 v = *(const u32x4*)(FR + (size_t)(tokb + t) * 256 + cb * 64 + c8);
            u32x4 m = (u32x4){0u, 0u, 0u, 0u};
            if (lat && t > 0) m = *(const u32x4*)(FR + (size_t)(tokb + SEQ - t) * 256 + cb * 64 + c8);
#pragma unroll
            for (int q = 0; q < 4; ++q) {
                if (lat) { const float a0 = bflo(v[q]), a1 = bfhi(v[q]), m0 = bflo(m[q]), m1 = bfhi(m[q]); const unsigned e_ = pk2(a0 + m0, a1 + m1), o_ = (t > 0) ? pk2(a0 - m0, a1 - m1) : 0u;
                    te[(c8 + 2 * q) * 66 + tt] = (unsigned short)(e_ & 0xffffu); te[(c8 + 2 * q + 1) * 66 + tt] = (unsigned short)(e_ >> 16);
                    to[(c8 + 2 * q) * 66 + tt] = (unsigned short)(o_ & 0xffffu); to[(c8 + 2 * q + 1) * 66 + tt] = (unsigned short)(o_ >> 16); }
                else { te[(c8 + 2 * q) * 66 + tt] = (unsigned short)(v[q] & 0xffffu); te[(c8 + 2 * q + 1) * 66 + tt] = (unsigned short)(v[q] >> 16); } } }
        LDS_WAIT(); asm volatile("" ::: "memory");
        const size_t drow = (size_t)(b * 256 + cb * 64) * 1024 + tb * 64;
#pragma unroll
        for (int i = 0; i < 8; ++i) { const int cc = (F.lane >> 3) + 8 * i, t8 = (F.lane & 7) * 8; u32x4 o;
#pragma unroll
            for (int q = 0; q < 4; ++q) o[q] = (unsigned)te[cc * 66 + t8 + 2 * q] | ((unsigned)te[cc * 66 + t8 + 2 * q + 1] << 16);
            *(u32x4*)((lat ? ZE : ZTC) + drow + (size_t)cc * 1024 + t8) = o;
            if (lat) {
#pragma unroll
                for (int q = 0; q < 4; ++q) o[q] = (unsigned)to[cc * 66 + t8 + 2 * q] | ((unsigned)to[cc * 66 + t8 + 2 * q + 1] << 16);
                *(u32x4*)(ZO + drow + (size_t)cc * 1024 + t8) = o; } }
        LDS_WAIT(); asm volatile("" ::: "memory");
    }
}
__device__ __forceinline__ void finalize_h(Frame& F, int l) {
    const bf16_t* HF = WSP(bf16_t, WS_HF); const bf16_t* HB = WSP(bf16_t, WS_HB); const bf16_t* O = WSP(bf16_t, WS_O); bf16_t* Y = WSP(bf16_t, WS_Y);
    const int gw = F.bid * NWAVES + F.wave, ngw = F.G * NWAVES;
    const int ntok = (l == 0) ? NTOK : NLAT;
    float gh[8];
    const float* g_hnorm = FIN(I_GH);
#pragma unroll
    for (int q = 0; q < 8; ++q) gh[q] = g_hnorm[l * 512 + 8 * F.lane + q];
    for (int tok = gw; tok < ntok; tok += ngw) {
        const size_t o = (size_t)tok * 512 + 8 * F.lane;
        const u32x4 a = *(const u32x4*)(HF + o), b = *(const u32x4*)(HB + o), og = *(const u32x4*)(O + o);
        float h[8]; float ss = 0.f;
#pragma unroll
        for (int q = 0; q < 4; ++q) { h[2 * q] = bflo(a[q]) + bflo(b[q]); h[2 * q + 1] = bfhi(a[q]) + bfhi(b[q]); ss += h[2 * q] * h[2 * q] + h[2 * q + 1] * h[2 * q + 1]; }
#pragma unroll
        for (int s = 1; s < 16; s <<= 1) ss += __shfl_xor(ss, s);
        const float r = 1.0f / sqrtf(ss * (1.0f / 128.f) + EPS);
        u32x4 w;
#pragma unroll
        for (int q = 0; q < 4; ++q) w[q] = pk2(h[2 * q] * r * gh[2 * q] * bflo(og[q]), h[2 * q + 1] * r * gh[2 * q + 1] * bfhi(og[q]));
        *(u32x4*)(Y + (size_t)tok * KOUT + 8 * F.lane) = w;
    }
}

using pg8::Unit;
enum { GM_INPROJ = 0, GM_DFT, GM_OUT, GM_MOE1, GM_MOE2 };
struct GemmCtl {
    int mode, l, G, c; GAS unsigned char* ws; const Args& A;
    __device__ __forceinline__ GAS unsigned char* W() const { GAS unsigned char* p = ws; asm volatile("" : "+s"(p)); return p; }
    __device__ __forceinline__ bool next(int i, Unit& u) const {
        const int L = i * G + c; int pm, pn;
        u.rows = nullptr; u.ex = 0;
        switch (mode) {
        case GM_INPROJ: {
            const int n0 = 64 * 11, npn = (l == 0) ? 11 : 6;
            if (L >= n0 + 8 * npn) return false;
            if (L < n0) pg8::map_tile(L, 64, 11, pm, pn); else { pg8::map_tile(L - n0, 8, npn, pm, pn); pm += 64; }
            u.A = (const char*)(W() + WS_XN) + (size_t)pm * 256 * D * 2; u.B = (const char*)(W() + WS_WIN) + ((size_t)l * NIN + pn * 256) * D * 2; u.K = D;
        } break;
        case GM_DFT: {
            const int nctx = (l == 0) ? 16 : 0;
            if (L >= 128 + nctx) return false;
            if (L < 128) { pg8::map_tile(L, 16, 8, pm, pn); u.A = (const char*)(W() + WS_FL) + (size_t)pm * 256 * 1024 * 2; u.B = (const char*)(W() + ((pm >> 3) ? WS_ZO : WS_ZT)) + (size_t)pn * 256 * 1024 * 2; u.K = 1024; }
            else { const int r = L - 128; pm = r & 1; pn = r >> 1; u.A = (const char*)(W() + WS_FC) + (size_t)pm * 256 * 1024 * 2; u.B = (const char*)(W() + WS_ZTC) + (size_t)pn * 256 * 1024 * 2; u.K = CTXL; u.ex = 1; }
        } break;
        case GM_OUT: {
            const int nM = (l == 0) ? 72 : 64;
            if (L >= nM * 4) return false;
            pg8::map_tile(L, nM, 4, pm, pn);
            u.A = (const char*)(W() + WS_Y) + (size_t)pm * 256 * KOUT * 2; u.B = (const char*)(W() + WS_WOUT) + ((size_t)l * D + pn * 256) * KOUT * 2; u.K = KOUT;
        } break;
        case GM_MOE1: {
            const int nMe = (l == 0) ? 9 : 8; int pmg;
            if (L >= NE * nMe * 8) return false;
            pg8::map_tile(L, NE * nMe, 8, pmg, pn);
            const int e = pmg / nMe; pm = pmg % nMe;
            u.A = (const char*)(W() + WS_XN); u.rows = (const int*)(W() + WS_ROWTOK) + e * RPE + pm * 256; u.B = (const char*)(W() + WS_WGU) + ((size_t)e * 2048 + pn * 256) * D * 2; u.K = D; u.ex = e;
        } break;
        default: {
            const int nMe = (l == 0) ? 9 : 8; int pmg;
            if (L >= NE * nMe * 4) return false;
            pg8::map_tile(L, NE * nMe, 4, pmg, pn);
            const int e = pmg / nMe; pm = pmg % nMe;
            u.A = (const char*)(W() + WS_HID) + ((size_t)e * RPE + pm * 256) * D * 2; u.B = (const char*)(W() + WS_WD) + ((size_t)e * D + pn * 256) * D * 2; u.K = D; u.ex = e;
        } break;
        }
        u.pm = pm; u.pn = pn;
        return true;
    }
    struct CxIn { bf16_t* dst; int ld; float sc; int act; };
    __device__ __forceinline__ CxIn prep_in(const Unit& u) const {
        CxIn c; const int pn = u.pn; c.sc = 1.f; c.act = 0; size_t off; int cb;
        if (pn < 2) { off = WS_Q; c.ld = 512; cb = pn * 256; }
        else if (pn < 4) { off = WS_K; c.ld = 512; cb = (pn - 2) * 256; c.sc = 0.08838834764831845f; }
        else if (pn < 6) { off = WS_V; c.ld = 512; cb = (pn - 4) * 256; }
        else if (pn < 8) { off = WS_O; c.ld = 512; cb = (pn - 6) * 256; c.act = 1; }
        else if (pn == 8) { off = WS_CA; c.ld = 256; cb = 0; }
        else if (pn == 9) { off = WS_CG; c.ld = 256; cb = 0; }
        else { off = WS_FR; c.ld = 256; cb = 0; }
        c.dst = (bf16_t*)(W() + off) + (size_t)u.pm * 256 * c.ld + cb;
        return c;
    }
    __device__ __forceinline__ void store_in(const CxIn& c, int r, int col, f32x4 v0, f32x4 v1) const {
        if (c.act) {
#pragma unroll
            for (int q = 0; q < 4; ++q) { v0[q] = sigmoidf_(v0[q]); v1[q] = sigmoidf_(v1[q]); }
        } else { v0 = v0 * c.sc; v1 = v1 * c.sc; }
        bf16_t* p = c.dst + (size_t)r * c.ld + col;
        *(u32x2*)p = pk4(v0); *(u32x2*)(p + 16) = pk4(v1);
    }
    struct CxDft { bf16_t* dst; const bf16_t* z1024; };
    __device__ __forceinline__ CxDft prep_dft(const Unit& u) const {
        CxDft c; int part, tokb; c.z1024 = nullptr;
        if (u.ex == 0) { part = u.pm >> 3; tokb = u.pn * SEQ + (u.pm & 7) * 256; if (part == 0) c.z1024 = (const bf16_t*)(W() + WS_FR) + (size_t)(u.pn * SEQ + 1024) * 256; }
        else { part = u.pm; tokb = NLAT + u.pn * CTXL; }
        c.dst = (bf16_t*)(W() + WS_Y) + (size_t)tokb * KOUT + 768 + part * 256; return c;
    }
    __device__ __forceinline__ void store_dft(const CxDft& c, int r, int col, f32x4 v0, f32x4 v1) const {
        if (c.z1024) { const float sg = (r & 1) ? -0.022097086912079608f : 0.022097086912079608f; const u32x2 z0 = *(const u32x2*)(c.z1024 + col), z1 = *(const u32x2*)(c.z1024 + col + 16);
            v0[0] += sg * bflo(z0.x); v0[1] += sg * bfhi(z0.x); v0[2] += sg * bflo(z0.y); v0[3] += sg * bfhi(z0.y);
            v1[0] += sg * bflo(z1.x); v1[1] += sg * bfhi(z1.x); v1[2] += sg * bflo(z1.y); v1[3] += sg * bfhi(z1.y); }
        bf16_t* p = c.dst + (size_t)r * KOUT + col;
        *(u32x2*)p = pk4(v0); *(u32x2*)(p + 16) = pk4(v1);
    }
    struct CxOut { const float* src; float* dst; const float* gt; };
    __device__ __forceinline__ CxOut prep_out(const Unit& u) const {
        CxOut c; const int tok0 = u.pm * 256, col0 = u.pn * 256;
        if (l == 0) c.src = (tok0 < NLAT ? arg_in(A, I_X) + (size_t)tok0 * D : arg_in(A, I_CTX) + (size_t)(tok0 - NLAT) * D) + col0;
        else c.src = (const float*)(W() + WS_X) + (size_t)tok0 * D + col0;
        c.dst = (float*)(W() + WS_X) + (size_t)tok0 * D + col0;
        c.gt = (const float*)(W() + WS_MOD) + ((size_t)l * 9 + mod_row(tok0)) * 6144 + 2 * 1024 + col0;
        return c;
    }
    __device__ __forceinline__ void store_out(const CxOut& c, int r, int col, f32x4 v0, f32x4 v1) const {
        const size_t o = (size_t)r * D + col;
        const f32x4 g0 = *(const f32x4*)(c.gt + col), g1 = *(const f32x4*)(c.gt + col + 16);
        const f32x4 s0 = *(const f32x4*)(c.src + o), s1 = *(const f32x4*)(c.src + o + 16);
        *(f32x4*)(c.dst + o) = s0 + g0 * v0; *(f32x4*)(c.dst + o + 16) = s1 + g1 * v1;
    }
    __device__ __forceinline__ bf16_t* prep_m1(const Unit& u) const { return (bf16_t*)(W() + WS_HID) + ((size_t)u.ex * RPE + u.pm * 256) * D + u.pn * 128; }
    __device__ __forceinline__ void store_m1(bf16_t* dst, int r, int col, f32x4 v0, f32x4 v1) const {
        f32x4 h;
#pragma unroll
        for (int q = 0; q < 4; ++q) h[q] = siluf_(v0[q]) * v1[q];
        *(u32x2*)(dst + (size_t)r * D + (col >> 5) * 16 + (col & 15)) = pk4(h);
    }
    struct CxM2 { bf16_t* dst; const float* g; };
    __device__ __forceinline__ CxM2 prep_m2(const Unit& u) const { CxM2 c; c.dst = (bf16_t*)(W() + WS_YS) + ((size_t)u.ex * RPE + u.pm * 256) * D + u.pn * 256; c.g = (const float*)(W() + WS_GATEV) + u.ex * RPE + u.pm * 256; return c; }
    __device__ __forceinline__ void store_m2(const CxM2& c, int r, int col, f32x4 v0, f32x4 v1) const {
        const float g = c.g[r];
        bf16_t* p = c.dst + (size_t)r * D + col;
        *(u32x2*)p = pk4(v0 * g); *(u32x2*)(p + 16) = pk4(v1 * g);
    }
#define EPI_WALK(PREP, STORE) do { const auto cx = PREP(u); _Pragma("unroll") for (int ai = 0; ai < 2; ++ai) _Pragma("unroll") for (int m = 0; m < 4; ++m) _Pragma("unroll") for (int bj = 0; bj < 2; ++bj) \
        STORE(cx, ai * 128 + wr * 64 + m * 16 + fr, bj * 128 + wc * 32 + 4 * fq, acc[ai][bj][m][0], acc[ai][bj][m][1]); } while (0)
    __device__ __forceinline__ void run(const f32x4 (&acc)[2][2][4][2], const Unit& u, int wr, int wc, int fr, int fq) const {
        switch (mode) {
        case GM_INPROJ: EPI_WALK(prep_in, store_in); break;
        case GM_DFT: EPI_WALK(prep_dft, store_dft); break;
        case GM_OUT: EPI_WALK(prep_out, store_out); break;
        case GM_MOE1: EPI_WALK(prep_m1, store_m1); break;
        default: EPI_WALK(prep_m2, store_m2); break;
        }
    }
    __device__ __forceinline__ void store1(const Unit& u, int r, int c, f32x4 v0, f32x4 v1) const {
        switch (mode) {
        case GM_INPROJ: store_in(prep_in(u), r, c, v0, v1); break;
        case GM_DFT: store_dft(prep_dft(u), r, c, v0, v1); break;
        case GM_OUT: store_out(prep_out(u), r, c, v0, v1); break;
        case GM_MOE1: store_m1(prep_m1(u), r, c, v0, v1); break;
        default: store_m2(prep_m2(u), r, c, v0, v1); break;
        }
    }
};

__device__ __forceinline__ void scan_simt(Frame& F, int l) {
    if (F.bid >= 64) return;
    const int b = F.bid >> 3, h = (F.bid >> 1) & 3, dir = F.bid & 1;
    LAS float* qs = (LAS float*)F.lds; LAS float* ks = qs + 64 * 132; LAS float* vs = ks + 64 * 132; LAS float* st = vs + 64 * 132;
    LAS float* sm = st + 64 * 65;
    LAS float* as_ = sm; LAS float* Ms = sm + 64; LAS float* wint = sm + 128; LAS float* enm = sm + 192; LAS float* wst = sm + 256; LAS float* denom = sm + 320;
    LAS float* nvec = sm + 384; LAS float* ig = sm + 512; LAS float* lf = sm + 576; LAS int* toks = (LAS int*)(sm + 640); LAS float* scal = sm + 704;
    const bf16_t* Q = WSP(bf16_t, WS_Q); const bf16_t* K = WSP(bf16_t, WS_K); const bf16_t* V = WSP(bf16_t, WS_V); const float* GATES = WSP(float, WS_GATES);
    bf16_t* H = dir ? WSP(bf16_t, WS_HB) : WSP(bf16_t, WS_HF);
    float Creg[32];
#pragma unroll
    for (int i = 0; i < 32; ++i) Creg[i] = 0.f;
    float m_st = 0.f;
    if (F.tid < 128) nvec[F.tid] = 0.f;
    __syncthreads();
    for (int cc = 0; cc < 36; ++cc) {
        int tid = F.tid; asm volatile("" : "+v"(tid));
        const int lane = tid & 63, e = tid >> 2, dq = tid & 3;
        const bool isctx = cc < 4;
        const int c = isctx ? (dir ? 3 - cc : cc) : (dir ? 35 - cc : cc - 4);
        const bool want_out = !(isctx && l == 1);
        if (tid < 64) { const int j = tid;
            const int tok = isctx ? NLAT + b * CTXL + c * 64 + j : (h < 2 ? b * SEQ + c * 64 + j : b * SEQ + (j & 31) * 64 + 2 * c + (j >> 5));
            toks[j] = tok; const float* g = GATES + (size_t)tok * 16 + h * 4 + 2 * dir; ig[j] = g[0]; lf[j] = logsigmoidf_(g[1]); }
        __syncthreads();
        for (int it = tid; it < 1024; it += NTHR) { const int j = it >> 4, c8 = (it & 15) * 8; const size_t o = (size_t)toks[j] * 512 + h * 128 + c8;
            const u32x4 qv = *(const u32x4*)(Q + o), kv = *(const u32x4*)(K + o), vv = *(const u32x4*)(V + o);
#pragma unroll
            for (int q = 0; q < 4; ++q) { qs[j * 132 + c8 + 2 * q] = bflo(qv[q]); qs[j * 132 + c8 + 2 * q + 1] = bfhi(qv[q]); ks[j * 132 + c8 + 2 * q] = bflo(kv[q]); ks[j * 132 + c8 + 2 * q + 1] = bfhi(kv[q]);
                vs[j * 132 + c8 + 2 * q] = bflo(vv[q]); vs[j * 132 + c8 + 2 * q + 1] = bfhi(vv[q]); } }
        if (F.wave == 0) {
            const int p = dir ? 63 - lane : lane;
            float x = lf[p];
#pragma unroll
            for (int o = 1; o < 64; o <<= 1) { const float y = __shfl_up(x, o); if (lane >= o) x += y; }
            const float a = ig[p] - x; float cm = a;
#pragma unroll
            for (int o = 1; o < 64; o <<= 1) { const float y = __shfl_up(cm, o); if (lane >= o) cm = fmaxf(cm, y); }
            const float M = fmaxf(m_st, cm), Mend = __shfl(M, 63), blast = __shfl(x, 63);
            as_[p] = a; Ms[p] = M; wint[p] = expf(m_st - M); enm[p] = expf(-(x + M)); wst[p] = expf(a - Mend);
            if (lane == 0) { scal[0] = Mend; scal[1] = blast; }
        }
        __syncthreads();
        const float Mend = scal[0], blast = scal[1], decay = expf(m_st - Mend);
        if (want_out) {
            { const int t = tid >> 3, sg = tid & 7; float sacc[8];
#pragma unroll
                for (int i = 0; i < 8; ++i) sacc[i] = 0.f;
                for (int d4 = 0; d4 < 32; ++d4) { const f32x4 q4 = *(const LAS f32x4*)(qs + t * 132 + d4 * 4);
#pragma unroll
                    for (int i = 0; i < 8; ++i) { const f32x4 k4 = *(const LAS f32x4*)(ks + (i * 8 + sg) * 132 + d4 * 4); sacc[i] += (q4[0] * k4[0] + q4[1] * k4[1]) + (q4[2] * k4[2] + q4[3] * k4[3]); } }
#pragma unroll
                for (int i = 0; i < 8; ++i) { const int s = i * 8 + sg; const bool valid = dir ? (s >= t) : (s <= t); st[t * 65 + s] = valid ? sacc[i] * expf(as_[s] - Ms[t]) : 0.f; } }
            __syncthreads();
            if (tid < 64) { const int t = tid; float qn = 0.f, ssum = 0.f;
                for (int d = 0; d < 128; ++d) qn += qs[t * 132 + d] * nvec[d];
                for (int s = 0; s < 64; ++s) ssum += st[t * 65 + s];
                const float den = wint[t] * qn + ssum; denom[t] = fmaxf(fabsf(den), enm[t]); }
            float mine[16];
#pragma unroll
            for (int tt = 0; tt < 16; ++tt) {
                mine[tt] = 0.f;
#pragma unroll
                for (int u = 0; u < 4; ++u) { const int t = 4 * tt + u; float p = 0.f;
#pragma unroll
                    for (int i4 = 0; i4 < 8; ++i4) { const f32x4 q4 = *(const LAS f32x4*)(qs + t * 132 + dq * 32 + i4 * 4); p += (Creg[4 * i4] * q4[0] + Creg[4 * i4 + 1] * q4[1]) + (Creg[4 * i4 + 2] * q4[2] + Creg[4 * i4 + 3] * q4[3]); }
                    p += __shfl_xor(p, 1); p += __shfl_xor(p, 2);
                    mine[tt] = (u == dq) ? p : mine[tt]; asm volatile("" ::: "memory"); }
            }
#pragma unroll
            for (int tt = 0; tt < 16; ++tt) { const int t = 4 * tt + dq; float intra = 0.f;
#pragma unroll 8
                for (int s = 0; s < 64; ++s) intra += st[t * 65 + s] * vs[s * 132 + e];
                mine[tt] = wint[t] * mine[tt] + intra; asm volatile("" ::: "memory"); }
            __syncthreads();
#pragma unroll
            for (int tt = 0; tt < 16; ++tt) { const int t = 4 * tt + dq; H[(size_t)toks[t] * 512 + h * 128 + e] = (bf16_t)f2bf(mine[tt] / denom[t]); }
        }
#pragma unroll
        for (int i = 0; i < 32; ++i) Creg[i] *= decay;
#pragma unroll 2
        for (int s = 0; s < 64; ++s) { const float wv = wst[s] * vs[s * 132 + e];
#pragma unroll
            for (int i4 = 0; i4 < 8; ++i4) { const f32x4 k4 = *(const LAS f32x4*)(ks + s * 132 + dq * 32 + i4 * 4); Creg[4 * i4] += wv * k4[0]; Creg[4 * i4 + 1] += wv * k4[1]; Creg[4 * i4 + 2] += wv * k4[2]; Creg[4 * i4 + 3] += wv * k4[3]; } }
        float nn = 0.f;
        if (tid < 128) { nn = decay * nvec[tid]; for (int s = 0; s < 64; ++s) nn += wst[s] * ks[s * 132 + tid]; }
        __syncthreads();
        if (tid < 128) nvec[tid] = nn;
        m_st = blast + Mend;
        __syncthreads();
    }
}

__device__ __forceinline__ int scan_tok(bool isctx, int b, int h, int c, int j) {
    return isctx ? NLAT + b * CTXL + c * 64 + j : (h < 2 ? b * SEQ + c * 64 + j : b * SEQ + (j & 31) * 64 + 2 * c + (j >> 5));
}
__device__ __forceinline__ int img256(int row, int chunk) { return row * 256 + ((chunk ^ (row & 15)) << 4); }
__device__ __forceinline__ int img128(int row, int chunk) { return row * 128 + ((chunk ^ ((row >> 1) & 7)) << 4); }
__device__ __forceinline__ int off_b(int row, int ch) { return 256 * row + 16 * (ch ^ (((row & 3) << 2) | ((row >> 2) & 3))); }
__device__ __forceinline__ int rowrd16(int lane, int rb, int ks) { return off_b((lane & 15) + 16 * rb, 4 * ks + (lane >> 4)); }
__device__ __forceinline__ int trrd16(int lane, int c, int ks, int t) { const int g = lane >> 4, q = (lane & 15) >> 2, p = lane & 3;
    return off_b(32 * ks + 8 * g + 4 * t + q, 2 * c + (p >> 1)) + 8 * (p & 1); }
typedef short s16x4 __attribute__((ext_vector_type(4)));
__device__ __forceinline__ bf16x8 tr_frag(LAS unsigned char* img, int lane, int c, int ks, unsigned zv) {
    const s16x4 lo = __builtin_amdgcn_ds_read_tr16_b64_v4i16((LAS s16x4*)(img + trrd16(lane, c, ks, 0)));
    const s16x4 hi = __builtin_amdgcn_ds_read_tr16_b64_v4i16((LAS s16x4*)(img + trrd16(lane, c, ks, 1)));
    u32x2 a = __builtin_bit_cast(u32x2, lo), b = __builtin_bit_cast(u32x2, hi);
    a.x ^= zv; a.y ^= zv; b.x ^= zv; b.y ^= zv;
    const u32x4 r = (u32x4){a.x, a.y, b.x, b.y};
    return __builtin_bit_cast(bf16x8, r);
}
__device__ __forceinline__ void scan_mfma(Frame& F, int l) {
    if (F.bid >= 64) return;
    const int b = F.bid >> 3, h = (F.bid >> 1) & 3, dir = F.bid & 1;
    LAS unsigned char* L = F.lds;
    constexpr int O_QI = 0, O_KI = 16384, O_VI = 32768, O_ST = 49152, O_CL = 57344, O_HO = 94208, O_SM = 110592;
    LAS float* GV = (LAS float*)(L + O_SM);
    LAS float* SC = GV + 36 * 192;
    LAS float* DEN = SC + 36 * 4;
    const bf16_t* Q = WSP(bf16_t, WS_Q); const bf16_t* K = WSP(bf16_t, WS_K); const bf16_t* V = WSP(bf16_t, WS_V); const float* GATES = WSP(float, WS_GATES);
    bf16_t* H = dir ? WSP(bf16_t, WS_HB) : WSP(bf16_t, WS_HF);
    const int w = F.wave;
    { unsigned z0 = 0u; asm volatile("" : "+v"(z0));
      for (int i = F.tid; i < 36864 / 16; i += NTHR) *(LAS u32x4*)(L + O_CL + i * 16) = (u32x4){z0, z0, z0, z0}; }
    for (int cc = w; cc < 36; cc += NWAVES) {
        const bool ic = cc < 4; const int c_ = ic ? (dir ? 3 - cc : cc) : (dir ? 35 - cc : cc - 4), p_ = dir ? 63 - F.lane : F.lane;
        const f32x2 g = *(const f32x2*)(GATES + (size_t)scan_tok(ic, b, h, c_, p_) * 16 + h * 4 + 2 * dir);
        float x = logsigmoidf_(g[1]);
#pragma unroll
        for (int o = 1; o < 64; o <<= 1) { const float y = __shfl_up(x, o); if (F.lane >= o) x += y; }
        const float a = g[0] - x; float cm = a;
#pragma unroll
        for (int o = 1; o < 64; o <<= 1) { const float y = __shfl_up(cm, o); if (F.lane >= o) cm = fmaxf(cm, y); }
        GV[cc * 192 + p_] = a; GV[cc * 192 + 64 + p_] = x; GV[cc * 192 + 128 + p_] = cm;
        if (F.lane == 63) { SC[cc * 4 + 3] = x; SC[cc * 4 + 1] = cm; }
    }
    __syncthreads();
    if (F.tid == 0) { float m = 0.f;
        for (int cc = 0; cc < 36; ++cc) { const float Mend = fmaxf(m, SC[cc * 4 + 1]); SC[cc * 4 + 0] = m; SC[cc * 4 + 1] = Mend; SC[cc * 4 + 2] = expf(m - Mend); m = SC[cc * 4 + 3] + Mend; } }
    f32x4 accC[9];
#pragma unroll
    for (int i = 0; i < 9; ++i) accC[i] = (f32x4){0.f, 0.f, 0.f, 0.f};
    u32x4 pq[2], pk[2], pv[2];
#define SC_LOAD(CC) do { const int cc_ = (CC); const bool ic_ = cc_ < 4; const int c_ = ic_ ? (dir ? 3 - cc_ : cc_) : (dir ? 35 - cc_ : cc_ - 4); \
        _Pragma("unroll") for (int i_ = 0; i_ < 2; ++i_) { const int it_ = tid + NTHR * i_, s_ = it_ >> 4, c8_ = it_ & 15; const size_t o_ = (size_t)scan_tok(ic_, b, h, c_, s_) * 512 + h * 128 + c8_ * 8; \
            pq[i_] = *(const u32x4*)(Q + o_); pk[i_] = *(const u32x4*)(K + o_); pv[i_] = *(const u32x4*)(V + o_); } } while (0)
#define SC_WRITE() do { _Pragma("unroll") for (int i_ = 0; i_ < 2; ++i_) { const int it_ = tid + NTHR * i_, s_ = it_ >> 4, c8_ = it_ & 15; \
            *(LAS u32x4*)(L + O_QI + img256(s_, c8_)) = pq[i_]; *(LAS u32x4*)(L + O_KI + off_b(s_, c8_)) = pk[i_]; *(LAS u32x4*)(L + O_VI + off_b(s_, c8_)) = pv[i_]; } } while (0)
#define SC_MFMA(A, B, C) __builtin_amdgcn_mfma_f32_16x16x32_bf16((A), (B), (C), 0, 0, 0)
#define SC_BAR() do { asm volatile("s_waitcnt lgkmcnt(0)" ::: "memory"); __builtin_amdgcn_s_barrier(); asm volatile("" ::: "memory"); } while (0)
    {
        const int tid = F.tid;
        SC_LOAD(0);
        __syncthreads();
        SC_WRITE();
        __syncthreads();
    }
    for (int cc = 0; cc < 36; ++cc) {
        int tid = F.tid; asm volatile("" : "+v"(tid));
        const int lane = tid & 63, fr = lane & 15, fq = lane >> 4;
        const bool isctx = cc < 4, want_out = !(isctx && l == 1), more = cc + 1 < 36;
        const int c = isctx ? (dir ? 3 - cc : cc) : (dir ? 35 - cc : cc - 4);
        const LAS float* vb = GV + cc * 192; const float m_in = SC[cc * 4 + 0];
        unsigned zv = 0u; asm volatile("" : "+v"(zv));
        const short one_ = (fr == 0) ? (short)0x3F80 : (short)0;
        const bf16x8 ONES = (bf16x8){one_, one_, one_, one_, one_, one_, one_, one_};
        if (more) SC_LOAD(cc + 1);
        if (want_out) {
            const int tb = w >> 1, sb = 2 * (w & 1);
            f32x4 s0 = (f32x4){0.f, 0.f, 0.f, 0.f}, s1 = s0;
#pragma unroll
            for (int ks = 0; ks < 4; ++ks) {
                const bf16x8 fy = *(const LAS bf16x8*)(L + O_QI + img256(tb * 16 + fr, ks * 4 + fq));
                const bf16x8 fx0 = *(const LAS bf16x8*)(L + O_KI + rowrd16(lane, sb, ks)), fx1 = *(const LAS bf16x8*)(L + O_KI + rowrd16(lane, sb + 1, ks));
                s0 = SC_MFMA(fx0, fy, s0); s1 = SC_MFMA(fx1, fy, s1); }
            const int t = tb * 16 + fr; const float Mt = fmaxf(m_in, vb[128 + t]);
#pragma unroll
            for (int i = 0; i < 2; ++i) { const int sr0 = (sb + i) * 16 + 4 * fq; const f32x4 a4 = *(const LAS f32x4*)(vb + sr0); const f32x4 sv = i ? s1 : s0; f32x4 o;
#pragma unroll
                for (int r = 0; r < 4; ++r) { const int sI = sr0 + r; const bool valid = dir ? (sI >= t) : (sI <= t); o[r] = valid ? sv[r] * __expf(a4[r] - Mt) : 0.f; }
                *(LAS u32x2*)(L + O_ST + img128(t, sr0 >> 3) + (sr0 & 7) * 2) = pk4(o); }
        }
        SC_BAR();
        {
            const float decay = SC[cc * 4 + 2], Mend = SC[cc * 4 + 1];
#pragma unroll
            for (int et = 0; et < 9; ++et) accC[et] = accC[et] * decay;
#pragma unroll
            for (int ks = 0; ks < 2; ++ks) {
                const bf16x8 kx = tr_frag(L + O_KI, lane, w, ks, zv);
                const f32x4 a0 = *(const LAS f32x4*)(vb + 32 * ks + 8 * fq), a1 = *(const LAS f32x4*)(vb + 32 * ks + 8 * fq + 4);
                u32x4 ax;
#pragma unroll
                for (int j = 0; j < 4; ++j) { const float w0 = __expf((j < 2 ? a0[2 * j] : a1[2 * j - 4]) - Mend), w1 = __expf((j < 2 ? a0[2 * j + 1] : a1[2 * j - 3]) - Mend);
                    ax[j] = pk2(bf2f((unsigned short)kx[2 * j]) * w0, bf2f((unsigned short)kx[2 * j + 1]) * w1); }
                const bf16x8 axf = __builtin_bit_cast(bf16x8, ax);
#pragma unroll
                for (int et = 0; et < 8; ++et) { const bf16x8 fv = tr_frag(L + O_VI, lane, et, ks, zv); accC[et] = SC_MFMA(axf, fv, accC[et]); }
                accC[8] = SC_MFMA(axf, ONES, accC[8]);
            }
        }
        f32x4 num[4];
        if (want_out) {
            bf16x8 ac[4], av[2];
#pragma unroll
            for (int ks = 0; ks < 4; ++ks) ac[ks] = *(const LAS bf16x8*)(L + O_CL + img256(w * 16 + fr, ks * 4 + fq));
#pragma unroll
            for (int ks = 0; ks < 2; ++ks) av[ks] = tr_frag(L + O_VI, lane, w, ks, zv);
#pragma unroll
            for (int tb = 0; tb < 4; ++tb) {
                f32x4 nI = (f32x4){0.f, 0.f, 0.f, 0.f}, nS = nI;
#pragma unroll
                for (int ks = 0; ks < 4; ++ks) { const bf16x8 fy = *(const LAS bf16x8*)(L + O_QI + img256(tb * 16 + fr, ks * 4 + fq)); nI = SC_MFMA(ac[ks], fy, nI); }
#pragma unroll
                for (int ks = 0; ks < 2; ++ks) { const bf16x8 fs = *(const LAS bf16x8*)(L + O_ST + img128(tb * 16 + fr, ks * 4 + fq)); nS = SC_MFMA(av[ks], fs, nS); }
                num[tb] = nI * __expf(m_in - fmaxf(m_in, vb[128 + tb * 16 + fr])) + nS;
            }
            if (w < 4) {
                f32x4 dI = (f32x4){0.f, 0.f, 0.f, 0.f}, dS = dI;
#pragma unroll
                for (int ks = 0; ks < 4; ++ks) { const bf16x8 a8 = *(const LAS bf16x8*)(L + O_CL + img256(128 + fr, ks * 4 + fq)); const bf16x8 fy = *(const LAS bf16x8*)(L + O_QI + img256(w * 16 + fr, ks * 4 + fq)); dI = SC_MFMA(a8, fy, dI); }
#pragma unroll
                for (int ks = 0; ks < 2; ++ks) { const bf16x8 fs = *(const LAS bf16x8*)(L + O_ST + img128(w * 16 + fr, ks * 4 + fq)); dS = SC_MFMA(ONES, fs, dS); }
                const int t = w * 16 + fr; const float Mt = fmaxf(m_in, vb[128 + t]); const float den = __expf(m_in - Mt) * dI[0] + dS[0];
                if (lane < 16) DEN[t] = fmaxf(fabsf(den), __expf(-(vb[64 + t] + Mt)));
            }
        }
        SC_BAR();
        if (want_out) {
#pragma unroll
            for (int tb = 0; tb < 4; ++tb) { const int t = tb * 16 + fr, e0 = w * 16 + 4 * fq; const float rd = 1.0f / DEN[t];
                *(LAS u32x2*)(L + O_HO + img256(t, e0 >> 3) + (e0 & 7) * 2) = pk4(num[tb] * rd); }
        }
#pragma unroll
        for (int et = 0; et < 9; ++et) { const int d0 = w * 16 + 4 * fq; *(LAS u32x2*)(L + O_CL + img256(et * 16 + fr, d0 >> 3) + (d0 & 7) * 2) = pk4(accC[et]); }
        if (more) SC_WRITE();
        SC_BAR();
        if (want_out) {
            const int t = tid >> 3; bf16_t* hp = H + (size_t)scan_tok(isctx, b, h, c, t) * 512 + h * 128;
#pragma unroll
            for (int i = 0; i < 2; ++i) { const int ch = (tid & 7) * 2 + i; *(u32x4*)(hp + ch * 8) = *(const LAS u32x4*)(L + O_HO + img256(t, ch)); }
        }
    }
#undef SC_LOAD
#undef SC_WRITE
#undef SC_MFMA
#undef SC_BAR
}

__device__ __forceinline__ void helper_barrier(Frame& F, unsigned* cnt, unsigned nhelpers) {
    asm volatile("s_waitcnt vmcnt(0)" ::: "memory");
    __syncthreads();
    if (F.tid == 0) {
        __builtin_amdgcn_fence(__ATOMIC_RELEASE, "agent");
        asm volatile("s_waitcnt vmcnt(0)" ::: "memory");
        __hip_atomic_fetch_add(cnt, 1u, __ATOMIC_RELAXED, __HIP_MEMORY_SCOPE_AGENT);
        unsigned sp = 0;
        while (__hip_atomic_load(cnt, __ATOMIC_RELAXED, __HIP_MEMORY_SCOPE_AGENT) < nhelpers) { __builtin_amdgcn_s_sleep(2); if (++sp > (1u << 22)) break; }
        __builtin_amdgcn_fence(__ATOMIC_ACQUIRE, "agent");
        asm volatile("s_waitcnt vmcnt(0)" ::: "memory");
    }
    __syncthreads();
}

constexpr int NPHASES = 20;
enum { K_PREP = 0, K_NORM1, K_INPROJ, K_MIX1, K_MIX2, K_OUTPROJ, K_NORM2, K_TOPK, K_MOE1, K_MOE2, K_COMBINE };

__global__ void __launch_bounds__(NTHR, 2) fwd_kernel(Args args) {
    extern __shared__ __attribute__((aligned(16))) unsigned char lds_raw[];
    Frame F{(LAS unsigned char*)lds_raw, (int)threadIdx.x, (int)(threadIdx.x & 63), __builtin_amdgcn_readfirstlane((int)(threadIdx.x >> 6)), (int)gridDim.x, (int)blockIdx.x, (GAS unsigned char*)args.ws, args};
    volatile LAS unsigned* MISC = (volatile LAS unsigned*)(F.lds + LDSCTL_OFF);
    if (F.tid < 16) MISC[F.tid] = 0u;
    __syncthreads();
    XcdBarrier bar; bar.bar = (unsigned*)(F.ws + WS_CTL); bar.x = 0; bar.st = MISC;
    const int lo = args.ph_lo, hi = args.ph_hi;
    if (hi - lo > 1) bar = xcd_barrier_post((unsigned*)(F.ws + WS_CTL), MISC);
    for (int ph = lo; ph < hi; ++ph) {
        int l, kind;
        if (ph == 0) { l = 0; kind = K_PREP; } else if (ph == 1) { l = 0; kind = K_NORM1; } else if (ph < 11) { l = 0; kind = K_INPROJ + (ph - 2); } else { l = 1; kind = K_INPROJ + (ph - 11); }
#ifndef PHMASK
#define PHMASK 0xFFFF
#endif
#define PHON(k) ((PHMASK >> (k)) & 1)
#ifndef REPMASK
#define REPMASK 0
#endif
        int nrep_ = 1 + ((REPMASK >> kind) & 1); asm volatile("" : "+s"(nrep_));
        for (int rep_ = 0; rep_ < nrep_; ++rep_) {
        if (rep_) xcd_barrier(bar);
        { int t_ = threadIdx.x, b_ = blockIdx.x; GAS unsigned char* w_ = (GAS unsigned char*)args.ws; asm volatile("" : "+v"(t_)); asm volatile("" : "+s"(b_)); asm volatile("" : "+s"(w_));
          F.tid = t_; F.lane = t_ & 63; F.wave = __builtin_amdgcn_readfirstlane(t_ >> 6); F.bid = b_; F.ws = w_; }
        l = __builtin_amdgcn_readfirstlane(l); kind = __builtin_amdgcn_readfirstlane(kind); asm volatile("" : "+s"(l)); asm volatile("" : "+s"(kind));
        GAS unsigned char* ws = F.ws;
        bool run_gemm = (kind == K_INPROJ || kind == K_OUTPROJ || kind == K_MOE1 || kind == K_MOE2);
        int gm = kind == K_INPROJ ? GM_INPROJ : kind == K_OUTPROJ ? GM_OUT : kind == K_MOE1 ? GM_MOE1 : GM_MOE2, gc = F.bid, gG = F.G;
        const bool helper = (kind == K_MIX1) && (F.bid >= 64);
        switch (kind) {
        case K_PREP: if (PHON(0)) phase_prep(F); break;
        case K_NORM1: if (PHON(1)) phase_norm1_l0(F); break;
        case K_MIX1: if (PHON(3)) {
            if (!helper) scan_mfma(F, l);
            else { const int hb = F.bid - 64, hg = F.G - 64;
                conv_items(F, l, hb, hg);
                ztrans_items(F, l, hb * NWAVES + F.wave, hg * NWAVES);
                helper_barrier(F, (unsigned*)(ws + WS_CTL) + 8192 + 64 * l + 64 * 2 * rep_, (unsigned)hg);
                run_gemm = true; gm = GM_DFT; gc = hb; gG = hg; }
        } break;
        case K_MIX2: if (PHON(4)) finalize_h(F, l); break;
        case K_NORM2: if (PHON(6)) phase_norm2(F, l); break;
        case K_TOPK: if (PHON(7)) phase_topk(F, l); break;
        case K_COMBINE: if (PHON(10)) phase_combine(F, l); break;
        default: break;
        }
        if (run_gemm && PHON(2)) {
            GemmCtl S{gm, l, gG, gc, ws, F.A};
            const int ld = gm == GM_OUT ? KOUT : D;
            GEMM_PHASE(F.lds, ld, ld, S, S);
        }
        if (helper && PHON(3)) convert_moe_weights(F, l, (F.bid - 64) * NWAVES + F.wave, (F.G - 64) * NWAVES);
        }
        if (ph + 1 < hi) xcd_barrier(bar);
    }
}

extern "C" void kernel_launch(void* const* d_in, const int* in_sizes, int n_in, void* d_out, int out_size, void* d_ws, size_t ws_size, hipStream_t stream) {
    static int grid = 0;
    if (grid == 0) {
        if (n_in != 21 || out_size != NLAT * D || ws_size < WS_END) { fprintf(stderr, "kernel_launch: unexpected shapes (n_in %d out %d ws %zu need %zu)\n", n_in, out_size, ws_size, (size_t)WS_END); grid = -1; return; }
        int dev = 0, cus = 0, per_cu = 0;
        hipGetDevice(&dev); hipDeviceGetAttribute(&cus, hipDeviceAttributeMultiprocessorCount, dev);
        if (hipFuncSetAttribute((const void*)fwd_kernel, hipFuncAttributeMaxDynamicSharedMemorySize, LDS_BYTES) != hipSuccess) { fprintf(stderr, "kernel_launch: hipFuncSetAttribute failed\n"); grid = -1; return; }
        hipOccupancyMaxActiveBlocksPerMultiprocessor(&per_cu, (const void*)fwd_kernel, NTHR, LDS_BYTES);
        (void)hipGetLastError();
        if (per_cu < 1) fprintf(stderr, "kernel_launch: occupancy query reports %d\n", per_cu);
        grid = cus;
    }
    if (grid < 0) return;
    hipMemsetAsync((char*)d_ws + WS_CTL, 0, 65536, stream);
    Args a{};
    for (int i = 0; i < 21; ++i) a.in[i] = (const float*)d_in[i];
    a.out = (float*)d_out; a.ws = (unsigned char*)d_ws;
#if N_LAUNCHES == 1
    a.ph_lo = 0; a.ph_hi = NPHASES;
    void* kargs[] = {&a};
    hipError_t e = hipLaunchCooperativeKernel((const void*)fwd_kernel, dim3(grid), dim3(NTHR), kargs, LDS_BYTES, stream);
    if (e != hipSuccess) fprintf(stderr, "kernel_launch: cooperative launch failed: %s (grid %d)\n", hipGetErrorString(e), grid);
#else
#ifndef MAXPH
#define MAXPH NPHASES
#endif
    for (int ph = 0; ph < MAXPH; ++ph) { a.ph_lo = ph; a.ph_hi = ph + 1; hipLaunchKernelGGL(fwd_kernel, dim3(grid), dim3(NTHR), LDS_BYTES, stream, a); }
#endif
}
```

```cpp
#include <hip/hip_runtime.h>
#include <cstdio>
#include <cstdint>

#ifndef N_LAUNCHES
#define N_LAUNCHES 1
#endif
#ifndef USE_MFMA_GEMM
#define USE_MFMA_GEMM 1
#endif

#define LAS __attribute__((address_space(3)))
#define GAS __attribute__((address_space(1)))
typedef unsigned short bf16_t;
typedef short bf16x8 __attribute__((ext_vector_type(8)));
typedef float f32x4 __attribute__((ext_vector_type(4)));
typedef float f32x2 __attribute__((ext_vector_type(2)));
typedef unsigned u32x4 __attribute__((ext_vector_type(4)));
typedef unsigned u32x2 __attribute__((ext_vector_type(2)));
typedef GAS unsigned gu32;
#define RLX_AGENT __ATOMIC_RELAXED, __HIP_MEMORY_SCOPE_AGENT
#define LDS_WAIT() asm volatile("s_waitcnt lgkmcnt(0)" ::: "memory")
#define VM_WAIT() asm volatile("s_waitcnt vmcnt(0)" ::: "memory")

constexpr int D = 1024, NB = 8, SEQ = 2048, CTXL = 256;
constexpr int NLAT = NB * SEQ, NCTX = NB * CTXL, NTOK = NLAT + NCTX;
constexpr int INC = 2832, NIN = 2816;
constexpr int KOUT = 1280;
constexpr int NE = 16, RPE = 2304;
constexpr float EPS = 1e-6f;
constexpr int NTHR = 512, NWAVES = 8;

constexpr size_t al256(size_t x) { return (x + 255) & ~(size_t)255; }
constexpr size_t WS_CTL = 0;
constexpr size_t WS_MOD = WS_CTL + 65536;
constexpr size_t WS_WIN = WS_MOD + al256((size_t)2 * 9 * 6144 * 4);
constexpr size_t WS_WOUT = WS_WIN + (size_t)2 * NIN * D * 2;
constexpr size_t WS_WGU = WS_WOUT + (size_t)2 * D * KOUT * 2;
constexpr size_t WS_WD = WS_WGU + (size_t)NE * 2048 * D * 2;
constexpr size_t WS_FL = WS_WD + (size_t)NE * D * D * 2;
constexpr size_t WS_FC = WS_FL + (size_t)4096 * 1024 * 2;
constexpr size_t WS_X = WS_FL + (size_t)4096 * 2048 * 2 + (size_t)512 * 2048 * 2;
constexpr size_t WS_XN = WS_X + (size_t)NTOK * D * 4;
constexpr size_t WS_GATES = WS_XN + (size_t)NTOK * D * 2;
constexpr size_t WS_AFF = WS_GATES + (size_t)NTOK * 16 * 4;
constexpr size_t WS_INV = WS_AFF + (size_t)NTOK * 16 * 4;
constexpr size_t WS_ROWTOK = WS_INV + (size_t)NTOK * 16 * 4;
constexpr size_t WS_GATEV = WS_ROWTOK + (size_t)NE * RPE * 4;
constexpr size_t WS_R1 = WS_GATEV + (size_t)NE * RPE * 4;
constexpr size_t SZ_QKV = (size_t)NTOK * 512 * 2;
constexpr size_t WS_Q = WS_R1, WS_K = WS_Q + SZ_QKV, WS_V = WS_K + SZ_QKV, WS_O = WS_V + SZ_QKV;
constexpr size_t WS_HID = WS_R1;
constexpr size_t WS_R2 = WS_R1 + 4 * SZ_QKV;
constexpr size_t SZ_C = (size_t)NTOK * 256 * 2;
constexpr size_t WS_CA = WS_R2, WS_CG = WS_CA + SZ_C, WS_FR = WS_CG + SZ_C, WS_ZT = WS_FR + SZ_C;
constexpr size_t WS_ZO = WS_ZT + (size_t)2048 * 1024 * 2;
constexpr size_t WS_ZTC = WS_ZT + (size_t)2048 * 2048 * 2;
constexpr size_t WS_HF = WS_ZT + 2 * (size_t)2048 * 2048 * 2, WS_HB = WS_HF + SZ_QKV, WS_Y = WS_HB + SZ_QKV;
constexpr size_t WS_YS = WS_R2;
constexpr size_t WS_END = WS_Y + (size_t)NTOK * KOUT * 2;
static_assert((size_t)NE * RPE * D * 2 <= 4 * SZ_QKV, "HID alias");
static_assert(WS_YS + (size_t)NE * RPE * D * 2 <= WS_END, "YS alias");

constexpr int RING_BYTES = 139264;
constexpr int LDSCTL_OFF = RING_BYTES;
constexpr int LDS_BYTES = RING_BYTES + 1024;

#define GAS __attribute__((address_space(1)))
template <class T> __device__ __forceinline__ T* as_global(T* p) { return (T*)(GAS T*)(uintptr_t)p; }
__device__ __forceinline__ unsigned f2bf(float f) { unsigned u = __float_as_uint(f); u += 0x7FFFu + ((u >> 16) & 1u); return u >> 16; }
typedef __bf16 bf16x2_t __attribute__((ext_vector_type(2)));
__device__ __forceinline__ unsigned pk2(float lo, float hi) { const bf16x2_t r = __builtin_convertvector((f32x2){lo, hi}, bf16x2_t); return __builtin_bit_cast(unsigned, r); }
__device__ __forceinline__ float bf2f(unsigned b) { return __uint_as_float(b << 16); }
__device__ __forceinline__ float bflo(unsigned w) { return __uint_as_float(w << 16); }
__device__ __forceinline__ float bfhi(unsigned w) { return __uint_as_float(w & 0xffff0000u); }
__device__ __forceinline__ float sigmoidf_(float x) { return __builtin_amdgcn_rcpf(1.0f + __expf(-x)); }
__device__ __forceinline__ float siluf_(float x) { return x * __builtin_amdgcn_rcpf(1.0f + __expf(-x)); }
__device__ __forceinline__ float logsigmoidf_(float x) { return x >= 0.f ? -log1pf(expf(-x)) : x - log1pf(expf(x)); }
__device__ __forceinline__ float wave_sum(float v) {
#pragma unroll
    for (int o = 1; o < 64; o <<= 1) v += __shfl_xor(v, o);
    return v;
}
__device__ __forceinline__ u32x2 pk4(f32x4 v) { u32x2 w; w.x = pk2(v[0], v[1]); w.y = pk2(v[2], v[3]); return w; }

#define XB_TMO      128
#define XB_XCNT(j)  (256  + 64 * (j))
#define XB_XSUB(j)  (1280 + 64 * (j))
#define XB_XGEN(j)  (2304 + 64 * (j))
#define XB_TOP      3328
#define XB_TOPGEN   3392
#define XCD_BAR_WORDS 3456
#define XB_SPIN_CAP (1u << 22)
__device__ __forceinline__ unsigned xb_ld(unsigned* p)              { return __hip_atomic_load(p, __ATOMIC_RELAXED, __HIP_MEMORY_SCOPE_AGENT); }
__device__ __forceinline__ unsigned xb_add(unsigned* p, unsigned v) { return __hip_atomic_fetch_add(p, v, __ATOMIC_RELAXED, __HIP_MEMORY_SCOPE_AGENT); }
__device__ __forceinline__ unsigned xb_xcc_id() { return (unsigned)__builtin_amdgcn_s_getreg((3 << 11) | 20) & 0xFu; }
#define XB_SPIN(cond, bar) do { unsigned _sp = 0; while (cond) { __builtin_amdgcn_s_sleep(1); \
    if ((++_sp & 255u) == 0u) { if (xb_ld(&(bar)[XB_TMO])) break; if (_sp > XB_SPIN_CAP) { atomicAdd(&(bar)[XB_TMO], 1u); break; } } } } while (0)
struct XcdBarrier { unsigned* bar; unsigned x; volatile LAS unsigned* st; };
__device__ __forceinline__ XcdBarrier xcd_barrier_post(unsigned* bar, volatile LAS unsigned* st) {
    XcdBarrier b; b.bar = bar; b.x = xb_xcc_id(); b.st = st;
    if (threadIdx.x == 0) (void)xb_add(&bar[XB_XCNT(b.x)], 1u);
    return b;
}
__device__ __forceinline__ void xcd_barrier_complete(unsigned* bar, unsigned x, unsigned& nloc, unsigned& nx) {
    const unsigned G = gridDim.x * gridDim.y * gridDim.z;
    unsigned sum, cnt, mine, sp = 0u;
    for (;;) {
        sum = 0u; cnt = 0u; mine = 0u;
#pragma unroll
        for (unsigned j = 0; j < 16; ++j) { const unsigned c = xb_ld(&bar[XB_XCNT(j)]); sum += c; cnt += (c > 0u) ? 1u : 0u; mine = (j == x) ? c : mine; }
        if (sum == G) break;
        __builtin_amdgcn_s_sleep(1);
        if ((++sp & 255u) == 0u) { if (xb_ld(&bar[XB_TMO])) break; if (sp > XB_SPIN_CAP) { atomicAdd(&bar[XB_TMO], 1u); break; } }
    }
    nloc = mine > 0u ? mine : 1u; nx = cnt > 0u ? cnt : 1u;
}
__device__ __forceinline__ void xcd_barrier(const XcdBarrier& b) {
    asm volatile("s_waitcnt vmcnt(0)" ::: "memory");
    __syncthreads();
    if (threadIdx.x == 0) {
        unsigned* bar = b.bar;
        __builtin_amdgcn_s_waitcnt(0);
        unsigned nloc = b.st[0], nx = b.st[1];
        if (nloc == 0u) { xcd_barrier_complete(bar, b.x, nloc, nx); b.st[0] = nloc; b.st[1] = nx; }
        const unsigned old = xb_add(&bar[XB_XSUB(b.x)], 1u);
        const unsigned gen = old / nloc;
        if (old + 1u == (gen + 1u) * nloc) {
            __builtin_amdgcn_fence(__ATOMIC_RELEASE, "agent");
            asm volatile("s_waitcnt vmcnt(0)" ::: "memory");
            const unsigned og = xb_add(&bar[XB_TOP], 1u);
            const unsigned tg = og / nx;
            if (og + 1u == (tg + 1u) * nx) xb_add(&bar[XB_TOPGEN], 1u);
            else XB_SPIN(xb_ld(&bar[XB_TOPGEN]) == tg, bar);
            __builtin_amdgcn_fence(__ATOMIC_ACQUIRE, "agent");
            xb_add(&bar[XB_XGEN(b.x)], 1u);
            asm volatile("s_waitcnt vmcnt(0)" ::: "memory");
        } else {
            XB_SPIN(xb_ld(&bar[XB_XGEN(b.x)]) == gen, bar);
            __builtin_amdgcn_fence(__ATOMIC_ACQUIRE, "agent");
            asm volatile("s_waitcnt vmcnt(0)" ::: "memory");
        }
    }
    __syncthreads();
}

namespace pg8 {
constexpr int BM = 256, BK = 64, HALF = 128, HTB = HALF * BK * 2, STAGE_BYTES = 8 * HTB, NXCD = 8, WGM = 8;
__host__ __device__ __forceinline__ int lds_byte(int r, int c) { const int st = (r >> 4) * 2 + (c >> 5), rr = r & 15, cc = c & 31, ob = rr * 64 + cc * 2; return st * 1024 + (ob ^ (((ob >> 9) & 1) << 5)); }
__host__ __device__ __forceinline__ void stage_rc(int b, int& R, int& C) { const int st = b / 1024, sb = b % 1024, swz = sb ^ (((sb >> 9) & 1) << 5); R = (st >> 1) * 16 + swz / 64; C = (st & 1) * 32 + (swz % 64) / 2; }

struct Unit { const char* A; const char* B; const int* rows; int K, pm, pn, ex; };

__device__ __forceinline__ void map_tile(int L, int nM, int nN, int& pm, int& pn) {
    const int nwg = nM * nN; int wgid = L;
    { const int q = nwg / NXCD, r = nwg % NXCD, xcd = wgid % NXCD, off = wgid / NXCD; wgid = (xcd < r ? xcd * (q + 1) : r * (q + 1) + (xcd - r) * q) + off; }
    const int nig = WGM * nN, gid = wgid / nig, fm = gid * WGM, gsz = (nM - fm) < WGM ? (nM - fm) : WGM;
    pm = fm + ((wgid % nig) % gsz); pn = (wgid % nig) / gsz;
}
__device__ __forceinline__ void a_offs(const Unit& u, int lda, int tid, unsigned (&vA)[2][2]) {
#pragma unroll
    for (int h = 0; h < 2; ++h)
#pragma unroll
        for (int i = 0; i < 2; ++i) { int R, C; stage_rc(tid * 16 + i * 8192, R, C); const int r = h * HALF + R; const int ar = u.rows ? u.rows[r] : r; vA[h][i] = (unsigned)(ar * lda + C) * 2u; }
}

template <class Epi, class Sched>
__device__ __forceinline__ void gemm_phase(LAS unsigned char* lds, const int tid, const int lda, const int ldb, const Sched& S, const Epi& E) {
    const int wid = __builtin_amdgcn_readfirstlane(tid >> 6), lane = tid & 63, wr = wid >> 2, wc = wid & 3, fr = lane & 15, fq = lane >> 4;
    unsigned voffB[2];
#pragma unroll
    for (int i = 0; i < 2; ++i) { int R, C; stage_rc(tid * 16 + i * 8192, R, C); voffB[i] = (unsigned)(R * ldb + C) * 2u; }
    const size_t kstep = (size_t)(BK * 2);
    const size_t hsB = (size_t)HALF * ldb * 2;
    const unsigned ldsw = (unsigned)wid * 1024u;
    const int aoff = lds_byte(wr * 64 + fr, fq * 8), boff = lds_byte(wc * 32 + fr, fq * 8);
#define PG8_SA(b, h) (((b) * 2 + (h)) * HTB)
#define PG8_SB(b, h) ((4 + (b) * 2 + (h)) * HTB)
#define PG8_STAGE(bufoff, gbase, voff) do { _Pragma("unroll") for (int _i = 0; _i < 2; ++_i) \
        __builtin_amdgcn_global_load_lds((const unsigned*)((const char*)(gbase) + (voff)[_i]), (LAS unsigned*)(lds + (bufoff) + ldsw + _i * 8192), 16, 0, 0); } while (0)
#define PG8_LDA(dst, b, h) do { _Pragma("unroll") for (int m = 0; m < 4; ++m) _Pragma("unroll") for (int k = 0; k < 2; ++k) dst[m][k] = *(const LAS bf16x8*)(lds + PG8_SA(b, h) + aoff + m * 2048 + k * 1024); } while (0)
#define PG8_LDB(dst, b, h) do { _Pragma("unroll") for (int n = 0; n < 2; ++n) _Pragma("unroll") for (int k = 0; k < 2; ++k) dst[n][k] = *(const LAS bf16x8*)(lds + PG8_SB(b, h) + boff + n * 2048 + k * 1024); } while (0)
#define PG8_MMA(ai, bj, At, Bt) do { __builtin_amdgcn_s_setprio(1); _Pragma("unroll") for (int m = 0; m < 4; ++m) _Pragma("unroll") for (int n = 0; n < 2; ++n) _Pragma("unroll") for (int k = 0; k < 2; ++k) \
        acc[ai][bj][m][n] = __builtin_amdgcn_mfma_f32_16x16x32_bf16(Bt[n][k], At[m][k], acc[ai][bj][m][n], 0, 0, 0); __builtin_amdgcn_s_setprio(0); } while (0)
#define PG8_WAIT_V(n) asm volatile("s_waitcnt vmcnt(" #n ")" ::: "memory")
#define PG8_WAIT_L(n) asm volatile("s_waitcnt lgkmcnt(" #n ")" ::: "memory")
#define PG8_BAR __builtin_amdgcn_s_barrier()
#define PG8_SCHED __builtin_amdgcn_sched_barrier(0)
    Unit cur, nxt; int ui = 0;
    if (!S.next(0, cur)) return;
    f32x4 acc[2][2][4][2];
#pragma unroll
    for (int a = 0; a < 2; ++a)
#pragma unroll
        for (int b = 0; b < 2; ++b)
#pragma unroll
            for (int m = 0; m < 4; ++m)
#pragma unroll
                for (int n = 0; n < 2; ++n) acc[a][b][m][n] = (f32x4){0.f, 0.f, 0.f, 0.f};
    bf16x8 At[4][2], B0[2][2], B1[2][2];
    unsigned vA[2][2], wA[2][2];
    a_offs(cur, lda, tid, vA);
    const char* cA = cur.A; const char* cB = cur.B;
    PG8_STAGE(PG8_SB(0, 0), cB, voffB); PG8_STAGE(PG8_SB(0, 1), cB + hsB, voffB); PG8_STAGE(PG8_SA(0, 0), cA, vA[0]); PG8_STAGE(PG8_SA(0, 1), cA, vA[1]);
    if (wr == 1) PG8_BAR;
    PG8_WAIT_V(2); PG8_BAR;
    PG8_STAGE(PG8_SB(1, 0), cB + kstep, voffB); PG8_STAGE(PG8_SA(1, 0), cA + kstep, vA[0]); PG8_STAGE(PG8_SB(1, 1), cB + hsB + kstep, voffB);
    PG8_WAIT_V(6); PG8_BAR;
    for (;;) {
        const bool has_next = S.next(ui + 1, nxt);
        if (!has_next) nxt = cur;
        const char* nA = nxt.A; const char* nB = nxt.B;
        a_offs(nxt, lda, tid, wA);
        const int nt = cur.K / BK;
        asm volatile(".p2align 8" ::: "memory");
        for (int t = 0; t < nt; t += 2) {
            const bool last = (t == nt - 2);
            const char* a1 = cA + (size_t)(t + 1) * kstep;
            const char* a2 = last ? nA : cA + (size_t)(t + 2) * kstep; const char* b2 = last ? nB : cB + (size_t)(t + 2) * kstep;
            const char* a3 = a2 + kstep; const char* b3 = b2 + kstep;
            PG8_LDB(B0, 0, 0); PG8_LDB(B1, 0, 1); PG8_SCHED; PG8_LDA(At, 0, 0); PG8_STAGE(PG8_SA(1, 1), a1, vA[1]);
            if (last) {
#pragma unroll
                for (int h = 0; h < 2; ++h)
#pragma unroll
                    for (int i = 0; i < 2; ++i) vA[h][i] = wA[h][i];
            }
            PG8_WAIT_V(8); PG8_WAIT_L(0); PG8_BAR; PG8_MMA(0, 0, At, B0); PG8_MMA(0, 1, At, B1); PG8_BAR; PG8_SCHED;
            PG8_LDA(At, 0, 1); PG8_STAGE(PG8_SB(0, 0), b2, voffB); PG8_STAGE(PG8_SB(0, 1), b2 + hsB, voffB); PG8_STAGE(PG8_SA(0, 0), a2, vA[0]);
            PG8_WAIT_V(8); PG8_WAIT_L(0); PG8_BAR; PG8_MMA(1, 0, At, B0); PG8_MMA(1, 1, At, B1); PG8_BAR; PG8_SCHED;
            PG8_LDB(B0, 1, 0); PG8_LDB(B1, 1, 1); PG8_SCHED; PG8_LDA(At, 1, 0); PG8_STAGE(PG8_SA(0, 1), a2, vA[1]);
            PG8_WAIT_V(8); PG8_WAIT_L(0); PG8_BAR; PG8_MMA(0, 0, At, B0); PG8_MMA(0, 1, At, B1); PG8_BAR; PG8_SCHED;
            PG8_LDA(At, 1, 1); PG8_STAGE(PG8_SB(1, 0), b3, voffB); PG8_STAGE(PG8_SB(1, 1), b3 + hsB, voffB); PG8_STAGE(PG8_SA(1, 0), a3, vA[0]);
            PG8_WAIT_V(8); PG8_WAIT_L(0); PG8_BAR; PG8_MMA(1, 0, At, B0); PG8_MMA(1, 1, At, B1); PG8_BAR; PG8_SCHED;
        }
        if (wr == 0) PG8_BAR;
        { int fr_ = fr, fq_ = fq; asm volatile("" : "+v"(fr_), "+v"(fq_));
          E.run(acc, cur, wr, wc, fr_, fq_); }
        if (!has_next) break;
#pragma unroll
        for (int a = 0; a < 2; ++a)
#pragma unroll
            for (int b = 0; b < 2; ++b)
#pragma unroll
                for (int m = 0; m < 4; ++m)
#pragma unroll
                    for (int n = 0; n < 2; ++n) acc[a][b][m][n] = (f32x4){0.f, 0.f, 0.f, 0.f};
        cur = nxt; cA = nA; cB = nB; ++ui;
        if (wr == 1) PG8_BAR;
    }
    PG8_WAIT_V(0);
    PG8_BAR;
#undef PG8_SA
#undef PG8_SB
#undef PG8_STAGE
#undef PG8_LDA
#undef PG8_LDB
#undef PG8_MMA
#undef PG8_WAIT_V
#undef PG8_WAIT_L
#undef PG8_BAR
#undef PG8_SCHED
}
template <class Epi, class Sched>
__device__ __forceinline__ void gemm_phase_simt(LAS unsigned char* lds, const int tid, const int lda, const int ldb, const Sched& S, const Epi& E) {
    LAS float* As = (LAS float*)lds;
    LAS float* Bs = (LAS float*)(lds + 32 * 132 * 4);
    const int ty = tid >> 4, tx = tid & 15, c0 = (tx >> 2) * 32 + (tx & 3) * 4;
    const int lr = tid >> 2, lk = (tid & 3) * 8;
    Unit u;
    for (int ui = 0; S.next(ui, u); ++ui) {
        for (int sub = 0; sub < 4; ++sub) {
            const int sr = sub >> 1, sc = sub & 1;
            float acc[4][8];
#pragma unroll
            for (int i = 0; i < 4; ++i)
#pragma unroll
                for (int j = 0; j < 8; ++j) acc[i][j] = 0.f;
            const int arow = sr * 128 + lr, brow = sc * 128 + lr;
            const int ar = u.rows ? u.rows[arow] : arow;
            const bf16_t* ap = (const bf16_t*)u.A + (size_t)ar * lda + lk;
            const bf16_t* bp = (const bf16_t*)u.B + (size_t)brow * ldb + lk;
            for (int k0 = 0; k0 < u.K; k0 += 32) {
                const u32x4 av = *(const u32x4*)(ap + k0), bv = *(const u32x4*)(bp + k0);
                __syncthreads();
#pragma unroll
                for (int j = 0; j < 4; ++j) {
                    As[(lk + 2 * j) * 132 + lr] = bflo(av[j]); As[(lk + 2 * j + 1) * 132 + lr] = bfhi(av[j]);
                    Bs[(lk + 2 * j) * 132 + lr] = bflo(bv[j]); Bs[(lk + 2 * j + 1) * 132 + lr] = bfhi(bv[j]);
                }
                __syncthreads();
#pragma unroll 4
                for (int k = 0; k < 32; ++k) {
                    const f32x4 a4 = *(const LAS f32x4*)(As + k * 132 + ty * 4);
                    const f32x4 b0 = *(const LAS f32x4*)(Bs + k * 132 + c0), b1 = *(const LAS f32x4*)(Bs + k * 132 + c0 + 16);
#pragma unroll
                    for (int i = 0; i < 4; ++i)
#pragma unroll
                        for (int j = 0; j < 4; ++j) { acc[i][j] += a4[i] * b0[j]; acc[i][4 + j] += a4[i] * b1[j]; }
                }
            }
#pragma unroll
            for (int i = 0; i < 4; ++i)
                E.store1(u, sr * 128 + ty * 4 + i, sc * 128 + c0, (f32x4){acc[i][0], acc[i][1], acc[i][2], acc[i][3]}, (f32x4){acc[i][4], acc[i][5], acc[i][6], acc[i][7]});
        }
    }
    __syncthreads();
}
}

#if USE_MFMA_GEMM
#define GEMM_PHASE(lds, lda, ldb, S, E) pg8::gemm_phase(lds, F.tid, lda, ldb, S, E)
#else
#define GEMM_PHASE(lds, lda, ldb, S, E) pg8::gemm_phase_simt(lds, F.tid, lda, ldb, S, E)
#endif

struct Args { const float* in[21]; float* out; unsigned char* ws; int ph_lo, ph_hi; };
enum { I_X = 0, I_C, I_CTX, I_CCTX, I_WADA, I_BADA, I_GN1, I_WIN, I_BG, I_GH, I_CW, I_CB, I_CLG, I_CLB, I_WOUT, I_GN2, I_WR, I_WEG, I_WEU, I_WED, I_GF };
__device__ __forceinline__ const float* arg_in(const Args& a, int i) { asm volatile("" : "+s"(i)); return a.in[i]; }
struct Frame {
    LAS unsigned char* lds;
    int tid, lane, wave, G, bid;
    GAS unsigned char* ws;
    const Args& A;
};
#define FIN(i) arg_in(F.A, (i))
#define WSP(T, off) ((T*)(F.ws + (off)))

template <class Src>
__device__ __forceinline__ void tr_item(const Src& src, bf16_t* dst, int ldd, int n0, int k0, LAS float* scr, int lane) {
    f32x4 v[8];
#pragma unroll
    for (int i = 0; i < 8; ++i) v[i] = src.ld4(k0 + i * 8 + (lane >> 3), n0 + (lane & 7) * 4);
#pragma unroll
    for (int i = 0; i < 8; ++i) { LAS float* p = scr + (i * 8 + (lane >> 3)) * 33 + (lane & 7) * 4; p[0] = v[i][0]; p[1] = v[i][1]; p[2] = v[i][2]; p[3] = v[i][3]; }
    LDS_WAIT(); asm volatile("" ::: "memory");
    const int c = lane & 7;
#pragma unroll
    for (int j = 0; j < 4; ++j) { const int n = (lane >> 3) + 8 * j; const LAS float* s = scr + (8 * c) * 33 + n;
        u32x4 o; o.x = pk2(s[0 * 33], s[1 * 33]); o.y = pk2(s[2 * 33], s[3 * 33]); o.z = pk2(s[4 * 33], s[5 * 33]); o.w = pk2(s[6 * 33], s[7 * 33]);
        *(u32x4*)(dst + (size_t)(n0 + n) * ldd + k0 + 8 * c) = o; }
    LDS_WAIT(); asm volatile("" ::: "memory");
}
struct SrcWin { const float* w; __device__ __forceinline__ f32x4 ld4(int k, int n) const { return *(const f32x4*)(w + (size_t)k * INC + (n < 1536 ? n : n + 16)); } };
struct SrcPlain { const float* w; int ld; __device__ __forceinline__ f32x4 ld4(int k, int n) const { return *(const f32x4*)(w + (size_t)k * ld + n); } };
struct SrcGU { const float* wg; const float* wu; __device__ __forceinline__ f32x4 ld4(int k, int n) const { const int grp = n >> 5, i = n & 31;
    const uintptr_t base = (uintptr_t)wg + ((i < 16) ? (uintptr_t)0 : ((uintptr_t)wu - (uintptr_t)wg));
    return *(const f32x4*)(as_global((const float*)base) + (size_t)k * D + grp * 16 + (i & 15)); } };

__device__ __forceinline__ void tr_store(const f32x4 (&v)[8], bf16_t* dst, int ldd, int n0, int k0, LAS float* scr, int lane) {
#pragma unroll
    for (int i = 0; i < 8; ++i) { LAS float* p = scr + (i * 8 + (lane >> 3)) * 33 + (lane & 7) * 4; p[0] = v[i][0]; p[1] = v[i][1]; p[2] = v[i][2]; p[3] = v[i][3]; }
    LDS_WAIT(); asm volatile("" ::: "memory");
    const int c = lane & 7;
#pragma unroll
    for (int j = 0; j < 4; ++j) { const int n = (lane >> 3) + 8 * j; const LAS float* s = scr + (8 * c) * 33 + n;
        u32x4 o; o.x = pk2(s[0 * 33], s[1 * 33]); o.y = pk2(s[2 * 33], s[3 * 33]); o.z = pk2(s[4 * 33], s[5 * 33]); o.w = pk2(s[6 * 33], s[7 * 33]);
        *(u32x4*)(dst + (size_t)(n0 + n) * ldd + k0 + 8 * c) = o; }
    LDS_WAIT(); asm volatile("" ::: "memory");
}
struct MoeItem { bf16_t* dst; int n0, k0; };
__device__ __forceinline__ MoeItem moe_item_load(Frame& F, int l, int it, const float* wg, const float* wu, const float* wd, f32x4 (&v)[8]) {
    constexpr int I_GU = NE * 64 * 16;
    MoeItem m; const int lane = F.lane;
    asm volatile("" : "+v"(it));
    const bool gu = it < I_GU; const int r0 = gu ? it : it - I_GU;
    const int e = gu ? (r0 >> 10) : (r0 >> 9), r = gu ? (r0 & 1023) : (r0 & 511), sup = r >> 3, wv = r & 7;
    const int nb = gu ? (sup & 15) * 4 + (wv & 3) : (sup & 7) * 4 + (wv & 3), kb = gu ? (sup >> 4) * 2 + (wv >> 2) : (sup >> 3) * 2 + (wv >> 2);
    m.n0 = nb * 32; m.k0 = kb * 64;
    m.dst = gu ? WSP(bf16_t, WS_WGU) + (size_t)e * 2048 * D : WSP(bf16_t, WS_WD) + (size_t)e * D * D;
    const int n = m.n0 + (lane & 7) * 4, grp = n >> 5, i = n & 31;
    const size_t eoff = ((size_t)l * NE + e) * D * D;
    const uintptr_t base = gu ? ((i < 16) ? (uintptr_t)wg : (uintptr_t)wu) : (uintptr_t)wd;
    const float* p0 = as_global((const float*)base) + eoff + (size_t)(m.k0 + (lane >> 3)) * D + (gu ? grp * 16 + (i & 15) : n);
#pragma unroll
    for (int q = 0; q < 8; ++q) v[q] = *(const f32x4*)(p0 + (size_t)q * 8 * D);
    return m;
}
__device__ __forceinline__ void convert_moe_weights(Frame& F, int l, int gw, int ngw) {
    LAS float* scr = (LAS float*)(F.lds + F.wave * 8448);
    const float* w_e_gate = FIN(I_WEG); const float* w_e_up = FIN(I_WEU); const float* w_e_down = FIN(I_WED);
    constexpr int NIT = NE * 64 * 16 + NE * 32 * 16;
    if (gw >= NIT) return;
    f32x4 va[8], vb[8];
    MoeItem ma = moe_item_load(F, l, gw, w_e_gate, w_e_up, w_e_down, va), mb = ma;
    for (int it = gw; it < NIT; it += 2 * ngw) {
        const int i1 = it + ngw, i2 = it + 2 * ngw;
        mb = moe_item_load(F, l, min(i1, NIT - 1), w_e_gate, w_e_up, w_e_down, vb);
        __builtin_amdgcn_sched_barrier(0);
        tr_store(va, ma.dst, D, ma.n0, ma.k0, scr, F.lane);
        ma = moe_item_load(F, l, min(i2, NIT - 1), w_e_gate, w_e_up, w_e_down, va);
        __builtin_amdgcn_sched_barrier(0);
        tr_store(vb, mb.dst, D, mb.n0, mb.k0, scr, F.lane);
    }
}

__device__ __forceinline__ void phase_prep(Frame& F) {
    const int tid = F.tid;
    {
        LAS float* s = (LAS float*)F.lds;
        LAS float* red = (LAS float*)(F.lds + 9 * 1024 * 4);
        float* MOD = WSP(float, WS_MOD);
        const float* c_in = FIN(I_C); const float* c_ctx = FIN(I_CCTX); const float* w_ada = FIN(I_WADA); const float* b_ada = FIN(I_BADA);
        bool staged = false;
        for (int it = F.bid; it < 192; it += F.G) {
            if (!staged) { for (int i = tid; i < 9 * 1024; i += NTHR) { const int r = i >> 10, k = i & 1023; const float cv = (r < 8) ? c_in[r * 1024 + k] : c_ctx[k]; s[i] = siluf_(cv); } staged = true; }
            __syncthreads();
            const int l = it / 96, cgp = it % 96, col = cgp * 64 + (tid & 63), kq = tid >> 6;
            float acc[9];
#pragma unroll
            for (int r = 0; r < 9; ++r) acc[r] = 0.f;
            const float* w = w_ada + ((size_t)l * 1024 + kq * 128) * 6144 + col;
            for (int k0 = 0; k0 < 128; k0 += 32) {
                float wv[32];
#pragma unroll
                for (int k = 0; k < 32; ++k) wv[k] = w[(size_t)(k0 + k) * 6144];
#pragma unroll
                for (int k = 0; k < 32; ++k)
#pragma unroll
                    for (int r = 0; r < 9; ++r) acc[r] += s[r * 1024 + kq * 128 + k0 + k] * wv[k];
            }
#pragma unroll
            for (int r = 0; r < 9; ++r) red[(kq * 9 + r) * 64 + (tid & 63)] = acc[r];
            __syncthreads();
            for (int o = tid; o < 576; o += NTHR) { const int r = o >> 6, cc = o & 63; float sum = 0.f;
#pragma unroll
                for (int q = 0; q < 8; ++q) sum += red[(q * 9 + r) * 64 + cc];
                MOD[((size_t)l * 9 + r) * 6144 + cgp * 64 + cc] = sum + b_ada[l * 6144 + cgp * 64 + cc]; }
            __syncthreads();
        }
        __syncthreads();
    }
    {
        bf16_t* FL = WSP(bf16_t, WS_FL); bf16_t* FC = WSP(bf16_t, WS_FC);
        const size_t gth = (size_t)F.bid * NTHR + tid, nth = (size_t)F.G * NTHR;
        for (size_t it = gth; it < (size_t)4096 * 1024 / 8; it += nth) {
            const int r = (int)(it / 128), t0 = (int)(it % 128) * 8, part = r >> 11, k = r & 2047; unsigned w[4];
#pragma unroll
            for (int j = 0; j < 4; ++j) { float v[2];
#pragma unroll
                for (int q = 0; q < 2; ++q) { const int ph = (k * (t0 + 2 * j + q)) & 2047; const float ang = (float)ph * (6.283185307179586f / 2048.f); v[q] = (part ? sinf(ang) : cosf(ang)) * 0.022097086912079608f; }
                w[j] = pk2(v[0], v[1]); }
            *(u32x4*)(FL + (size_t)r * 1024 + t0) = (u32x4){w[0], w[1], w[2], w[3]};
        }
        for (size_t it = gth; it < (size_t)512 * 256 / 8; it += nth) {
            const int r = (int)(it / 32), t0 = (int)(it % 32) * 8, part = r >> 8, k = r & 255; unsigned w[4];
#pragma unroll
            for (int j = 0; j < 4; ++j) { float v[2];
#pragma unroll
                for (int q = 0; q < 2; ++q) { const int ph = (k * (t0 + 2 * j + q)) & 255; const float ang = (float)ph * (6.283185307179586f / 256.f); v[q] = (part ? sinf(ang) : cosf(ang)) * 0.0625f; }
                w[j] = pk2(v[0], v[1]); }
            *(u32x4*)(FC + (size_t)r * 1024 + t0) = (u32x4){w[0], w[1], w[2], w[3]};
        }
    }
    const int gw = F.bid * NWAVES + F.wave, ngw = F.G * NWAVES;
    {
        LAS float* scr = (LAS float*)(F.lds + F.wave * 8448);
        bf16_t* WIN = WSP(bf16_t, WS_WIN); bf16_t* WOUT = WSP(bf16_t, WS_WOUT);
        const float* w_in = FIN(I_WIN); const float* w_out = FIN(I_WOUT);
        constexpr int I_IN = 2 * 88 * 16, I_OP = 2 * 32 * 12, I_PQ = 2 * 32 * 8;
        for (int it = gw; it < I_IN + I_OP + I_PQ; it += ngw) {
            if (it < I_IN) { const int l = it / 1408, r = it % 1408, nb = r / 16, kb = r % 16;
                SrcWin s{w_in + (size_t)l * D * INC};
                tr_item(s, WIN + (size_t)l * NIN * D, D, nb * 32, kb * 64, scr, F.lane);
            } else if (it < I_IN + I_OP) { const int r0 = it - I_IN, l = r0 / 384, r = r0 % 384, nb = r / 12, kb = r % 12;
                SrcPlain s{w_out + (size_t)l * D * D, D};
                tr_item(s, WOUT + (size_t)l * D * KOUT, KOUT, nb * 32, kb * 64, scr, F.lane);
            } else { const int r0 = it - I_IN - I_OP, l = r0 / 256, r = r0 % 256, nb = r / 8, gp = r % 8, g = gp & 3, part = gp >> 2;
                const float* wsrc = w_out + (size_t)l * D * D + (size_t)(768 + g * 64) * D + nb * 32;
#pragma unroll 8
                for (int i = 0; i < 32; ++i) { const int kk = 2 * i + (F.lane >> 5), nn = F.lane & 31; scr[kk * 33 + nn] = wsrc[(size_t)kk * D + nn]; }
                LDS_WAIT(); asm volatile("" ::: "memory");
                const int c8 = F.lane & 7;
                float o[4][8];
#pragma unroll
                for (int j = 0; j < 4; ++j)
#pragma unroll
                    for (int q = 0; q < 8; ++q) o[j][q] = 0.f;
                for (int m = 0; m < 64; ++m) {
                    float twd[8];
#pragma unroll
                    for (int q = 0; q < 8; ++q) { const float ang = (float)((m * (c8 * 8 + q)) & 63) * (6.283185307179586f / 64.f); twd[q] = part ? -__sinf(ang) : __cosf(ang); }
#pragma unroll
                    for (int j = 0; j < 4; ++j) { const float bv = scr[m * 33 + (F.lane >> 3) + 8 * j];
#pragma unroll
                        for (int q = 0; q < 8; ++q) o[j][q] += twd[q] * bv; }
                }
#pragma unroll
                for (int j = 0; j < 4; ++j) { const int n = (F.lane >> 3) + 8 * j;
                    u32x4 ov; ov.x = pk2(o[j][0] * 0.125f, o[j][1] * 0.125f); ov.y = pk2(o[j][2] * 0.125f, o[j][3] * 0.125f); ov.z = pk2(o[j][4] * 0.125f, o[j][5] * 0.125f); ov.w = pk2(o[j][6] * 0.125f, o[j][7] * 0.125f);
                    *(u32x4*)(WOUT + (size_t)l * D * KOUT + (size_t)(nb * 32 + n) * KOUT + 768 + part * 256 + g * 64 + c8 * 8) = ov; }
                LDS_WAIT(); asm volatile("" ::: "memory");
            }
        }
    }
}

constexpr int WTS = 1028;
constexpr int ROW_PRM = 16 * WTS * 4;
template <int CTRL> __device__ __forceinline__ float dppf(float v) { return __builtin_bit_cast(float, __builtin_amdgcn_update_dpp(0, __builtin_bit_cast(int, v), CTRL, 0xF, 0xF, true)); }
__device__ __forceinline__ float rdlane(float v, int l) { return __builtin_bit_cast(float, __builtin_amdgcn_readlane(__builtin_bit_cast(int, v), l)); }
__device__ __forceinline__ float wave_sum_dpp(float v) {
    v += dppf<0xB1>(v); v += dppf<0x4E>(v); v += dppf<0x141>(v); v += dppf<0x140>(v);
    return (rdlane(v, 0) + rdlane(v, 16)) + (rdlane(v, 32) + rdlane(v, 48));
}
__device__ __forceinline__ void stage_small_w(Frame& F, LAS float* wT, const float* src, int ld, int coloff) {
    f32x4 v[8];
#pragma unroll
    for (int q = 0; q < 8; ++q) { const int i = F.tid + NTHR * q, k = i >> 2, c4 = i & 3; v[q] = *(const f32x4*)(src + (size_t)k * ld + coloff + 4 * c4); }
#pragma unroll
    for (int q = 0; q < 8; ++q) { const int i = F.tid + NTHR * q, k = i >> 2, c4 = i & 3;
#pragma unroll
        for (int e = 0; e < 4; ++e) wT[(4 * c4 + e) * WTS + k] = v[q][e]; }
}
#define SWAP4(INS, a0, b0, a1, b1, a2, b2, a3, b3) asm volatile("s_nop 1\n\t" INS " %0, %1\n\t" INS " %2, %3\n\t" INS " %4, %5\n\t" INS " %6, %7\n\ts_nop 1" : "+v"(a0), "+v"(b0), "+v"(a1), "+v"(b1), "+v"(a2), "+v"(b2), "+v"(a3), "+v"(b3))
#ifdef OLD_REDUCE
__device__ __forceinline__ float reduce16(const float (&acc)[16], int lane) {
    float v8[8], v4[4], v2[2], v1;
#pragma unroll
    for (int i = 0; i < 8; ++i) { const float snd = (lane & 32) ? acc[i] : acc[i + 8], kp = (lane & 32) ? acc[i + 8] : acc[i]; v8[i] = kp + __shfl_xor(snd, 32); }
#pragma unroll
    for (int i = 0; i < 4; ++i) { const float snd = (lane & 16) ? v8[i] : v8[i + 4], kp = (lane & 16) ? v8[i + 4] : v8[i]; v4[i] = kp + __shfl_xor(snd, 16); }
#pragma unroll
    for (int i = 0; i < 2; ++i) { const float snd = (lane & 8) ? v4[i] : v4[i + 2], kp = (lane & 8) ? v4[i + 2] : v4[i]; v2[i] = kp + __shfl_xor(snd, 8); }
    { const float snd = (lane & 4) ? v2[0] : v2[1], kp = (lane & 4) ? v2[1] : v2[0]; v1 = kp + __shfl_xor(snd, 4); }
    v1 += __shfl_xor(v1, 2); v1 += __shfl_xor(v1, 1);
    return v1;
}
#else
__device__ __forceinline__ float reduce16(const float (&acc)[16], int lane) {
    float v8[8], v4[4], v2[2], v1, t[16];
#pragma unroll
    for (int i = 0; i < 16; ++i) t[i] = acc[i];
    SWAP4("v_permlane32_swap_b32", t[0], t[8], t[1], t[9], t[2], t[10], t[3], t[11]); SWAP4("v_permlane32_swap_b32", t[4], t[12], t[5], t[13], t[6], t[14], t[7], t[15]);
#pragma unroll
    for (int i = 0; i < 8; ++i) v8[i] = t[i] + t[i + 8];
    SWAP4("v_permlane16_swap_b32", v8[0], v8[4], v8[1], v8[5], v8[2], v8[6], v8[3], v8[7]);
#pragma unroll
    for (int i = 0; i < 4; ++i) v4[i] = v8[i] + v8[i + 4];
#pragma unroll
    for (int i = 0; i < 2; ++i) { const float snd = (lane & 8) ? v4[i] : v4[i + 2], kp = (lane & 8) ? v4[i + 2] : v4[i]; v2[i] = kp + dppf<0x140>(snd); }
    { const float snd = (lane & 4) ? v2[0] : v2[1], kp = (lane & 4) ? v2[1] : v2[0]; v1 = kp + dppf<0x141>(snd); }
    v1 += dppf<0x4E>(v1); v1 += dppf<0xB1>(v1);
    return v1;
}
#endif
__device__ __forceinline__ int mod_row(int tok) { return tok < NLAT ? (tok >> 11) : 8; }
__device__ __forceinline__ void pair_range(int ntok, int gw, int ngw, int& p0, int& p1) { const int np = ntok >> 1; p0 = (int)(((long long)np * gw) / ngw); p1 = (int)(((long long)np * (gw + 1)) / ngw); }
__device__ __forceinline__ void block_mod_rows(Frame& F, int ntok, int& mrA, int& mrB) {
    int q0, q1, r0, r1; pair_range(ntok, F.bid * NWAVES, F.G * NWAVES, q0, q1); pair_range(ntok, F.bid * NWAVES + NWAVES - 1, F.G * NWAVES, r0, r1);
    mrA = mod_row(min(2 * q0, ntok - 1)); mrB = mod_row(min(max(2 * r1 - 1, 0), ntok - 1));
}
__device__ __forceinline__ float sumsq4(const f32x4 (&v)[4]) { float ss = 0.f;
#pragma unroll
    for (int j = 0; j < 4; ++j) ss += (v[j][0] * v[j][0] + v[j][1] * v[j][1]) + (v[j][2] * v[j][2] + v[j][3] * v[j][3]);
    return ss; }
__device__ __forceinline__ void norm_pair(const f32x4 (&va)[4], const f32x4 (&vb)[4], const LAS float* cfp, const LAS float* shp, bf16_t* xn_a, f32x2 (&yy)[16], int lane) {
    const float ra = 1.0f / sqrtf(wave_sum_dpp(sumsq4(va)) * (1.0f / D) + EPS), rb = 1.0f / sqrtf(wave_sum_dpp(sumsq4(vb)) * (1.0f / D) + EPS);
#pragma unroll
    for (int j = 0; j < 4; ++j) { const int o = 4 * lane + 256 * j;
        const f32x4 cf = *(const LAS f32x4*)(cfp + o), sh = *(const LAS f32x4*)(shp + o);
        f32x4 ya, yb;
#pragma unroll
        for (int q = 0; q < 4; ++q) { ya[q] = va[j][q] * ra * cf[q] + sh[q]; yb[q] = vb[j][q] * rb * cf[q] + sh[q]; yy[4 * j + q] = (f32x2){ya[q], yb[q]}; }
        *(u32x2*)(xn_a + o) = pk4(ya); *(u32x2*)(xn_a + D + o) = pk4(yb); }
}
__device__ __forceinline__ void gate_products2(const f32x2 (&yy)[16], const LAS float* wT, int lane, float& ga, float& gb) {
    f32x2 acc[16];
#pragma unroll
    for (int c = 0; c < 16; ++c) acc[c] = (f32x2){0.f, 0.f};
#pragma unroll
    for (int j = 0; j < 4; ++j) {
#pragma unroll
        for (int h = 0; h < 2; ++h) {
            f32x4 wv[8];
#pragma unroll
            for (int c = 0; c < 8; ++c) wv[c] = *(const LAS f32x4*)(wT + (8 * h + c) * WTS + 4 * lane + 256 * j);
            __builtin_amdgcn_sched_barrier(0);
#pragma unroll
            for (int c = 0; c < 8; ++c)
#pragma unroll
                for (int q = 0; q < 4; ++q) acc[8 * h + c] += yy[4 * j + q] * (f32x2){wv[c][q], wv[c][q]};
            __builtin_amdgcn_sched_barrier(0);
        }
    }
    float a1[16], b1[16];
#pragma unroll
    for (int c = 0; c < 16; ++c) { a1[c] = acc[c][0]; b1[c] = acc[c][1]; }
    ga = reduce16(a1, lane); gb = reduce16(b1, lane);
}
__device__ __forceinline__ void row_tail_gates(float myv, float bg  , float* gates_row, int lane) {
    if ((lane & 3) == 0) { const int c = lane >> 2; gates_row[c] = myv + bg; }
}
__device__ __forceinline__ void row_tail_router(float myv, float* aff_row, int lane) {
    float mx = myv;
#pragma unroll
    for (int o = 4; o < 64; o <<= 1) mx = fmaxf(mx, __shfl_xor(mx, o));
    const float e = expf(myv - mx); float s = e;
#pragma unroll
    for (int o = 4; o < 64; o <<= 1) s += __shfl_xor(s, o);
    if ((lane & 3) == 0) aff_row[lane >> 2] = e / s;
}
#define LOAD_PAIR(va, vb, src) { _Pragma("unroll") for (int j = 0; j < 4; ++j) { va[j] = *(const f32x4*)((src) + 4 * F.lane + 256 * j); vb[j] = *(const f32x4*)((src) + D + 4 * F.lane + 256 * j); } }

__device__ __forceinline__ void phase_norm1_l0(Frame& F) {
    LAS float* wT = (LAS float*)F.lds; LAS float* prm = (LAS float*)(F.lds + ROW_PRM);
    const float* MOD = WSP(float, WS_MOD); bf16_t* XN = WSP(bf16_t, WS_XN); float* GATES = WSP(float, WS_GATES);
    const float* x_in = FIN(I_X); const float* ctx_in = FIN(I_CTX); const float* g_norm1 = FIN(I_GN1); const float* b_gates = FIN(I_BG);
    const int gw = F.bid * NWAVES + F.wave, ngw = F.G * NWAVES;
    int p0, p1; pair_range(NTOK, gw, ngw, p0, p1);
    const float bg = b_gates[F.lane >> 2];
#define N1_SRC(t) ((t) < NLAT ? x_in + (size_t)(t) * D : ctx_in + (size_t)((t) - NLAT) * D)
    f32x4 va[4], vb[4];
    if (p0 < p1) { const float* src = N1_SRC(2 * p0); LOAD_PAIR(va, vb, src) }
    int mrA, mrB; block_mod_rows(F, NTOK, mrA, mrB);
    stage_small_w(F, wT, FIN(I_WIN), INC, 1536);
#pragma unroll
    for (int i = F.tid; i < 2048; i += NTHR) { const int set = i >> 10, k = i & 1023; const float* md = MOD + (size_t)(set ? mrB : mrA) * 6144;
        prm[(set * 3 + 0) * 1024 + k] = g_norm1[k] * (1.0f + md[1024 + k]); prm[(set * 3 + 1) * 1024 + k] = md[k]; }
    __syncthreads();
    for (int p = p0; p < p1; ++p) {
        const int tok = 2 * p, set = (mod_row(tok) != mrA) ? 1 : 0;
        f32x2 yy[16];
        norm_pair(va, vb, prm + (set * 3 + 0) * 1024, prm + (set * 3 + 1) * 1024, XN + (size_t)tok * D, yy, F.lane);
        if (p + 1 < p1) { const float* src = N1_SRC(tok + 2); LOAD_PAIR(va, vb, src) }
        float ga, gb; gate_products2(yy, wT, F.lane, ga, gb);
        row_tail_gates(ga, bg, GATES + (size_t)tok * 16, F.lane); row_tail_gates(gb, bg, GATES + (size_t)(tok + 1) * 16, F.lane);
    }
#undef N1_SRC
    __syncthreads();
}
__device__ __forceinline__ void phase_norm2(Frame& F, int l) {
    LAS float* wT = (LAS float*)F.lds; LAS float* prm = (LAS float*)(F.lds + ROW_PRM);
    const float* g_norm2 = FIN(I_GN2) + l * D;
    const float* MOD = WSP(float, WS_MOD); bf16_t* XN = WSP(bf16_t, WS_XN); float* AFF = WSP(float, WS_AFF); const float* X = WSP(float, WS_X);
    const int gw = F.bid * NWAVES + F.wave, ngw = F.G * NWAVES;
    const int ntok = (l == 0) ? NTOK : NLAT;
    int p0, p1; pair_range(ntok, gw, ngw, p0, p1);
    f32x4 va[4], vb[4];
    if (p0 < p1) { const float* src = X + (size_t)(2 * p0) * D; LOAD_PAIR(va, vb, src) }
    int mrA, mrB; block_mod_rows(F, ntok, mrA, mrB);
    stage_small_w(F, wT, FIN(I_WR) + (size_t)l * D * 16, 16, 0);
#pragma unroll
    for (int i = F.tid; i < 2048; i += NTHR) { const int set = i >> 10, k = i & 1023; const float* md = MOD + ((size_t)l * 9 + (set ? mrB : mrA)) * 6144;
        prm[(set * 3 + 0) * 1024 + k] = g_norm2[k] * (1.0f + md[4 * 1024 + k]); prm[(set * 3 + 1) * 1024 + k] = md[3 * 1024 + k]; }
    __syncthreads();
    for (int p = p0; p < p1; ++p) {
        const int tok = 2 * p, set = (mod_row(tok) != mrA) ? 1 : 0;
        f32x2 yy[16];
        norm_pair(va, vb, prm + (set * 3 + 0) * 1024, prm + (set * 3 + 1) * 1024, XN + (size_t)tok * D, yy, F.lane);
        if (p + 1 < p1) { const float* src = X + (size_t)(tok + 2) * D; LOAD_PAIR(va, vb, src) }
        float ga, gb; gate_products2(yy, wT, F.lane, ga, gb);
        row_tail_router(ga, AFF + (size_t)tok * 16, F.lane); row_tail_router(gb, AFF + (size_t)(tok + 1) * 16, F.lane);
    }
    __syncthreads();
}
constexpr int CMB_K = 2;
struct CmbSlots { u32x2 y[2][CMB_K][4]; };
__device__ __forceinline__ unsigned row_inv_mask(int invw, int sub) { return (unsigned)((__ballot(invw >= 0) >> (16 * sub)) & 0xffffull); }
__device__ __forceinline__ void cmb_issue(CmbSlots& S, const bf16_t* YS, int invw_a, int sub_a, int invw_b, int sub_b, int lane) {
#pragma unroll
    for (int rr = 0; rr < 2; ++rr) { const int invw = rr ? invw_b : invw_a, sub = rr ? sub_b : sub_a; unsigned mask = row_inv_mask(invw, sub);
#pragma unroll
        for (int s = 0; s < CMB_K; ++s) {
            int e = 0, r = 0;
            if (mask) { e = __builtin_ctz(mask); mask &= mask - 1; r = __builtin_amdgcn_readlane(invw, 16 * sub + e); }
            const bf16_t* yr = YS + ((size_t)e * RPE + r) * D;
#pragma unroll
            for (int j = 0; j < 4; ++j) S.y[rr][s][j] = *(const u32x2*)(yr + 4 * lane + 256 * j); } }
}
__device__ __forceinline__ void cmb_accum(f32x4 (&a)[4], const u32x2 (&w)[4]) {
#pragma unroll
    for (int j = 0; j < 4; ++j) { a[j][0] += bflo(w[j].x); a[j][1] += bfhi(w[j].x); a[j][2] += bflo(w[j].y); a[j][3] += bfhi(w[j].y); }
}
__device__ __forceinline__ void phase_combine(Frame& F, int l) {
    LAS float* wT = (LAS float*)F.lds; LAS float* prm = (LAS float*)(F.lds + ROW_PRM);
    const float* g_norm1 = FIN(I_GN1) + D; const float* b_gates = FIN(I_BG) + 16; const float* g_final = FIN(I_GF); float* outp = as_global(F.A.out);
    const float* MOD = WSP(float, WS_MOD); bf16_t* XN = WSP(bf16_t, WS_XN); float* GATES = WSP(float, WS_GATES); float* X = WSP(float, WS_X);
    const int* INV = WSP(int, WS_INV); const bf16_t* YS = WSP(bf16_t, WS_YS);
    const int gw = F.bid * NWAVES + F.wave, ngw = F.G * NWAVES;
    const int ntok = (l == 0) ? NTOK : NLAT;
    int p0, p1; pair_range(ntok, gw, ngw, p0, p1);
    const float bg = b_gates[F.lane >> 2];
    const int t0 = 2 * p0;
    int invw[3];
#pragma unroll
    for (int i = 0; i < 3; ++i) { const int idx = t0 * 16 + 64 * i + F.lane; invw[i] = (idx < ntok * 16) ? INV[idx] : -1; }
#define INVW(ri) (((ri) >> 2) == 0 ? invw[0] : ((ri) >> 2) == 1 ? invw[1] : invw[2])
    f32x4 va[4], vb[4]; CmbSlots S;
    if (p0 < p1) { const float* src = X + (size_t)t0 * D; LOAD_PAIR(va, vb, src) cmb_issue(S, YS, INVW(0), 0, INVW(1), 1, F.lane); }
    int mrA, mrB; block_mod_rows(F, ntok, mrA, mrB);
    if (l == 0) stage_small_w(F, wT, FIN(I_WIN) + (size_t)1 * D * INC, INC, 1536);
    for (int i = F.tid; i < 2048; i += NTHR) { const int set = i >> 10, k = i & 1023, mr = set ? mrB : mrA; const float* md = MOD + ((size_t)l * 9 + mr) * 6144; const float* md1 = MOD + ((size_t)9 + mr) * 6144;
        prm[(set * 3 + 2) * 1024 + k] = md[5 * 1024 + k];
        if (l == 0) { prm[(set * 3 + 0) * 1024 + k] = g_norm1[k] * (1.0f + md1[1024 + k]); prm[(set * 3 + 1) * 1024 + k] = md1[k]; }
        else prm[(set * 3 + 0) * 1024 + k] = g_final[k]; }
    __syncthreads();
    for (int p = p0; p < p1; ++p) {
        const int tok = 2 * p, ri = tok - t0, set = (mod_row(tok) != mrA) ? 1 : 0;
        const LAS float* pp = prm + set * 3 * 1024;
#pragma unroll
        for (int rr = 0; rr < 2; ++rr) {
            f32x4 a[4];
#pragma unroll
            for (int j = 0; j < 4; ++j) a[j] = (f32x4){0.f, 0.f, 0.f, 0.f};
            const int iw = INVW(ri + rr), sub = (ri + rr) & 3;
            unsigned mask = row_inv_mask(iw, sub);
#pragma unroll
            for (int s = 0; s < CMB_K; ++s) if (mask) { mask &= mask - 1; cmb_accum(a, S.y[rr][s]); }
            while (mask) { const int e = __builtin_ctz(mask); mask &= mask - 1;
                const int r = __builtin_amdgcn_readlane(iw, 16 * sub + e);
                const bf16_t* yr = YS + ((size_t)e * RPE + r) * D;
                u32x2 w[4];
#pragma unroll
                for (int j = 0; j < 4; ++j) w[j] = *(const u32x2*)(yr + 4 * F.lane + 256 * j);
                cmb_accum(a, w); }
#pragma unroll
            for (int j = 0; j < 4; ++j) { const f32x4 gt = *(const LAS f32x4*)(pp + 2 * 1024 + 4 * F.lane + 256 * j); if (rr == 0) va[j] = va[j] + gt * a[j]; else vb[j] = vb[j] + gt * a[j]; }
        }
        if (l == 0) {
#pragma unroll
            for (int j = 0; j < 4; ++j) { *(f32x4*)(X + (size_t)tok * D + 4 * F.lane + 256 * j) = va[j]; *(f32x4*)(X + (size_t)(tok + 1) * D + 4 * F.lane + 256 * j) = vb[j]; }
            f32x2 yy[16];
            norm_pair(va, vb, pp, pp + 1024, XN + (size_t)tok * D, yy, F.lane);
            if (p + 1 < p1) { const float* src = X + (size_t)(tok + 2) * D; LOAD_PAIR(va, vb, src) cmb_issue(S, YS, INVW(ri + 2), (ri + 2) & 3, INVW(ri + 3), (ri + 3) & 3, F.lane); }
            float ga, gb; gate_products2(yy, wT, F.lane, ga, gb);
            row_tail_gates(ga, bg, GATES + (size_t)tok * 16, F.lane); row_tail_gates(gb, bg, GATES + (size_t)(tok + 1) * 16, F.lane);
        } else {
            const float ra = 1.0f / sqrtf(wave_sum_dpp(sumsq4(va)) * (1.0f / D) + EPS), rb = 1.0f / sqrtf(wave_sum_dpp(sumsq4(vb)) * (1.0f / D) + EPS);
#pragma unroll
            for (int j = 0; j < 4; ++j) { const f32x4 g = *(const LAS f32x4*)(pp + 4 * F.lane + 256 * j);
                *(f32x4*)(outp + (size_t)tok * D + 4 * F.lane + 256 * j) = va[j] * ra * g; *(f32x4*)(outp + (size_t)(tok + 1) * D + 4 * F.lane + 256 * j) = vb[j] * rb * g; }
            if (p + 1 < p1) { const float* src = X + (size_t)(tok + 2) * D; LOAD_PAIR(va, vb, src) cmb_issue(S, YS, INVW(ri + 2), (ri + 2) & 3, INVW(ri + 3), (ri + 3) & 3, F.lane); }
        }
    }
#undef INVW
    __syncthreads();
}

__device__ __forceinline__ int block_count(LAS int* cbuf, int par, int wave, int lane, int c_wave  ) {
    if (lane == 0) cbuf[par * 8 + wave] = c_wave;
    __syncthreads();
    int t = 0;
#pragma unroll
    for (int q = 0; q < 8; ++q) t += cbuf[par * 8 + q];
    return t;
}
__device__ __forceinline__ void phase_topk(Frame& F, int l) {
    LAS int* cbuf = (LAS int*)F.lds;
    const float* AFF = WSP(float, WS_AFF); int* INV = WSP(int, WS_INV); int* ROWTOK = WSP(int, WS_ROWTOK); float* GATEV = WSP(float, WS_GATEV);
    const int nitems = (l == 0) ? 256 : 128;
    for (int it = F.bid; it < nitems; it += F.G) {
        const int s = it >> 4, e = it & 15;
        const bool lat = s < 8;
        const int n = lat ? SEQ : CTXL, cap = lat ? 256 : 32, tok0 = lat ? s * SEQ : NLAT + (s - 8) * CTXL, rowbase = lat ? s * 256 : 2048 + (s - 8) * 32;
        const bool active = 4 * F.tid < n;
        unsigned k[4];
#pragma unroll
        for (int q = 0; q < 4; ++q) k[q] = active ? __float_as_uint(AFF[(size_t)(tok0 + 4 * F.tid + q) * 16 + e]) : 0u;
        __syncthreads();
        unsigned T = 0u; int par = 0;
        for (int bit = 30; bit >= 0; --bit) {
            const unsigned cand = T | (1u << bit);
            int cw = 0;
#pragma unroll
            for (int q = 0; q < 4; ++q) cw += __popcll(__ballot(k[q] >= cand));
            const int tot = block_count(cbuf, par, F.wave, F.lane, cw); par ^= 1;
            if (tot >= cap) T = cand;
        }
        int cw = 0;
#pragma unroll
        for (int q = 0; q < 4; ++q) cw += __popcll(__ballot(k[q] > T));
        const int c_gt = block_count(cbuf, par, F.wave, F.lane, cw); par ^= 1;
        int mg = 0, me = 0;
#pragma unroll
        for (int q = 0; q < 4; ++q) { mg += (k[q] > T) ? 1 : 0; me += (k[q] == T && active) ? 1 : 0; }
        int pk_ = mg | (me << 16), inc = pk_;
#pragma unroll
        for (int o = 1; o < 64; o <<= 1) { const int y = __shfl_up(inc, o); if (F.lane >= o) inc += y; }
        if (F.lane == 63) cbuf[16 + F.wave] = inc;
        __syncthreads();
        int base = 0;
#pragma unroll
        for (int q = 0; q < 8; ++q) base += (q < F.wave) ? cbuf[16 + q] : 0;
        int pre = base + inc - pk_; int pg = pre & 0xffff, pe = pre >> 16;
        if (active) {
#pragma unroll
            for (int q = 0; q < 4; ++q) {
                const int tok = tok0 + 4 * F.tid + q; int slot = -1;
                if (k[q] > T) { slot = pg; ++pg; }
                else if (k[q] == T) { if (c_gt + pe < cap) slot = c_gt + pe; ++pe; }
                if (slot >= 0) { ROWTOK[e * RPE + rowbase + slot] = tok; GATEV[e * RPE + rowbase + slot] = __uint_as_float(k[q]); }
                INV[(size_t)tok * 16 + e] = slot >= 0 ? rowbase + slot : -1;
            }
        }
        __syncthreads();
    }
    __syncthreads();
}

__device__ __forceinline__ void conv_items(Frame& F, int l, int first, int stride) {
    LAS float* gl = (LAS float*)F.lds;
    LAS float* ob = gl + 62 * 256;
    const bf16_t* CA = WSP(bf16_t, WS_CA); const bf16_t* CG = WSP(bf16_t, WS_CG); bf16_t* Y = WSP(bf16_t, WS_Y);
    const int nitems = (l == 0) ? 512 + 64 : 512;
    const int ch = F.tid & 255, th = F.tid >> 8;
    const float* conv_w = FIN(I_CW); const float* conv_b = FIN(I_CB); const float* conv_ln_g = FIN(I_CLG); const float* conv_ln_b = FIN(I_CLB);
    float w[31];
#pragma unroll
    for (int j = 0; j < 31; ++j) w[j] = conv_w[((size_t)l * 31 + j) * 256 + ch];
    const float cb = conv_b[l * 256 + ch];
    for (int it = first; it < nitems; it += stride) {
        const bool lat = it < 512;
        const int seqlen = lat ? SEQ : CTXL;
        const int b = lat ? it >> 6 : (it - 512) >> 3, t0 = lat ? (it & 63) * 32 : ((it - 512) & 7) * 32;
        const int tokb = lat ? b * SEQ : NLAT + b * CTXL;
        __syncthreads();
        for (int i = F.tid; i < 62 * 64; i += NTHR) {
            const int rr = i >> 6, c4 = (i & 63) * 4, t = t0 - 15 + rr;
            f32x4 g = (f32x4){0.f, 0.f, 0.f, 0.f};
            if (t >= 0 && t < seqlen) { const size_t o = (size_t)(tokb + t) * 256 + c4; const u32x2 a = *(const u32x2*)(CA + o), gg = *(const u32x2*)(CG + o);
                g[0] = bflo(a.x) * sigmoidf_(bflo(gg.x)); g[1] = bfhi(a.x) * sigmoidf_(bfhi(gg.x)); g[2] = bflo(a.y) * sigmoidf_(bflo(gg.y)); g[3] = bfhi(a.y) * sigmoidf_(bfhi(gg.y)); }
            *(LAS f32x4*)(gl + rr * 256 + c4) = g;
        }
        __syncthreads();
        for (int tt = 0; tt < 16; ++tt) {
            const LAS float* gp = gl + (th * 16 + tt) * 256 + ch;
            float gv[31];
#pragma unroll
            for (int j = 0; j < 31; ++j) gv[j] = gp[j * 256];
            __builtin_amdgcn_sched_barrier(0);
            float o = cb;
#pragma unroll
            for (int j = 0; j < 31; ++j) o += w[j] * gv[j];
            __builtin_amdgcn_sched_barrier(0);
            ob[(th * 16 + tt) * 256 + ch] = o;
        }
        __syncthreads();
        for (int tt = F.wave; tt < 32; tt += NWAVES) {
            const f32x4 v = *(const LAS f32x4*)(ob + tt * 256 + 4 * F.lane);
            const float mean = wave_sum((v[0] + v[1]) + (v[2] + v[3])) * (1.0f / 256.f);
            const f32x4 d = v - mean;
            const float var = wave_sum((d[0] * d[0] + d[1] * d[1]) + (d[2] * d[2] + d[3] * d[3])) * (1.0f / 256.f);
            const float rs = 1.0f / sqrtf(var + EPS);
            const f32x4 lg = *(const f32x4*)(conv_ln_g + l * 256 + 4 * F.lane), lb = *(const f32x4*)(conv_ln_b + l * 256 + 4 * F.lane);
            f32x4 y;
#pragma unroll
            for (int q = 0; q < 4; ++q) y[q] = siluf_(d[q] * rs * lg[q] + lb[q]);
            *(u32x2*)(Y + (size_t)(tokb + t0 + tt) * KOUT + 512 + 4 * F.lane) = pk4(y);
        }
    }
    __syncthreads();
}
__device__ __forceinline__ void ztrans_items(Frame& F, int l, int first, int stride) {
    LAS unsigned short* te = (LAS unsigned short*)(F.lds + F.wave * (2 * 64 * 66 * 2));
    LAS unsigned short* to = te + 64 * 66;
    const bf16_t* FR = WSP(bf16_t, WS_FR); bf16_t* ZE = WSP(bf16_t, WS_ZT); bf16_t* ZO = WSP(bf16_t, WS_ZO); bf16_t* ZTC = WSP(bf16_t, WS_ZTC);
    const int nlat = 8 * 16 * 4, nctx = (l == 0) ? 8 * 4 * 4 : 0;
    for (int it = first; it < nlat + nctx; it += stride) {
        const bool lat = it < nlat; const int r = lat ? it : it - nlat;
        const int b = lat ? r >> 6 : r >> 4, tb = lat ? (r >> 2) & 15 : (r >> 2) & 3, cb = r & 3;
        const int tokb = lat ? b * SEQ : NLAT + b * CTXL;
#pragma unroll
        for (int i = 0; i < 8; ++i) { const int tt = (F.lane >> 3) + 8 * i, c8 = (F.lane & 7) * 8, t = tb * 64 + tt;
            const u32x4 v = *(const u32x4*)(FR + (size_t)(tokb + t) * 256 + cb * 64 + c8);
            u32x4 m = (u32x4){0u, 0u, 0u, 0u};
            if (lat && t > 0) m = *(const u32x4*)(FR + (size_t)(tokb + SEQ - t) * 256 + cb * 64 + c8);
#pragma unroll
            for (int q = 0; q < 4; ++q) {
                if (lat) { const float a0 = bflo(v[q]), a1 = bfhi(v[q]), m0 = bflo(m[q]), m1 = bfhi(m[q]); const unsigned e_ = pk2(a0 + m0, a1 + m1), o_ = (t > 0) ? pk2(a0 - m0, a1 - m1) : 0u;
                    te[(c8 + 2 * q) * 66 + tt] = (unsigned short)(e_ & 0xffffu); te[(c8 + 2 * q + 1) * 66 + tt] = (unsigned short)(e_ >> 16);
                    to[(c8 + 2 * q) * 66 + tt] = (unsigned short)(o_ & 0xffffu); to[(c8 + 2 * q + 1) * 66 + tt] = (unsigned short)(o_ >> 16); }
                else { te[(c8 + 2 * q) * 66 + tt] = (unsigned short)(v[q] & 0xffffu); te[(c8 + 2 * q + 1) * 66 + tt] = (unsigned short)(v[q] >> 16); } } }
        LDS_WAIT(); asm volatile("" ::: "memory");
        const size_t drow = (size_t)(b * 256 + cb * 64) * 1024 + tb * 64;
#pragma unroll
        for (int i = 0; i < 8; ++i) { const int cc = (F.lane >> 3) + 8 * i, t8 = (F.lane & 7) * 8; u32x4 o;
#pragma unroll
            for (int q = 0; q < 4; ++q) o[q] = (unsigned)te[cc * 66 + t8 + 2 * q] | ((unsigned)te[cc * 66 + t8 + 2 * q + 1] << 16);
            *(u32x4*)((lat ? ZE : ZTC) + drow + (size_t)cc * 1024 + t8) = o;
            if (lat) {
#pragma unroll
                for (int q = 0; q < 4; ++q) o[q] = (unsigned)to[cc * 66 + t8 + 2 * q] | ((unsigned)to[cc * 66 + t8 + 2 * q + 1] << 16);
                *(u32x4*)(ZO + drow + (size_t)cc * 1024 + t8) = o; } }
        LDS_WAIT(); asm volatile("" ::: "memory");
    }
}
__device__ __forceinline__ void finalize_h(Frame& F, int l) {
    const bf16_t* HF = WSP(bf16_t, WS_HF); const bf16_t* HB = WSP(bf16_t, WS_HB); const bf16_t* O = WSP(bf16_t, WS_O); bf16_t* Y = WSP(bf16_t, WS_Y);
    const int gw = F.bid * NWAVES + F.wave, ngw = F.G * NWAVES;
    const int ntok = (l == 0) ? NTOK : NLAT;
    float gh[8];
    const float* g_hnorm = FIN(I_GH);
#pragma unroll
    for (int q = 0; q < 8; ++q) gh[q] = g_hnorm[l * 512 + 8 * F.lane + q];
    for (int tok = gw; tok < ntok; tok += ngw) {
        const size_t o = (size_t)tok * 512 + 8 * F.lane;
        const u32x4 a = *(const u32x4*)(HF + o), b = *(const u32x4*)(HB + o), og = *(const u32x4*)(O + o);
        float h[8]; float ss = 0.f;
#pragma unroll
        for (int q = 0; q < 4; ++q) { h[2 * q] = bflo(a[q]) + bflo(b[q]); h[2 * q + 1] = bfhi(a[q]) + bfhi(b[q]); ss += h[2 * q] * h[2 * q] + h[2 * q + 1] * h[2 * q + 1]; }
#pragma unroll
        for (int s = 1; s < 16; s <<= 1) ss += __shfl_xor(ss, s);
        const float r = 1.0f / sqrtf(ss * (1.0f / 128.f) + EPS);
        u32x4 w;
#pragma unroll
        for (int q = 0; q < 4; ++q) w[q] = pk2(h[2 * q] * r * gh[2 * q] * bflo(og[q]), h[2 * q + 1] * r * gh[2 * q + 1] * bfhi(og[q]));
        *(u32x4*)(Y + (size_t)tok * KOUT + 8 * F.lane) = w;
    }
}

using pg8::Unit;
enum { GM_INPROJ = 0, GM_DFT, GM_OUT, GM_MOE1, GM_MOE2 };
struct GemmCtl {
    int mode, l, G, c; GAS unsigned char* ws; const Args& A;
    __device__ __forceinline__ GAS unsigned char* W() const { GAS unsigned char* p = ws; asm volatile("" : "+s"(p)); return p; }
    __device__ __forceinline__ bool next(int i, Unit& u) const {
        const int L = i * G + c; int pm, pn;
        u.rows = nullptr; u.ex = 0;
        switch (mode) {
        case GM_INPROJ: {
            const int n0 = 64 * 11, npn = (l == 0) ? 11 : 6;
            if (L >= n0 + 8 * npn) return false;
            if (L < n0) pg8::map_tile(L, 64, 11, pm, pn); else { pg8::map_tile(L - n0, 8, npn, pm, pn); pm += 64; }
            u.A = (const char*)(W() + WS_XN) + (size_t)pm * 256 * D * 2; u.B = (const char*)(W() + WS_WIN) + ((size_t)l * NIN + pn * 256) * D * 2; u.K = D;
        } break;
        case GM_DFT: {
            const int nctx = (l == 0) ? 16 : 0;
            if (L >= 128 + nctx) return false;
            if (L < 128) { pg8::map_tile(L, 16, 8, pm, pn); u.A = (const char*)(W() + WS_FL) + (size_t)pm * 256 * 1024 * 2; u.B = (const char*)(W() + ((pm >> 3) ? WS_ZO : WS_ZT)) + (size_t)pn * 256 * 1024 * 2; u.K = 1024; }
            else { const int r = L - 128; pm = r & 1; pn = r >> 1; u.A = (const char*)(W() + WS_FC) + (size_t)pm * 256 * 1024 * 2; u.B = (const char*)(W() + WS_ZTC) + (size_t)pn * 256 * 1024 * 2; u.K = CTXL; u.ex = 1; }
        } break;
        case GM_OUT: {
            const int nM = (l == 0) ? 72 : 64;
            if (L >= nM * 4) return false;
            pg8::map_tile(L, nM, 4, pm, pn);
            u.A = (const char*)(W() + WS_Y) + (size_t)pm * 256 * KOUT * 2; u.B = (const char*)(W() + WS_WOUT) + ((size_t)l * D + pn * 256) * KOUT * 2; u.K = KOUT;
        } break;
        case GM_MOE1: {
            const int nMe = (l == 0) ? 9 : 8; int pmg;
            if (L >= NE * nMe * 8) return false;
            pg8::map_tile(L, NE * nMe, 8, pmg, pn);
            const int e = pmg / nMe; pm = pmg % nMe;
            u.A = (const char*)(W() + WS_XN); u.rows = (const int*)(W() + WS_ROWTOK) + e * RPE + pm * 256; u.B = (const char*)(W() + WS_WGU) + ((size_t)e * 2048 + pn * 256) * D * 2; u.K = D; u.ex = e;
        } break;
        default: {
            const int nMe = (l == 0) ? 9 : 8; int pmg;
            if (L >= NE * nMe * 4) return false;
            pg8::map_tile(L, NE * nMe, 4, pmg, pn);
            const int e = pmg / nMe; pm = pmg % nMe;
            u.A = (const char*)(W() + WS_HID) + ((size_t)e * RPE + pm * 256) * D * 2; u.B = (const char*)(W() + WS_WD) + ((size_t)e * D + pn * 256) * D * 2; u.K = D; u.ex = e;
        } break;
        }
        u.pm = pm; u.pn = pn;
        return true;
    }
    struct CxIn { bf16_t* dst; int ld; float sc; int act; };
    __device__ __forceinline__ CxIn prep_in(const Unit& u) const {
        CxIn c; const int pn = u.pn; c.sc = 1.f; c.act = 0; size_t off; int cb;
        if (pn < 2) { off = WS_Q; c.ld = 512; cb = pn * 256; }
        else if (pn < 4) { off = WS_K; c.ld = 512; cb = (pn - 2) * 256; c.sc = 0.08838834764831845f; }
        else if (pn < 6) { off = WS_V; c.ld = 512; cb = (pn - 4) * 256; }
        else if (pn < 8) { off = WS_O; c.ld = 512; cb = (pn - 6) * 256; c.act = 1; }
        else if (pn == 8) { off = WS_CA; c.ld = 256; cb = 0; }
        else if (pn == 9) { off = WS_CG; c.ld = 256; cb = 0; }
        else { off = WS_FR; c.ld = 256; cb = 0; }
        c.dst = (bf16_t*)(W() + off) + (size_t)u.pm * 256 * c.ld + cb;
        return c;
    }
    __device__ __forceinline__ void store_in(const CxIn& c, int r, int col, f32x4 v0, f32x4 v1) const {
        if (c.act) {
#pragma unroll
            for (int q = 0; q < 4; ++q) { v0[q] = sigmoidf_(v0[q]); v1[q] = sigmoidf_(v1[q]); }
        } else { v0 = v0 * c.sc; v1 = v1 * c.sc; }
        bf16_t* p = c.dst + (size_t)r * c.ld + col;
        *(u32x2*)p = pk4(v0); *(u32x2*)(p + 16) = pk4(v1);
    }
    struct CxDft { bf16_t* dst; const bf16_t* z1024; };
    __device__ __forceinline__ CxDft prep_dft(const Unit& u) const {
        CxDft c; int part, tokb; c.z1024 = nullptr;
        if (u.ex == 0) { part = u.pm >> 3; tokb = u.pn * SEQ + (u.pm & 7) * 256; if (part == 0) c.z1024 = (const bf16_t*)(W() + WS_FR) + (size_t)(u.pn * SEQ + 1024) * 256; }
        else { part = u.pm; tokb = NLAT + u.pn * CTXL; }
        c.dst = (bf16_t*)(W() + WS_Y) + (size_t)tokb * KOUT + 768 + part * 256; return c;
    }
    __device__ __forceinline__ void store_dft(const CxDft& c, int r, int col, f32x4 v0, f32x4 v1) const {
        if (c.z1024) { const float sg = (r & 1) ? -0.022097086912079608f : 0.022097086912079608f; const u32x2 z0 = *(const u32x2*)(c.z1024 + col), z1 = *(const u32x2*)(c.z1024 + col + 16);
            v0[0] += sg * bflo(z0.x); v0[1] += sg * bfhi(z0.x); v0[2] += sg * bflo(z0.y); v0[3] += sg * bfhi(z0.y);
            v1[0] += sg * bflo(z1.x); v1[1] += sg * bfhi(z1.x); v1[2] += sg * bflo(z1.y); v1[3] += sg * bfhi(z1.y); }
        bf16_t* p = c.dst + (size_t)r * KOUT + col;
        *(u32x2*)p = pk4(v0); *(u32x2*)(p + 16) = pk4(v1);
    }
    struct CxOut { const float* src; float* dst; const float* gt; };
    __device__ __forceinline__ CxOut prep_out(const Unit& u) const {
        CxOut c; const int tok0 = u.pm * 256, col0 = u.pn * 256;
        if (l == 0) c.src = (tok0 < NLAT ? arg_in(A, I_X) + (size_t)tok0 * D : arg_in(A, I_CTX) + (size_t)(tok0 - NLAT) * D) + col0;
        else c.src = (const float*)(W() + WS_X) + (size_t)tok0 * D + col0;
        c.dst = (float*)(W() + WS_X) + (size_t)tok0 * D + col0;
        c.gt = (const float*)(W() + WS_MOD) + ((size_t)l * 9 + mod_row(tok0)) * 6144 + 2 * 1024 + col0;
        return c;
    }
    __device__ __forceinline__ void store_out(const CxOut& c, int r, int col, f32x4 v0, f32x4 v1) const {
        const size_t o = (size_t)r * D + col;
        const f32x4 g0 = *(const f32x4*)(c.gt + col), g1 = *(const f32x4*)(c.gt + col + 16);
        const f32x4 s0 = *(const f32x4*)(c.src + o), s1 = *(const f32x4*)(c.src + o + 16);
        *(f32x4*)(c.dst + o) = s0 + g0 * v0; *(f32x4*)(c.dst + o + 16) = s1 + g1 * v1;
    }
    __device__ __forceinline__ bf16_t* prep_m1(const Unit& u) const { return (bf16_t*)(W() + WS_HID) + ((size_t)u.ex * RPE + u.pm * 256) * D + u.pn * 128; }
    __device__ __forceinline__ void store_m1(bf16_t* dst, int r, int col, f32x4 v0, f32x4 v1) const {
        f32x4 h;
#pragma unroll
        for (int q = 0; q < 4; ++q) h[q] = siluf_(v0[q]) * v1[q];
        *(u32x2*)(dst + (size_t)r * D + (col >> 5) * 16 + (col & 15)) = pk4(h);
    }
    struct CxM2 { bf16_t* dst; const float* g; };
    __device__ __forceinline__ CxM2 prep_m2(const Unit& u) const { CxM2 c; c.dst = (bf16_t*)(W() + WS_YS) + ((size_t)u.ex * RPE + u.pm * 256) * D + u.pn * 256; c.g = (const float*)(W() + WS_GATEV) + u.ex * RPE + u.pm * 256; return c; }
    __device__ __forceinline__ void store_m2(const CxM2& c, int r, int col, f32x4 v0, f32x4 v1) const {
        const float g = c.g[r];
        bf16_t* p = c.dst + (size_t)r * D + col;
        *(u32x2*)p = pk4(v0 * g); *(u32x2*)(p + 16) = pk4(v1 * g);
    }
#define EPI_WALK(PREP, STORE) do { const auto cx = PREP(u); _Pragma("unroll") for (int ai = 0; ai < 2; ++ai) _Pragma("unroll") for (int m = 0; m < 4; ++m) _Pragma("unroll") for (int bj = 0; bj < 2; ++bj) \
        STORE(cx, ai * 128 + wr * 64 + m * 16 + fr, bj * 128 + wc * 32 + 4 * fq, acc[ai][bj][m][0], acc[ai][bj][m][1]); } while (0)
    __device__ __forceinline__ void run(const f32x4 (&acc)[2][2][4][2], const Unit& u, int wr, int wc, int fr, int fq) const {
        switch (mode) {
        case GM_INPROJ: EPI_WALK(prep_in, store_in); break;
        case GM_DFT: EPI_WALK(prep_dft, store_dft); break;
        case GM_OUT: EPI_WALK(prep_out, store_out); break;
        case GM_MOE1: EPI_WALK(prep_m1, store_m1); break;
        default: EPI_WALK(prep_m2, store_m2); break;
        }
    }
    __device__ __forceinline__ void store1(const Unit& u, int r, int c, f32x4 v0, f32x4 v1) const {
        switch (mode) {
        case GM_INPROJ: store_in(prep_in(u), r, c, v0, v1); break;
        case GM_DFT: store_dft(prep_dft(u), r, c, v0, v1); break;
        case GM_OUT: store_out(prep_out(u), r, c, v0, v1); break;
        case GM_MOE1: store_m1(prep_m1(u), r, c, v0, v1); break;
        default: store_m2(prep_m2(u), r, c, v0, v1); break;
        }
    }
};

__device__ __forceinline__ void scan_simt(Frame& F, int l) {
    if (F.bid >= 64) return;
    const int b = F.bid >> 3, h = (F.bid >> 1) & 3, dir = F.bid & 1;
    LAS float* qs = (LAS float*)F.lds; LAS float* ks = qs + 64 * 132; LAS float* vs = ks + 64 * 132; LAS float* st = vs + 64 * 132;
    LAS float* sm = st + 64 * 65;
    LAS float* as_ = sm; LAS float* Ms = sm + 64; LAS float* wint = sm + 128; LAS float* enm = sm + 192; LAS float* wst = sm + 256; LAS float* denom = sm + 320;
    LAS float* nvec = sm + 384; LAS float* ig = sm + 512; LAS float* lf = sm + 576; LAS int* toks = (LAS int*)(sm + 640); LAS float* scal = sm + 704;
    const bf16_t* Q = WSP(bf16_t, WS_Q); const bf16_t* K = WSP(bf16_t, WS_K); const bf16_t* V = WSP(bf16_t, WS_V); const float* GATES = WSP(float, WS_GATES);
    bf16_t* H = dir ? WSP(bf16_t, WS_HB) : WSP(bf16_t, WS_HF);
    float Creg[32];
#pragma unroll
    for (int i = 0; i < 32; ++i) Creg[i] = 0.f;
    float m_st = 0.f;
    if (F.tid < 128) nvec[F.tid] = 0.f;
    __syncthreads();
    for (int cc = 0; cc < 36; ++cc) {
        int tid = F.tid; asm volatile("" : "+v"(tid));
        const int lane = tid & 63, e = tid >> 2, dq = tid & 3;
        const bool isctx = cc < 4;
        const int c = isctx ? (dir ? 3 - cc : cc) : (dir ? 35 - cc : cc - 4);
        const bool want_out = !(isctx && l == 1);
        if (tid < 64) { const int j = tid;
            const int tok = isctx ? NLAT + b * CTXL + c * 64 + j : (h < 2 ? b * SEQ + c * 64 + j : b * SEQ + (j & 31) * 64 + 2 * c + (j >> 5));
            toks[j] = tok; const float* g = GATES + (size_t)tok * 16 + h * 4 + 2 * dir; ig[j] = g[0]; lf[j] = logsigmoidf_(g[1]); }
        __syncthreads();
        for (int it = tid; it < 1024; it += NTHR) { const int j = it >> 4, c8 = (it & 15) * 8; const size_t o = (size_t)toks[j] * 512 + h * 128 + c8;
            const u32x4 qv = *(const u32x4*)(Q + o), kv = *(const u32x4*)(K + o), vv = *(const u32x4*)(V + o);
#pragma unroll
            for (int q = 0; q < 4; ++q) { qs[j * 132 + c8 + 2 * q] = bflo(qv[q]); qs[j * 132 + c8 + 2 * q + 1] = bfhi(qv[q]); ks[j * 132 + c8 + 2 * q] = bflo(kv[q]); ks[j * 132 + c8 + 2 * q + 1] = bfhi(kv[q]);
                vs[j * 132 + c8 + 2 * q] = bflo(vv[q]); vs[j * 132 + c8 + 2 * q + 1] = bfhi(vv[q]); } }
        if (F.wave == 0) {
            const int p = dir ? 63 - lane : lane;
            float x = lf[p];
#pragma unroll
            for (int o = 1; o < 64; o <<= 1) { const float y = __shfl_up(x, o); if (lane >= o) x += y; }
            const float a = ig[p] - x; float cm = a;
#pragma unroll
            for (int o = 1; o < 64; o <<= 1) { const float y = __shfl_up(cm, o); if (lane >= o) cm = fmaxf(cm, y); }
            const float M = fmaxf(m_st, cm), Mend = __shfl(M, 63), blast = __shfl(x, 63);
            as_[p] = a; Ms[p] = M; wint[p] = expf(m_st - M); enm[p] = expf(-(x + M)); wst[p] = expf(a - Mend);
            if (lane == 0) { scal[0] = Mend; scal[1] = blast; }
        }
        __syncthreads();
        const float Mend = scal[0], blast = scal[1], decay = expf(m_st - Mend);
        if (want_out) {
            { const int t = tid >> 3, sg = tid & 7; float sacc[8];
#pragma unroll
                for (int i = 0; i < 8; ++i) sacc[i] = 0.f;
                for (int d4 = 0; d4 < 32; ++d4) { const f32x4 q4 = *(const LAS f32x4*)(qs + t * 132 + d4 * 4);
#pragma unroll
                    for (int i = 0; i < 8; ++i) { const f32x4 k4 = *(const LAS f32x4*)(ks + (i * 8 + sg) * 132 + d4 * 4); sacc[i] += (q4[0] * k4[0] + q4[1] * k4[1]) + (q4[2] * k4[2] + q4[3] * k4[3]); } }
#pragma unroll
                for (int i = 0; i < 8; ++i) { const int s = i * 8 + sg; const bool valid = dir ? (s >= t) : (s <= t); st[t * 65 + s] = valid ? sacc[i] * expf(as_[s] - Ms[t]) : 0.f; } }
            __syncthreads();
            if (tid < 64) { const int t = tid; float qn = 0.f, ssum = 0.f;
                for (int d = 0; d < 128; ++d) qn += qs[t * 132 + d] * nvec[d];
                for (int s = 0; s < 64; ++s) ssum += st[t * 65 + s];
                const float den = wint[t] * qn + ssum; denom[t] = fmaxf(fabsf(den), enm[t]); }
            float mine[16];
#pragma unroll
            for (int tt = 0; tt < 16; ++tt) {
                mine[tt] = 0.f;
#pragma unroll
                for (int u = 0; u < 4; ++u) { const int t = 4 * tt + u; float p = 0.f;
#pragma unroll
                    for (int i4 = 0; i4 < 8; ++i4) { const f32x4 q4 = *(const LAS f32x4*)(qs + t * 132 + dq * 32 + i4 * 4); p += (Creg[4 * i4] * q4[0] + Creg[4 * i4 + 1] * q4[1]) + (Creg[4 * i4 + 2] * q4[2] + Creg[4 * i4 + 3] * q4[3]); }
                    p += __shfl_xor(p, 1); p += __shfl_xor(p, 2);
                    mine[tt] = (u == dq) ? p : mine[tt]; asm volatile("" ::: "memory"); }
            }
#pragma unroll
            for (int tt = 0; tt < 16; ++tt) { const int t = 4 * tt + dq; float intra = 0.f;
#pragma unroll 8
                for (int s = 0; s < 64; ++s) intra += st[t * 65 + s] * vs[s * 132 + e];
                mine[tt] = wint[t] * mine[tt] + intra; asm volatile("" ::: "memory"); }
            __syncthreads();
#pragma unroll
            for (int tt = 0; tt < 16; ++tt) { const int t = 4 * tt + dq; H[(size_t)toks[t] * 512 + h * 128 + e] = (bf16_t)f2bf(mine[tt] / denom[t]); }
        }
#pragma unroll
        for (int i = 0; i < 32; ++i) Creg[i] *= decay;
#pragma unroll 2
        for (int s = 0; s < 64; ++s) { const float wv = wst[s] * vs[s * 132 + e];
#pragma unroll
            for (int i4 = 0; i4 < 8; ++i4) { const f32x4 k4 = *(const LAS f32x4*)(ks + s * 132 + dq * 32 + i4 * 4); Creg[4 * i4] += wv * k4[0]; Creg[4 * i4 + 1] += wv * k4[1]; Creg[4 * i4 + 2] += wv * k4[2]; Creg[4 * i4 + 3] += wv * k4[3]; } }
        float nn = 0.f;
        if (tid < 128) { nn = decay * nvec[tid]; for (int s = 0; s < 64; ++s) nn += wst[s] * ks[s * 132 + tid]; }
        __syncthreads();
        if (tid < 128) nvec[tid] = nn;
        m_st = blast + Mend;
        __syncthreads();
    }
}

__device__ __forceinline__ int scan_tok(bool isctx, int b, int h, int c, int j) {
    return isctx ? NLAT + b * CTXL + c * 64 + j : (h < 2 ? b * SEQ + c * 64 + j : b * SEQ + (j & 31) * 64 + 2 * c + (j >> 5));
}
__device__ __forceinline__ int img256(int row, int chunk) { return row * 256 + ((chunk ^ (row & 15)) << 4); }
__device__ __forceinline__ int img128(int row, int chunk) { return row * 128 + ((chunk ^ ((row >> 1) & 7)) << 4); }
__device__ __forceinline__ int off_b(int row, int ch) { return 256 * row + 16 * (ch ^ (((row & 3) << 2) | ((row >> 2) & 3))); }
__device__ __forceinline__ int rowrd16(int lane, int rb, int ks) { return off_b((lane & 15) + 16 * rb, 4 * ks + (lane >> 4)); }
__device__ __forceinline__ int trrd16(int lane, int c, int ks, int t) { const int g = lane >> 4, q = (lane & 15) >> 2, p = lane & 3;
    return off_b(32 * ks + 8 * g + 4 * t + q, 2 * c + (p >> 1)) + 8 * (p & 1); }
typedef short s16x4 __attribute__((ext_vector_type(4)));
__device__ __forceinline__ bf16x8 tr_frag(LAS unsigned char* img, int lane, int c, int ks, unsigned zv) {
    const s16x4 lo = __builtin_amdgcn_ds_read_tr16_b64_v4i16((LAS s16x4*)(img + trrd16(lane, c, ks, 0)));
    const s16x4 hi = __builtin_amdgcn_ds_read_tr16_b64_v4i16((LAS s16x4*)(img + trrd16(lane, c, ks, 1)));
    u32x2 a = __builtin_bit_cast(u32x2, lo), b = __builtin_bit_cast(u32x2, hi);
    a.x ^= zv; a.y ^= zv; b.x ^= zv; b.y ^= zv;
    const u32x4 r = (u32x4){a.x, a.y, b.x, b.y};
    return __builtin_bit_cast(bf16x8, r);
}
__device__ __forceinline__ void scan_mfma(Frame& F, int l) {
    if (F.bid >= 64) return;
    const int b = F.bid >> 3, h = (F.bid >> 1) & 3, dir = F.bid & 1;
    LAS unsigned char* L = F.lds;
    constexpr int O_QI = 0, O_KI = 16384, O_VI = 32768, O_ST = 49152, O_CL = 57344, O_HO = 94208, O_SM = 110592;
    LAS float* GV = (LAS float*)(L + O_SM);
    LAS float* SC = GV + 36 * 192;
    LAS float* DEN = SC + 36 * 4;
    const bf16_t* Q = WSP(bf16_t, WS_Q); const bf16_t* K = WSP(bf16_t, WS_K); const bf16_t* V = WSP(bf16_t, WS_V); const float* GATES = WSP(float, WS_GATES);
    bf16_t* H = dir ? WSP(bf16_t, WS_HB) : WSP(bf16_t, WS_HF);
    const int w = F.wave;
    { unsigned z0 = 0u; asm volatile("" : "+v"(z0));
      for (int i = F.tid; i < 36864 / 16; i += NTHR) *(LAS u32x4*)(L + O_CL + i * 16) = (u32x4){z0, z0, z0, z0}; }
    for (int cc = w; cc < 36; cc += NWAVES) {
        const bool ic = cc < 4; const int c_ = ic ? (dir ? 3 - cc : cc) : (dir ? 35 - cc : cc - 4), p_ = dir ? 63 - F.lane : F.lane;
        const f32x2 g = *(const f32x2*)(GATES + (size_t)scan_tok(ic, b, h, c_, p_) * 16 + h * 4 + 2 * dir);
        float x = logsigmoidf_(g[1]);
#pragma unroll
        for (int o = 1; o < 64; o <<= 1) { const float y = __shfl_up(x, o); if (F.lane >= o) x += y; }
        const float a = g[0] - x; float cm = a;
#pragma unroll
        for (int o = 1; o < 64; o <<= 1) { const float y = __shfl_up(cm, o); if (F.lane >= o) cm = fmaxf(cm, y); }
        GV[cc * 192 + p_] = a; GV[cc * 192 + 64 + p_] = x; GV[cc * 192 + 128 + p_] = cm;
        if (F.lane == 63) { SC[cc * 4 + 3] = x; SC[cc * 4 + 1] = cm; }
    }
    __syncthreads();
    if (F.tid == 0) { float m = 0.f;
        for (int cc = 0; cc < 36; ++cc) { const float Mend = fmaxf(m, SC[cc * 4 + 1]); SC[cc * 4 + 0] = m; SC[cc * 4 + 1] = Mend; SC[cc * 4 + 2] = expf(m - Mend); m = SC[cc * 4 + 3] + Mend; } }
    f32x4 accC[9];
#pragma unroll
    for (int i = 0; i < 9; ++i) accC[i] = (f32x4){0.f, 0.f, 0.f, 0.f};
    u32x4 pq[2], pk[2], pv[2];
#define SC_LOAD(CC) do { const int cc_ = (CC); const bool ic_ = cc_ < 4; const int c_ = ic_ ? (dir ? 3 - cc_ : cc_) : (dir ? 35 - cc_ : cc_ - 4); \
        _Pragma("unroll") for (int i_ = 0; i_ < 2; ++i_) { const int it_ = tid + NTHR * i_, s_ = it_ >> 4, c8_ = it_ & 15; const size_t o_ = (size_t)scan_tok(ic_, b, h, c_, s_) * 512 + h * 128 + c8_ * 8; \
            pq[i_] = *(const u32x4*)(Q + o_); pk[i_] = *(const u32x4*)(K + o_); pv[i_] = *(const u32x4*)(V + o_); } } while (0)
#define SC_WRITE() do { _Pragma("unroll") for (int i_ = 0; i_ < 2; ++i_) { const int it_ = tid + NTHR * i_, s_ = it_ >> 4, c8_ = it_ & 15; \
            *(LAS u32x4*)(L + O_QI + img256(s_, c8_)) = pq[i_]; *(LAS u32x4*)(L + O_KI + off_b(s_, c8_)) = pk[i_]; *(LAS u32x4*)(L + O_VI + off_b(s_, c8_)) = pv[i_]; } } while (0)
#define SC_MFMA(A, B, C) __builtin_amdgcn_mfma_f32_16x16x32_bf16((A), (B), (C), 0, 0, 0)
#define SC_BAR() do { asm volatile("s_waitcnt lgkmcnt(0)" ::: "memory"); __builtin_amdgcn_s_barrier(); asm volatile("" ::: "memory"); } while (0)
    {
        const int tid = F.tid;
        SC_LOAD(0);
        __syncthreads();
        SC_WRITE();
        __syncthreads();
    }
    for (int cc = 0; cc < 36; ++cc) {
        int tid = F.tid; asm volatile("" : "+v"(tid));
        const int lane = tid & 63, fr = lane & 15, fq = lane >> 4;
        const bool isctx = cc < 4, want_out = !(isctx && l == 1), more = cc + 1 < 36;
        const int c = isctx ? (dir ? 3 - cc : cc) : (dir ? 35 - cc : cc - 4);
        const LAS float* vb = GV + cc * 192; const float m_in = SC[cc * 4 + 0];
        unsigned zv = 0u; asm volatile("" : "+v"(zv));
        const short one_ = (fr == 0) ? (short)0x3F80 : (short)0;
        const bf16x8 ONES = (bf16x8){one_, one_, one_, one_, one_, one_, one_, one_};
        if (more) SC_LOAD(cc + 1);
        if (want_out) {
            const int tb = w >> 1, sb = 2 * (w & 1);
            f32x4 s0 = (f32x4){0.f, 0.f, 0.f, 0.f}, s1 = s0;
#pragma unroll
            for (int ks = 0; ks < 4; ++ks) {
                const bf16x8 fy = *(const LAS bf16x8*)(L + O_QI + img256(tb * 16 + fr, ks * 4 + fq));
                const bf16x8 fx0 = *(const LAS bf16x8*)(L + O_KI + rowrd16(lane, sb, ks)), fx1 = *(const LAS bf16x8*)(L + O_KI + rowrd16(lane, sb + 1, ks));
                s0 = SC_MFMA(fx0, fy, s0); s1 = SC_MFMA(fx1, fy, s1); }
            const int t = tb * 16 + fr; const float Mt = fmaxf(m_in, vb[128 + t]);
#pragma unroll
            for (int i = 0; i < 2; ++i) { const int sr0 = (sb + i) * 16 + 4 * fq; const f32x4 a4 = *(const LAS f32x4*)(vb + sr0); const f32x4 sv = i ? s1 : s0; f32x4 o;
#pragma unroll
                for (int r = 0; r < 4; ++r) { const int sI = sr0 + r; const bool valid = dir ? (sI >= t) : (sI <= t); o[r] = valid ? sv[r] * __expf(a4[r] - Mt) : 0.f; }
                *(LAS u32x2*)(L + O_ST + img128(t, sr0 >> 3) + (sr0 & 7) * 2) = pk4(o); }
        }
        SC_BAR();
        {
            const float decay = SC[cc * 4 + 2], Mend = SC[cc * 4 + 1];
#pragma unroll
            for (int et = 0; et < 9; ++et) accC[et] = accC[et] * decay;
#pragma unroll
            for (int ks = 0; ks < 2; ++ks) {
                const bf16x8 kx = tr_frag(L + O_KI, lane, w, ks, zv);
                const f32x4 a0 = *(const LAS f32x4*)(vb + 32 * ks + 8 * fq), a1 = *(const LAS f32x4*)(vb + 32 * ks + 8 * fq + 4);
                u32x4 ax;
#pragma unroll
                for (int j = 0; j < 4; ++j) { const float w0 = __expf((j < 2 ? a0[2 * j] : a1[2 * j - 4]) - Mend), w1 = __expf((j < 2 ? a0[2 * j + 1] : a1[2 * j - 3]) - Mend);
                    ax[j] = pk2(bf2f((unsigned short)kx[2 * j]) * w0, bf2f((unsigned short)kx[2 * j + 1]) * w1); }
                const bf16x8 axf = __builtin_bit_cast(bf16x8, ax);
#pragma unroll
                for (int et = 0; et < 8; ++et) { const bf16x8 fv = tr_frag(L + O_VI, lane, et, ks, zv); accC[et] = SC_MFMA(axf, fv, accC[et]); }
                accC[8] = SC_MFMA(axf, ONES, accC[8]);
            }
        }
        f32x4 num[4];
        if (want_out) {
            bf16x8 ac[4], av[2];
#pragma unroll
            for (int ks = 0; ks < 4; ++ks) ac[ks] = *(const LAS bf16x8*)(L + O_CL + img256(w * 16 + fr, ks * 4 + fq));
#pragma unroll
            for (int ks = 0; ks < 2; ++ks) av[ks] = tr_frag(L + O_VI, lane, w, ks, zv);
#pragma unroll
            for (int tb = 0; tb < 4; ++tb) {
                f32x4 nI = (f32x4){0.f, 0.f, 0.f, 0.f}, nS = nI;
#pragma unroll
                for (int ks = 0; ks < 4; ++ks) { const bf16x8 fy = *(const LAS bf16x8*)(L + O_QI + img256(tb * 16 + fr, ks * 4 + fq)); nI = SC_MFMA(ac[ks], fy, nI); }
#pragma unroll
                for (int ks = 0; ks < 2; ++ks) { const bf16x8 fs = *(const LAS bf16x8*)(L + O_ST + img128(tb * 16 + fr, ks * 4 + fq)); nS = SC_MFMA(av[ks], fs, nS); }
                num[tb] = nI * __expf(m_in - fmaxf(m_in, vb[128 + tb * 16 + fr])) + nS;
            }
            if (w < 4) {
                f32x4 dI = (f32x4){0.f, 0.f, 0.f, 0.f}, dS = dI;
#pragma unroll
                for (int ks = 0; ks < 4; ++ks) { const bf16x8 a8 = *(const LAS bf16x8*)(L + O_CL + img256(128 + fr, ks * 4 + fq)); const bf16x8 fy = *(const LAS bf16x8*)(L + O_QI + img256(w * 16 + fr, ks * 4 + fq)); dI = SC_MFMA(a8, fy, dI); }
#pragma unroll
                for (int ks = 0; ks < 2; ++ks) { const bf16x8 fs = *(const LAS bf16x8*)(L + O_ST + img128(w * 16 + fr, ks * 4 + fq)); dS = SC_MFMA(ONES, fs, dS); }
                const int t = w * 16 + fr; const float Mt = fmaxf(m_in, vb[128 + t]); const float den = __expf(m_in - Mt) * dI[0] + dS[0];
                if (lane < 16) DEN[t] = fmaxf(fabsf(den), __expf(-(vb[64 + t] + Mt)));
            }
        }
        SC_BAR();
        if (want_out) {
#pragma unroll
            for (int tb = 0; tb < 4; ++tb) { const int t = tb * 16 + fr, e0 = w * 16 + 4 * fq; const float rd = 1.0f / DEN[t];
                *(LAS u32x2*)(L + O_HO + img256(t, e0 >> 3) + (e0 & 7) * 2) = pk4(num[tb] * rd); }
        }
#pragma unroll
        for (int et = 0; et < 9; ++et) { const int d0 = w * 16 + 4 * fq; *(LAS u32x2*)(L + O_CL + img256(et * 16 + fr, d0 >> 3) + (d0 & 7) * 2) = pk4(accC[et]); }
        if (more) SC_WRITE();
        SC_BAR();
        if (want_out) {
            const int t = tid >> 3; bf16_t* hp = H + (size_t)scan_tok(isctx, b, h, c, t) * 512 + h * 128;
#pragma unroll
            for (int i = 0; i < 2; ++i) { const int ch = (tid & 7) * 2 + i; *(u32x4*)(hp + ch * 8) = *(const LAS u32x4*)(L + O_HO + img256(t, ch)); }
        }
    }
#undef SC_LOAD
#undef SC_WRITE
#undef SC_MFMA
#undef SC_BAR
}

__device__ __forceinline__ void helper_barrier(Frame& F, unsigned* cnt, unsigned nhelpers) {
    asm volatile("s_waitcnt vmcnt(0)" ::: "memory");
    __syncthreads();
    if (F.tid == 0) {
        __builtin_amdgcn_fence(__ATOMIC_RELEASE, "agent");
        asm volatile("s_waitcnt vmcnt(0)" ::: "memory");
        __hip_atomic_fetch_add(cnt, 1u, __ATOMIC_RELAXED, __HIP_MEMORY_SCOPE_AGENT);
        unsigned sp = 0;
        while (__hip_atomic_load(cnt, __ATOMIC_RELAXED, __HIP_MEMORY_SCOPE_AGENT) < nhelpers) { __builtin_amdgcn_s_sleep(2); if (++sp > (1u << 22)) break; }
        __builtin_amdgcn_fence(__ATOMIC_ACQUIRE, "agent");
        asm volatile("s_waitcnt vmcnt(0)" ::: "memory");
    }
    __syncthreads();
}

constexpr int NPHASES = 20;
enum { K_PREP = 0, K_NORM1, K_INPROJ, K_MIX1, K_MIX2, K_OUTPROJ, K_NORM2, K_TOPK, K_MOE1, K_MOE2, K_COMBINE };

__global__ void __launch_bounds__(NTHR, 2) fwd_kernel(Args args) {
    extern __shared__ __attribute__((aligned(16))) unsigned char lds_raw[];
    Frame F{(LAS unsigned char*)lds_raw, (int)threadIdx.x, (int)(threadIdx.x & 63), __builtin_amdgcn_readfirstlane((int)(threadIdx.x >> 6)), (int)gridDim.x, (int)blockIdx.x, (GAS unsigned char*)args.ws, args};
    volatile LAS unsigned* MISC = (volatile LAS unsigned*)(F.lds + LDSCTL_OFF);
    if (F.tid < 16) MISC[F.tid] = 0u;
    __syncthreads();
    XcdBarrier bar; bar.bar = (unsigned*)(F.ws + WS_CTL); bar.x = 0; bar.st = MISC;
    const int lo = args.ph_lo, hi = args.ph_hi;
    if (hi - lo > 1) bar = xcd_barrier_post((unsigned*)(F.ws + WS_CTL), MISC);
    for (int ph = lo; ph < hi; ++ph) {
        int l, kind;
        if (ph == 0) { l = 0; kind = K_PREP; } else if (ph == 1) { l = 0; kind = K_NORM1; } else if (ph < 11) { l = 0; kind = K_INPROJ + (ph - 2); } else { l = 1; kind = K_INPROJ + (ph - 11); }
#ifndef PHMASK
#define PHMASK 0xFFFF
#endif
#define PHON(k) ((PHMASK >> (k)) & 1)
#ifndef REPMASK
#define REPMASK 0
#endif
        int nrep_ = 1 + ((REPMASK >> kind) & 1); asm volatile("" : "+s"(nrep_));
        for (int rep_ = 0; rep_ < nrep_; ++rep_) {
        if (rep_) xcd_barrier(bar);
        { int t_ = threadIdx.x, b_ = blockIdx.x; GAS unsigned char* w_ = (GAS unsigned char*)args.ws; asm volatile("" : "+v"(t_)); asm volatile("" : "+s"(b_)); asm volatile("" : "+s"(w_));
          F.tid = t_; F.lane = t_ & 63; F.wave = __builtin_amdgcn_readfirstlane(t_ >> 6); F.bid = b_; F.ws = w_; }
        l = __builtin_amdgcn_readfirstlane(l); kind = __builtin_amdgcn_readfirstlane(kind); asm volatile("" : "+s"(l)); asm volatile("" : "+s"(kind));
        GAS unsigned char* ws = F.ws;
        bool run_gemm = (kind == K_INPROJ || kind == K_OUTPROJ || kind == K_MOE1 || kind == K_MOE2);
        int gm = kind == K_INPROJ ? GM_INPROJ : kind == K_OUTPROJ ? GM_OUT : kind == K_MOE1 ? GM_MOE1 : GM_MOE2, gc = F.bid, gG = F.G;
        const bool helper = (kind == K_MIX1) && (F.bid >= 64);
        switch (kind) {
        case K_PREP: if (PHON(0)) phase_prep(F); break;
        case K_NORM1: if (PHON(1)) phase_norm1_l0(F); break;
        case K_MIX1: if (PHON(3)) {
            if (!helper) scan_mfma(F, l);
            else { const int hb = F.bid - 64, hg = F.G - 64;
                conv_items(F, l, hb, hg);
                ztrans_items(F, l, hb * NWAVES + F.wave, hg * NWAVES);
                helper_barrier(F, (unsigned*)(ws + WS_CTL) + 8192 + 64 * l + 64 * 2 * rep_, (unsigned)hg);
                run_gemm = true; gm = GM_DFT; gc = hb; gG = hg; }
        } break;
        case K_MIX2: if (PHON(4)) finalize_h(F, l); break;
        case K_NORM2: if (PHON(6)) phase_norm2(F, l); break;
        case K_TOPK: if (PHON(7)) phase_topk(F, l); break;
        case K_COMBINE: if (PHON(10)) phase_combine(F, l); break;
        default: break;
        }
        if (run_gemm && PHON(2)) {
            GemmCtl S{gm, l, gG, gc, ws, F.A};
            const int ld = gm == GM_OUT ? KOUT : D;
            GEMM_PHASE(F.lds, ld, ld, S, S);
        }
        if (helper && PHON(3)) convert_moe_weights(F, l, (F.bid - 64) * NWAVES + F.wave, (F.G - 64) * NWAVES);
        }
        if (ph + 1 < hi) xcd_barrier(bar);
    }
}

extern "C" void kernel_launch(void* const* d_in, const int* in_sizes, int n_in, void* d_out, int out_size, void* d_ws, size_t ws_size, hipStream_t stream) {
    static int grid = 0;
    if (grid == 0) {
        if (n_in != 21 || out_size != NLAT * D || ws_size < WS_END) { fprintf(stderr, "kernel_launch: unexpected shapes (n_in %d out %d ws %zu need %zu)\n", n_in, out_size, ws_size, (size_t)WS_END); grid = -1; return; }
        int dev = 0, cus = 0, per_cu = 0;
        hipGetDevice(&dev); hipDeviceGetAttribute(&cus, hipDeviceAttributeMultiprocessorCount, dev);
        if (hipFuncSetAttribute((const void*)fwd_kernel, hipFuncAttributeMaxDynamicSharedMemorySize, LDS_BYTES) != hipSuccess) { fprintf(stderr, "kernel_launch: hipFuncSetAttribute failed\n"); grid = -1; return; }
        hipOccupancyMaxActiveBlocksPerMultiprocessor(&per_cu, (const void*)fwd_kernel, NTHR, LDS_BYTES);
        (void)hipGetLastError();
        if (per_cu < 1) fprintf(stderr, "kernel_launch: occupancy query reports %d\n", per_cu);
        grid = cus;
    }
    if (grid < 0) return;
    hipMemsetAsync((char*)d_ws + WS_CTL, 0, 65536, stream);
    Args a{};
    for (int i = 0; i < 21; ++i) a.in[i] = (const float*)d_in[i];
    a.out = (float*)d_out; a.ws = (unsigned char*)d_ws;
#if N_LAUNCHES == 1
    a.ph_lo = 0; a.ph_hi = NPHASES;
    void* kargs[] = {&a};
    hipError_t e = hipLaunchCooperativeKernel((const void*)fwd_kernel, dim3(grid), dim3(NTHR), kargs, LDS_BYTES, stream);
    if (e != hipSuccess) fprintf(stderr, "kernel_launch: cooperative launch failed: %s (grid %d)\n", hipGetErrorString(e), grid);
#else
#ifndef MAXPH
#define MAXPH NPHASES
#endif
    for (int ph = 0; ph < MAXPH; ++ph) { a.ph_lo = ph; a.ph_hi = ph + 1; hipLaunchKernelGGL(fwd_kernel, dim3(grid), dim3(NTHR), LDS_BYTES, stream, a); }
#endif
}
```

```cpp
#include <hip/hip_runtime.h>
#include <cstdio>
#include <cstdint>

#ifndef N_LAUNCHES
#define N_LAUNCHES 1
#endif
#ifndef USE_MFMA_GEMM
#define USE_MFMA_GEMM 1
#endif

#define LAS __attribute__((address_space(3)))
#define GAS __attribute__((address_space(1)))
typedef unsigned short bf16_t;
typedef short bf16x8 __attribute__((ext_vector_type(8)));
typedef float f32x4 __attribute__((ext_vector_type(4)));
typedef float f32x2 __attribute__((ext_vector_type(2)));
typedef unsigned u32x4 __attribute__((ext_vector_type(4)));
typedef unsigned u32x2 __attribute__((ext_vector_type(2)));
typedef GAS unsigned gu32;
#define RLX_AGENT __ATOMIC_RELAXED, __HIP_MEMORY_SCOPE_AGENT
#define LDS_WAIT() asm volatile("s_waitcnt lgkmcnt(0)" ::: "memory")
#define VM_WAIT() asm volatile("s_waitcnt vmcnt(0)" ::: "memory")

constexpr int D = 1024, NB = 8, SEQ = 2048, CTXL = 256;
constexpr int NLAT = NB * SEQ, NCTX = NB * CTXL, NTOK = NLAT + NCTX;
constexpr int INC = 2832, NIN = 2816;
constexpr int KOUT = 1280;
constexpr int NE = 16, RPE = 2304;
constexpr float EPS = 1e-6f;
constexpr int NTHR = 512, NWAVES = 8;

constexpr size_t al256(size_t x) { return (x + 255) & ~(size_t)255; }
constexpr size_t WS_CTL = 0;
constexpr size_t WS_MOD = WS_CTL + 65536;
constexpr size_t WS_WIN = WS_MOD + al256((size_t)2 * 9 * 6144 * 4);
constexpr size_t WS_WOUT = WS_WIN + (size_t)2 * NIN * D * 2;
constexpr size_t WS_WGU = WS_WOUT + (size_t)2 * D * KOUT * 2;
constexpr size_t WS_WD = WS_WGU + (size_t)NE * 2048 * D * 2;
constexpr size_t WS_FL = WS_WD + (size_t)NE * D * D * 2;
constexpr size_t WS_FC = WS_FL + (size_t)4096 * 1024 * 2;
constexpr size_t WS_X = WS_FL + (size_t)4096 * 2048 * 2 + (size_t)512 * 2048 * 2;
constexpr size_t WS_XN = WS_X + (size_t)NTOK * D * 4;
constexpr size_t WS_GATES = WS_XN + (size_t)NTOK * D * 2;
constexpr size_t WS_AFF = WS_GATES + (size_t)NTOK * 16 * 4;
constexpr size_t WS_INV = WS_AFF + (size_t)NTOK * 16 * 4;
constexpr size_t WS_ROWTOK = WS_INV + (size_t)NTOK * 16 * 4;
constexpr size_t WS_GATEV = WS_ROWTOK + (size_t)NE * RPE * 4;
constexpr size_t WS_R1 = WS_GATEV + (size_t)NE * RPE * 4;
constexpr size_t SZ_QKV = (size_t)NTOK * 512 * 2;
constexpr size_t WS_Q = WS_R1, WS_K = WS_Q + SZ_QKV, WS_V = WS_K + SZ_QKV, WS_O = WS_V + SZ_QKV;
constexpr size_t WS_HID = WS_R1;
constexpr size_t WS_R2 = WS_R1 + 4 * SZ_QKV;
constexpr size_t SZ_C = (size_t)NTOK * 256 * 2;
constexpr size_t WS_CA = WS_R2, WS_CG = WS_CA + SZ_C, WS_FR = WS_CG + SZ_C, WS_ZT = WS_FR + SZ_C;
constexpr size_t WS_ZO = WS_ZT + (size_t)2048 * 1024 * 2;
constexpr size_t WS_ZTC = WS_ZT + (size_t)2048 * 2048 * 2;
constexpr size_t WS_HF = WS_ZT + 2 * (size_t)2048 * 2048 * 2, WS_HB = WS_HF + SZ_QKV, WS_Y = WS_HB + SZ_QKV;
constexpr size_t WS_YS = WS_R2;
constexpr size_t WS_END = WS_Y + (size_t)NTOK * KOUT * 2;
static_assert((size_t)NE * RPE * D * 2 <= 4 * SZ_QKV, "HID alias");
static_assert(WS_YS + (size_t)NE * RPE * D * 2 <= WS_END, "YS alias");

constexpr int RING_BYTES = 139264;
constexpr int LDSCTL_OFF = RING_BYTES;
constexpr int LDS_BYTES = RING_BYTES + 1024;

#define GAS __attribute__((address_space(1)))
template <class T> __device__ __forceinline__ T* as_global(T* p) { return (T*)(GAS T*)(uintptr_t)p; }
__device__ __forceinline__ u32x4 widen16(u32x2 a, u32x2 b) {
    asm volatile("s_nop 1\n\tv_permlane16_swap_b32 %0, %2\n\tv_permlane16_swap_b32 %1, %3\n\ts_nop 1" : "+v"(a.x), "+v"(a.y), "+v"(b.x), "+v"(b.y));
    return (u32x4){a.x, a.y, b.x, b.y};
}
__device__ __forceinline__ int widen16_col(int col, int fq) { return (col - 4 * fq) + ((fq & 1) ? 16 : 0) + 8 * (fq >> 1); }
__device__ __forceinline__ unsigned f2bf(float f) { unsigned u = __float_as_uint(f); u += 0x7FFFu + ((u >> 16) & 1u); return u >> 16; }
typedef __bf16 bf16x2_t __attribute__((ext_vector_type(2)));
__device__ __forceinline__ unsigned pk2(float lo, float hi) { const bf16x2_t r = __builtin_convertvector((f32x2){lo, hi}, bf16x2_t); return __builtin_bit_cast(unsigned, r); }
__device__ __forceinline__ float bf2f(unsigned b) { return __uint_as_float(b << 16); }
__device__ __forceinline__ float bflo(unsigned w) { return __uint_as_float(w << 16); }
__device__ __forceinline__ float bfhi(unsigned w) { return __uint_as_float(w & 0xffff0000u); }
__device__ __forceinline__ float sigmoidf_(float x) { return __builtin_amdgcn_rcpf(1.0f + __expf(-x)); }
__device__ __forceinline__ float siluf_(float x) { return x * __builtin_amdgcn_rcpf(1.0f + __expf(-x)); }
__device__ __forceinline__ float logsigmoidf_(float x) { return x >= 0.f ? -log1pf(expf(-x)) : x - log1pf(expf(x)); }
__device__ __forceinline__ float wave_sum(float v) {
#pragma unroll
    for (int o = 1; o < 64; o <<= 1) v += __shfl_xor(v, o);
    return v;
}
__device__ __forceinline__ u32x2 pk4(f32x4 v) { u32x2 w; w.x = pk2(v[0], v[1]); w.y = pk2(v[2], v[3]); return w; }

#define XB_TMO      128
#define XB_XCNT(j)  (256  + 64 * (j))
#define XB_XSUB(j)  (1280 + 64 * (j))
#define XB_XGEN(j)  (2304 + 64 * (j))
#define XB_TOP      3328
#define XB_TOPGEN   3392
#define XCD_BAR_WORDS 3456
#define XB_HXCNT(j) (13312 + 16 * (j))
#define XB_HSUB     13568
#define XB_MODRDY   12288
#define XB_SPIN_CAP (1u << 22)
__device__ __forceinline__ unsigned xb_ld(unsigned* p)              { return __hip_atomic_load(p, __ATOMIC_RELAXED, __HIP_MEMORY_SCOPE_AGENT); }
__device__ __forceinline__ unsigned xb_add(unsigned* p, unsigned v) { return __hip_atomic_fetch_add(p, v, __ATOMIC_RELAXED, __HIP_MEMORY_SCOPE_AGENT); }
__device__ __forceinline__ unsigned xb_xcc_id() { return (unsigned)__builtin_amdgcn_s_getreg((3 << 11) | 20) & 0xFu; }
#define XB_SPIN(cond, bar) do { unsigned _sp = 0; while (cond) { __builtin_amdgcn_s_sleep(1); \
    if ((++_sp & 255u) == 0u) { if (xb_ld(&(bar)[XB_TMO])) break; if (_sp > XB_SPIN_CAP) { atomicAdd(&(bar)[XB_TMO], 1u); break; } } } } while (0)
struct XcdBarrier { unsigned* bar; unsigned x; volatile LAS unsigned* st; };
__device__ __forceinline__ XcdBarrier xcd_barrier_post(unsigned* bar, volatile LAS unsigned* st) {
    XcdBarrier b; b.bar = bar; b.x = xb_xcc_id(); b.st = st;
    if (threadIdx.x == 0) (void)xb_add(&bar[XB_XCNT(b.x)], 1u);
    return b;
}
__device__ __forceinline__ void xcd_barrier_complete(unsigned* bar, unsigned x, unsigned& nloc, unsigned& nx) {
    const unsigned G = gridDim.x * gridDim.y * gridDim.z;
    unsigned sum, cnt, mine, sp = 0u;
    for (;;) {
        sum = 0u; cnt = 0u; mine = 0u;
#pragma unroll
        for (unsigned j = 0; j < 16; ++j) { const unsigned c = xb_ld(&bar[XB_XCNT(j)]); sum += c; cnt += (c > 0u) ? 1u : 0u; mine = (j == x) ? c : mine; }
        if (sum == G) break;
        __builtin_amdgcn_s_sleep(1);
        if ((++sp & 255u) == 0u) { if (xb_ld(&bar[XB_TMO])) break; if (sp > XB_SPIN_CAP) { atomicAdd(&bar[XB_TMO], 1u); break; } }
    }
    nloc = mine > 0u ? mine : 1u; nx = cnt > 0u ? cnt : 1u;
}
__device__ __forceinline__ void xcd_barrier(const XcdBarrier& b) {
    asm volatile("s_waitcnt vmcnt(0)" ::: "memory");
    __syncthreads();
    if (threadIdx.x == 0) {
        unsigned* bar = b.bar;
        __builtin_amdgcn_s_waitcnt(0);
        asm volatile("buffer_inv sc1" ::: "memory");
        const unsigned old = xb_add(&bar[XB_XSUB(b.x)], 1u);
        unsigned nloc = b.st[0], nx = b.st[1];
        if (nloc == 0u) { xcd_barrier_complete(bar, b.x, nloc, nx); b.st[0] = nloc; b.st[1] = nx; }
        const unsigned gen = old / nloc;
        if (old + 1u == (gen + 1u) * nloc) {
            __builtin_amdgcn_fence(__ATOMIC_RELEASE, "agent");
            asm volatile("s_waitcnt vmcnt(0)" ::: "memory");
            const unsigned og = xb_add(&bar[XB_TOP], 1u);
            const unsigned tg = og / nx;
            if (og + 1u == (tg + 1u) * nx) xb_add(&bar[XB_TOPGEN], 1u);
            else XB_SPIN(xb_ld(&bar[XB_TOPGEN]) == tg, bar);
            xb_add(&bar[XB_XGEN(b.x)], 1u);
            asm volatile("s_waitcnt vmcnt(0)" ::: "memory");
        } else {
            XB_SPIN(xb_ld(&bar[XB_XGEN(b.x)]) == gen, bar);
            asm volatile("s_waitcnt vmcnt(0)" ::: "memory");
        }
    }
    __syncthreads();
}

namespace pg8 {
constexpr int BM = 256, BK = 64, HALF = 128, HTB = HALF * BK * 2, STAGE_BYTES = 8 * HTB, NXCD = 8, WGM = 4;
__host__ __device__ __forceinline__ int lds_byte(int r, int c) { const int st = (r >> 4) * 2 + (c >> 5), rr = r & 15, cc = c & 31, ob = rr * 64 + cc * 2; return st * 1024 + (ob ^ (((ob >> 9) & 1) << 5)); }
__host__ __device__ __forceinline__ void stage_rc(int b, int& R, int& C) { const int st = b / 1024, sb = b % 1024, swz = sb ^ (((sb >> 9) & 1) << 5); R = (st >> 1) * 16 + swz / 64; C = (st & 1) * 32 + (swz % 64) / 2; }

struct Unit { const char* A; const char* B; const int* rows; int K, pm, pn, ex; };

__device__ __forceinline__ void map_tile(int L, int nM, int nN, int& pm, int& pn) {
    const int nwg = nM * nN; int wgid = L;
    { const int q = nwg / NXCD, r = nwg % NXCD, xcd = wgid % NXCD, off = wgid / NXCD; wgid = (xcd < r ? xcd * (q + 1) : r * (q + 1) + (xcd - r) * q) + off; }
    const int nig = WGM * nN, gid = wgid / nig, fm = gid * WGM, gsz = (nM - fm) < WGM ? (nM - fm) : WGM;
    pm = fm + ((wgid % nig) % gsz); pn = (wgid % nig) / gsz;
}
__device__ __forceinline__ void a_offs(const Unit& u, int lda, int tid, unsigned (&vA)[2][2]) {
#pragma unroll
    for (int h = 0; h < 2; ++h)
#pragma unroll
        for (int i = 0; i < 2; ++i) { int R, C; stage_rc(tid * 16 + i * 8192, R, C); const int r = h * HALF + R; const int ar = u.rows ? u.rows[r] : r; vA[h][i] = (unsigned)(ar * lda + C) * 2u; }
}

template <class Epi, class Sched>
__device__ __forceinline__ void gemm_phase(LAS unsigned char* lds, const int tid, const int lda, const int ldb, const Sched& S, const Epi& E) {
    const int wid = __builtin_amdgcn_readfirstlane(tid >> 6), lane = tid & 63, wr = wid >> 2, wc = wid & 3, fr = lane & 15, fq = lane >> 4;
    unsigned voffB[2];
#pragma unroll
    for (int i = 0; i < 2; ++i) { int R, C; stage_rc(tid * 16 + i * 8192, R, C); voffB[i] = (unsigned)(R * ldb + C) * 2u; }
    const size_t kstep = (size_t)(BK * 2);
    const size_t hsB = (size_t)HALF * ldb * 2;
    const unsigned ldsw = (unsigned)wid * 1024u;
    const int aoff = lds_byte(wr * 64 + fr, fq * 8), boff = lds_byte(wc * 32 + fr, fq * 8);
#define PG8_SA(b, h) (((b) * 2 + (h)) * HTB)
#define PG8_SB(b, h) ((4 + (b) * 2 + (h)) * HTB)
#define PG8_STAGE(bufoff, gbase, voff) do { _Pragma("unroll") for (int _i = 0; _i < 2; ++_i) \
        __builtin_amdgcn_global_load_lds((const unsigned*)((const char*)(gbase) + (voff)[_i]), (LAS unsigned*)(lds + (bufoff) + ldsw + _i * 8192), 16, 0, 0); } while (0)
#define PG8_LDA(dst, b, h) do { _Pragma("unroll") for (int m = 0; m < 4; ++m) _Pragma("unroll") for (int k = 0; k < 2; ++k) dst[m][k] = *(const LAS bf16x8*)(lds + PG8_SA(b, h) + aoff + m * 2048 + k * 1024); } while (0)
#define PG8_LDB(dst, b, h) do { _Pragma("unroll") for (int n = 0; n < 2; ++n) _Pragma("unroll") for (int k = 0; k < 2; ++k) dst[n][k] = *(const LAS bf16x8*)(lds + PG8_SB(b, h) + boff + n * 2048 + k * 1024); } while (0)
#define PG8_MMA(ai, bj, At, Bt) do { __builtin_amdgcn_s_setprio(1); _Pragma("unroll") for (int m = 0; m < 4; ++m) _Pragma("unroll") for (int n = 0; n < 2; ++n) _Pragma("unroll") for (int k = 0; k < 2; ++k) \
        acc[ai][bj][m][n] = __builtin_amdgcn_mfma_f32_16x16x32_bf16(Bt[n][k], At[m][k], acc[ai][bj][m][n], 0, 0, 0); __builtin_amdgcn_s_setprio(0); } while (0)
#define PG8_WAIT_V(n) asm volatile("s_waitcnt vmcnt(" #n ")" ::: "memory")
#define PG8_WAIT_L(n) asm volatile("s_waitcnt lgkmcnt(" #n ")" ::: "memory")
#define PG8_BAR __builtin_amdgcn_s_barrier()
#define PG8_SCHED __builtin_amdgcn_sched_barrier(0)
    Unit cur, nxt; int ui = 0;
    if (!S.next(0, cur)) return;
    f32x4 acc[2][2][4][2];
#pragma unroll
    for (int a = 0; a < 2; ++a)
#pragma unroll
        for (int b = 0; b < 2; ++b)
#pragma unroll
            for (int m = 0; m < 4; ++m)
#pragma unroll
                for (int n = 0; n < 2; ++n) acc[a][b][m][n] = (f32x4){0.f, 0.f, 0.f, 0.f};
    bf16x8 At[4][2], B0[2][2], B1[2][2];
    unsigned vA[2][2], wA[2][2];
    a_offs(cur, lda, tid, vA);
    const char* cA = cur.A; const char* cB = cur.B;
    PG8_STAGE(PG8_SB(0, 0), cB, voffB); PG8_STAGE(PG8_SB(0, 1), cB + hsB, voffB); PG8_STAGE(PG8_SA(0, 0), cA, vA[0]); PG8_STAGE(PG8_SA(0, 1), cA, vA[1]);
    if (wr == 1) PG8_BAR;
    PG8_WAIT_V(2); PG8_BAR;
    PG8_STAGE(PG8_SB(1, 0), cB + kstep, voffB); PG8_STAGE(PG8_SA(1, 0), cA + kstep, vA[0]); PG8_STAGE(PG8_SB(1, 1), cB + hsB + kstep, voffB);
    PG8_WAIT_V(6); PG8_BAR;
    for (;;) {
        const bool has_next = S.next(ui + 1, nxt);
        if (!has_next) nxt = cur;
        const char* nA = nxt.A; const char* nB = nxt.B;
        a_offs(nxt, lda, tid, wA);
        const int nt = cur.K / BK;
        asm volatile(".p2align 8" ::: "memory");
        for (int t = 0; t < nt; t += 2) {
            const bool last = (t == nt - 2);
            const char* a1 = cA + (size_t)(t + 1) * kstep;
            const char* a2 = last ? nA : cA + (size_t)(t + 2) * kstep; const char* b2 = last ? nB : cB + (size_t)(t + 2) * kstep;
            const char* a3 = a2 + kstep; const char* b3 = b2 + kstep;
            PG8_LDB(B0, 0, 0); PG8_LDB(B1, 0, 1); PG8_SCHED; PG8_LDA(At, 0, 0); PG8_STAGE(PG8_SA(1, 1), a1, vA[1]);
            if (last) {
#pragma unroll
                for (int h = 0; h < 2; ++h)
#pragma unroll
                    for (int i = 0; i < 2; ++i) vA[h][i] = wA[h][i];
            }
            PG8_WAIT_V(8); PG8_WAIT_L(0); PG8_BAR; PG8_MMA(0, 0, At, B0); PG8_MMA(0, 1, At, B1); PG8_BAR; PG8_SCHED;
            PG8_LDA(At, 0, 1); PG8_STAGE(PG8_SB(0, 0), b2, voffB); PG8_STAGE(PG8_SB(0, 1), b2 + hsB, voffB); PG8_STAGE(PG8_SA(0, 0), a2, vA[0]);
            PG8_WAIT_V(8); PG8_WAIT_L(0); PG8_BAR; PG8_MMA(1, 0, At, B0); PG8_MMA(1, 1, At, B1); PG8_BAR; PG8_SCHED;
            PG8_LDB(B0, 1, 0); PG8_LDB(B1, 1, 1); PG8_SCHED; PG8_LDA(At, 1, 0); PG8_STAGE(PG8_SA(0, 1), a2, vA[1]);
            PG8_WAIT_V(8); PG8_WAIT_L(0); PG8_BAR; PG8_MMA(0, 0, At, B0); PG8_MMA(0, 1, At, B1); PG8_BAR; PG8_SCHED;
            PG8_LDA(At, 1, 1); PG8_STAGE(PG8_SB(1, 0), b3, voffB); PG8_STAGE(PG8_SB(1, 1), b3 + hsB, voffB); PG8_STAGE(PG8_SA(1, 0), a3, vA[0]);
            PG8_WAIT_V(8); PG8_WAIT_L(0); PG8_BAR; PG8_MMA(1, 0, At, B0); PG8_MMA(1, 1, At, B1); PG8_BAR; PG8_SCHED;
        }
        if (wr == 0) PG8_BAR;
        { int fr_ = fr, fq_ = fq; asm volatile("" : "+v"(fr_), "+v"(fq_));
          E.run(acc, cur, wr, wc, fr_, fq_); }
        if (!has_next) break;
#pragma unroll
        for (int a = 0; a < 2; ++a)
#pragma unroll
            for (int b = 0; b < 2; ++b)
#pragma unroll
                for (int m = 0; m < 4; ++m)
#pragma unroll
                    for (int n = 0; n < 2; ++n) acc[a][b][m][n] = (f32x4){0.f, 0.f, 0.f, 0.f};
        cur = nxt; cA = nA; cB = nB; ++ui;
        if (wr == 1) PG8_BAR;
    }
    PG8_WAIT_V(0);
    PG8_BAR;
#undef PG8_SA
#undef PG8_SB
#undef PG8_STAGE
#undef PG8_LDA
#undef PG8_LDB
#undef PG8_MMA
#undef PG8_WAIT_V
#undef PG8_WAIT_L
#undef PG8_BAR
#undef PG8_SCHED
}
template <class Epi, class Sched>
__device__ __forceinline__ void gemm_phase_simt(LAS unsigned char* lds, const int tid, const int lda, const int ldb, const Sched& S, const Epi& E) {
    LAS float* As = (LAS float*)lds;
    LAS float* Bs = (LAS float*)(lds + 32 * 132 * 4);
    const int ty = tid >> 4, tx = tid & 15, c0 = (tx >> 2) * 32 + (tx & 3) * 4;
    const int lr = tid >> 2, lk = (tid & 3) * 8;
    Unit u;
    for (int ui = 0; S.next(ui, u); ++ui) {
        for (int sub = 0; sub < 4; ++sub) {
            const int sr = sub >> 1, sc = sub & 1;
            float acc[4][8];
#pragma unroll
            for (int i = 0; i < 4; ++i)
#pragma unroll
                for (int j = 0; j < 8; ++j) acc[i][j] = 0.f;
            const int arow = sr * 128 + lr, brow = sc * 128 + lr;
            const int ar = u.rows ? u.rows[arow] : arow;
            const bf16_t* ap = (const bf16_t*)u.A + (size_t)ar * lda + lk;
            const bf16_t* bp = (const bf16_t*)u.B + (size_t)brow * ldb + lk;
            for (int k0 = 0; k0 < u.K; k0 += 32) {
                const u32x4 av = *(const u32x4*)(ap + k0), bv = *(const u32x4*)(bp + k0);
                __syncthreads();
#pragma unroll
                for (int j = 0; j < 4; ++j) {
                    As[(lk + 2 * j) * 132 + lr] = bflo(av[j]); As[(lk + 2 * j + 1) * 132 + lr] = bfhi(av[j]);
                    Bs[(lk + 2 * j) * 132 + lr] = bflo(bv[j]); Bs[(lk + 2 * j + 1) * 132 + lr] = bfhi(bv[j]);
                }
                __syncthreads();
#pragma unroll 4
                for (int k = 0; k < 32; ++k) {
                    const f32x4 a4 = *(const LAS f32x4*)(As + k * 132 + ty * 4);
                    const f32x4 b0 = *(const LAS f32x4*)(Bs + k * 132 + c0), b1 = *(const LAS f32x4*)(Bs + k * 132 + c0 + 16);
#pragma unroll
                    for (int i = 0; i < 4; ++i)
#pragma unroll
                        for (int j = 0; j < 4; ++j) { acc[i][j] += a4[i] * b0[j]; acc[i][4 + j] += a4[i] * b1[j]; }
                }
            }
#pragma unroll
            for (int i = 0; i < 4; ++i)
                E.store1(u, sr * 128 + ty * 4 + i, sc * 128 + c0, (f32x4){acc[i][0], acc[i][1], acc[i][2], acc[i][3]}, (f32x4){acc[i][4], acc[i][5], acc[i][6], acc[i][7]});
        }
    }
    __syncthreads();
}
}

#if USE_MFMA_GEMM
#define GEMM_PHASE(lds, lda, ldb, S, E) pg8::gemm_phase(lds, F.tid, lda, ldb, S, E)
#else
#define GEMM_PHASE(lds, lda, ldb, S, E) pg8::gemm_phase_simt(lds, F.tid, lda, ldb, S, E)
#endif

struct Args { const float* in[21]; float* out; unsigned char* ws; int ph_lo, ph_hi; };
enum { I_X = 0, I_C, I_CTX, I_CCTX, I_WADA, I_BADA, I_GN1, I_WIN, I_BG, I_GH, I_CW, I_CB, I_CLG, I_CLB, I_WOUT, I_GN2, I_WR, I_WEG, I_WEU, I_WED, I_GF };
__device__ __forceinline__ const float* arg_in(const Args& a, int i) { asm volatile("" : "+s"(i)); return a.in[i]; }
struct Frame {
    LAS unsigned char* lds;
    int tid, lane, wave, G, bid;
    GAS unsigned char* ws;
    const Args& A;
};
#define FIN(i) arg_in(F.A, (i))
#define WSP(T, off) ((T*)(F.ws + (off)))

template <class Src>
__device__ __forceinline__ void tr_item(const Src& src, bf16_t* dst, int ldd, int n0, int k0, LAS float* scr, int lane) {
    f32x4 v[8];
#pragma unroll
    for (int i = 0; i < 8; ++i) v[i] = src.ld4(k0 + i * 8 + (lane >> 3), n0 + (lane & 7) * 4);
#pragma unroll
    for (int i = 0; i < 8; ++i) { LAS float* p = scr + (i * 8 + (lane >> 3)) * 33 + (lane & 7) * 4; p[0] = v[i][0]; p[1] = v[i][1]; p[2] = v[i][2]; p[3] = v[i][3]; }
    LDS_WAIT(); asm volatile("" ::: "memory");
    const int c = lane & 7;
#pragma unroll
    for (int j = 0; j < 4; ++j) { const int n = (lane >> 3) + 8 * j; const LAS float* s = scr + (8 * c) * 33 + n;
        u32x4 o; o.x = pk2(s[0 * 33], s[1 * 33]); o.y = pk2(s[2 * 33], s[3 * 33]); o.z = pk2(s[4 * 33], s[5 * 33]); o.w = pk2(s[6 * 33], s[7 * 33]);
        *(u32x4*)(dst + (size_t)(n0 + n) * ldd + k0 + 8 * c) = o; }
    LDS_WAIT(); asm volatile("" ::: "memory");
}
struct SrcWin { const float* w; __device__ __forceinline__ f32x4 ld4(int k, int n) const { return *(const f32x4*)(w + (size_t)k * INC + (n < 1536 ? n : n + 16)); } };
struct SrcPlain { const float* w; int ld; __device__ __forceinline__ f32x4 ld4(int k, int n) const { return *(const f32x4*)(w + (size_t)k * ld + n); } };
struct SrcGU { const float* wg; const float* wu; __device__ __forceinline__ f32x4 ld4(int k, int n) const { const int grp = n >> 5, i = n & 31;
    const uintptr_t base = (uintptr_t)wg + ((i < 16) ? (uintptr_t)0 : ((uintptr_t)wu - (uintptr_t)wg));
    return *(const f32x4*)(as_global((const float*)base) + (size_t)k * D + grp * 16 + (i & 15)); } };

__device__ __forceinline__ void tr_store(const f32x4 (&v)[8], bf16_t* dst, int ldd, int n0, int k0, LAS float* scr, int lane) {
#pragma unroll
    for (int i = 0; i < 8; ++i) { LAS float* p = scr + (i * 8 + (lane >> 3)) * 33 + (lane & 7) * 4; p[0] = v[i][0]; p[1] = v[i][1]; p[2] = v[i][2]; p[3] = v[i][3]; }
    LDS_WAIT(); asm volatile("" ::: "memory");
    const int c = lane & 7;
#pragma unroll
    for (int j = 0; j < 4; ++j) { const int n = (lane >> 3) + 8 * j; const LAS float* s = scr + (8 * c) * 33 + n;
        u32x4 o; o.x = pk2(s[0 * 33], s[1 * 33]); o.y = pk2(s[2 * 33], s[3 * 33]); o.z = pk2(s[4 * 33], s[5 * 33]); o.w = pk2(s[6 * 33], s[7 * 33]);
        *(u32x4*)(dst + (size_t)(n0 + n) * ldd + k0 + 8 * c) = o; }
    LDS_WAIT(); asm volatile("" ::: "memory");
}
struct MoeItem { bf16_t* dst; int n0, k0; };
__device__ __forceinline__ MoeItem moe_item_load(Frame& F, int l, int it, const float* wg, const float* wu, const float* wd, f32x4 (&v)[8]) {
    constexpr int I_GU = NE * 64 * 16;
    MoeItem m; const int lane = F.lane;
    asm volatile("" : "+v"(it));
    const bool gu = it < I_GU; const int r0 = gu ? it : it - I_GU;
    const int e = gu ? (r0 >> 10) : (r0 >> 9), r = gu ? (r0 & 1023) : (r0 & 511), sup = r >> 3, wv = r & 7;
    const int nb = gu ? (sup & 15) * 4 + (wv & 3) : (sup & 7) * 4 + (wv & 3), kb = gu ? (sup >> 4) * 2 + (wv >> 2) : (sup >> 3) * 2 + (wv >> 2);
    m.n0 = nb * 32; m.k0 = kb * 64;
    m.dst = gu ? WSP(bf16_t, WS_WGU) + (size_t)e * 2048 * D : WSP(bf16_t, WS_WD) + (size_t)e * D * D;
    const int n = m.n0 + (lane & 7) * 4, grp = n >> 5, i = n & 31;
    const size_t eoff = ((size_t)l * NE + e) * D * D;
    const uintptr_t base = gu ? ((i < 16) ? (uintptr_t)wg : (uintptr_t)wu) : (uintptr_t)wd;
    const float* p0 = as_global((const float*)base) + eoff + (size_t)(m.k0 + (lane >> 3)) * D + (gu ? grp * 16 + (i & 15) : n);
#pragma unroll
    for (int q = 0; q < 8; ++q) v[q] = *(const f32x4*)(p0 + (size_t)q * 8 * D);
    return m;
}
__device__ __forceinline__ void convert_moe_weights(Frame& F, int l, int gw, int ngw) {
    LAS float* scr = (LAS float*)(F.lds + F.wave * 8448);
    const float* w_e_gate = FIN(I_WEG); const float* w_e_up = FIN(I_WEU); const float* w_e_down = FIN(I_WED);
    constexpr int NIT = NE * 64 * 16 + NE * 32 * 16;
    if (gw >= NIT) return;
    f32x4 va[8], vb[8];
    MoeItem ma = moe_item_load(F, l, gw, w_e_gate, w_e_up, w_e_down, va), mb = ma;
    for (int it = gw; it < NIT; it += 2 * ngw) {
        const int i1 = it + ngw, i2 = it + 2 * ngw;
        mb = moe_item_load(F, l, min(i1, NIT - 1), w_e_gate, w_e_up, w_e_down, vb);
        __builtin_amdgcn_sched_barrier(0);
        tr_store(va, ma.dst, D, ma.n0, ma.k0, scr, F.lane);
        ma = moe_item_load(F, l, min(i2, NIT - 1), w_e_gate, w_e_up, w_e_down, va);
        __builtin_amdgcn_sched_barrier(0);
        tr_store(vb, mb.dst, D, mb.n0, mb.k0, scr, F.lane);
    }
}

__device__ __forceinline__ void gen_dft_matrices(Frame& F, int vb_, int vG) {
    const int tid = F.tid;
    {
        bf16_t* FL = WSP(bf16_t, WS_FL); bf16_t* FC = WSP(bf16_t, WS_FC);
        const size_t gth = (size_t)vb_ * NTHR + tid, nth = (size_t)vG * NTHR;
        for (size_t it = gth; it < (size_t)4096 * 1024 / 8; it += nth) {
            const int r = (int)(it / 128), t0 = (int)(it % 128) * 8, part = r >> 11, k = r & 2047; unsigned w[4];
#pragma unroll
            for (int j = 0; j < 4; ++j) { float v[2];
#pragma unroll
                for (int q = 0; q < 2; ++q) { const int ph = (k * (t0 + 2 * j + q)) & 2047; const float ang = (float)ph * (6.283185307179586f / 2048.f); v[q] = (part ? sinf(ang) : cosf(ang)) * 0.022097086912079608f; }
                w[j] = pk2(v[0], v[1]); }
            *(u32x4*)(FL + (size_t)r * 1024 + t0) = (u32x4){w[0], w[1], w[2], w[3]};
        }
        for (size_t it = gth; it < (size_t)512 * 256 / 8; it += nth) {
            const int r = (int)(it / 32), t0 = (int)(it % 32) * 8, part = r >> 8, k = r & 255; unsigned w[4];
#pragma unroll
            for (int j = 0; j < 4; ++j) { float v[2];
#pragma unroll
                for (int q = 0; q < 2; ++q) { const int ph = (k * (t0 + 2 * j + q)) & 255; const float ang = (float)ph * (6.283185307179586f / 256.f); v[q] = (part ? sinf(ang) : cosf(ang)) * 0.0625f; }
                w[j] = pk2(v[0], v[1]); }
            *(u32x4*)(FC + (size_t)r * 1024 + t0) = (u32x4){w[0], w[1], w[2], w[3]};
        }
    }
}
__device__ __forceinline__ void mod_item(Frame& F, int l, int cgp, int half) {
    const int tid = F.tid;
    LAS float* s = (LAS float*)F.lds;
    LAS float* red = (LAS float*)(F.lds + 9 * 1024 * 4);
    float* MOD = WSP(float, WS_MOD);
    const float* c_in = FIN(I_C); const float* c_ctx = FIN(I_CCTX); const float* w_ada = FIN(I_WADA); const float* b_ada = FIN(I_BADA);
    {
        const float* c_sh = c_ctx - 8 * 1024; float cv[18];
#pragma unroll
        for (int q = 0; q < 18; ++q) { const int i = tid + NTHR * q; cv[q] = ((i >> 10) < 8 ? c_in : c_sh)[i]; }
#pragma unroll
        for (int q = 0; q < 18; ++q) s[tid + NTHR * q] = siluf_(cv[q]);
    }
    __syncthreads();
    const int col = cgp * 64 + (tid & 63), kq = tid >> 6;
    const int rows = (half < 0) ? 128 : 64, kb = (half < 0) ? kq * 128 : half * 512 + kq * 64;
    float acc[9];
#pragma unroll
    for (int r = 0; r < 9; ++r) acc[r] = 0.f;
    const float* w = w_ada + ((size_t)l * 1024 + kb) * 6144 + col;
    for (int k0 = 0; k0 < rows; k0 += 32) {
        float wv[32];
#pragma unroll
        for (int k = 0; k < 32; ++k) wv[k] = w[(size_t)(k0 + k) * 6144];
#pragma unroll
        for (int k = 0; k < 32; ++k)
#pragma unroll
            for (int r = 0; r < 9; ++r) acc[r] += s[r * 1024 + kb + k0 + k] * wv[k];
    }
#pragma unroll
    for (int r = 0; r < 9; ++r) red[(kq * 9 + r) * 64 + (tid & 63)] = acc[r];
    __syncthreads();
    for (int o = tid; o < 576; o += NTHR) { const int r = o >> 6, cc = o & 63; float sum = 0.f;
#pragma unroll
        for (int q = 0; q < 8; ++q) sum += red[(q * 9 + r) * 64 + cc];
        float* dst = MOD + ((size_t)l * 9 + r) * 6144 + cgp * 64 + cc;
        if (half < 0) *dst = sum + b_ada[l * 6144 + cgp * 64 + cc];
        else __hip_atomic_fetch_add(dst, half == 0 ? sum + b_ada[l * 6144 + cgp * 64 + cc] : sum, __ATOMIC_RELAXED, __HIP_MEMORY_SCOPE_AGENT); }
    __syncthreads();
}
__device__ __forceinline__ void phase_prep(Frame& F) {
    const int tid = F.tid;
    if (F.G == 256) { if (F.bid < 192) { mod_item(F, 0, F.bid % 96, F.bid / 96);
        asm volatile("s_waitcnt vmcnt(0)" ::: "memory"); __syncthreads();
        if (tid == 0) (void)xb_add((unsigned*)(F.ws + WS_CTL) + XB_MODRDY, 1u); } }
    else for (int it = F.bid; it < 192; it += F.G) mod_item(F, it / 96, it % 96, -1);
    if (F.G != 256) gen_dft_matrices(F, F.bid, F.G);
    const int gw = F.bid * NWAVES + F.wave, ngw = F.G * NWAVES;
    {
        LAS float* scr = (LAS float*)(F.lds + F.wave * 8448);
        bf16_t* WIN = WSP(bf16_t, WS_WIN); bf16_t* WOUT = WSP(bf16_t, WS_WOUT);
        const float* w_in = FIN(I_WIN); const float* w_out = FIN(I_WOUT);
        constexpr int I_IN = 2 * 88 * 16, I_OP = 2 * 32 * 12, I_PQ = 2 * 32 * 8;
        int it_first = gw;
        if (F.G == 256 && F.bid < 192) {
            f32x4 pa[8], pb[8];
            const int it1 = gw + 2048; const bool b_in = it1 < I_IN;
            const int la = gw / 1408, ra = gw % 1408, nba = ra / 16, kba = ra % 16;
            { SrcWin sw{w_in + (size_t)la * D * INC};
#pragma unroll
              for (int i = 0; i < 8; ++i) pa[i] = sw.ld4(kba * 64 + i * 8 + (F.lane >> 3), nba * 32 + (F.lane & 7) * 4); }
            const int r0 = b_in ? it1 : it1 - I_IN, lb = b_in ? r0 / 1408 : r0 / 384, rb = b_in ? r0 % 1408 : r0 % 384, nbb = b_in ? rb / 16 : rb / 12, kbb = b_in ? rb % 16 : rb % 12;
            { const int n = nbb * 32 + (F.lane & 7) * 4, ld = b_in ? INC : D, col = b_in ? (n < 1536 ? n : n + 16) : n;
              const float* base = b_in ? w_in + (size_t)lb * D * INC : w_out + (size_t)lb * D * D;
#pragma unroll
              for (int i = 0; i < 8; ++i) pb[i] = *(const f32x4*)(base + (size_t)(kbb * 64 + i * 8 + (F.lane >> 3)) * ld + col); }
            __builtin_amdgcn_sched_barrier(0);
            tr_store(pa, WIN + (size_t)la * NIN * D, D, nba * 32, kba * 64, scr, F.lane);
            tr_store(pb, b_in ? WIN + (size_t)lb * NIN * D : WOUT + (size_t)lb * D * KOUT, b_in ? D : KOUT, nbb * 32, kbb * 64, scr, F.lane);
            it_first = I_IN + I_OP + I_PQ;
        }
        for (int it = it_first; it < I_IN + I_OP + I_PQ; it += ngw) {
            if (it < I_IN) { const int l = it / 1408, r = it % 1408, nb = r / 16, kb = r % 16;
                SrcWin s{w_in + (size_t)l * D * INC};
                tr_item(s, WIN + (size_t)l * NIN * D, D, nb * 32, kb * 64, scr, F.lane);
            } else if (it < I_IN + I_OP) { const int r0 = it - I_IN, l = r0 / 384, r = r0 % 384, nb = r / 12, kb = r % 12;
                SrcPlain s{w_out + (size_t)l * D * D, D};
                tr_item(s, WOUT + (size_t)l * D * KOUT, KOUT, nb * 32, kb * 64, scr, F.lane);
            } else { const int r0 = it - I_IN - I_OP, l = r0 / 256, r = r0 % 256, nb = r / 8, gp = r % 8, g = gp & 3, part = gp >> 2;
                const float* wsrc = w_out + (size_t)l * D * D + (size_t)(768 + g * 64) * D + nb * 32;
#pragma unroll 8
                for (int i = 0; i < 32; ++i) { const int kk = 2 * i + (F.lane >> 5), nn = F.lane & 31; scr[kk * 33 + nn] = wsrc[(size_t)kk * D + nn]; }
                LDS_WAIT(); asm volatile("" ::: "memory");
                const int c8 = F.lane & 7;
                float o[4][8];
#pragma unroll
                for (int j = 0; j < 4; ++j)
#pragma unroll
                    for (int q = 0; q < 8; ++q) o[j][q] = 0.f;
                int i0 = 0;
                for (int m = 0; m < 64; ++m) {
                    float twd[8];
                    float cr = __builtin_amdgcn_cosf((float)i0 * (1.0f / 64.f)), ci = __builtin_amdgcn_sinf((float)i0 * (1.0f / 64.f));
                    const float sr = __builtin_amdgcn_cosf((float)m * (1.0f / 64.f)), si = __builtin_amdgcn_sinf((float)m * (1.0f / 64.f));
#pragma unroll
                    for (int q = 0; q < 8; ++q) { twd[q] = part ? -ci : cr; const float nr = cr * sr - ci * si, ni = cr * si + ci * sr; cr = nr; ci = ni; }
                    i0 = (i0 + 8 * c8) & 63;
#pragma unroll
                    for (int j = 0; j < 4; ++j) { const float bv = scr[m * 33 + (F.lane >> 3) + 8 * j];
#pragma unroll
                        for (int q = 0; q < 8; ++q) o[j][q] += twd[q] * bv; }
                }
#pragma unroll
                for (int j = 0; j < 4; ++j) { const int n = (F.lane >> 3) + 8 * j;
                    u32x4 ov; ov.x = pk2(o[j][0] * 0.125f, o[j][1] * 0.125f); ov.y = pk2(o[j][2] * 0.125f, o[j][3] * 0.125f); ov.z = pk2(o[j][4] * 0.125f, o[j][5] * 0.125f); ov.w = pk2(o[j][6] * 0.125f, o[j][7] * 0.125f);
                    *(u32x4*)(WOUT + (size_t)l * D * KOUT + (size_t)(nb * 32 + n) * KOUT + 768 + part * 256 + g * 64 + c8 * 8) = ov; }
                LDS_WAIT(); asm volatile("" ::: "memory");
            }
        }
    }
    __syncthreads();
}

constexpr int WTS = 1028;
constexpr int ROW_PRM = 16 * WTS * 4;
template <int CTRL> __device__ __forceinline__ float dppf(float v) { return __builtin_bit_cast(float, __builtin_amdgcn_update_dpp(0, __builtin_bit_cast(int, v), CTRL, 0xF, 0xF, true)); }
__device__ __forceinline__ float rdlane(float v, int l) { return __builtin_bit_cast(float, __builtin_amdgcn_readlane(__builtin_bit_cast(int, v), l)); }
__device__ __forceinline__ float wave_sum_dpp(float v) {
    v += dppf<0xB1>(v); v += dppf<0x4E>(v); v += dppf<0x141>(v); v += dppf<0x140>(v);
    return (rdlane(v, 0) + rdlane(v, 16)) + (rdlane(v, 32) + rdlane(v, 48));
}
__device__ __forceinline__ void stage_small_w(Frame& F, LAS float* wT, const float* src, int ld, int coloff) {
    f32x4 v[8];
#pragma unroll
    for (int q = 0; q < 8; ++q) { const int i = F.tid + NTHR * q, k = i >> 2, c4 = i & 3; v[q] = *(const f32x4*)(src + (size_t)k * ld + coloff + 4 * c4); }
#pragma unroll
    for (int q = 0; q < 8; ++q) { const int i = F.tid + NTHR * q, k = i >> 2, c4 = i & 3;
#pragma unroll
        for (int e = 0; e < 4; ++e) wT[(4 * c4 + e) * WTS + k] = v[q][e]; }
}
#define SWAP4(INS, a0, b0, a1, b1, a2, b2, a3, b3) asm volatile("s_nop 1\n\t" INS " %0, %1\n\t" INS " %2, %3\n\t" INS " %4, %5\n\t" INS " %6, %7\n\ts_nop 1" : "+v"(a0), "+v"(b0), "+v"(a1), "+v"(b1), "+v"(a2), "+v"(b2), "+v"(a3), "+v"(b3))
#ifdef OLD_REDUCE
__device__ __forceinline__ float reduce16(const float (&acc)[16], int lane) {
    float v8[8], v4[4], v2[2], v1;
#pragma unroll
    for (int i = 0; i < 8; ++i) { const float snd = (lane & 32) ? acc[i] : acc[i + 8], kp = (lane & 32) ? acc[i + 8] : acc[i]; v8[i] = kp + __shfl_xor(snd, 32); }
#pragma unroll
    for (int i = 0; i < 4; ++i) { const float snd = (lane & 16) ? v8[i] : v8[i + 4], kp = (lane & 16) ? v8[i + 4] : v8[i]; v4[i] = kp + __shfl_xor(snd, 16); }
#pragma unroll
    for (int i = 0; i < 2; ++i) { const float snd = (lane & 8) ? v4[i] : v4[i + 2], kp = (lane & 8) ? v4[i + 2] : v4[i]; v2[i] = kp + __shfl_xor(snd, 8); }
    { const float snd = (lane & 4) ? v2[0] : v2[1], kp = (lane & 4) ? v2[1] : v2[0]; v1 = kp + __shfl_xor(snd, 4); }
    v1 += __shfl_xor(v1, 2); v1 += __shfl_xor(v1, 1);
    return v1;
}
#else
__device__ __forceinline__ float reduce16(const float (&acc)[16], int lane) {
    float v8[8], v4[4], v2[2], v1, t[16];
#pragma unroll
    for (int i = 0; i < 16; ++i) t[i] = acc[i];
    SWAP4("v_permlane32_swap_b32", t[0], t[8], t[1], t[9], t[2], t[10], t[3], t[11]); SWAP4("v_permlane32_swap_b32", t[4], t[12], t[5], t[13], t[6], t[14], t[7], t[15]);
#pragma unroll
    for (int i = 0; i < 8; ++i) v8[i] = t[i] + t[i + 8];
    SWAP4("v_permlane16_swap_b32", v8[0], v8[4], v8[1], v8[5], v8[2], v8[6], v8[3], v8[7]);
#pragma unroll
    for (int i = 0; i < 4; ++i) v4[i] = v8[i] + v8[i + 4];
#pragma unroll
    for (int i = 0; i < 2; ++i) { const float snd = (lane & 8) ? v4[i] : v4[i + 2], kp = (lane & 8) ? v4[i + 2] : v4[i]; v2[i] = kp + dppf<0x140>(snd); }
    { const float snd = (lane & 4) ? v2[0] : v2[1], kp = (lane & 4) ? v2[1] : v2[0]; v1 = kp + dppf<0x141>(snd); }
    v1 += dppf<0x4E>(v1); v1 += dppf<0xB1>(v1);
    return v1;
}
#endif
__device__ __forceinline__ int mod_row(int tok) { return tok < NLAT ? (tok >> 11) : 8; }
__device__ __forceinline__ void pair_range(int ntok, int gw, int ngw, int& p0, int& p1) { const int np = ntok >> 1; p0 = (int)(((long long)np * gw) / ngw); p1 = (int)(((long long)np * (gw + 1)) / ngw); }
__device__ __forceinline__ void block_mod_rows(Frame& F, int ntok, int& mrA, int& mrB) {
    int q0, q1, r0, r1; pair_range(ntok, F.bid * NWAVES, F.G * NWAVES, q0, q1); pair_range(ntok, F.bid * NWAVES + NWAVES - 1, F.G * NWAVES, r0, r1);
    mrA = mod_row(min(2 * q0, ntok - 1)); mrB = mod_row(min(max(2 * r1 - 1, 0), ntok - 1));
}
__device__ __forceinline__ float sumsq4(const f32x4 (&v)[4]) { float ss = 0.f;
#pragma unroll
    for (int j = 0; j < 4; ++j) ss += (v[j][0] * v[j][0] + v[j][1] * v[j][1]) + (v[j][2] * v[j][2] + v[j][3] * v[j][3]);
    return ss; }
__device__ __forceinline__ void norm_pair(const f32x4 (&va)[4], const f32x4 (&vb)[4], const LAS float* cfp, const LAS float* shp, bf16_t* xn_a, f32x2 (&yy)[16], int lane) {
    const float ra = 1.0f / sqrtf(wave_sum_dpp(sumsq4(va)) * (1.0f / D) + EPS), rb = 1.0f / sqrtf(wave_sum_dpp(sumsq4(vb)) * (1.0f / D) + EPS);
#pragma unroll
    for (int j = 0; j < 4; ++j) { const int o = 4 * lane + 256 * j;
        const f32x4 cf = *(const LAS f32x4*)(cfp + o), sh = *(const LAS f32x4*)(shp + o);
        f32x4 ya, yb;
#pragma unroll
        for (int q = 0; q < 4; ++q) { ya[q] = va[j][q] * ra * cf[q] + sh[q]; yb[q] = vb[j][q] * rb * cf[q] + sh[q]; yy[4 * j + q] = (f32x2){ya[q], yb[q]}; }
        *(u32x2*)(xn_a + o) = pk4(ya); *(u32x2*)(xn_a + D + o) = pk4(yb); }
}
__device__ __forceinline__ void gate_products2(const f32x2 (&yy)[16], const LAS float* wT, int lane, float& ga, float& gb) {
    f32x2 acc[16];
#pragma unroll
    for (int c = 0; c < 16; ++c) acc[c] = (f32x2){0.f, 0.f};
#pragma unroll
    for (int j = 0; j < 4; ++j) {
#pragma unroll
        for (int h = 0; h < 2; ++h) {
            f32x4 wv[8];
#pragma unroll
            for (int c = 0; c < 8; ++c) wv[c] = *(const LAS f32x4*)(wT + (8 * h + c) * WTS + 4 * lane + 256 * j);
            __builtin_amdgcn_sched_barrier(0);
#pragma unroll
            for (int c = 0; c < 8; ++c)
#pragma unroll
                for (int q = 0; q < 4; ++q) acc[8 * h + c] += yy[4 * j + q] * (f32x2){wv[c][q], wv[c][q]};
            __builtin_amdgcn_sched_barrier(0);
        }
    }
    float a1[16], b1[16];
#pragma unroll
    for (int c = 0; c < 16; ++c) { a1[c] = acc[c][0]; b1[c] = acc[c][1]; }
    ga = reduce16(a1, lane); gb = reduce16(b1, lane);
}
__device__ __forceinline__ void row_tail_gates(float myv, float bg  , float* gates_row, int lane) {
    if ((lane & 3) == 0) { const int c = lane >> 2; gates_row[c] = myv + bg; }
}
__device__ __forceinline__ void row_tail_router(float myv, float* aff_row, int lane) {
    float mx = myv;
#pragma unroll
    for (int o = 4; o < 64; o <<= 1) mx = fmaxf(mx, __shfl_xor(mx, o));
    const float e = expf(myv - mx); float s = e;
#pragma unroll
    for (int o = 4; o < 64; o <<= 1) s += __shfl_xor(s, o);
    if ((lane & 3) == 0) aff_row[lane >> 2] = e / s;
}
#define LOAD_PAIR_BF(va, vb, srcb) { _Pragma("unroll") for (int j = 0; j < 4; ++j) { const u32x2 wa_ = *(const u32x2*)((srcb) + 4 * F.lane + 256 * j), wb_ = *(const u32x2*)((srcb) + D + 4 * F.lane + 256 * j); \
        va[j] = (f32x4){bflo(wa_.x), bfhi(wa_.x), bflo(wa_.y), bfhi(wa_.y)}; vb[j] = (f32x4){bflo(wb_.x), bfhi(wb_.x), bflo(wb_.y), bfhi(wb_.y)}; } }
#define LOAD_PAIR(va, vb, src) { _Pragma("unroll") for (int j = 0; j < 4; ++j) { va[j] = *(const f32x4*)((src) + 4 * F.lane + 256 * j); vb[j] = *(const f32x4*)((src) + D + 4 * F.lane + 256 * j); } }

__device__ __forceinline__ void phase_norm1_l0(Frame& F) {
    LAS float* wT = (LAS float*)F.lds; LAS float* prm = (LAS float*)(F.lds + ROW_PRM);
    const float* MOD = WSP(float, WS_MOD); bf16_t* XN = WSP(bf16_t, WS_XN); float* GATES = WSP(float, WS_GATES);
    const float* x_in = FIN(I_X); const float* ctx_in = FIN(I_CTX); const float* g_norm1 = FIN(I_GN1); const float* b_gates = FIN(I_BG);
    const int gw = F.bid * NWAVES + F.wave, ngw = F.G * NWAVES;
    int p0, p1; pair_range(NTOK, gw, ngw, p0, p1);
    const float bg = b_gates[F.lane >> 2];
#define N1_SRC(t) ((t) < NLAT ? x_in + (size_t)(t) * D : ctx_in + (size_t)((t) - NLAT) * D)
    f32x4 va[4], vb[4];
    if (p0 < p1) { const float* src = N1_SRC(2 * p0); LOAD_PAIR(va, vb, src) }
    int mrA, mrB; block_mod_rows(F, NTOK, mrA, mrB);
    stage_small_w(F, wT, FIN(I_WIN), INC, 1536);
    if (F.G == 256) {
        if (F.tid == 0) { unsigned* bar = (unsigned*)(F.ws + WS_CTL); asm volatile("buffer_inv sc1" ::: "memory"); XB_SPIN(xb_ld(&bar[XB_MODRDY]) < 192u, bar); asm volatile("s_waitcnt vmcnt(0)" ::: "memory"); }
        __syncthreads();
    }
#pragma unroll
    for (int i = F.tid; i < 2048; i += NTHR) { const int set = i >> 10, k = i & 1023; const float* md = MOD + (size_t)(set ? mrB : mrA) * 6144;
        prm[(set * 3 + 0) * 1024 + k] = g_norm1[k] * (1.0f + md[1024 + k]); prm[(set * 3 + 1) * 1024 + k] = md[k]; }
    __syncthreads();
    for (int p = p0; p < p1; ++p) {
        const int tok = 2 * p, set = (mod_row(tok) != mrA) ? 1 : 0;
        f32x2 yy[16];
        norm_pair(va, vb, prm + (set * 3 + 0) * 1024, prm + (set * 3 + 1) * 1024, XN + (size_t)tok * D, yy, F.lane);
        if (p + 1 < p1) { const float* src = N1_SRC(tok + 2); LOAD_PAIR(va, vb, src) }
        float ga, gb; gate_products2(yy, wT, F.lane, ga, gb);
        row_tail_gates(ga, bg, GATES + (size_t)tok * 16, F.lane); row_tail_gates(gb, bg, GATES + (size_t)(tok + 1) * 16, F.lane);
    }
#undef N1_SRC
    __syncthreads();
}
__device__ __forceinline__ void phase_norm2(Frame& F, int l) {
    LAS float* wT = (LAS float*)F.lds; LAS float* prm = (LAS float*)(F.lds + ROW_PRM);
    const float* g_norm2 = FIN(I_GN2) + l * D;
    const float* MOD = WSP(float, WS_MOD); bf16_t* XN = WSP(bf16_t, WS_XN); float* AFF = WSP(float, WS_AFF); const bf16_t* X = WSP(bf16_t, WS_X);
    const int gw = F.bid * NWAVES + F.wave, ngw = F.G * NWAVES;
    const int ntok = (l == 0) ? NTOK : NLAT;
    int p0, p1; pair_range(ntok, gw, ngw, p0, p1);
    f32x4 va[4], vb[4];
    if (p0 < p1) { const bf16_t* src = X + (size_t)(2 * p0) * D; LOAD_PAIR_BF(va, vb, src) }
    int mrA, mrB; block_mod_rows(F, ntok, mrA, mrB);
    stage_small_w(F, wT, FIN(I_WR) + (size_t)l * D * 16, 16, 0);
#pragma unroll
    for (int i = F.tid; i < 2048; i += NTHR) { const int set = i >> 10, k = i & 1023; const float* md = MOD + ((size_t)l * 9 + (set ? mrB : mrA)) * 6144;
        prm[(set * 3 + 0) * 1024 + k] = g_norm2[k] * (1.0f + md[4 * 1024 + k]); prm[(set * 3 + 1) * 1024 + k] = md[3 * 1024 + k]; }
    __syncthreads();
    for (int p = p0; p < p1; ++p) {
        const int tok = 2 * p, set = (mod_row(tok) != mrA) ? 1 : 0;
        f32x2 yy[16];
        norm_pair(va, vb, prm + (set * 3 + 0) * 1024, prm + (set * 3 + 1) * 1024, XN + (size_t)tok * D, yy, F.lane);
        if (p + 1 < p1) { const bf16_t* src = X + (size_t)(tok + 2) * D; LOAD_PAIR_BF(va, vb, src) }
        float ga, gb; gate_products2(yy, wT, F.lane, ga, gb);
        row_tail_router(ga, AFF + (size_t)tok * 16, F.lane); row_tail_router(gb, AFF + (size_t)(tok + 1) * 16, F.lane);
    }
    __syncthreads();
}
constexpr int CMB_K = 2;
struct CmbSlots { u32x2 y[2][CMB_K][4]; };
__device__ __forceinline__ unsigned row_inv_mask(int invw, int sub) { return (unsigned)((__ballot(invw >= 0) >> (16 * sub)) & 0xffffull); }
__device__ __forceinline__ void cmb_issue(CmbSlots& S, const bf16_t* YS, const bf16_t* dummy  , int invw_a, int sub_a, int invw_b, int sub_b, int lane) {
#pragma unroll
    for (int rr = 0; rr < 2; ++rr) { const int invw = rr ? invw_b : invw_a, sub = rr ? sub_b : sub_a; unsigned mask = row_inv_mask(invw, sub);
#pragma unroll
        for (int s = 0; s < CMB_K; ++s) {
            const bf16_t* yr = dummy + (size_t)rr * D;
            if (mask) { const int e = __builtin_ctz(mask); mask &= mask - 1; const int r = __builtin_amdgcn_readlane(invw, 16 * sub + e); yr = YS + ((size_t)e * RPE + r) * D; }
#pragma unroll
            for (int j = 0; j < 4; ++j) S.y[rr][s][j] = *(const u32x2*)(yr + 4 * lane + 256 * j); } }
}
__device__ __forceinline__ void cmb_accum(f32x4 (&a)[4], const u32x2 (&w)[4]) {
#pragma unroll
    for (int j = 0; j < 4; ++j) { a[j][0] += bflo(w[j].x); a[j][1] += bfhi(w[j].x); a[j][2] += bflo(w[j].y); a[j][3] += bfhi(w[j].y); }
}
__device__ __forceinline__ void phase_combine(Frame& F, int l) {
    LAS float* wT = (LAS float*)F.lds; LAS float* prm = (LAS float*)(F.lds + ROW_PRM);
    const float* g_norm1 = FIN(I_GN1) + D; const float* b_gates = FIN(I_BG) + 16; const float* g_final = FIN(I_GF); float* outp = as_global(F.A.out);
    const float* MOD = WSP(float, WS_MOD); bf16_t* XN = WSP(bf16_t, WS_XN); float* GATES = WSP(float, WS_GATES); bf16_t* X = WSP(bf16_t, WS_X);
    const int* INV = WSP(int, WS_INV); const bf16_t* YS = WSP(bf16_t, WS_YS);
    const int gw = F.bid * NWAVES + F.wave, ngw = F.G * NWAVES;
    const int ntok = (l == 0) ? NTOK : NLAT;
    int p0, p1; pair_range(ntok, gw, ngw, p0, p1);
    const float bg = b_gates[F.lane >> 2];
    const int t0 = 2 * p0;
    int invw[3];
#pragma unroll
    for (int i = 0; i < 3; ++i) { const int idx = t0 * 16 + 64 * i + F.lane; invw[i] = (idx < ntok * 16) ? INV[idx] : -1; }
#define INVW(ri) (((ri) >> 2) == 0 ? invw[0] : ((ri) >> 2) == 1 ? invw[1] : invw[2])
    f32x4 va[4], vb[4]; CmbSlots S;
    if (p0 < p1) { const bf16_t* src = X + (size_t)t0 * D; LOAD_PAIR_BF(va, vb, src) cmb_issue(S, YS, src, INVW(0), 0, INVW(1), 1, F.lane); }
    int mrA, mrB; block_mod_rows(F, ntok, mrA, mrB);
    if (l == 0) stage_small_w(F, wT, FIN(I_WIN) + (size_t)1 * D * INC, INC, 1536);
    for (int i = F.tid; i < 2048; i += NTHR) { const int set = i >> 10, k = i & 1023, mr = set ? mrB : mrA; const float* md = MOD + ((size_t)l * 9 + mr) * 6144; const float* md1 = MOD + ((size_t)9 + mr) * 6144;
        prm[(set * 3 + 2) * 1024 + k] = md[5 * 1024 + k];
        if (l == 0) { prm[(set * 3 + 0) * 1024 + k] = g_norm1[k] * (1.0f + md1[1024 + k]); prm[(set * 3 + 1) * 1024 + k] = md1[k]; }
        else prm[(set * 3 + 0) * 1024 + k] = g_final[k]; }
    __syncthreads();
    for (int p = p0; p < p1; ++p) {
        const int tok = 2 * p, ri = tok - t0, set = (mod_row(tok) != mrA) ? 1 : 0;
        const LAS float* pp = prm + set * 3 * 1024;
#pragma unroll
        for (int rr = 0; rr < 2; ++rr) {
            f32x4 a[4];
#pragma unroll
            for (int j = 0; j < 4; ++j) a[j] = (f32x4){0.f, 0.f, 0.f, 0.f};
            const int iw = INVW(ri + rr), sub = (ri + rr) & 3;
            unsigned mask = row_inv_mask(iw, sub);
#pragma unroll
            for (int s = 0; s < CMB_K; ++s) if (mask) { mask &= mask - 1; cmb_accum(a, S.y[rr][s]); }
            while (mask) { const int e = __builtin_ctz(mask); mask &= mask - 1;
                const int r = __builtin_amdgcn_readlane(iw, 16 * sub + e);
                const bf16_t* yr = YS + ((size_t)e * RPE + r) * D;
                u32x2 w[4];
#pragma unroll
                for (int j = 0; j < 4; ++j) w[j] = *(const u32x2*)(yr + 4 * F.lane + 256 * j);
                cmb_accum(a, w); }
#pragma unroll
            for (int j = 0; j < 4; ++j) { const f32x4 gt = *(const LAS f32x4*)(pp + 2 * 1024 + 4 * F.lane + 256 * j); if (rr == 0) va[j] = va[j] + gt * a[j]; else vb[j] = vb[j] + gt * a[j]; }
        }
        if (l == 0) {
#pragma unroll
            for (int j = 0; j < 4; ++j) { *(u32x2*)(X + (size_t)tok * D + 4 * F.lane + 256 * j) = pk4(va[j]); *(u32x2*)(X + (size_t)(tok + 1) * D + 4 * F.lane + 256 * j) = pk4(vb[j]); }
            f32x2 yy[16];
            norm_pair(va, vb, pp, pp + 1024, XN + (size_t)tok * D, yy, F.lane);
            if (p + 1 < p1) { const bf16_t* src = X + (size_t)(tok + 2) * D; LOAD_PAIR_BF(va, vb, src) cmb_issue(S, YS, src, INVW(ri + 2), (ri + 2) & 3, INVW(ri + 3), (ri + 3) & 3, F.lane); }
            float ga, gb; gate_products2(yy, wT, F.lane, ga, gb);
            row_tail_gates(ga, bg, GATES + (size_t)tok * 16, F.lane); row_tail_gates(gb, bg, GATES + (size_t)(tok + 1) * 16, F.lane);
        } else {
            const float ra = 1.0f / sqrtf(wave_sum_dpp(sumsq4(va)) * (1.0f / D) + EPS), rb = 1.0f / sqrtf(wave_sum_dpp(sumsq4(vb)) * (1.0f / D) + EPS);
#pragma unroll
            for (int j = 0; j < 4; ++j) { const f32x4 g = *(const LAS f32x4*)(pp + 4 * F.lane + 256 * j);
                *(f32x4*)(outp + (size_t)tok * D + 4 * F.lane + 256 * j) = va[j] * ra * g; *(f32x4*)(outp + (size_t)(tok + 1) * D + 4 * F.lane + 256 * j) = vb[j] * rb * g; }
            if (p + 1 < p1) { const bf16_t* src = X + (size_t)(tok + 2) * D; LOAD_PAIR_BF(va, vb, src) cmb_issue(S, YS, src, INVW(ri + 2), (ri + 2) & 3, INVW(ri + 3), (ri + 3) & 3, F.lane); }
        }
    }
#undef INVW
    __syncthreads();
}

__device__ __forceinline__ int block_count(LAS int* cbuf, int par, int wave, int lane, int c_wave  ) {
    if (lane == 0) cbuf[par * 8 + wave] = c_wave;
    __syncthreads();
    int t = 0;
#pragma unroll
    for (int q = 0; q < 8; ++q) t += cbuf[par * 8 + q];
    return t;
}
__device__ __forceinline__ void phase_topk(Frame& F, int l) {
    LAS int* cbuf = (LAS int*)F.lds;
    const float* AFF = WSP(float, WS_AFF); int* INV = WSP(int, WS_INV); int* ROWTOK = WSP(int, WS_ROWTOK); float* GATEV = WSP(float, WS_GATEV);
    const int nitems = (l == 0) ? 256 : 128;
    for (int it = F.bid; it < nitems; it += F.G) {
        const int s = (nitems == 256) ? (it & 15) : (it & 7), e = (nitems == 256) ? (it >> 4) : (it >> 3);
        const bool lat = s < 8;
        const int n = lat ? SEQ : CTXL, cap = lat ? 256 : 32, tok0 = lat ? s * SEQ : NLAT + (s - 8) * CTXL, rowbase = lat ? s * 256 : 2048 + (s - 8) * 32;
        const bool active = 4 * F.tid < n;
        unsigned k[4];
#pragma unroll
        for (int q = 0; q < 4; ++q) k[q] = active ? __float_as_uint(AFF[(size_t)(tok0 + 4 * F.tid + q) * 16 + e]) : 0u;
        __syncthreads();
        unsigned T = 0u; int par = 0;
        for (int bit = 30; bit >= 0; --bit) {
            const unsigned cand = T | (1u << bit);
            int cw = 0;
#pragma unroll
            for (int q = 0; q < 4; ++q) cw += __popcll(__ballot(k[q] >= cand));
            const int tot = block_count(cbuf, par, F.wave, F.lane, cw); par ^= 1;
            if (tot >= cap) T = cand;
        }
        int cw = 0;
#pragma unroll
        for (int q = 0; q < 4; ++q) cw += __popcll(__ballot(k[q] > T));
        const int c_gt = block_count(cbuf, par, F.wave, F.lane, cw); par ^= 1;
        int mg = 0, me = 0;
#pragma unroll
        for (int q = 0; q < 4; ++q) { mg += (k[q] > T) ? 1 : 0; me += (k[q] == T && active) ? 1 : 0; }
        int pk_ = mg | (me << 16), inc = pk_;
#pragma unroll
        for (int o = 1; o < 64; o <<= 1) { const int y = __shfl_up(inc, o); if (F.lane >= o) inc += y; }
        if (F.lane == 63) cbuf[16 + F.wave] = inc;
        __syncthreads();
        int base = 0;
#pragma unroll
        for (int q = 0; q < 8; ++q) base += (q < F.wave) ? cbuf[16 + q] : 0;
        int pre = base + inc - pk_; int pg = pre & 0xffff, pe = pre >> 16;
        if (active) {
#pragma unroll
            for (int q = 0; q < 4; ++q) {
                const int tok = tok0 + 4 * F.tid + q; int slot = -1;
                if (k[q] > T) { slot = pg; ++pg; }
                else if (k[q] == T) { if (c_gt + pe < cap) slot = c_gt + pe; ++pe; }
                if (slot >= 0) { ROWTOK[e * RPE + rowbase + slot] = tok; GATEV[e * RPE + rowbase + slot] = __uint_as_float(k[q]); }
                INV[(size_t)tok * 16 + e] = slot >= 0 ? rowbase + slot : -1;
            }
        }
        __syncthreads();
    }
    __syncthreads();
}

__device__ __forceinline__ void conv_items(Frame& F, int l, int first, int stride) {
    LAS float* gl = (LAS float*)F.lds;
    LAS float* ob = gl + 62 * 256;
    const bf16_t* CA = WSP(bf16_t, WS_CA); const bf16_t* CG = WSP(bf16_t, WS_CG); bf16_t* Y = WSP(bf16_t, WS_Y);
    const int nitems = (l == 0) ? 512 + 64 : 512;
    const int ch = F.tid & 255, th = F.tid >> 8;
    const float* conv_w = FIN(I_CW); const float* conv_b = FIN(I_CB); const float* conv_ln_g = FIN(I_CLG); const float* conv_ln_b = FIN(I_CLB);
    float w[31];
#pragma unroll
    for (int j = 0; j < 31; ++j) w[j] = conv_w[((size_t)l * 31 + j) * 256 + ch];
    const float cb = conv_b[l * 256 + ch];
    for (int it = first; it < nitems; it += stride) {
        const bool lat = it < 512;
        const int seqlen = lat ? SEQ : CTXL;
        const int b = lat ? it >> 6 : (it - 512) >> 3, t0 = lat ? (it & 63) * 32 : ((it - 512) & 7) * 32;
        const int tokb = lat ? b * SEQ : NLAT + b * CTXL;
        __syncthreads();
        for (int i = F.tid; i < 62 * 64; i += NTHR) {
            const int rr = i >> 6, c4 = (i & 63) * 4, t = t0 - 15 + rr;
            f32x4 g = (f32x4){0.f, 0.f, 0.f, 0.f};
            if (t >= 0 && t < seqlen) { const size_t o = (size_t)(tokb + t) * 256 + c4; const u32x2 a = *(const u32x2*)(CA + o), gg = *(const u32x2*)(CG + o);
                g[0] = bflo(a.x) * sigmoidf_(bflo(gg.x)); g[1] = bfhi(a.x) * sigmoidf_(bfhi(gg.x)); g[2] = bflo(a.y) * sigmoidf_(bflo(gg.y)); g[3] = bfhi(a.y) * sigmoidf_(bfhi(gg.y)); }
            *(LAS f32x4*)(gl + rr * 256 + c4) = g;
        }
        __syncthreads();
        for (int tt = 0; tt < 16; ++tt) {
            const LAS float* gp = gl + (th * 16 + tt) * 256 + ch;
            float gv[31];
#pragma unroll
            for (int j = 0; j < 31; ++j) gv[j] = gp[j * 256];
            __builtin_amdgcn_sched_barrier(0);
            float o = cb;
#pragma unroll
            for (int j = 0; j < 31; ++j) o += w[j] * gv[j];
            __builtin_amdgcn_sched_barrier(0);
            ob[(th * 16 + tt) * 256 + ch] = o;
        }
        __syncthreads();
        for (int tt = F.wave; tt < 32; tt += NWAVES) {
            const f32x4 v = *(const LAS f32x4*)(ob + tt * 256 + 4 * F.lane);
            const float mean = wave_sum((v[0] + v[1]) + (v[2] + v[3])) * (1.0f / 256.f);
            const f32x4 d = v - mean;
            const float var = wave_sum((d[0] * d[0] + d[1] * d[1]) + (d[2] * d[2] + d[3] * d[3])) * (1.0f / 256.f);
            const float rs = 1.0f / sqrtf(var + EPS);
            const f32x4 lg = *(const f32x4*)(conv_ln_g + l * 256 + 4 * F.lane), lb = *(const f32x4*)(conv_ln_b + l * 256 + 4 * F.lane);
            f32x4 y;
#pragma unroll
            for (int q = 0; q < 4; ++q) y[q] = siluf_(d[q] * rs * lg[q] + lb[q]);
            *(u32x2*)(Y + (size_t)(tokb + t0 + tt) * KOUT + 512 + 4 * F.lane) = pk4(y);
        }
    }
    __syncthreads();
}
__device__ __forceinline__ void ztrans_items(Frame& F, int l, int first, int stride) {
    LAS unsigned short* te = (LAS unsigned short*)(F.lds + F.wave * (2 * 64 * 66 * 2));
    LAS unsigned short* to = te + 64 * 66;
    const bf16_t* FR = WSP(bf16_t, WS_FR); bf16_t* ZE = WSP(bf16_t, WS_ZT); bf16_t* ZO = WSP(bf16_t, WS_ZO); bf16_t* ZTC = WSP(bf16_t, WS_ZTC);
    const int nlat = 8 * 16 * 4, nctx = (l == 0) ? 8 * 4 * 4 : 0;
    for (int it = first; it < nlat + nctx; it += stride) {
        const bool lat = it < nlat; const int r = lat ? it : it - nlat;
        const int b = lat ? r >> 6 : r >> 4, tb = lat ? (r >> 2) & 15 : (r >> 2) & 3, cb = r & 3;
        const int tokb = lat ? b * SEQ : NLAT + b * CTXL;
        u32x4 vv[8], mm[8];
#pragma unroll
        for (int i = 0; i < 8; ++i) { const int tt = (F.lane >> 3) + 8 * i, c8 = (F.lane & 7) * 8, t = tb * 64 + tt;
            vv[i] = *(const u32x4*)(FR + (size_t)(tokb + t) * 256 + cb * 64 + c8);
            mm[i] = *(const u32x4*)(FR + (size_t)(tokb + ((lat && t > 0) ? SEQ - t : t)) * 256 + cb * 64 + c8); }
#pragma unroll
        for (int i = 0; i < 8; ++i) { const int tt = (F.lane >> 3) + 8 * i, c8 = (F.lane & 7) * 8, t = tb * 64 + tt;
            const u32x4 v = vv[i]; u32x4 m = mm[i];
            if (!(lat && t > 0)) m = (u32x4){0u, 0u, 0u, 0u};
#pragma unroll
            for (int q = 0; q < 4; ++q) {
                if (lat) { const float a0 = bflo(v[q]), a1 = bfhi(v[q]), m0 = bflo(m[q]), m1 = bfhi(m[q]); const unsigned e_ = pk2(a0 + m0, a1 + m1), o_ = (t > 0) ? pk2(a0 - m0, a1 - m1) : 0u;
                    te[(c8 + 2 * q) * 66 + tt] = (unsigned short)(e_ & 0xffffu); te[(c8 + 2 * q + 1) * 66 + tt] = (unsigned short)(e_ >> 16);
                    to[(c8 + 2 * q) * 66 + tt] = (unsigned short)(o_ & 0xffffu); to[(c8 + 2 * q + 1) * 66 + tt] = (unsigned short)(o_ >> 16); }
                else { te[(c8 + 2 * q) * 66 + tt] = (unsigned short)(v[q] & 0xffffu); te[(c8 + 2 * q + 1) * 66 + tt] = (unsigned short)(v[q] >> 16); } } }
        LDS_WAIT(); asm volatile("" ::: "memory");
        const size_t drow = (size_t)(b * 256 + cb * 64) * 1024 + tb * 64;
#pragma unroll
        for (int i = 0; i < 8; ++i) { const int cc = (F.lane >> 3) + 8 * i, t8 = (F.lane & 7) * 8; u32x4 o;
#pragma unroll
            for (int q = 0; q < 4; ++q) o[q] = (unsigned)te[cc * 66 + t8 + 2 * q] | ((unsigned)te[cc * 66 + t8 + 2 * q + 1] << 16);
            *(u32x4*)((lat ? ZE : ZTC) + drow + (size_t)cc * 1024 + t8) = o;
            if (lat) {
#pragma unroll
                for (int q = 0; q < 4; ++q) o[q] = (unsigned)to[cc * 66 + t8 + 2 * q] | ((unsigned)to[cc * 66 + t8 + 2 * q + 1] << 16);
                *(u32x4*)(ZO + drow + (size_t)cc * 1024 + t8) = o; } }
        LDS_WAIT(); asm volatile("" ::: "memory");
    }
}
__device__ __forceinline__ void finalize_h(Frame& F, int l) {
    const bf16_t* HF = WSP(bf16_t, WS_HF); const bf16_t* HB = WSP(bf16_t, WS_HB); const bf16_t* O = WSP(bf16_t, WS_O); bf16_t* Y = WSP(bf16_t, WS_Y);
    const int gw = F.bid * NWAVES + F.wave, ngw = F.G * NWAVES;
    const int ntok = (l == 0) ? NTOK : NLAT;
    float gh[8];
    const float* g_hnorm = FIN(I_GH);
#pragma unroll
    for (int q = 0; q < 8; ++q) gh[q] = g_hnorm[l * 512 + 8 * F.lane + q];
    for (int tok = gw; tok < ntok; tok += ngw) {
        const size_t o = (size_t)tok * 512 + 8 * F.lane;
        const u32x4 a = *(const u32x4*)(HF + o), b = *(const u32x4*)(HB + o), og = *(const u32x4*)(O + o);
        float h[8]; float ss = 0.f;
#pragma unroll
        for (int q = 0; q < 4; ++q) { h[2 * q] = bflo(a[q]) + bflo(b[q]); h[2 * q + 1] = bfhi(a[q]) + bfhi(b[q]); ss += h[2 * q] * h[2 * q] + h[2 * q + 1] * h[2 * q + 1]; }
#pragma unroll
        for (int s = 1; s < 16; s <<= 1) ss += __shfl_xor(ss, s);
        const float r = 1.0f / sqrtf(ss * (1.0f / 128.f) + EPS);
        u32x4 w;
#pragma unroll
        for (int q = 0; q < 4; ++q) w[q] = pk2(h[2 * q] * r * gh[2 * q] * bflo(og[q]), h[2 * q + 1] * r * gh[2 * q + 1] * bfhi(og[q]));
        *(u32x4*)(Y + (size_t)tok * KOUT + 8 * F.lane) = w;
    }
}

using pg8::Unit;
enum { GM_INPROJ = 0, GM_DFT, GM_OUT, GM_MOE1, GM_MOE2 };
struct GemmCtl {
    int mode, l, G, c; GAS unsigned char* ws; const Args& A;
    __device__ __forceinline__ GAS unsigned char* W() const { GAS unsigned char* p = ws; asm volatile("" : "+s"(p)); return p; }
    __device__ __forceinline__ bool next(int i, Unit& u) const {
        const int L = i * G + c; int pm, pn;
        u.rows = nullptr; u.ex = 0;
        switch (mode) {
        case GM_INPROJ: {
            const int n0 = 64 * 11, npn = (l == 0) ? 11 : 6;
            if (L >= n0 + 8 * npn) return false;
            if (L < n0) pg8::map_tile(L, 64, 11, pm, pn); else { pg8::map_tile(L - n0, 8, npn, pm, pn); pm += 64; }
            u.A = (const char*)(W() + WS_XN) + (size_t)pm * 256 * D * 2; u.B = (const char*)(W() + WS_WIN) + ((size_t)l * NIN + pn * 256) * D * 2; u.K = D;
        } break;
        case GM_DFT: {
            const int nctx = (l == 0) ? 16 : 0;
            if (L >= 128 + nctx) return false;
            if (L < 128) { pg8::map_tile(L, 16, 8, pm, pn); u.A = (const char*)(W() + WS_FL) + (size_t)pm * 256 * 1024 * 2; u.B = (const char*)(W() + ((pm >> 3) ? WS_ZO : WS_ZT)) + (size_t)pn * 256 * 1024 * 2; u.K = 1024; }
            else { const int r = L - 128; pm = r & 1; pn = r >> 1; u.A = (const char*)(W() + WS_FC) + (size_t)pm * 256 * 1024 * 2; u.B = (const char*)(W() + WS_ZTC) + (size_t)pn * 256 * 1024 * 2; u.K = CTXL; u.ex = 1; }
        } break;
        case GM_OUT: {
            const int nM = (l == 0) ? 72 : 64;
            if (L >= nM * 4) return false;
            pg8::map_tile(L, nM, 4, pm, pn);
            u.A = (const char*)(W() + WS_Y) + (size_t)pm * 256 * KOUT * 2; u.B = (const char*)(W() + WS_WOUT) + ((size_t)l * D + pn * 256) * KOUT * 2; u.K = KOUT;
        } break;
        case GM_MOE1: {
            const int nMe = (l == 0) ? 9 : 8; int pmg;
            if (L >= NE * nMe * 8) return false;
            pg8::map_tile(L, NE * nMe, 8, pmg, pn);
            const int e = pmg / nMe; pm = pmg % nMe;
            u.A = (const char*)(W() + WS_XN); u.rows = (const int*)(W() + WS_ROWTOK) + e * RPE + pm * 256; u.B = (const char*)(W() + WS_WGU) + ((size_t)e * 2048 + pn * 256) * D * 2; u.K = D; u.ex = e;
        } break;
        default: {
            const int nMe = (l == 0) ? 9 : 8; int pmg;
            if (L >= NE * nMe * 4) return false;
            pg8::map_tile(L, NE * nMe, 4, pmg, pn);
            const int e = pmg / nMe; pm = pmg % nMe;
            u.A = (const char*)(W() + WS_HID) + ((size_t)e * RPE + pm * 256) * D * 2; u.B = (const char*)(W() + WS_WD) + ((size_t)e * D + pn * 256) * D * 2; u.K = D; u.ex = e;
        } break;
        }
        u.pm = pm; u.pn = pn;
        return true;
    }
    struct CxIn { bf16_t* dst; int ld; float sc; int act; };
    __device__ __forceinline__ CxIn prep_in(const Unit& u) const {
        CxIn c; const int pn = u.pn; c.sc = 1.f; c.act = 0; size_t off; int cb;
        if (pn < 2) { off = WS_Q; c.ld = 512; cb = pn * 256; }
        else if (pn < 4) { off = WS_K; c.ld = 512; cb = (pn - 2) * 256; c.sc = 0.08838834764831845f; }
        else if (pn < 6) { off = WS_V; c.ld = 512; cb = (pn - 4) * 256; }
        else if (pn < 8) { off = WS_O; c.ld = 512; cb = (pn - 6) * 256; c.act = 1; }
        else if (pn == 8) { off = WS_CA; c.ld = 256; cb = 0; }
        else if (pn == 9) { off = WS_CG; c.ld = 256; cb = 0; }
        else { off = WS_FR; c.ld = 256; cb = 0; }
        c.dst = (bf16_t*)(W() + off) + (size_t)u.pm * 256 * c.ld + cb;
        return c;
    }
    __device__ __forceinline__ void store_in(const CxIn& c, int r, int col, f32x4 v0, f32x4 v1) const {
        if (c.act) {
#pragma unroll
            for (int q = 0; q < 4; ++q) { v0[q] = sigmoidf_(v0[q]); v1[q] = sigmoidf_(v1[q]); }
        } else { v0 = v0 * c.sc; v1 = v1 * c.sc; }
        *(u32x4*)(c.dst + (size_t)r * c.ld + widen16_col(col, (col >> 2) & 3)) = widen16(pk4(v0), pk4(v1));
    }
    struct CxDft { bf16_t* dst; const bf16_t* z1024; };
    __device__ __forceinline__ CxDft prep_dft(const Unit& u) const {
        CxDft c; int part, tokb; c.z1024 = nullptr;
        if (u.ex == 0) { part = u.pm >> 3; tokb = u.pn * SEQ + (u.pm & 7) * 256; if (part == 0) c.z1024 = (const bf16_t*)(W() + WS_FR) + (size_t)(u.pn * SEQ + 1024) * 256; }
        else { part = u.pm; tokb = NLAT + u.pn * CTXL; }
        c.dst = (bf16_t*)(W() + WS_Y) + (size_t)tokb * KOUT + 768 + part * 256; return c;
    }
    __device__ __forceinline__ void store_dft(const CxDft& c, int r, int col, f32x4 v0, f32x4 v1) const {
        if (c.z1024) { const float sg = (r & 1) ? -0.022097086912079608f : 0.022097086912079608f; const u32x2 z0 = *(const u32x2*)(c.z1024 + col), z1 = *(const u32x2*)(c.z1024 + col + 16);
            v0[0] += sg * bflo(z0.x); v0[1] += sg * bfhi(z0.x); v0[2] += sg * bflo(z0.y); v0[3] += sg * bfhi(z0.y);
            v1[0] += sg * bflo(z1.x); v1[1] += sg * bfhi(z1.x); v1[2] += sg * bflo(z1.y); v1[3] += sg * bfhi(z1.y); }
        *(u32x4*)(c.dst + (size_t)r * KOUT + widen16_col(col, (col >> 2) & 3)) = widen16(pk4(v0), pk4(v1));
    }
    struct CxOut { const float* src; bf16_t* xb; const float* gt; };
    __device__ __forceinline__ CxOut prep_out(const Unit& u) const {
        CxOut c; const int tok0 = u.pm * 256, col0 = u.pn * 256;
        c.src = (tok0 < NLAT ? arg_in(A, I_X) + (size_t)tok0 * D : arg_in(A, I_CTX) + (size_t)(tok0 - NLAT) * D) + col0;
        c.xb = (bf16_t*)(W() + WS_X) + (size_t)tok0 * D + col0;
        c.gt = (const float*)(W() + WS_MOD) + ((size_t)l * 9 + mod_row(tok0)) * 6144 + 2 * 1024 + col0;
        return c;
    }
    __device__ __forceinline__ void store_out_g(const CxOut& c, int r, int col, f32x4 v0, f32x4 v1, f32x4 g0, f32x4 g1) const {
        const size_t o = (size_t)r * D + col; f32x4 s0, s1;
        if (l == 0) { s0 = *(const f32x4*)(c.src + o); s1 = *(const f32x4*)(c.src + o + 16); }
        else { const u32x2 w0 = *(const u32x2*)(c.xb + o), w1 = *(const u32x2*)(c.xb + o + 16);
            s0 = (f32x4){bflo(w0.x), bfhi(w0.x), bflo(w0.y), bfhi(w0.y)}; s1 = (f32x4){bflo(w1.x), bfhi(w1.x), bflo(w1.y), bfhi(w1.y)}; }
        *(u32x4*)(c.xb + (size_t)r * D + widen16_col(col, (col >> 2) & 3)) = widen16(pk4(s0 + g0 * v0), pk4(s1 + g1 * v1));
    }
    __device__ __forceinline__ void store_out(const CxOut& c, int r, int col, f32x4 v0, f32x4 v1) const { store_out_g(c, r, col, v0, v1, *(const f32x4*)(c.gt + col), *(const f32x4*)(c.gt + col + 16)); }
    __device__ __forceinline__ bf16_t* prep_m1(const Unit& u) const { return (bf16_t*)(W() + WS_HID) + ((size_t)u.ex * RPE + u.pm * 256) * D + u.pn * 128; }
    __device__ __forceinline__ void store_m1(bf16_t* dst, int r, int col, f32x4 v0, f32x4 v1) const {
        f32x4 h;
#pragma unroll
        for (int q = 0; q < 4; ++q) h[q] = siluf_(v0[q]) * v1[q];
        *(u32x2*)(dst + (size_t)r * D + (col >> 5) * 16 + (col & 15)) = pk4(h);
    }
    struct CxM2 { bf16_t* dst; const float* g; };
    __device__ __forceinline__ CxM2 prep_m2(const Unit& u) const { CxM2 c; c.dst = (bf16_t*)(W() + WS_YS) + ((size_t)u.ex * RPE + u.pm * 256) * D + u.pn * 256; c.g = (const float*)(W() + WS_GATEV) + u.ex * RPE + u.pm * 256; return c; }
    __device__ __forceinline__ void store_m2(const CxM2& c, int r, int col, f32x4 v0, f32x4 v1, float g) const {
        *(u32x4*)(c.dst + (size_t)r * D + widen16_col(col, (col >> 2) & 3)) = widen16(pk4(v0 * g), pk4(v1 * g));
    }
#define EPI_WALK(PREP, STORE) do { const auto cx = PREP(u); _Pragma("unroll") for (int ai = 0; ai < 2; ++ai) _Pragma("unroll") for (int m = 0; m < 4; ++m) _Pragma("unroll") for (int bj = 0; bj < 2; ++bj) \
        STORE(cx, ai * 128 + wr * 64 + m * 16 + fr, bj * 128 + wc * 32 + 4 * fq, acc[ai][bj][m][0], acc[ai][bj][m][1]); } while (0)
    __device__ __forceinline__ void run(const f32x4 (&acc)[2][2][4][2], const Unit& u, int wr, int wc, int fr, int fq) const {
        switch (mode) {
        case GM_INPROJ: EPI_WALK(prep_in, store_in); break;
        case GM_DFT: EPI_WALK(prep_dft, store_dft); break;
        case GM_OUT: { const auto cx = prep_out(u);
            f32x4 gq[2][2];
#pragma unroll
            for (int bj = 0; bj < 2; ++bj) { const int col = bj * 128 + wc * 32 + 4 * fq; gq[bj][0] = *(const f32x4*)(cx.gt + col); gq[bj][1] = *(const f32x4*)(cx.gt + col + 16); }
#pragma unroll
            for (int ai = 0; ai < 2; ++ai)
#pragma unroll
                for (int m = 0; m < 4; ++m)
#pragma unroll
                    for (int bj = 0; bj < 2; ++bj) store_out_g(cx, ai * 128 + wr * 64 + m * 16 + fr, bj * 128 + wc * 32 + 4 * fq, acc[ai][bj][m][0], acc[ai][bj][m][1], gq[bj][0], gq[bj][1]); } break;
        case GM_MOE1: { bf16_t* dst = prep_m1(u);
#pragma unroll
            for (int ai = 0; ai < 2; ++ai)
#pragma unroll
                for (int m = 0; m < 4; ++m) {
                    f32x4 h0, h1;
#pragma unroll
                    for (int q = 0; q < 4; ++q) { h0[q] = siluf_(acc[ai][0][m][0][q]) * acc[ai][0][m][1][q]; h1[q] = siluf_(acc[ai][1][m][0][q]) * acc[ai][1][m][1][q]; }
                    const u32x4 w = widen16(pk4(h0), pk4(h1));
                    const int r = ai * 128 + wr * 64 + m * 16 + fr;
                    *(u32x4*)(dst + (size_t)r * D + 16 * (4 * (fq & 1) + wc) + 8 * (fq >> 1)) = w; } } break;
        default: { const auto cx = prep_m2(u); float gv[2][4];
#pragma unroll
            for (int ai = 0; ai < 2; ++ai)
#pragma unroll
                for (int m = 0; m < 4; ++m) gv[ai][m] = cx.g[ai * 128 + wr * 64 + m * 16 + fr];
#pragma unroll
            for (int ai = 0; ai < 2; ++ai)
#pragma unroll
                for (int m = 0; m < 4; ++m)
#pragma unroll
                    for (int bj = 0; bj < 2; ++bj) store_m2(cx, ai * 128 + wr * 64 + m * 16 + fr, bj * 128 + wc * 32 + 4 * fq, acc[ai][bj][m][0], acc[ai][bj][m][1], gv[ai][m]); } break;
        }
    }
    __device__ __forceinline__ void store1(const Unit& u, int r, int c, f32x4 v0, f32x4 v1) const {
        switch (mode) {
        case GM_INPROJ: store_in(prep_in(u), r, c, v0, v1); break;
        case GM_DFT: store_dft(prep_dft(u), r, c, v0, v1); break;
        case GM_OUT: store_out(prep_out(u), r, c, v0, v1); break;
        case GM_MOE1: store_m1(prep_m1(u), r, c, v0, v1); break;
        default: { const auto cx = prep_m2(u); store_m2(cx, r, c, v0, v1, cx.g[r]); } break;
        }
    }
};

__device__ __forceinline__ void scan_simt(Frame& F, int l) {
    if (F.bid >= 64) return;
    const int b = F.bid >> 3, h = (F.bid >> 1) & 3, dir = F.bid & 1;
    LAS float* qs = (LAS float*)F.lds; LAS float* ks = qs + 64 * 132; LAS float* vs = ks + 64 * 132; LAS float* st = vs + 64 * 132;
    LAS float* sm = st + 64 * 65;
    LAS float* as_ = sm; LAS float* Ms = sm + 64; LAS float* wint = sm + 128; LAS float* enm = sm + 192; LAS float* wst = sm + 256; LAS float* denom = sm + 320;
    LAS float* nvec = sm + 384; LAS float* ig = sm + 512; LAS float* lf = sm + 576; LAS int* toks = (LAS int*)(sm + 640); LAS float* scal = sm + 704;
    const bf16_t* Q = WSP(bf16_t, WS_Q); const bf16_t* K = WSP(bf16_t, WS_K); const bf16_t* V = WSP(bf16_t, WS_V); const float* GATES = WSP(float, WS_GATES);
    bf16_t* H = dir ? WSP(bf16_t, WS_HB) : WSP(bf16_t, WS_HF);
    float Creg[32];
#pragma unroll
    for (int i = 0; i < 32; ++i) Creg[i] = 0.f;
    float m_st = 0.f;
    if (F.tid < 128) nvec[F.tid] = 0.f;
    __syncthreads();
    for (int cc = 0; cc < 36; ++cc) {
        int tid = F.tid; asm volatile("" : "+v"(tid));
        const int lane = tid & 63, e = tid >> 2, dq = tid & 3;
        const bool isctx = cc < 4;
        const int c = isctx ? (dir ? 3 - cc : cc) : (dir ? 35 - cc : cc - 4);
        const bool want_out = !(isctx && l == 1);
        if (tid < 64) { const int j = tid;
            const int tok = isctx ? NLAT + b * CTXL + c * 64 + j : (h < 2 ? b * SEQ + c * 64 + j : b * SEQ + (j & 31) * 64 + 2 * c + (j >> 5));
            toks[j] = tok; const float* g = GATES + (size_t)tok * 16 + h * 4 + 2 * dir; ig[j] = g[0]; lf[j] = logsigmoidf_(g[1]); }
        __syncthreads();
        for (int it = tid; it < 1024; it += NTHR) { const int j = it >> 4, c8 = (it & 15) * 8; const size_t o = (size_t)toks[j] * 512 + h * 128 + c8;
            const u32x4 qv = *(const u32x4*)(Q + o), kv = *(const u32x4*)(K + o), vv = *(const u32x4*)(V + o);
#pragma unroll
            for (int q = 0; q < 4; ++q) { qs[j * 132 + c8 + 2 * q] = bflo(qv[q]); qs[j * 132 + c8 + 2 * q + 1] = bfhi(qv[q]); ks[j * 132 + c8 + 2 * q] = bflo(kv[q]); ks[j * 132 + c8 + 2 * q + 1] = bfhi(kv[q]);
                vs[j * 132 + c8 + 2 * q] = bflo(vv[q]); vs[j * 132 + c8 + 2 * q + 1] = bfhi(vv[q]); } }
        if (F.wave == 0) {
            const int p = dir ? 63 - lane : lane;
            float x = lf[p];
#pragma unroll
            for (int o = 1; o < 64; o <<= 1) { const float y = __shfl_up(x, o); if (lane >= o) x += y; }
            const float a = ig[p] - x; float cm = a;
#pragma unroll
            for (int o = 1; o < 64; o <<= 1) { const float y = __shfl_up(cm, o); if (lane >= o) cm = fmaxf(cm, y); }
            const float M = fmaxf(m_st, cm), Mend = __shfl(M, 63), blast = __shfl(x, 63);
            as_[p] = a; Ms[p] = M; wint[p] = expf(m_st - M); enm[p] = expf(-(x + M)); wst[p] = expf(a - Mend);
            if (lane == 0) { scal[0] = Mend; scal[1] = blast; }
        }
        __syncthreads();
        const float Mend = scal[0], blast = scal[1], decay = expf(m_st - Mend);
        if (want_out) {
            { const int t = tid >> 3, sg = tid & 7; float sacc[8];
#pragma unroll
                for (int i = 0; i < 8; ++i) sacc[i] = 0.f;
                for (int d4 = 0; d4 < 32; ++d4) { const f32x4 q4 = *(const LAS f32x4*)(qs + t * 132 + d4 * 4);
#pragma unroll
                    for (int i = 0; i < 8; ++i) { const f32x4 k4 = *(const LAS f32x4*)(ks + (i * 8 + sg) * 132 + d4 * 4); sacc[i] += (q4[0] * k4[0] + q4[1] * k4[1]) + (q4[2] * k4[2] + q4[3] * k4[3]); } }
#pragma unroll
                for (int i = 0; i < 8; ++i) { const int s = i * 8 + sg; const bool valid = dir ? (s >= t) : (s <= t); st[t * 65 + s] = valid ? sacc[i] * expf(as_[s] - Ms[t]) : 0.f; } }
            __syncthreads();
            if (tid < 64) { const int t = tid; float qn = 0.f, ssum = 0.f;
                for (int d = 0; d < 128; ++d) qn += qs[t * 132 + d] * nvec[d];
                for (int s = 0; s < 64; ++s) ssum += st[t * 65 + s];
                const float den = wint[t] * qn + ssum; denom[t] = fmaxf(fabsf(den), enm[t]); }
            float mine[16];
#pragma unroll
            for (int tt = 0; tt < 16; ++tt) {
                mine[tt] = 0.f;
#pragma unroll
                for (int u = 0; u < 4; ++u) { const int t = 4 * tt + u; float p = 0.f;
#pragma unroll
                    for (int i4 = 0; i4 < 8; ++i4) { const f32x4 q4 = *(const LAS f32x4*)(qs + t * 132 + dq * 32 + i4 * 4); p += (Creg[4 * i4] * q4[0] + Creg[4 * i4 + 1] * q4[1]) + (Creg[4 * i4 + 2] * q4[2] + Creg[4 * i4 + 3] * q4[3]); }
                    p += __shfl_xor(p, 1); p += __shfl_xor(p, 2);
                    mine[tt] = (u == dq) ? p : mine[tt]; asm volatile("" ::: "memory"); }
            }
#pragma unroll
            for (int tt = 0; tt < 16; ++tt) { const int t = 4 * tt + dq; float intra = 0.f;
#pragma unroll 8
                for (int s = 0; s < 64; ++s) intra += st[t * 65 + s] * vs[s * 132 + e];
                mine[tt] = wint[t] * mine[tt] + intra; asm volatile("" ::: "memory"); }
            __syncthreads();
#pragma unroll
            for (int tt = 0; tt < 16; ++tt) { const int t = 4 * tt + dq; H[(size_t)toks[t] * 512 + h * 128 + e] = (bf16_t)f2bf(mine[tt] / denom[t]); }
        }
#pragma unroll
        for (int i = 0; i < 32; ++i) Creg[i] *= decay;
#pragma unroll 2
        for (int s = 0; s < 64; ++s) { const float wv = wst[s] * vs[s * 132 + e];
#pragma unroll
            for (int i4 = 0; i4 < 8; ++i4) { const f32x4 k4 = *(const LAS f32x4*)(ks + s * 132 + dq * 32 + i4 * 4); Creg[4 * i4] += wv * k4[0]; Creg[4 * i4 + 1] += wv * k4[1]; Creg[4 * i4 + 2] += wv * k4[2]; Creg[4 * i4 + 3] += wv * k4[3]; } }
        float nn = 0.f;
        if (tid < 128) { nn = decay * nvec[tid]; for (int s = 0; s < 64; ++s) nn += wst[s] * ks[s * 132 + tid]; }
        __syncthreads();
        if (tid < 128) nvec[tid] = nn;
        m_st = blast + Mend;
        __syncthreads();
    }
}

__device__ __forceinline__ int scan_tok(bool isctx, int b, int h, int c, int j) {
    return isctx ? NLAT + b * CTXL + c * 64 + j : (h < 2 ? b * SEQ + c * 64 + j : b * SEQ + (j & 31) * 64 + 2 * c + (j >> 5));
}
__device__ __forceinline__ int img256(int row, int chunk) { return row * 256 + ((chunk ^ (row & 15)) << 4); }
__device__ __forceinline__ int img128(int row, int chunk) { return row * 128 + ((chunk ^ ((row >> 1) & 7)) << 4); }
__device__ __forceinline__ int off_b(int row, int ch) { return 256 * row + 16 * (ch ^ (((row & 3) << 2) | ((row >> 2) & 3))); }
__device__ __forceinline__ int rowrd16(int lane, int rb, int ks) { return off_b((lane & 15) + 16 * rb, 4 * ks + (lane >> 4)); }
__device__ __forceinline__ int trrd16(int lane, int c, int ks, int t) { const int g = lane >> 4, q = (lane & 15) >> 2, p = lane & 3;
    return off_b(32 * ks + 8 * g + 4 * t + q, 2 * c + (p >> 1)) + 8 * (p & 1); }
typedef short s16x4 __attribute__((ext_vector_type(4)));
__device__ __forceinline__ bf16x8 tr_frag(LAS unsigned char* img, int lane, int c, int ks, unsigned zv) {
    const s16x4 lo = __builtin_amdgcn_ds_read_tr16_b64_v4i16((LAS s16x4*)(img + trrd16(lane, c, ks, 0)));
    const s16x4 hi = __builtin_amdgcn_ds_read_tr16_b64_v4i16((LAS s16x4*)(img + trrd16(lane, c, ks, 1)));
    u32x2 a = __builtin_bit_cast(u32x2, lo), b = __builtin_bit_cast(u32x2, hi);
    a.x ^= zv; a.y ^= zv; b.x ^= zv; b.y ^= zv;
    const u32x4 r = (u32x4){a.x, a.y, b.x, b.y};
    return __builtin_bit_cast(bf16x8, r);
}
__device__ __forceinline__ void scan_mfma(Frame& F, int l) {
    if (F.bid >= 64) return;
    const int b = F.bid >> 3, h = (F.bid >> 1) & 3, dir = F.bid & 1;
    LAS unsigned char* L = F.lds;
    constexpr int O_QI = 0, O_KI = 16384, O_VI = 32768, O_ST = 49152, O_CL = 57344, O_HO = 94208, O_SM = 110592;
    LAS float* GV = (LAS float*)(L + O_SM);
    LAS float* SC = GV + 36 * 192;
    LAS float* DEN = SC + 36 * 4;
    const bf16_t* Q = WSP(bf16_t, WS_Q); const bf16_t* K = WSP(bf16_t, WS_K); const bf16_t* V = WSP(bf16_t, WS_V); const float* GATES = WSP(float, WS_GATES);
    bf16_t* H = dir ? WSP(bf16_t, WS_HB) : WSP(bf16_t, WS_HF);
    const int w = F.wave;
    { unsigned z0 = 0u; asm volatile("" : "+v"(z0));
      for (int i = F.tid; i < 36864 / 16; i += NTHR) *(LAS u32x4*)(L + O_CL + i * 16) = (u32x4){z0, z0, z0, z0}; }
    u32x4 pq[2], pk[2], pv[2];
#define SC_LOAD(CC) do { const int cc_ = (CC); const bool ic_ = cc_ < 4; const int c_ = ic_ ? (dir ? 3 - cc_ : cc_) : (dir ? 35 - cc_ : cc_ - 4); \
        _Pragma("unroll") for (int i_ = 0; i_ < 2; ++i_) { const int it_ = tid + NTHR * i_, s_ = it_ >> 4, c8_ = it_ & 15; const size_t o_ = (size_t)scan_tok(ic_, b, h, c_, s_) * 512 + h * 128 + c8_ * 8; \
            pq[i_] = *(const u32x4*)(Q + o_); pk[i_] = *(const u32x4*)(K + o_); pv[i_] = *(const u32x4*)(V + o_); } } while (0)
    { const int tid = F.tid; SC_LOAD(0); }
#define SC_GLOAD(CCX) ({ const int ccx_ = min((CCX), 35); const bool ic_ = ccx_ < 4; const int cx_ = ic_ ? (dir ? 3 - ccx_ : ccx_) : (dir ? 35 - ccx_ : ccx_ - 4); \
        *(const f32x2*)(GATES + (size_t)scan_tok(ic_, b, h, cx_, dir ? 63 - F.lane : F.lane) * 16 + h * 4 + 2 * dir); })
    f32x2 gnext = SC_GLOAD(w);
    for (int cc = w; cc < 36; cc += NWAVES) {
        const int p_ = dir ? 63 - F.lane : F.lane;
        const f32x2 g = gnext;
        gnext = SC_GLOAD(cc + NWAVES);
#define SC_DPP(OLD, V, CTRL, RM) __builtin_bit_cast(float, __builtin_amdgcn_update_dpp(__builtin_bit_cast(int, (float)(OLD)), __builtin_bit_cast(int, (float)(V)), CTRL, RM, 0xF, false))
        float x = logsigmoidf_(g[1]);
        x += SC_DPP(0.f, x, 0x111, 0xF); x += SC_DPP(0.f, x, 0x112, 0xF); x += SC_DPP(0.f, x, 0x114, 0xF); x += SC_DPP(0.f, x, 0x118, 0xF);
        x += SC_DPP(0.f, x, 0x142, 0xA); x += SC_DPP(0.f, x, 0x143, 0xC);
        const float a = g[0] - x; float cm = a;
        const float ninf = -3.0e38f;
        cm = fmaxf(cm, SC_DPP(ninf, cm, 0x111, 0xF)); cm = fmaxf(cm, SC_DPP(ninf, cm, 0x112, 0xF)); cm = fmaxf(cm, SC_DPP(ninf, cm, 0x114, 0xF)); cm = fmaxf(cm, SC_DPP(ninf, cm, 0x118, 0xF));
        cm = fmaxf(cm, SC_DPP(ninf, cm, 0x142, 0xA)); cm = fmaxf(cm, SC_DPP(ninf, cm, 0x143, 0xC));
#undef SC_DPP
        GV[cc * 192 + p_] = a; GV[cc * 192 + 64 + p_] = x; GV[cc * 192 + 128 + p_] = cm;
        if (F.lane == 63) { SC[cc * 4 + 3] = x; SC[cc * 4 + 1] = cm; }
    }
    __syncthreads();
    if (F.tid == 0) { float m = 0.f;
        for (int cc = 0; cc < 36; ++cc) { const float Mend = fmaxf(m, SC[cc * 4 + 1]); SC[cc * 4 + 0] = m; SC[cc * 4 + 1] = Mend; SC[cc * 4 + 2] = expf(m - Mend); m = SC[cc * 4 + 3] + Mend; } }
    f32x4 accC[9];
#pragma unroll
    for (int i = 0; i < 9; ++i) accC[i] = (f32x4){0.f, 0.f, 0.f, 0.f};
#define SC_WRITE() do { _Pragma("unroll") for (int i_ = 0; i_ < 2; ++i_) { const int it_ = tid + NTHR * i_, s_ = it_ >> 4, c8_ = it_ & 15; \
            *(LAS u32x4*)(L + O_QI + img256(s_, c8_)) = pq[i_]; *(LAS u32x4*)(L + O_KI + off_b(s_, c8_)) = pk[i_]; *(LAS u32x4*)(L + O_VI + off_b(s_, c8_)) = pv[i_]; } } while (0)
#define SC_MFMA(A, B, C) __builtin_amdgcn_mfma_f32_16x16x32_bf16((A), (B), (C), 0, 0, 0)
#define SC_BAR() do { asm volatile("s_waitcnt lgkmcnt(0)" ::: "memory"); __builtin_amdgcn_s_barrier(); asm volatile("" ::: "memory"); } while (0)
    {
        const int tid = F.tid;
        __syncthreads();
        SC_WRITE();
        __syncthreads();
    }
    for (int cc = 0; cc < 36; ++cc) {
        int tid = F.tid; asm volatile("" : "+v"(tid));
        const int lane = tid & 63, fr = lane & 15, fq = lane >> 4;
        const bool isctx = cc < 4, want_out = !(isctx && l == 1), more = cc + 1 < 36;
        const int c = isctx ? (dir ? 3 - cc : cc) : (dir ? 35 - cc : cc - 4);
        const LAS float* vb = GV + cc * 192; const float m_in = SC[cc * 4 + 0];
        unsigned zv = 0u; asm volatile("" : "+v"(zv));
        const short one_ = (fr == 0) ? (short)0x3F80 : (short)0;
        const bf16x8 ONES = (bf16x8){one_, one_, one_, one_, one_, one_, one_, one_};
        if (more) SC_LOAD(cc + 1);
        if (want_out) {
            const int tb = w >> 1, sb = 2 * (w & 1);
            f32x4 s0 = (f32x4){0.f, 0.f, 0.f, 0.f}, s1 = s0;
#pragma unroll
            for (int ks = 0; ks < 4; ++ks) {
                const bf16x8 fy = *(const LAS bf16x8*)(L + O_QI + img256(tb * 16 + fr, ks * 4 + fq));
                const bf16x8 fx0 = *(const LAS bf16x8*)(L + O_KI + rowrd16(lane, sb, ks)), fx1 = *(const LAS bf16x8*)(L + O_KI + rowrd16(lane, sb + 1, ks));
                s0 = SC_MFMA(fx0, fy, s0); s1 = SC_MFMA(fx1, fy, s1); }
            const int t = tb * 16 + fr; const float Mt = fmaxf(m_in, vb[128 + t]);
#pragma unroll
            for (int i = 0; i < 2; ++i) { const int sr0 = (sb + i) * 16 + 4 * fq; const f32x4 a4 = *(const LAS f32x4*)(vb + sr0); const f32x4 sv = i ? s1 : s0; f32x4 o;
#pragma unroll
                for (int r = 0; r < 4; ++r) { const int sI = sr0 + r; const bool valid = dir ? (sI >= t) : (sI <= t); o[r] = valid ? sv[r] * __expf(a4[r] - Mt) : 0.f; }
                *(LAS u32x2*)(L + O_ST + img128(t, sr0 >> 3) + (sr0 & 7) * 2) = pk4(o); }
        }
        SC_BAR();
        {
            const float decay = SC[cc * 4 + 2], Mend = SC[cc * 4 + 1];
#pragma unroll
            for (int et = 0; et < 9; ++et) accC[et] = accC[et] * decay;
#pragma unroll
            for (int ks = 0; ks < 2; ++ks) {
                const bf16x8 kx = tr_frag(L + O_KI, lane, w, ks, zv);
                const f32x4 a0 = *(const LAS f32x4*)(vb + 32 * ks + 8 * fq), a1 = *(const LAS f32x4*)(vb + 32 * ks + 8 * fq + 4);
                u32x4 ax;
#pragma unroll
                for (int j = 0; j < 4; ++j) { const float w0 = __expf((j < 2 ? a0[2 * j] : a1[2 * j - 4]) - Mend), w1 = __expf((j < 2 ? a0[2 * j + 1] : a1[2 * j - 3]) - Mend);
                    ax[j] = pk2(bf2f((unsigned short)kx[2 * j]) * w0, bf2f((unsigned short)kx[2 * j + 1]) * w1); }
                const bf16x8 axf = __builtin_bit_cast(bf16x8, ax);
#pragma unroll
                for (int et = 0; et < 8; ++et) { const bf16x8 fv = tr_frag(L + O_VI, lane, et, ks, zv); accC[et] = SC_MFMA(axf, fv, accC[et]); }
                accC[8] = SC_MFMA(axf, ONES, accC[8]);
            }
        }
        f32x4 num[4];
        if (want_out) {
            bf16x8 ac[4], av[2];
#pragma unroll
            for (int ks = 0; ks < 4; ++ks) ac[ks] = *(const LAS bf16x8*)(L + O_CL + img256(w * 16 + fr, ks * 4 + fq));
#pragma unroll
            for (int ks = 0; ks < 2; ++ks) av[ks] = tr_frag(L + O_VI, lane, w, ks, zv);
#pragma unroll
            for (int tb = 0; tb < 4; ++tb) {
                f32x4 nI = (f32x4){0.f, 0.f, 0.f, 0.f}, nS = nI;
#pragma unroll
                for (int ks = 0; ks < 4; ++ks) { const bf16x8 fy = *(const LAS bf16x8*)(L + O_QI + img256(tb * 16 + fr, ks * 4 + fq)); nI = SC_MFMA(ac[ks], fy, nI); }
#pragma unroll
                for (int ks = 0; ks < 2; ++ks) { const bf16x8 fs = *(const LAS bf16x8*)(L + O_ST + img128(tb * 16 + fr, ks * 4 + fq)); nS = SC_MFMA(av[ks], fs, nS); }
                num[tb] = nI * __expf(m_in - fmaxf(m_in, vb[128 + tb * 16 + fr])) + nS;
            }
            if (w < 4) {
                f32x4 dI = (f32x4){0.f, 0.f, 0.f, 0.f}, dS = dI;
#pragma unroll
                for (int ks = 0; ks < 4; ++ks) { const bf16x8 a8 = *(const LAS bf16x8*)(L + O_CL + img256(128 + fr, ks * 4 + fq)); const bf16x8 fy = *(const LAS bf16x8*)(L + O_QI + img256(w * 16 + fr, ks * 4 + fq)); dI = SC_MFMA(a8, fy, dI); }
#pragma unroll
                for (int ks = 0; ks < 2; ++ks) { const bf16x8 fs = *(const LAS bf16x8*)(L + O_ST + img128(w * 16 + fr, ks * 4 + fq)); dS = SC_MFMA(ONES, fs, dS); }
                const int t = w * 16 + fr; const float Mt = fmaxf(m_in, vb[128 + t]); const float den = __expf(m_in - Mt) * dI[0] + dS[0];
                if (lane < 16) DEN[t] = fmaxf(fabsf(den), __expf(-(vb[64 + t] + Mt)));
            }
        }
        SC_BAR();
        if (want_out) {
#pragma unroll
            for (int tb = 0; tb < 4; ++tb) { const int t = tb * 16 + fr, e0 = w * 16 + 4 * fq; const float rd = 1.0f / DEN[t];
                *(LAS u32x2*)(L + O_HO + img256(t, e0 >> 3) + (e0 & 7) * 2) = pk4(num[tb] * rd); }
        }
#pragma unroll
        for (int et = 0; et < 9; ++et) { const int d0 = w * 16 + 4 * fq; *(LAS u32x2*)(L + O_CL + img256(et * 16 + fr, d0 >> 3) + (d0 & 7) * 2) = pk4(accC[et]); }
        if (more) SC_WRITE();
        SC_BAR();
        if (want_out) {
            const int t = tid >> 3; bf16_t* hp = H + (size_t)scan_tok(isctx, b, h, c, t) * 512 + h * 128;
#pragma unroll
            for (int i = 0; i < 2; ++i) { const int ch = (tid & 7) * 2 + i; *(u32x4*)(hp + ch * 8) = *(const LAS u32x4*)(L + O_HO + img256(t, ch)); }
        }
    }
#undef SC_LOAD
#undef SC_GLOAD
#undef SC_WRITE
#undef SC_MFMA
#undef SC_BAR
}

__device__ __forceinline__ void helper_barrier(Frame& F, unsigned* cnt, unsigned* hsub, unsigned nhelpers) {
    asm volatile("s_waitcnt vmcnt(0)" ::: "memory");
    __syncthreads();
    if (F.tid == 0) {
        unsigned* bar = (unsigned*)(F.ws + WS_CTL);
        asm volatile("buffer_inv sc1" ::: "memory");
        const unsigned x = xb_xcc_id(), nh = xb_ld(&bar[XB_HXCNT(x)]);
        unsigned add = 1u; bool rel = true;
        if (nh) { const unsigned old = xb_add(&hsub[16 * x], 1u); rel = (old + 1u == nh); add = nh; }
        if (rel) {
            __builtin_amdgcn_fence(__ATOMIC_RELEASE, "agent");
            asm volatile("s_waitcnt vmcnt(0)" ::: "memory");
            (void)xb_add(cnt, add);
        }
        unsigned sp = 0;
        while (__hip_atomic_load(cnt, __ATOMIC_RELAXED, __HIP_MEMORY_SCOPE_AGENT) < nhelpers) { __builtin_amdgcn_s_sleep(2); if (++sp > (1u << 22)) break; }
        asm volatile("s_waitcnt vmcnt(0)" ::: "memory");
    }
    __syncthreads();
}

constexpr int NPHASES = 20;
enum { K_PREP = 0, K_NORM1, K_INPROJ, K_MIX1, K_MIX2, K_OUTPROJ, K_NORM2, K_TOPK, K_MOE1, K_MOE2, K_COMBINE };

__global__ void __launch_bounds__(NTHR, 2) fwd_kernel(Args args) {
    extern __shared__ __attribute__((aligned(16))) unsigned char lds_raw[];
    Frame F{(LAS unsigned char*)lds_raw, (int)threadIdx.x, (int)(threadIdx.x & 63), __builtin_amdgcn_readfirstlane((int)(threadIdx.x >> 6)), (int)gridDim.x, (int)blockIdx.x, (GAS unsigned char*)args.ws, args};
    volatile LAS unsigned* MISC = (volatile LAS unsigned*)(F.lds + LDSCTL_OFF);
    if (F.tid < 16) MISC[F.tid] = 0u;
    __syncthreads();
    XcdBarrier bar; bar.bar = (unsigned*)(F.ws + WS_CTL); bar.x = 0; bar.st = MISC;
    const int lo = args.ph_lo, hi = args.ph_hi;
    if (hi - lo > 1) { bar = xcd_barrier_post((unsigned*)(F.ws + WS_CTL), MISC); if (F.tid == 0 && F.bid >= 64) (void)xb_add((unsigned*)(F.ws + WS_CTL) + XB_HXCNT(bar.x), 1u); }
    for (int ph = lo; ph < hi; ++ph) {
        int l, kind;
        if (ph == 0) { l = 0; kind = K_PREP; } else if (ph == 1) { l = 0; kind = K_NORM1; } else if (ph < 11) { l = 0; kind = K_INPROJ + (ph - 2); } else { l = 1; kind = K_INPROJ + (ph - 11); }
#ifndef PHMASK
#define PHMASK 0xFFFF
#endif
#define PHON(k) ((PHMASK >> (k)) & 1)
#ifndef REPMASK
#define REPMASK 0
#endif
        int nrep_ = 1 + ((REPMASK >> kind) & 1); asm volatile("" : "+s"(nrep_));
        for (int rep_ = 0; rep_ < nrep_; ++rep_) {
        if (rep_) xcd_barrier(bar);
        { int t_ = threadIdx.x, b_ = blockIdx.x; GAS unsigned char* w_ = (GAS unsigned char*)args.ws; asm volatile("" : "+v"(t_)); asm volatile("" : "+s"(b_)); asm volatile("" : "+s"(w_));
          F.tid = t_; F.lane = t_ & 63; F.wave = __builtin_amdgcn_readfirstlane(t_ >> 6); F.bid = b_; F.ws = w_; }
        l = __builtin_amdgcn_readfirstlane(l); kind = __builtin_amdgcn_readfirstlane(kind); asm volatile("" : "+s"(l)); asm volatile("" : "+s"(kind));
        GAS unsigned char* ws = F.ws;
        bool run_gemm = (kind == K_INPROJ || kind == K_OUTPROJ || kind == K_MOE1 || kind == K_MOE2);
        int gm = kind == K_INPROJ ? GM_INPROJ : kind == K_OUTPROJ ? GM_OUT : kind == K_MOE1 ? GM_MOE1 : GM_MOE2, gc = F.bid, gG = F.G;
        const bool helper = (kind == K_MIX1) && (F.bid >= 64);
        switch (kind) {
        case K_PREP: if (PHON(0)) phase_prep(F); break;
        case K_NORM1: if (PHON(1)) phase_norm1_l0(F); break;
        case K_MIX1: if (PHON(3)) {
            if (!helper) scan_mfma(F, l);
            else { const int hb = F.bid - 64, hg = F.G - 64;
                if (l == 0 && F.G == 256) gen_dft_matrices(F, hb, hg);
                conv_items(F, l, hb, hg);
                ztrans_items(F, l, hb * NWAVES + F.wave, hg * NWAVES);
                helper_barrier(F, (unsigned*)(ws + WS_CTL) + 8192 + 64 * l + 64 * 2 * rep_, (unsigned*)(ws + WS_CTL) + XB_HSUB + 256 * l + 512 * rep_, (unsigned)hg);
                run_gemm = true; gm = GM_DFT; gc = hb; gG = hg; }
        } break;
        case K_MIX2: if (PHON(4)) finalize_h(F, l); break;
        case K_NORM2: if (PHON(6)) phase_norm2(F, l); break;
        case K_TOPK: if (PHON(7)) phase_topk(F, l); break;
        case K_COMBINE: if (PHON(10)) phase_combine(F, l); break;
        default: break;
        }
        if (run_gemm && PHON(2)) {
            GemmCtl S{gm, l, gG, gc, ws, F.A};
            const int ld = gm == GM_OUT ? KOUT : D;
            GEMM_PHASE(F.lds, ld, ld, S, S);
        }
        if (helper && PHON(3)) convert_moe_weights(F, l, (F.bid - 64) * NWAVES + F.wave, (F.G - 64) * NWAVES);
        if (kind == K_MOE1 && l == 0 && F.G == 256 && F.bid >= 128 && F.bid < 224 && PHON(0)) mod_item(F, 1, F.bid - 128, -1);
        }
        if (ph + 1 < hi && !(ph == 0 && F.G == 256)) xcd_barrier(bar);
    }
}

extern "C" void kernel_launch(void* const* d_in, const int* in_sizes, int n_in, void* d_out, int out_size, void* d_ws, size_t ws_size, hipStream_t stream) {
    static int grid = 0;
    if (grid == 0) {
        if (n_in != 21 || out_size != NLAT * D || ws_size < WS_END) { fprintf(stderr, "kernel_launch: unexpected shapes (n_in %d out %d ws %zu need %zu)\n", n_in, out_size, ws_size, (size_t)WS_END); grid = -1; return; }
        int dev = 0, cus = 0, per_cu = 0;
        hipGetDevice(&dev); hipDeviceGetAttribute(&cus, hipDeviceAttributeMultiprocessorCount, dev);
        if (hipFuncSetAttribute((const void*)fwd_kernel, hipFuncAttributeMaxDynamicSharedMemorySize, LDS_BYTES) != hipSuccess) { fprintf(stderr, "kernel_launch: hipFuncSetAttribute failed\n"); grid = -1; return; }
        hipOccupancyMaxActiveBlocksPerMultiprocessor(&per_cu, (const void*)fwd_kernel, NTHR, LDS_BYTES);
        (void)hipGetLastError();
        if (per_cu < 1) fprintf(stderr, "kernel_launch: occupancy query reports %d\n", per_cu);
        grid = cus;
    }
    if (grid < 0) return;
    hipMemsetAsync((char*)d_ws + WS_CTL, 0, 65536 + (size_t)2 * 9 * 6144 * 4, stream);
    Args a{};
    for (int i = 0; i < 21; ++i) a.in[i] = (const float*)d_in[i];
    a.out = (float*)d_out; a.ws = (unsigned char*)d_ws;
#if N_LAUNCHES == 1
    a.ph_lo = 0; a.ph_hi = NPHASES;
    void* kargs[] = {&a};
    hipError_t e = hipLaunchCooperativeKernel((const void*)fwd_kernel, dim3(grid), dim3(NTHR), kargs, LDS_BYTES, stream);
    if (e != hipSuccess) fprintf(stderr, "kernel_launch: cooperative launch failed: %s (grid %d)\n", hipGetErrorString(e), grid);
#else
#ifndef MAXPH
#define MAXPH NPHASES
#endif
    for (int ph = 0; ph < MAXPH; ++ph) { a.ph_lo = ph; a.ph_hi = ph + 1; hipLaunchKernelGGL(fwd_kernel, dim3(grid), dim3(NTHR), LDS_BYTES, stream, a); }
#endif
}
```
